# Optimizing an MI355X kernel written in HIP

```python
import math
import jax, jax.numpy as jnp
from jax import lax
import numpy as np

D_MODEL = 1024
BATCH = 8
SEQ = 2048
DEPTH = 4

GRID_W = 64
CTX_LEN = 256
HEAD_DIM = 64
ROPE_THETA = 10000.0
Q_BLOCK = 128
WINDOW = 128
A_HEADS = 4
B_HEADS = 8
B_KV = 2
C_HEADS = 8
C_KV = 2
F_GROUPS = 8
F_GROUP_DIM = 64
BRANCH_W = 512
N_BRANCH = 4
D_FF = 2816
N_EXPERTS = 8
TOP_K = 2
D_FF_EXPERT = 3584
EPS = 1e-6
SUBLN_EPS = 1e-5
NEG_INF = -1e30
IN_WIDTHS = (
    A_HEADS * 2 * HEAD_DIM, A_HEADS * 2 * HEAD_DIM, A_HEADS * 2 * HEAD_DIM,
    B_HEADS * HEAD_DIM, B_KV * HEAD_DIM, B_KV * HEAD_DIM,
    C_HEADS * HEAD_DIM, C_KV * HEAD_DIM, C_KV * HEAD_DIM,
    F_GROUPS * F_GROUP_DIM,
    N_BRANCH * D_MODEL,
)
D_IN = sum(IN_WIDTHS)

kernel_name = "hybrid_diffusion_parallel_mixer_block"


def rmsnorm(x, g, eps=EPS):
    xf = x.astype(jnp.float32)
    y = xf * lax.rsqrt(jnp.mean(xf * xf, axis=-1, keepdims=True) + eps)
    return (y * g.astype(jnp.float32)).astype(x.dtype)


def adaln(x, g, shift, scale):
    return rmsnorm(x, g) * (1 + scale) + shift


def flat(o):
    return o.reshape(o.shape[0], o.shape[1], -1)


def axial_rope_tables(rows, dtype):
    pos_row = jnp.repeat(jnp.arange(rows, dtype=jnp.int32), GRID_W).astype(jnp.float32)
    pos_col = jnp.tile(jnp.arange(GRID_W, dtype=jnp.int32), rows).astype(jnp.float32)
    quarter = HEAD_DIM // 4
    inv_freq = ROPE_THETA ** (-jnp.arange(quarter, dtype=jnp.float32) / quarter)
    ang_r = pos_row[:, None] * inv_freq
    ang_c = pos_col[:, None] * inv_freq
    ang = jnp.concatenate([ang_r, ang_r, ang_c, ang_c], axis=-1)
    return jnp.cos(ang).astype(dtype), jnp.sin(ang).astype(dtype)


def apply_rope(x, cos, sin):
    shape = (cos.shape[0],) + (1,) * (x.ndim - 3) + (HEAD_DIM,)
    cos = cos.reshape(shape)
    sin = sin.reshape(shape)
    xa = x.reshape(x.shape[:-1] + (2, 2, HEAD_DIM // 4))
    rot = jnp.stack([-xa[..., 1, :], xa[..., 0, :]], axis=-2).reshape(x.shape)
    return x * cos + rot * sin


def sweep_query_blocks(fn, q):
    B, S = q.shape[:2]
    nb = S // Q_BLOCK
    qb = jnp.moveaxis(q.reshape((B, nb, Q_BLOCK) + q.shape[2:]), 1, 0)
    ob = lax.map(lambda a: fn(a[0], a[1]), (qb, jnp.arange(nb, dtype=jnp.int32)))
    return jnp.moveaxis(ob, 0, 1).reshape((B, S) + ob.shape[3:])


def split_projection(p):
    B, N = p.shape[:2]
    points = [int(v) for v in np.cumsum(IN_WIDTHS)[:-1]]
    aq, ak, av, bq, bk, bv, cq, ck, cv, fz, gt = jnp.split(p, points, axis=-1)
    return dict(
        aq=aq.reshape(B, N, A_HEADS, 2, HEAD_DIM),
        ak=ak.reshape(B, N, A_HEADS, 2, HEAD_DIM),
        av=av.reshape(B, N, A_HEADS, 2 * HEAD_DIM),
        bq=bq.reshape(B, N, B_KV, B_HEADS // B_KV, HEAD_DIM),
        bk=bk.reshape(B, N, B_KV, HEAD_DIM),
        bv=bv.reshape(B, N, B_KV, HEAD_DIM),
        cq=cq.reshape(B, N, C_KV, C_HEADS // C_KV, HEAD_DIM),
        ck=ck.reshape(B, N, C_KV, HEAD_DIM),
        cv=cv.reshape(B, N, C_KV, HEAD_DIM),
        fz=fz,
        gates=gt.reshape(B, N, N_BRANCH, D_MODEL),
    )


def diff_attention(q, k, v, lam):
    s = jnp.einsum("bqhmd,bkhmd->bhmqk", q, k).astype(jnp.float32) * HEAD_DIM ** -0.5
    p = jax.nn.softmax(s, axis=-1)
    a = (p[:, :, 0] - lam * p[:, :, 1]).astype(v.dtype)
    return jnp.einsum("bhqk,bkhe->bqhe", a, v)


def diff_head_norm(o, g, lam_init):
    return flat(rmsnorm(o, g, SUBLN_EPS) * (1.0 - lam_init))


def gqa_attention(q, k, v):
    s = jnp.einsum("bqhgd,bkhd->bhgqk", q, k).astype(jnp.float32) * HEAD_DIM ** -0.5
    p = jax.nn.softmax(s, axis=-1).astype(v.dtype)
    return jnp.einsum("bhgqk,bkhd->bqhgd", p, v)


def softmax_with_sink(s, sink):
    sk = jnp.broadcast_to(sink.astype(jnp.float32)[None, :, :, None, None], s.shape[:-1] + (1,))
    p = jax.nn.softmax(jnp.concatenate([s, sk], axis=-1), axis=-1)
    return p[..., :-1]


def sink_attention(q, k, v, sink):
    s = jnp.einsum("bqhgd,bkhd->bhgqk", q, k).astype(jnp.float32) * HEAD_DIM ** -0.5
    p = softmax_with_sink(s, sink).astype(v.dtype)
    return jnp.einsum("bhgqk,bkhd->bqhgd", p, v)


def window_block(q, b, k_pad, v_pad, k_ctx, v_ctx, sink, n_tokens):
    span = Q_BLOCK + 2 * WINDOW
    kb = lax.dynamic_slice_in_dim(k_pad, b * Q_BLOCK, span, axis=1)
    vb = lax.dynamic_slice_in_dim(v_pad, b * Q_BLOCK, span, axis=1)
    scale = HEAD_DIM ** -0.5
    s_band = jnp.einsum("bqhgd,bkhd->bhgqk", q, kb).astype(jnp.float32) * scale
    r = jnp.arange(Q_BLOCK, dtype=jnp.int32)[:, None]
    u = jnp.arange(span, dtype=jnp.int32)[None, :]
    j = b * Q_BLOCK - WINDOW + u
    valid = (u >= r) & (u - r <= 2 * WINDOW) & (j >= 0) & (j < n_tokens)
    s_band = jnp.where(valid, s_band, NEG_INF)
    s_ctx = jnp.einsum("bqhgd,bkhd->bhgqk", q, k_ctx).astype(jnp.float32) * scale
    p = softmax_with_sink(jnp.concatenate([s_band, s_ctx], axis=-1), sink).astype(v_pad.dtype)
    return (jnp.einsum("bhgqk,bkhd->bqhgd", p[..., :span], vb)
            + jnp.einsum("bhgqk,bkhd->bqhgd", p[..., span:], v_ctx))


def fourier_mix(z):
    B, N = z.shape[:2]
    zg = z.reshape(B, N, F_GROUPS, F_GROUP_DIM).astype(jnp.float32)
    y = jnp.fft.fft2(zg, axes=(1, 3), norm="ortho").real
    return y.reshape(B, N, F_GROUPS * F_GROUP_DIM).astype(z.dtype)


def merge_branches(branches, gates, w_br, w_o):
    o = jnp.stack(branches, axis=2)
    y = jnp.einsum("bnrc,rcd->bnrd", o, w_br)
    merged = jnp.sum(jax.nn.sigmoid(gates) * y, axis=2)
    return jnp.einsum("bnd,de->bne", merged, w_o)


def swiglu(h, wg, wu, wd):
    return (jax.nn.silu(h @ wg) * (h @ wu)) @ wd


def moe_swiglu(h, w_r, wg, wu, wd):
    logits = jnp.einsum("bnd,de->bne", h, w_r).astype(jnp.float32)
    top_v, top_i = lax.top_k(logits, TOP_K)
    top_w = jax.nn.softmax(top_v, axis=-1)
    gates = jnp.sum(jax.nn.one_hot(top_i, N_EXPERTS, dtype=jnp.float32) * top_w[..., None], axis=-2)
    gates = gates.astype(h.dtype)
    y = jnp.zeros_like(h)
    for e in range(N_EXPERTS):
        y = y + gates[..., e:e + 1] * swiglu(h, wg[e], wu[e], wd[e])
    return y


def setup_inputs(seed: int = 0) -> dict:
    key = jax.random.key(seed)
    ks = jax.random.split(key, 24)
    n_dense = (DEPTH + 1) // 2
    n_moe = DEPTH // 2
    f32 = jnp.float32

    def nrm(k, shape, scale):
        return jax.random.normal(k, shape, f32) * scale

    return {
        "x": nrm(ks[0], (BATCH, SEQ, D_MODEL), 1.0),
        "c": nrm(ks[1], (BATCH, D_MODEL), 1.0),
        "ctx": nrm(ks[2], (BATCH, CTX_LEN, D_MODEL), 1.0),
        "c_ctx": nrm(ks[3], (D_MODEL,), 1.0),
        "w_mod": nrm(ks[4], (DEPTH, D_MODEL, 6 * D_MODEL), 0.5 * D_MODEL ** -0.5),
        "b_mod": nrm(ks[5], (DEPTH, 6 * D_MODEL), 0.02),
        "norm1_g": 1.0 + nrm(ks[6], (DEPTH, D_MODEL), 0.05),
        "norm2_g": 1.0 + nrm(ks[7], (DEPTH, D_MODEL), 0.05),
        "w_in": nrm(ks[8], (DEPTH, D_MODEL, D_IN), D_MODEL ** -0.5),
        "diff_lambda": nrm(ks[9], (DEPTH, 4, HEAD_DIM), 0.1),
        "diff_subln_g": 1.0 + nrm(ks[10], (DEPTH, 2 * HEAD_DIM), 0.05),
        "qk_norm_g": 1.0 + nrm(ks[11], (DEPTH, 2, HEAD_DIM), 0.05),
        "sink_logits": nrm(ks[12], (DEPTH, C_HEADS), 0.5),
        "w_branch": nrm(ks[13], (DEPTH, N_BRANCH, BRANCH_W, D_MODEL), BRANCH_W ** -0.5),
        "w_out": nrm(ks[14], (DEPTH, D_MODEL, D_MODEL), D_MODEL ** -0.5),
        "ffn_w_gate": nrm(ks[15], (n_dense, D_MODEL, D_FF), D_MODEL ** -0.5),
        "ffn_w_up": nrm(ks[16], (n_dense, D_MODEL, D_FF), D_MODEL ** -0.5),
        "ffn_w_down": nrm(ks[17], (n_dense, D_FF, D_MODEL), D_FF ** -0.5),
        "router_w": nrm(ks[18], (n_moe, D_MODEL, N_EXPERTS), D_MODEL ** -0.5),
        "moe_w_gate": nrm(ks[19], (n_moe, N_EXPERTS, D_MODEL, D_FF_EXPERT), D_MODEL ** -0.5),
        "moe_w_up": nrm(ks[20], (n_moe, N_EXPERTS, D_MODEL, D_FF_EXPERT), D_MODEL ** -0.5),
        "moe_w_down": nrm(ks[21], (n_moe, N_EXPERTS, D_FF_EXPERT, D_MODEL), D_FF_EXPERT ** -0.5),
        "final_g": 1.0 + nrm(ks[22], (D_MODEL,), 0.05),
    }


def reference(x, c, ctx, c_ctx, w_mod, b_mod, norm1_g, norm2_g, w_in, diff_lambda, diff_subln_g,
              qk_norm_g, sink_logits, w_branch, w_out, ffn_w_gate, ffn_w_up, ffn_w_down,
              router_w, moe_w_gate, moe_w_up, moe_w_down, final_g):
    B, S, _ = x.shape
    rows = S // GRID_W
    cos, sin = axial_rope_tables(rows, x.dtype)
    silu_c = jax.nn.silu(c)
    silu_cc = jax.nn.silu(c_ctx)
    h_ctx = ctx
    band_pad = ((0, 0), (WINDOW, WINDOW), (0, 0), (0, 0))
    for l in range(DEPTH):
        last = l == DEPTH - 1
        mx = (silu_c @ w_mod[l] + b_mod[l])[:, None, :]
        mc = silu_cc @ w_mod[l] + b_mod[l]
        sh1, sc1, g1, sh2, sc2, g2 = jnp.split(mx, 6, axis=-1)
        csh1, csc1, cg1, csh2, csc2, cg2 = jnp.split(mc, 6, axis=-1)

        px = split_projection(adaln(x, norm1_g[l], sh1, sc1) @ w_in[l])
        pc = split_projection(adaln(h_ctx, norm1_g[l], csh1, csc1) @ w_in[l])

        lam_init = 0.8 - 0.6 * math.exp(-0.3 * l)
        lp = diff_lambda[l].astype(jnp.float32)
        lam = jnp.exp(jnp.sum(lp[0] * lp[1])) - jnp.exp(jnp.sum(lp[2] * lp[3])) + lam_init
        ka = jnp.concatenate([apply_rope(px["ak"], cos, sin), pc["ak"]], axis=1)
        va = jnp.concatenate([px["av"], pc["av"]], axis=1)
        oa = sweep_query_blocks(lambda q, b: diff_attention(q, ka, va, lam),
                                apply_rope(px["aq"], cos, sin))

        gq, gk = qk_norm_g[l, 0], qk_norm_g[l, 1]
        kb_ctx = rmsnorm(pc["bk"], gk)
        kb = jnp.concatenate([apply_rope(rmsnorm(px["bk"], gk), cos, sin), kb_ctx], axis=1)
        vb = jnp.concatenate([px["bv"], pc["bv"]], axis=1)
        ob = sweep_query_blocks(lambda q, b: gqa_attention(q, kb, vb),
                                apply_rope(rmsnorm(px["bq"], gq), cos, sin))

        sink = sink_logits[l].reshape(C_KV, C_HEADS // C_KV)
        kc = jnp.pad(apply_rope(px["ck"], cos, sin), band_pad)
        vc = jnp.pad(px["cv"], band_pad)
        oc = sweep_query_blocks(
            lambda q, b: window_block(q, b, kc, vc, pc["ck"], pc["cv"], sink, S),
            apply_rope(px["cq"], cos, sin))

        od = fourier_mix(px["fz"])

        branches = [diff_head_norm(oa, diff_subln_g[l], lam_init), flat(ob), flat(oc), od]
        x = x + g1 * merge_branches(branches, px["gates"], w_branch[l], w_out[l])

        if not last:
            oa_c = diff_attention(pc["aq"], pc["ak"], pc["av"], lam)
            ob_c = gqa_attention(rmsnorm(pc["bq"], gq), kb_ctx, pc["bv"])
            oc_c = sink_attention(pc["cq"], pc["ck"], pc["cv"], sink)
            od_c = fourier_mix(pc["fz"])
            branches_c = [diff_head_norm(oa_c, diff_subln_g[l], lam_init), flat(ob_c), flat(oc_c), od_c]
            h_ctx = h_ctx + cg1 * merge_branches(branches_c, pc["gates"], w_branch[l], w_out[l])

        i = l // 2
        if l % 2 == 0:
            ffn = lambda h: swiglu(h, ffn_w_gate[i], ffn_w_up[i], ffn_w_down[i])
        else:
            ffn = lambda h: moe_swiglu(h, router_w[i], moe_w_gate[i], moe_w_up[i], moe_w_down[i])
        x = x + g2 * ffn(adaln(x, norm2_g[l], sh2, sc2))
        if not last:
            h_ctx = h_ctx + cg2 * ffn(adaln(h_ctx, norm2_g[l], csh2, csc2))
    return rmsnorm(x, final_g)
```

```cpp
#include <hip/hip_runtime.h>
#include <cstdio>
#include <cstdint>

#ifndef DUP_MIX
#define DUP_MIX 0
#endif
#ifndef DUP_PRO
#define DUP_PRO 0
#endif
#ifndef DUP_BRANCH
#define DUP_BRANCH 0
#endif
#ifndef DUP_MOEG
#define DUP_MOEG 0
#endif
#ifndef DUP_UPD
#define DUP_UPD 0
#endif
#ifndef DUP_N2D
#define DUP_N2D 0
#endif
#ifndef DUP_GATH
#define DUP_GATH 0
#endif
#ifndef DUP_INPROJ
#define DUP_INPROJ 0
#endif
#define LAS __attribute__((address_space(3)))
#define GAS __attribute__((address_space(1)))
typedef unsigned short bf16_t;
typedef short bf16x8 __attribute__((ext_vector_type(8)));
typedef short s16x4 __attribute__((ext_vector_type(4)));
typedef float f32x4 __attribute__((ext_vector_type(4)));
typedef float f32x16 __attribute__((ext_vector_type(16)));
typedef unsigned u32x4 __attribute__((ext_vector_type(4)));
typedef unsigned u32x2 __attribute__((ext_vector_type(2)));

constexpr int NB = 8, SEQ = 2048, DM = 1024, DEPTH = 4, CTXL = 256;
constexpr int NLAT = NB * SEQ, NCTX = NB * CTXL, NTOK = NLAT + NCTX;
constexpr int DIN = 7680, PW = 3072, GW = 4096;
constexpr int C_AQ = 0, C_AK = 512, C_AV = 1024, C_BQ = 1536, C_BK = 2048, C_BV = 2176, C_CQ = 2304, C_CK = 2816, C_CV = 2944;
constexpr int DFF = 2816, DFE = 3584, NEXP = 8;
constexpr int OW = 2048;
constexpr int MAXSLOT = 2 * NTOK + 2048;
constexpr float C2 = 0.125f * 1.4426950408889634f;
constexpr float LOG2E = 1.4426950408889634f;

constexpr size_t MiB = 1u << 20;
constexpr size_t WS_CTL = 0, CTL_ZERO_BYTES = 1 * MiB;
constexpr size_t WS_MODV = 1 * MiB;
constexpr size_t WS_ROPE = 2 * MiB;
constexpr size_t WS_T256 = 3 * MiB;
constexpr size_t WS_MOE = 4 * MiB;
constexpr size_t WS_T = 6 * MiB;
constexpr size_t WS_W = 22 * MiB;
constexpr size_t W_IN = 0, W_FZ = 14 * MiB, W_BR = 16 * MiB, W_OUT = 20 * MiB, W_LAYER = 22 * MiB;
constexpr size_t W_DENSE0 = 4 * W_LAYER, W_DGU = 0, W_DD = 11 * MiB, W_DENSE = 33 * MiB / 2;
constexpr size_t W_MOE0 = W_DENSE0 + 2 * W_DENSE, W_MGU = 0, W_MD = 14 * MiB, W_EXPERT = 21 * MiB, W_MOE = 8 * W_EXPERT;
constexpr size_t WS_XS = WS_W + W_MOE0 + 2 * W_MOE;
constexpr size_t WS_XN = WS_XS + 72 * MiB;
constexpr size_t WS_P = WS_XN + 36 * MiB;
constexpr size_t WS_G = WS_P + 108 * MiB;
constexpr size_t WS_ZZ = WS_P + 252 * MiB;
constexpr size_t WS_ZZC = WS_ZZ + 32 * MiB;
constexpr size_t WS_O = WS_ZZC + 4 * MiB;
constexpr size_t WS_HY = WS_O + 72 * MiB;
constexpr size_t WS_Y1 = WS_HY + 76 * MiB;
constexpr size_t WS_END = WS_Y1 + 16 * MiB;
constexpr int MOE_RF = 128;
static_assert(WS_W + W_MOE0 + 2 * W_MOE == 479 * MiB, "weights");
static_assert((size_t)MAXSLOT * DFE * 2 <= 288 * MiB, "moe hidden fits p+zz");
static_assert((size_t)MAXSLOT * 1024 * 2 <= 76 * MiB, "hs fits");
static_assert(WS_END <= 1074 * MiB, "workspace");

constexpr int CW_BAR = 4096;
constexpr int CW_Q = 16384;
constexpr int CW_CNT = 24576;

constexpr int LDS_CTLOFF = 141312;
constexpr int LDS_BYTES = 147456;

typedef float f32x2_t __attribute__((ext_vector_type(2))); typedef __bf16 bf16x2_t __attribute__((ext_vector_type(2)));
__device__ __forceinline__ unsigned cvt_pk_bf16(float lo, float hi) { f32x2_t v = {lo, hi}; bf16x2_t b = __builtin_convertvector(v, bf16x2_t); return __builtin_bit_cast(unsigned, b); }
__device__ __forceinline__ float bf_lo(unsigned w) { return __uint_as_float(w << 16); }
__device__ __forceinline__ float bf_hi(unsigned w) { return __uint_as_float(w & 0xffff0000u); }
__device__ __forceinline__ float bf2f(bf16_t h) { return __uint_as_float(((unsigned)h) << 16); }
__device__ __forceinline__ bf16_t f2bf(float f) { unsigned u = __float_as_uint(f); u += 0x7fffu + ((u >> 16) & 1u); return (bf16_t)(u >> 16); }
__device__ __forceinline__ float fast_exp2(float x) { return __builtin_amdgcn_exp2f(x); }
__device__ __forceinline__ float fast_rcp(float x) { return __builtin_amdgcn_rcpf(x); }
__device__ __forceinline__ float sigmoidf_(float x) { return fast_rcp(1.0f + fast_exp2(-x * LOG2E)); }
__device__ __forceinline__ float siluf_(float x) { return x * sigmoidf_(x); }
__device__ __forceinline__ float wave_sum(float v) {
#pragma unroll
    for (int o = 1; o < 64; o <<= 1) v += __shfl_xor(v, o);
    return v;
}
#define LDS_WAIT() asm volatile("s_waitcnt lgkmcnt(0)" ::: "memory")
__device__ __forceinline__ int lane_id() { int l; asm volatile("v_mbcnt_lo_u32_b32 %0, -1, 0\n\tv_mbcnt_hi_u32_b32 %0, -1, %0" : "=v"(l)); return l; }

namespace pg8 {
constexpr int BM = 256, BK = 64, HALF = 128, HTB = HALF * BK * 2, STAGE_BYTES = 8 * HTB, NXCD = 8, WGM = 8;
__host__ __device__ __forceinline__ int lds_byte(int r, int c) { const int st = (r >> 4) * 2 + (c >> 5), rr = r & 15, cc = c & 31, ob = rr * 64 + cc * 2; return st * 1024 + (ob ^ (((ob >> 9) & 1) << 5)); }
__host__ __device__ __forceinline__ void stage_rc(int b, int& R, int& C) { const int st = b / 1024, sb = b % 1024, swz = sb ^ (((sb >> 9) & 1) << 5); R = (st >> 1) * 16 + swz / 64; C = (st & 1) * 32 + (swz % 64) / 2; }
__host__ __device__ __forceinline__ int perm32(int rho) { const int n = rho >> 4, i = rho & 15; return 8 * (i >> 2) + 4 * n + (i & 3); }

struct Unit { const char* A; const char* B; char* out; const char* aux; const char* aux2; int ldc; int flag; };

__device__ __forceinline__ void tile_of(int L, int nM, int nN, int& pm, int& pn) {
    const int nwg = nM * nN; int wgid = L;
    { const int q = nwg / NXCD, r = nwg % NXCD, xcd = wgid % NXCD, off = wgid / NXCD; wgid = (xcd < r ? xcd * (q + 1) : r * (q + 1) + (xcd - r) * q) + off; }
    const int nig = WGM * nN, gid = wgid / nig, fm = gid * WGM, gsz = (nM - fm) < WGM ? (nM - fm) : WGM;
    pm = fm + ((wgid % nig) % gsz); pn = (wgid % nig) / gsz;
}

template <class Epi, class Sched, bool ALIGN_EPI, bool SP2>
__device__ __forceinline__ void gemm_phase(LAS unsigned char* lds, const int tid, const int K, const int lda, const int ldb, const Sched& S, const Epi& E) {
    const int wid = __builtin_amdgcn_readfirstlane(tid >> 6), lane = tid & 63, wr = wid >> 2, wc = wid & 3, fr = lane & 15, fq = lane >> 4;
    const int nt = K / BK;
    unsigned voffA[2], voffB[2];
#pragma unroll
    for (int i = 0; i < 2; ++i) { int R, C; stage_rc(tid * 16 + i * 8192, R, C); const int Rb = Epi::PERM ? ((R & ~31) + perm32(R & 31)) : R;
        voffA[i] = (unsigned)(R * lda + C) * 2u; voffB[i] = (unsigned)(Rb * ldb + C) * 2u; }
    const size_t kstep = (size_t)(BK * 2);
    const size_t hstepA = (size_t)HALF * lda * 2, hstepB = (size_t)HALF * ldb * 2;
    const unsigned ldsw = (unsigned)wid * 1024u;
    const int aoff = lds_byte(wr * 64 + fr, fq * 8), boff = lds_byte(wc * 32 + fr, fq * 8);
#define PG8_SA(b, h) (((b) * 2 + (h)) * HTB)
#define PG8_SB(b, h) ((4 + (b) * 2 + (h)) * HTB)
#define PG8_STAGE(bufoff, gbase, voff) do { _Pragma("unroll") for (int _i = 0; _i < 2; ++_i) \
        __builtin_amdgcn_global_load_lds((const unsigned*)((const char*)(gbase) + (voff)[_i]), (LAS unsigned*)(lds + (bufoff) + ldsw + _i * 8192), 16, 0, 0); } while (0)
#define PG8_LDA(dst, b, h) do { _Pragma("unroll") for (int m = 0; m < 4; ++m) _Pragma("unroll") for (int k = 0; k < 2; ++k) dst[m][k] = *(const LAS bf16x8*)(lds + PG8_SA(b, h) + aoff + m * 2048 + k * 1024); } while (0)
#define PG8_LDB(dst, b, h) do { _Pragma("unroll") for (int n = 0; n < 2; ++n) _Pragma("unroll") for (int k = 0; k < 2; ++k) dst[n][k] = *(const LAS bf16x8*)(lds + PG8_SB(b, h) + boff + n * 2048 + k * 1024); } while (0)
#define PG8_MMA(ai, bj, At, Bt) do { __builtin_amdgcn_s_setprio(1); _Pragma("unroll") for (int m = 0; m < 4; ++m) _Pragma("unroll") for (int n = 0; n < 2; ++n) _Pragma("unroll") for (int k = 0; k < 2; ++k) \
        acc[ai][bj][m][n] = __builtin_amdgcn_mfma_f32_16x16x32_bf16(Bt[n][k], At[m][k], acc[ai][bj][m][n], 0, 0, 0); __builtin_amdgcn_s_setprio(0); } while (0)
#define PG8_WAIT_V(n) asm volatile("s_waitcnt vmcnt(" #n ")" ::: "memory")
#define PG8_WAIT_L(n) asm volatile("s_waitcnt lgkmcnt(" #n ")" ::: "memory")
#define PG8_BAR __builtin_amdgcn_s_barrier()
#define PG8_SCHED __builtin_amdgcn_sched_barrier(0)
    Unit cur, nxt; int ui = 0;
    if (!S.next(0, cur)) return;
    f32x4 acc[2][2][4][2];
#pragma unroll
    for (int a = 0; a < 2; ++a)
#pragma unroll
        for (int b = 0; b < 2; ++b)
#pragma unroll
            for (int m = 0; m < 4; ++m)
#pragma unroll
                for (int n = 0; n < 2; ++n) acc[a][b][m][n] = (f32x4){0.f, 0.f, 0.f, 0.f};
    bf16x8 At[4][2], B0[2][2], B1[2][2];
    const char* cA = cur.A; const char* cB = cur.B;
    if constexpr (SP2) {
        PG8_STAGE(PG8_SB(0, 0), cB, voffB); PG8_STAGE(PG8_SB(0, 1), cB + hstepB, voffB); PG8_STAGE(PG8_SA(0, 0), cA, voffA); PG8_STAGE(PG8_SA(0, 1), cA + hstepA, voffA);
        if (wr == 1) PG8_BAR;
        PG8_WAIT_V(2); PG8_BAR;
        PG8_STAGE(PG8_SB(1, 0), cB + kstep, voffB); PG8_STAGE(PG8_SA(1, 0), cA + kstep, voffA); PG8_STAGE(PG8_SB(1, 1), cB + hstepB + kstep, voffB);
        PG8_WAIT_V(6); PG8_BAR;
    } else {
        PG8_STAGE(PG8_SB(0, 0), cB, voffB); PG8_STAGE(PG8_SA(0, 0), cA, voffA); PG8_STAGE(PG8_SB(0, 1), cB + hstepB, voffB); PG8_STAGE(PG8_SA(0, 1), cA + hstepA, voffA);
        if (wr == 1) PG8_BAR;
        PG8_WAIT_V(4); PG8_BAR;
        PG8_STAGE(PG8_SB(1, 0), cB + kstep, voffB); PG8_STAGE(PG8_SA(1, 0), cA + kstep, voffA); PG8_STAGE(PG8_SB(1, 1), cB + hstepB + kstep, voffB);
        PG8_WAIT_V(6); PG8_BAR;
    }
    for (;;) {
        const bool has_next = S.next(ui + 1, nxt);
        const char* nA = has_next ? nxt.A : cA; const char* nB = has_next ? nxt.B : cB;
        for (int t = 0; t < nt; t += 2) {
            const bool last = (t == nt - 2);
            const char* a1 = cA + (size_t)(t + 1) * kstep;
            const char* a2 = last ? nA : cA + (size_t)(t + 2) * kstep; const char* b2 = last ? nB : cB + (size_t)(t + 2) * kstep;
            const char* a3 = a2 + kstep; const char* b3 = b2 + kstep;
            if constexpr (SP2) {
            PG8_LDB(B0, 0, 0); PG8_LDB(B1, 0, 1); PG8_SCHED; PG8_LDA(At, 0, 0); PG8_STAGE(PG8_SA(1, 1), a1 + hstepA, voffA);
            PG8_WAIT_V(8); PG8_WAIT_L(0); PG8_BAR; PG8_MMA(0, 0, At, B0); PG8_MMA(0, 1, At, B1); PG8_BAR; PG8_SCHED;
            PG8_LDA(At, 0, 1); PG8_STAGE(PG8_SB(0, 0), b2, voffB); PG8_STAGE(PG8_SB(0, 1), b2 + hstepB, voffB); PG8_STAGE(PG8_SA(0, 0), a2, voffA);
            PG8_WAIT_V(8); PG8_WAIT_L(0); PG8_BAR; PG8_MMA(1, 0, At, B0); PG8_MMA(1, 1, At, B1); PG8_BAR; PG8_SCHED;
            PG8_LDB(B0, 1, 0); PG8_LDB(B1, 1, 1); PG8_SCHED; PG8_LDA(At, 1, 0); PG8_STAGE(PG8_SA(0, 1), a2 + hstepA, voffA);
            PG8_WAIT_V(8); PG8_WAIT_L(0); PG8_BAR; PG8_MMA(0, 0, At, B0); PG8_MMA(0, 1, At, B1); PG8_BAR; PG8_SCHED;
            PG8_LDA(At, 1, 1); PG8_STAGE(PG8_SB(1, 0), b3, voffB); PG8_STAGE(PG8_SB(1, 1), b3 + hstepB, voffB); PG8_STAGE(PG8_SA(1, 0), a3, voffA);
            PG8_WAIT_V(8); PG8_WAIT_L(0); PG8_BAR; PG8_MMA(1, 0, At, B0); PG8_MMA(1, 1, At, B1); PG8_BAR; PG8_SCHED;
            } else {
            PG8_LDB(B0, 0, 0); PG8_SCHED; PG8_LDA(At, 0, 0); PG8_STAGE(PG8_SA(1, 1), a1 + hstepA, voffA);
            PG8_WAIT_L(8); PG8_BAR; PG8_WAIT_L(0); PG8_MMA(0, 0, At, B0); PG8_BAR; PG8_SCHED;
            PG8_LDB(B1, 0, 1); PG8_STAGE(PG8_SB(0, 0), b2, voffB);
            PG8_BAR; PG8_WAIT_L(0); PG8_MMA(0, 1, At, B1); PG8_BAR;
            PG8_LDA(At, 0, 1); PG8_STAGE(PG8_SA(0, 0), a2, voffA);
            PG8_BAR; PG8_WAIT_L(0); PG8_MMA(1, 0, At, B0); PG8_BAR; PG8_SCHED;
            PG8_STAGE(PG8_SB(0, 1), b2 + hstepB, voffB);
            PG8_WAIT_V(6); PG8_BAR; PG8_MMA(1, 1, At, B1); PG8_BAR;
            PG8_LDB(B0, 1, 0); PG8_SCHED; PG8_LDA(At, 1, 0); PG8_STAGE(PG8_SA(0, 1), a2 + hstepA, voffA);
            PG8_WAIT_L(8); PG8_BAR; PG8_WAIT_L(0); PG8_MMA(0, 0, At, B0); PG8_BAR; PG8_SCHED;
            PG8_LDB(B1, 1, 1); PG8_STAGE(PG8_SB(1, 0), b3, voffB);
            PG8_BAR; PG8_WAIT_L(0); PG8_MMA(0, 1, At, B1); PG8_BAR;
            PG8_LDA(At, 1, 1); PG8_STAGE(PG8_SA(1, 0), a3, voffA);
            PG8_BAR; PG8_WAIT_L(0); PG8_MMA(1, 0, At, B0); PG8_BAR; PG8_SCHED;
            PG8_STAGE(PG8_SB(1, 1), b3 + hstepB, voffB);
            PG8_WAIT_V(6); PG8_BAR; PG8_MMA(1, 1, At, B1); PG8_BAR;
            }
        }
        if constexpr (ALIGN_EPI) { if (wr == 0) PG8_BAR; }
        E(acc, cur, wr, wc, fr, fq);
        if (!has_next) break;
#pragma unroll
        for (int a = 0; a < 2; ++a)
#pragma unroll
            for (int b = 0; b < 2; ++b)
#pragma unroll
                for (int m = 0; m < 4; ++m)
#pragma unroll
                    for (int n = 0; n < 2; ++n) acc[a][b][m][n] = (f32x4){0.f, 0.f, 0.f, 0.f};
        cur = nxt; cA = nA; cB = nB; ++ui;
        if constexpr (ALIGN_EPI) { if (wr == 1) PG8_BAR; }
    }
    PG8_WAIT_V(0);
    if constexpr (!ALIGN_EPI) { if (wr == 0) PG8_BAR; }
    PG8_BAR;
#undef PG8_SA
#undef PG8_SB
#undef PG8_STAGE
#undef PG8_LDA
#undef PG8_LDB
#undef PG8_MMA
#undef PG8_WAIT_V
#undef PG8_WAIT_L
#undef PG8_BAR
#undef PG8_SCHED
}

struct EpiStore {
    static constexpr bool PERM = true;
    float scale;
    __device__ __forceinline__ void operator()(const f32x4 (&acc)[2][2][4][2], const Unit& u, int wr, int wc, int fr, int fq) const {
        bf16_t* base = (bf16_t*)u.out + (size_t)(wr * 64 + fr) * u.ldc + wc * 32 + 8 * fq;
        const bool sg = u.flag == 1;
#pragma unroll
        for (int ai = 0; ai < 2; ++ai)
#pragma unroll
            for (int m = 0; m < 4; ++m) { bf16_t* rowp = base + (size_t)(ai * HALF + m * 16) * u.ldc;
#pragma unroll
                for (int bj = 0; bj < 2; ++bj) { f32x4 v0 = acc[ai][bj][m][0] * scale, v1 = acc[ai][bj][m][1] * scale;
                    if (sg) {
#pragma unroll
                        for (int j = 0; j < 4; ++j) { v0[j] = sigmoidf_(v0[j]); v1[j] = sigmoidf_(v1[j]); } }
                    u32x4 w; w.x = cvt_pk_bf16(v0[0], v0[1]); w.y = cvt_pk_bf16(v0[2], v0[3]); w.z = cvt_pk_bf16(v1[0], v1[1]); w.w = cvt_pk_bf16(v1[2], v1[3]);
                    *(u32x4*)(rowp + bj * HALF) = w; } }
    }
};
struct EpiInproj {
    static constexpr bool PERM = true;
    __device__ __forceinline__ void operator()(const f32x4 (&acc)[2][2][4][2], const Unit& u, int wr, int wc, int fr, int fq) const {
        GAS bf16_t* base = (GAS bf16_t*)u.out + (size_t)(wr * 64 + fr) * u.ldc + wc * 32 + 8 * fq;
        const bool sg = (u.flag & 1) != 0, lat = (u.flag & 16) != 0, r0 = lat && (u.flag & 6) != 0, r1 = lat && (u.flag & 2) != 0;
        const float qs = (u.flag & 8) ? C2 : 1.0f;
        const GAS float* rp = (const GAS float*)u.aux + (size_t)(wr * 64 + fr) * 64 + (wc & 1) * 32 + 4 * fq;
#pragma unroll
        for (int ai = 0; ai < 2; ++ai)
#pragma unroll
            for (int m = 0; m < 4; ++m) { GAS bf16_t* rowp = base + (size_t)(ai * HALF + m * 16) * u.ldc;
                f32x4 cs = (f32x4){1.f, 1.f, 1.f, 1.f}, sn = (f32x4){0.f, 0.f, 0.f, 0.f};
                if (r0) { const GAS float* rt = rp + (size_t)(ai * HALF + m * 16) * 64; cs = *(const GAS f32x4*)rt; sn = *(const GAS f32x4*)(rt + 16); }
#pragma unroll
                for (int bj = 0; bj < 2; ++bj) { f32x4 v0 = acc[ai][bj][m][0], v1 = acc[ai][bj][m][1];
                    if (bj == 0 ? r0 : r1) {
                        const float a0 = v0[0] * cs[0] - v0[1] * sn[0], a1 = v0[1] * cs[0] + v0[0] * sn[0], a2 = v0[2] * cs[1] - v0[3] * sn[1], a3 = v0[3] * cs[1] + v0[2] * sn[1];
                        const float b0 = v1[0] * cs[2] - v1[1] * sn[2], b1 = v1[1] * cs[2] + v1[0] * sn[2], b2 = v1[2] * cs[3] - v1[3] * sn[3], b3 = v1[3] * cs[3] + v1[2] * sn[3];
                        v0 = (f32x4){a0, a1, a2, a3}; v1 = (f32x4){b0, b1, b2, b3}; }
                    v0 *= qs; v1 *= qs;
                    if (sg) {
                        unsigned q[8];
#pragma unroll
                        for (int j = 0; j < 4; ++j) { q[j] = (unsigned)(sigmoidf_(v0[j]) * 255.0f + 0.5f); q[4 + j] = (unsigned)(sigmoidf_(v1[j]) * 255.0f + 0.5f); }
                        u32x2 w8; w8.x = q[0] | (q[1] << 8) | (q[2] << 16) | (q[3] << 24); w8.y = q[4] | (q[5] << 8) | (q[6] << 16) | (q[7] << 24);
                        *(GAS u32x2*)((GAS unsigned char*)u.out + (size_t)(wr * 64 + fr + ai * HALF + m * 16) * GW + wc * 32 + 8 * fq + bj * HALF) = w8;
                    } else {
                    u32x4 w; w.x = cvt_pk_bf16(v0[0], v0[1]); w.y = cvt_pk_bf16(v0[2], v0[3]); w.z = cvt_pk_bf16(v1[0], v1[1]); w.w = cvt_pk_bf16(v1[2], v1[3]);
                    *(GAS u32x4*)(rowp + bj * HALF) = w; } } }
    }
};
struct EpiSwiglu {
    static constexpr bool PERM = true;
    __device__ __forceinline__ void operator()(const f32x4 (&acc)[2][2][4][2], const Unit& u, int wr, int wc, int fr, int fq) const {
        bf16_t* base = (bf16_t*)u.out + (size_t)(wr * 64 + fr) * u.ldc + wc * 32 + 8 * fq;
#pragma unroll
        for (int ai = 0; ai < 2; ++ai)
#pragma unroll
            for (int m = 0; m < 4; ++m) { bf16_t* rowp = base + (size_t)(ai * HALF + m * 16) * u.ldc;
                f32x4 g0 = acc[ai][0][m][0], g1 = acc[ai][0][m][1]; const f32x4 u0 = acc[ai][1][m][0], u1 = acc[ai][1][m][1];
#pragma unroll
                for (int j = 0; j < 4; ++j) { g0[j] = siluf_(g0[j]) * u0[j]; g1[j] = siluf_(g1[j]) * u1[j]; }
                u32x4 w; w.x = cvt_pk_bf16(g0[0], g0[1]); w.y = cvt_pk_bf16(g0[2], g0[3]); w.z = cvt_pk_bf16(g1[0], g1[1]); w.w = cvt_pk_bf16(g1[2], g1[3]);
                *(u32x4*)rowp = w; }
    }
};
struct EpiResid {
    static constexpr bool PERM = true;
    __device__ __forceinline__ void operator()(const f32x4 (&acc)[2][2][4][2], const Unit& u, int wr, int wc, int fr, int fq) const {
        GAS bf16_t* base = (GAS bf16_t*)u.out + (size_t)(wr * 64 + fr) * u.ldc + wc * 32 + 8 * fq;
        const size_t roff = (size_t)(wr * 64 + fr) * u.ldc + wc * 32 + 8 * fq;
        const bool srcf = u.flag == 1;
        const GAS float* g = (const GAS float*)u.aux + wc * 32 + 8 * fq;
        f32x4 gv[2][2];
#pragma unroll
        for (int bj = 0; bj < 2; ++bj)
#pragma unroll
            for (int n = 0; n < 2; ++n) gv[bj][n] = *(const GAS f32x4*)(g + bj * HALF + n * 4);
#pragma unroll
        for (int ai = 0; ai < 2; ++ai)
#pragma unroll
            for (int m = 0; m < 4; ++m) { const size_t ro = (size_t)(ai * HALF + m * 16) * u.ldc;
#pragma unroll
                for (int bj = 0; bj < 2; ++bj) {
                    f32x4 r0, r1;
                    if (srcf) { const GAS float* sp = (const GAS float*)u.aux2 + roff + ro + bj * HALF; r0 = *(const GAS f32x4*)sp; r1 = *(const GAS f32x4*)(sp + 4); }
                    else { const u32x4 w = *(const GAS u32x4*)((const GAS bf16_t*)u.aux2 + roff + ro + bj * HALF);
                        r0 = (f32x4){bf_lo(w.x), bf_hi(w.x), bf_lo(w.y), bf_hi(w.y)}; r1 = (f32x4){bf_lo(w.z), bf_hi(w.z), bf_lo(w.w), bf_hi(w.w)}; }
                    const f32x4 v0 = r0 + gv[bj][0] * acc[ai][bj][m][0], v1 = r1 + gv[bj][1] * acc[ai][bj][m][1];
                    u32x4 o; o.x = cvt_pk_bf16(v0[0], v0[1]); o.y = cvt_pk_bf16(v0[2], v0[3]); o.z = cvt_pk_bf16(v1[0], v1[1]); o.w = cvt_pk_bf16(v1[2], v1[3]);
                    *(GAS u32x4*)(base + ro + bj * HALF) = o; }
                asm volatile("" ::: "memory"); }
    }
};
struct BUnit { const char* A; const char* B; const char* gate; char* out; };
__device__ __forceinline__ void gload8_async(u32x2& dst, const void* p) { asm volatile("global_load_dwordx2 %0, %1, off" : "=&v"(dst) : "v"(p) : "memory"); }
template <class Sched>
__device__ __forceinline__ void branch_phase(LAS unsigned char* lds, const int tid, const Sched& S) {
    const int wid = __builtin_amdgcn_readfirstlane(tid >> 6), lane = tid & 63, wr = wid >> 2, wc = wid & 3, fr = lane & 15, fq = lane >> 4;
    constexpr int K = 2048, nt = K / BK, lda = 2048, ldb = 2048;
    unsigned voffA[2], voffB[2];
#pragma unroll
    for (int i = 0; i < 2; ++i) { int R, C; stage_rc(tid * 16 + i * 8192, R, C); const int Rb = (R & ~31) + perm32(R & 31);
        voffA[i] = (unsigned)(R * lda + C) * 2u; voffB[i] = (unsigned)(Rb * ldb + C) * 2u; }
    const size_t kstep = (size_t)(BK * 2);
    const size_t hstepA = (size_t)HALF * lda * 2;
    const unsigned ldsw = (unsigned)wid * 1024u;
    const int aoff = lds_byte(wr * 64 + fr, fq * 8), boff = lds_byte(wc * 32 + fr, fq * 8);
#define BR_SA(b, h) (((b) * 2 + (h)) * HTB)
#define BR_SB(b) ((4 + (b) * 2) * HTB)
#define BR_STAGE(bufoff, gbase, voff) do { _Pragma("unroll") for (int _i = 0; _i < 2; ++_i) \
        __builtin_amdgcn_global_load_lds((const unsigned*)((const char*)(gbase) + (voff)[_i]), (LAS unsigned*)(lds + (bufoff) + ldsw + _i * 8192), 16, 0, 0); } while (0)
#define BR_LDA(dst, b, h) do { _Pragma("unroll") for (int m = 0; m < 4; ++m) _Pragma("unroll") for (int k = 0; k < 2; ++k) dst[m][k] = *(const LAS bf16x8*)(lds + BR_SA(b, h) + aoff + m * 2048 + k * 1024); } while (0)
#define BR_LDB(dst, b) do { _Pragma("unroll") for (int n = 0; n < 2; ++n) _Pragma("unroll") for (int k = 0; k < 2; ++k) dst[n][k] = *(const LAS bf16x8*)(lds + BR_SB(b) + boff + n * 2048 + k * 1024); } while (0)
#define BR_MMA(ai) do { __builtin_amdgcn_s_setprio(1); _Pragma("unroll") for (int m = 0; m < 4; ++m) _Pragma("unroll") for (int n = 0; n < 2; ++n) _Pragma("unroll") for (int k = 0; k < 2; ++k) \
        acc[ai][m][n] = __builtin_amdgcn_mfma_f32_16x16x32_bf16(B0[n][k], At[m][k], acc[ai][m][n], 0, 0, 0); __builtin_amdgcn_s_setprio(0); } while (0)
#define BR_WAIT_V(n) asm volatile("s_waitcnt vmcnt(" #n ")" ::: "memory")
#define BR_WAIT_L0 asm volatile("s_waitcnt lgkmcnt(0)" ::: "memory")
#define BR_BAR __builtin_amdgcn_s_barrier()
#define BR_SCHED __builtin_amdgcn_sched_barrier(0)
    BUnit cur, nxt; int ui = 0;
    if (!S.next(0, cur)) return;
    f32x4 acc[2][4][2], macc[2][4][2];
#pragma unroll
    for (int a = 0; a < 2; ++a)
#pragma unroll
        for (int m = 0; m < 4; ++m)
#pragma unroll
            for (int n = 0; n < 2; ++n) { acc[a][m][n] = (f32x4){0.f, 0.f, 0.f, 0.f}; macc[a][m][n] = (f32x4){0.f, 0.f, 0.f, 0.f}; }
    bf16x8 At[4][2], B0[2][2];
    const char* cA = cur.A; const char* cB = cur.B;
    BR_STAGE(BR_SB(0), cB, voffB); BR_STAGE(BR_SA(0, 0), cA, voffA); BR_STAGE(BR_SA(0, 1), cA + hstepA, voffA);
    if (wr == 1) BR_BAR;
    BR_WAIT_V(2); BR_BAR;
    BR_STAGE(BR_SB(1), cB + kstep, voffB); BR_STAGE(BR_SA(1, 0), cA + kstep, voffA);
    BR_WAIT_V(4); BR_BAR;
    const size_t rowoff = (size_t)(wr * 64 + fr), coloff = (size_t)(wc * 32 + 8 * fq);
    for (;;) {
        const bool has_next = S.next(ui + 1, nxt);
        const char* nA = has_next ? nxt.A : cA; const char* nB = has_next ? nxt.B : cB;
        const char* gbase = cur.gate + (rowoff * GW + coloff);
        u32x2 g[8];
        for (int t = 0; t < nt; t += 2) {
            const bool last = (t == nt - 2);
            const bool hook = (t & 6) == 6;
            const char* a1 = cA + (size_t)(t + 1) * kstep;
            const char* a2 = last ? nA : cA + (size_t)(t + 2) * kstep; const char* b2 = last ? nB : cB + (size_t)(t + 2) * kstep;
            const char* a3 = a2 + kstep; const char* b3 = b2 + kstep;
            if (hook) {
                const char* gp = gbase + (size_t)(t >> 3) * 1024;
#pragma unroll
                for (int q = 0; q < 8; ++q) gload8_async(g[q], gp + (size_t)((q >> 2) * HALF + (q & 3) * 16) * GW);
            }
            BR_LDB(B0, 0); BR_SCHED; BR_LDA(At, 0, 0); BR_STAGE(BR_SA(1, 1), a1 + hstepA, voffA);
            if (hook) BR_WAIT_V(14); else BR_WAIT_V(6);
            BR_WAIT_L0; BR_BAR; BR_MMA(0); BR_BAR; BR_SCHED;
            BR_LDA(At, 0, 1); BR_STAGE(BR_SB(0), b2, voffB); BR_STAGE(BR_SA(0, 0), a2, voffA);
            if (hook) BR_WAIT_V(14); else BR_WAIT_V(6);
            BR_WAIT_L0; BR_BAR; BR_MMA(1); BR_BAR; BR_SCHED;
            BR_LDB(B0, 1); BR_SCHED; BR_LDA(At, 1, 0); BR_STAGE(BR_SA(0, 1), a2 + hstepA, voffA);
            BR_WAIT_V(6); BR_WAIT_L0; BR_BAR; BR_MMA(0); BR_BAR; BR_SCHED;
            BR_LDA(At, 1, 1); BR_STAGE(BR_SB(1), b3, voffB); BR_STAGE(BR_SA(1, 0), a3, voffA);
            BR_WAIT_V(6); BR_WAIT_L0; BR_BAR; BR_MMA(1); BR_BAR; BR_SCHED;
            if (hook) {
                asm volatile("s_waitcnt vmcnt(10)" : "+v"(g[0]), "+v"(g[1]), "+v"(g[2]), "+v"(g[3]), "+v"(g[4]), "+v"(g[5]), "+v"(g[6]), "+v"(g[7]) :: "memory");
#pragma unroll
                for (int ai = 0; ai < 2; ++ai)
#pragma unroll
                    for (int m = 0; m < 4; ++m) { const u32x2 gw = g[ai * 4 + m];
                        const f32x4 g0 = (f32x4){(float)(gw.x & 255u), (float)((gw.x >> 8) & 255u), (float)((gw.x >> 16) & 255u), (float)(gw.x >> 24)};
                        const f32x4 g1 = (f32x4){(float)(gw.y & 255u), (float)((gw.y >> 8) & 255u), (float)((gw.y >> 16) & 255u), (float)(gw.y >> 24)};
                        macc[ai][m][0] += acc[ai][m][0] * g0; macc[ai][m][1] += acc[ai][m][1] * g1;
                        acc[ai][m][0] = (f32x4){0.f, 0.f, 0.f, 0.f}; acc[ai][m][1] = (f32x4){0.f, 0.f, 0.f, 0.f}; }
            }
        }
        {
            GAS bf16_t* op = (GAS bf16_t*)cur.out + rowoff * 1024 + coloff;
#pragma unroll
            for (int ai = 0; ai < 2; ++ai)
#pragma unroll
                for (int m = 0; m < 4; ++m) { const f32x4 v0 = macc[ai][m][0] * (1.0f / 255.0f), v1 = macc[ai][m][1] * (1.0f / 255.0f);
                    u32x4 w; w.x = cvt_pk_bf16(v0[0], v0[1]); w.y = cvt_pk_bf16(v0[2], v0[3]); w.z = cvt_pk_bf16(v1[0], v1[1]); w.w = cvt_pk_bf16(v1[2], v1[3]);
                    *(GAS u32x4*)(op + (size_t)(ai * HALF + m * 16) * 1024) = w;
                    macc[ai][m][0] = (f32x4){0.f, 0.f, 0.f, 0.f}; macc[ai][m][1] = (f32x4){0.f, 0.f, 0.f, 0.f}; }
        }
        if (!has_next) break;
        cur = nxt; cA = nA; cB = nB; ++ui;
    }
    BR_WAIT_V(0);
    if (wr == 0) BR_BAR;
    BR_BAR;
#undef BR_SA
#undef BR_SB
#undef BR_STAGE
#undef BR_LDA
#undef BR_LDB
#undef BR_MMA
#undef BR_WAIT_V
#undef BR_WAIT_L0
#undef BR_BAR
#undef BR_SCHED
}
}

#define XB_TMO      128
#define XB_XCNT(j)  (256  + 64 * (j))
#define XB_XSUB(j)  (1280 + 64 * (j))
#define XB_XGEN(j)  (2304 + 64 * (j))
#define XB_TOP      3328
#define XB_TOPGEN   3392
#define XCD_BAR_WORDS 3456
#define XB_SPIN_CAP (1u << 20)

__device__ __forceinline__ unsigned xb_ld(unsigned* p)              { return __hip_atomic_load(p, __ATOMIC_RELAXED, __HIP_MEMORY_SCOPE_AGENT); }
__device__ __forceinline__ unsigned xb_add(unsigned* p, unsigned v) { return __hip_atomic_fetch_add(p, v, __ATOMIC_RELAXED, __HIP_MEMORY_SCOPE_AGENT); }
__device__ __forceinline__ unsigned xb_xcc_id() { return (unsigned)__builtin_amdgcn_s_getreg((3 << 11) | 20) & 0xFu; }
#define XB_SPIN(cond, bar) do { unsigned _sp = 0; while (cond) { __builtin_amdgcn_s_sleep(1); \
    if ((++_sp & 255u) == 0u) { if (xb_ld(&(bar)[XB_TMO])) break; if (_sp > XB_SPIN_CAP) { atomicAdd(&(bar)[XB_TMO], 1u); break; } } } } while (0)

struct XcdBarrier { unsigned* bar; unsigned x; volatile LAS unsigned* st; };

__device__ __forceinline__ XcdBarrier xcd_barrier_post(unsigned* bar, volatile LAS unsigned* st) {
    XcdBarrier b; b.bar = bar; b.x = xb_xcc_id(); b.st = st;
    if (threadIdx.x == 0) (void)xb_add(&bar[XB_XCNT(b.x)], 1u);
    return b;
}
__device__ __forceinline__ void xcd_barrier_complete(unsigned* bar, unsigned x, unsigned& nloc, unsigned& nx) {
    const unsigned G = gridDim.x * gridDim.y * gridDim.z;
    unsigned sum, cnt, mine, sp = 0u;
    for (;;) {
        sum = 0u; cnt = 0u; mine = 0u;
#pragma unroll
        for (unsigned j = 0; j < 16; ++j) { const unsigned c = xb_ld(&bar[XB_XCNT(j)]); sum += c; cnt += (c > 0u) ? 1u : 0u; mine = (j == x) ? c : mine; }
        if (sum == G) break;
        __builtin_amdgcn_s_sleep(1);
        if ((++sp & 255u) == 0u) { if (xb_ld(&bar[XB_TMO])) break; if (sp > XB_SPIN_CAP) { atomicAdd(&bar[XB_TMO], 1u); break; } }
    }
    nloc = mine > 0u ? mine : 1u; nx = cnt > 0u ? cnt : 1u;
}
__device__ __forceinline__ void xcd_barrier(const XcdBarrier& b, const bool leader) {
    asm volatile("s_waitcnt vmcnt(0)" ::: "memory");
    __syncthreads();
    unsigned* bar = b.bar; asm volatile("" : "+v"(bar));
    if (leader) {
        __builtin_amdgcn_s_waitcnt(0);
        unsigned nloc = b.st[0], nx = b.st[1];
        if (nloc == 0u) { xcd_barrier_complete(bar, b.x, nloc, nx); b.st[0] = nloc; b.st[1] = nx; }
        const unsigned old = xb_add(&bar[XB_XSUB(b.x)], 1u);
        const unsigned gen = old / nloc;
        if (old + 1u == (gen + 1u) * nloc) {
            __builtin_amdgcn_fence(__ATOMIC_RELEASE, "agent");
            asm volatile("s_waitcnt vmcnt(0)" ::: "memory");
            const unsigned og = xb_add(&bar[XB_TOP], 1u);
            const unsigned tg = og / nx;
            if (og + 1u == (tg + 1u) * nx) xb_add(&bar[XB_TOPGEN], 1u);
            else XB_SPIN(xb_ld(&bar[XB_TOPGEN]) == tg, bar);
            __builtin_amdgcn_fence(__ATOMIC_ACQUIRE, "agent");
            xb_add(&bar[XB_XGEN(b.x)], 1u);
            asm volatile("s_waitcnt vmcnt(0)" ::: "memory");
        } else {
            XB_SPIN(xb_ld(&bar[XB_XGEN(b.x)]) == gen, bar);
            __builtin_amdgcn_fence(__ATOMIC_ACQUIRE, "agent");
            asm volatile("s_waitcnt vmcnt(0)" ::: "memory");
        }
    }
    __syncthreads();
}

struct Args { const float* in[23]; float* out; unsigned char* ws; };
enum { I_X = 0, I_C, I_CTX, I_CCTX, I_WMOD, I_BMOD, I_N1G, I_N2G, I_WIN, I_DLAM, I_SUBLN, I_QKG, I_SINK, I_WBR, I_WOUT, I_FG, I_FU, I_FD, I_RW, I_MG, I_MU, I_MD, I_FINALG };

__device__ __forceinline__ bf16_t* w_layer(unsigned char* ws, int l, size_t off) { return (bf16_t*)(ws + WS_W + (size_t)l * W_LAYER + off); }
__device__ __forceinline__ bf16_t* w_dense(unsigned char* ws, int i, size_t off) { return (bf16_t*)(ws + WS_W + W_DENSE0 + (size_t)i * W_DENSE + off); }
__device__ __forceinline__ bf16_t* w_moe(unsigned char* ws, int i, int e, size_t off) { return (bf16_t*)(ws + WS_W + W_MOE0 + (size_t)i * W_MOE + (size_t)e * W_EXPERT + off); }

constexpr int CV_LAYER = 1536 + 2048 + 1024 + 512;
constexpr int CV_DENSE = 3 * 1408;
constexpr int CV_EXP = 3 * 1792;
constexpr int CV_TOTAL = 4 * CV_LAYER + 2 * CV_DENSE + 16 * CV_EXP;
struct ConvDesc { const float* src; bf16_t* dst; int ldsrc, lddst, perm; };
__device__ __forceinline__ ConvDesc conv_decode(const Args& a, int it) {
    unsigned char* ws = a.ws;
    const float* src; int ldsrc, K, c0, ncols, mode = 0, drow0 = 0, blk, ldd = 0; bf16_t* dst; bool win = false;
    if (it < 4 * CV_LAYER) { const int l = it / CV_LAYER, r = it % CV_LAYER;
        if (r < 1536) { blk = r; src = a.in[I_WIN] + (size_t)l * DM * DIN; ldsrc = DIN; K = DM; c0 = 0; ncols = 3072; dst = w_layer(ws, l, W_IN); drow0 = 0; win = true; }
        else if (r < 3584) { blk = r - 1536; src = a.in[I_WIN] + (size_t)l * DM * DIN; ldsrc = DIN; K = DM; c0 = 3584; ncols = 4096; dst = w_layer(ws, l, W_IN); drow0 = 3072; }
        else if (r < 4608) { const int q = r - 3584, rr = q / 256; blk = q % 256; src = a.in[I_WBR] + (size_t)(l * 4 + rr) * 512 * DM; ldsrc = DM; K = 512; c0 = 0; ncols = DM; dst = w_layer(ws, l, W_BR) + (size_t)rr * 512; ldd = 2048; }
        else { blk = r - 4608; src = a.in[I_WOUT] + (size_t)l * DM * DM; ldsrc = DM; K = DM; c0 = 0; ncols = DM; dst = w_layer(ws, l, W_OUT); }
    } else if (it < 4 * CV_LAYER + 2 * CV_DENSE) { const int q = it - 4 * CV_LAYER, i = q / CV_DENSE, r = q % CV_DENSE, which = r / 1408; blk = r % 1408;
        if (which < 2) { src = a.in[which == 0 ? I_FG : I_FU] + (size_t)i * DM * DFF; ldsrc = DFF; K = DM; c0 = 0; ncols = DFF; dst = w_dense(ws, i, W_DGU); mode = 1 + which; }
        else { src = a.in[I_FD] + (size_t)i * DFF * DM; ldsrc = DM; K = DFF; c0 = 0; ncols = DM; dst = w_dense(ws, i, W_DD); }
    } else { const int q = it - 4 * CV_LAYER - 2 * CV_DENSE, ie = q / CV_EXP, r = q % CV_EXP, which = r / 1792, i = ie >> 3, e = ie & 7; blk = r % 1792;
        if (which < 2) { src = a.in[which == 0 ? I_MG : I_MU] + (size_t)ie * DM * DFE; ldsrc = DFE; K = DM; c0 = 0; ncols = DFE; dst = w_moe(ws, i, e, W_MGU); mode = 1 + which; }
        else { src = a.in[I_MD] + (size_t)ie * DFE * DM; ldsrc = DM; K = DFE; c0 = 0; ncols = DM; dst = w_moe(ws, i, e, W_MD); }
    }
    const int nbn = ncols / 32, kb = blk / nbn, nb = blk % nbn, n = 32 * nb;
    const int drow = mode == 0 ? drow0 + n : 256 * (n >> 7) + (n & 127) + (mode == 2 ? 128 : 0);
    const bool perm = win && (n < 1024 || (n >= 1536 && n < 2176) || (n >= 2304 && n < 2944));
    ConvDesc d; d.src = src + (size_t)(64 * kb) * ldsrc + c0 + n; if (ldd == 0) ldd = K;
    d.dst = dst + (size_t)drow * ldd + 64 * kb; d.ldsrc = ldsrc; d.lddst = ldd; d.perm = perm ? 1 : 0;
    return d;
}
__device__ __forceinline__ void conv_load(const ConvDesc& d, float (&r)[32], int lane) {
    const GAS float* s = (const GAS float*)d.src + (size_t)(lane >> 5) * d.ldsrc + (lane & 31);
#pragma unroll
    for (int i = 0; i < 32; ++i) r[i] = __builtin_nontemporal_load(s + (size_t)(2 * i) * d.ldsrc);
}
__device__ __forceinline__ void conv_store(const ConvDesc& d, const float (&r)[32], LAS float* scr, int lane) {
#pragma unroll
    for (int i = 0; i < 32; ++i) scr[(2 * i + (lane >> 5)) * 33 + (lane & 31)] = r[i];
    LDS_WAIT(); asm volatile("" ::: "memory");
    const int c = lane & 7;
#pragma unroll
    for (int j = 0; j < 4; ++j) { const int n = (lane >> 3) + 8 * j; const LAS float* s = scr + (8 * c) * 33 + n;
        u32x4 o; o.x = cvt_pk_bf16(s[0 * 33], s[1 * 33]); o.y = cvt_pk_bf16(s[2 * 33], s[3 * 33]); o.z = cvt_pk_bf16(s[4 * 33], s[5 * 33]); o.w = cvt_pk_bf16(s[6 * 33], s[7 * 33]);
        const int dn = d.perm ? 2 * (n & 15) + (n >> 4) : n;
        __builtin_nontemporal_store(o, (GAS u32x4*)(d.dst + (size_t)dn * d.lddst + 8 * c)); }
    LDS_WAIT(); asm volatile("" ::: "memory");
}
__device__ __forceinline__ void fzfold_item(const Args& a, int it, int lane) {
    const int mq = it & 3, kb = (it >> 2) & 15, g = (it >> 6) & 7, l = it >> 9, k0 = 64 * kb;
    const GAS f32x4* src = (const GAS f32x4*)(a.in[I_WIN] + (size_t)l * DM * DIN + (size_t)(k0 + lane) * DIN + 3072 + g * 64);
    float w[64];
#pragma unroll
    for (int i = 0; i < 16; ++i) { const f32x4 v = src[i]; w[4 * i] = v[0]; w[4 * i + 1] = v[1]; w[4 * i + 2] = v[2]; w[4 * i + 3] = v[3]; }
    const float cv = cospif((float)lane * (1.0f / 32.0f)), sv = sinpif((float)lane * (1.0f / 32.0f));
    GAS bf16_t* dst = (GAS bf16_t*)w_layer(a.ws, l, W_FZ);
    for (int m = 16 * mq; m < 16 * mq + 16; ++m) {
        float sc = 0.f, ss = 0.f;
#pragma unroll
        for (int c = 0; c < 64; ++c) { const int j = (c * m) & 63;
            const float cj = __builtin_bit_cast(float, __builtin_amdgcn_readlane(__builtin_bit_cast(int, cv), j)), sj = __builtin_bit_cast(float, __builtin_amdgcn_readlane(__builtin_bit_cast(int, sv), j));
            sc += w[c] * cj; ss += w[c] * sj; }
        dst[(size_t)(g * 64 + m) * DM + k0 + lane] = f2bf(sc);
        dst[(size_t)(512 + g * 64 + m) * DM + k0 + lane] = f2bf(ss);
    }
}
__device__ __forceinline__ void mod_item(const Args& a, int item, LAS unsigned char* lds, int tid) {
    const int l = item / 24, chunk = item % 24, wid = tid >> 6, lane = tid & 63;
    LAS float* sc = (LAS float*)lds;
    LAS float* red = (LAS float*)(lds + 36864);
    for (int i = tid; i < 9 * 1024; i += 512) { const float v = i < 8192 ? a.in[I_C][i] : a.in[I_CCTX][i - 8192]; sc[i] = siluf_(v); }
    __syncthreads();
    const float* w = a.in[I_WMOD] + (size_t)l * DM * 6144 + chunk * 256 + lane * 4;
    f32x4 acc[9];
#pragma unroll
    for (int r = 0; r < 9; ++r) acc[r] = (f32x4){0.f, 0.f, 0.f, 0.f};
    const int kb = wid * 128;
#pragma unroll 8
    for (int k = 0; k < 128; ++k) { const f32x4 wv = *(const GAS f32x4*)(w + (size_t)(kb + k) * 6144);
#pragma unroll
        for (int r = 0; r < 9; ++r) acc[r] += wv * sc[r * 1024 + kb + k]; }
#pragma unroll
    for (int r = 0; r < 9; ++r) *(LAS f32x4*)(red + (wid * 9 + r) * 256 + lane * 4) = acc[r];
    __syncthreads();
    float* modv = (float*)(a.ws + WS_MODV) + (size_t)l * 9 * 6144;
    for (int i = tid; i < 9 * 256; i += 512) { const int r = i >> 8, c = i & 255; float s = 0.f;
#pragma unroll
        for (int w8 = 0; w8 < 8; ++w8) s += red[(w8 * 9 + r) * 256 + c];
        modv[r * 6144 + chunk * 256 + c] = s + a.in[I_BMOD][l * 6144 + chunk * 256 + c]; }
    __syncthreads();
}

struct RowV { f32x4 v[4]; };
__device__ __forceinline__ RowV load_row_f32(const float* p, int lane) { RowV r; const f32x4* q = (const f32x4*)p + lane;
#pragma unroll
    for (int j = 0; j < 4; ++j) r.v[j] = q[64 * j];
    return r; }
__device__ __forceinline__ void store_row_f32(float* p, const RowV& r, int lane) { f32x4* q = (f32x4*)p + lane;
#pragma unroll
    for (int j = 0; j < 4; ++j) q[64 * j] = r.v[j]; }
__device__ __forceinline__ RowV load_row_bf16(const bf16_t* p, int lane) { RowV r; const u32x2* q = (const u32x2*)p + lane;
#pragma unroll
    for (int j = 0; j < 4; ++j) { const u32x2 w = q[64 * j]; r.v[j] = (f32x4){bf_lo(w.x), bf_hi(w.x), bf_lo(w.y), bf_hi(w.y)}; }
    return r; }
__device__ __forceinline__ void store_row_bf16(bf16_t* p, const RowV& r, int lane) { u32x2* q = (u32x2*)p + lane;
#pragma unroll
    for (int j = 0; j < 4; ++j) { u32x2 w; w.x = cvt_pk_bf16(r.v[j][0], r.v[j][1]); w.y = cvt_pk_bf16(r.v[j][2], r.v[j][3]); q[64 * j] = w; } }
__device__ __forceinline__ RowV adaln_row(const RowV& x, const float* g, const float* shift, const float* scale, int lane) {
    float ss = 0.f;
#pragma unroll
    for (int j = 0; j < 4; ++j) ss += (x.v[j][0] * x.v[j][0] + x.v[j][1] * x.v[j][1]) + (x.v[j][2] * x.v[j][2] + x.v[j][3] * x.v[j][3]);
    const float rstd = 1.0f / sqrtf(wave_sum(ss) * (1.0f / DM) + 1e-6f);
    const RowV gv = load_row_f32(g, lane), sh = load_row_f32(shift, lane), sc = load_row_f32(scale, lane);
    RowV y;
#pragma unroll
    for (int j = 0; j < 4; ++j) y.v[j] = x.v[j] * rstd * gv.v[j] * (1.0f + sc.v[j]) + sh.v[j];
    return y;
}
__device__ __forceinline__ int mod_row_of(int row) { return row < NLAT ? (row >> 11) : 8; }
struct AdaCoef { RowV A, B; int mr; };
__device__ __forceinline__ void ada_coef_update(AdaCoef& c, int row, const float* g, const float* modbase, int shift_off, int scale_off, int lane) {
    const int mr = mod_row_of(row);
    if (mr != c.mr) { c.mr = mr; const float* mv = modbase + (size_t)mr * 6144;
        const RowV gv = load_row_f32(g, lane), sh = load_row_f32(mv + shift_off, lane), sc = load_row_f32(mv + scale_off, lane);
#pragma unroll
        for (int j = 0; j < 4; ++j) { c.A.v[j] = gv.v[j] * (1.0f + sc.v[j]); c.B.v[j] = sh.v[j]; } }
}
__device__ __forceinline__ RowV adaln_apply(const RowV& x, const AdaCoef& c) {
    float ss = 0.f;
#pragma unroll
    for (int j = 0; j < 4; ++j) ss += (x.v[j][0] * x.v[j][0] + x.v[j][1] * x.v[j][1]) + (x.v[j][2] * x.v[j][2] + x.v[j][3] * x.v[j][3]);
    const float rstd = 1.0f / sqrtf(wave_sum(ss) * (1.0f / DM) + 1e-6f);
    RowV y;
#pragma unroll
    for (int j = 0; j < 4; ++j) y.v[j] = x.v[j] * rstd * c.A.v[j] + c.B.v[j];
    return y;
}

struct MoeTiles { int tb[9]; };
__device__ __forceinline__ MoeTiles moe_tiles(unsigned* ctl, int i) { MoeTiles t; int s = 0;
#pragma unroll
    for (int e = 0; e < 8; ++e) { t.tb[e] = s; const unsigned c = (unsigned)__builtin_amdgcn_readfirstlane((int)__hip_atomic_load(ctl + CW_CNT + 64 * (8 * i + e), __ATOMIC_RELAXED, __HIP_MEMORY_SCOPE_AGENT)); s += (int)((c + 255u) >> 8); }
    t.tb[8] = s; return t; }

__device__ __forceinline__ float max3f(float a, float b, float c) { return __builtin_fmaxf(__builtin_fmaxf(a, b), c); }
__device__ __forceinline__ int crow(int r, int hi) { return (r & 3) + 8 * (r >> 2) + 4 * hi; }
typedef short v4i16_t __attribute__((ext_vector_type(4)));
__device__ __forceinline__ s16x4 vtr(const LAS unsigned char* p) { return __builtin_bit_cast(s16x4, __builtin_amdgcn_ds_read_tr16_b64_v4i16((LAS v4i16_t*)p)); }

struct AttnCtx { const bf16_t* P; bf16_t* O; const float* subln_g; float lam, one_m_li; const float* sink; };

constexpr float ATT_THR = 8.0f;
__device__ __forceinline__ void glds16(const void* gsrc, unsigned lds_dst) { unsigned keep;
    asm volatile("s_mov_b32 %0, m0\n\ts_mov_b32 m0, %2\n\ts_nop 0\n\tglobal_load_lds_dwordx4 %1, off\n\ts_mov_b32 m0, %0" : "=&s"(keep) : "v"(gsrc), "s"(lds_dst) : "memory"); }
#define ATT_BAR() do { __builtin_amdgcn_sched_barrier(0); asm volatile("s_waitcnt lgkmcnt(0)" ::: "memory"); __builtin_amdgcn_s_barrier(); asm volatile("" ::: "memory"); __builtin_amdgcn_sched_barrier(0); } while (0)
template <int VAR>
__device__ __forceinline__ void attn_unit(LAS unsigned char* lds, const int tid, const AttnCtx& ac, int b, int hh, int qb, bool ctxq) {
    constexpr int NDB = (VAR == 0) ? 4 : 2;
    constexpr int NLD = (VAR == 0) ? 2 : 1;
    constexpr int KB = (VAR == 0) ? 16384 : 8192;
    constexpr int VB = (VAR == 0) ? 16384 : 8192;
    constexpr int VBASE = 3 * KB;
    constexpr int WSF_OFF = 135168;
    const int lane = tid & 63, r32 = lane & 31, hi = lane >> 5; const int wid = __builtin_amdgcn_readfirstlane(tid >> 6);
    const int half = wid >> 2;
    int map = 0, g = 0, qsub, qcol, kcol, vcol, ocol, qpb;
    if (VAR == 0) { map = wid >> 2; qsub = wid & 3; qpb = 128; qcol = C_AQ + hh * 128 + map * 64; kcol = C_AK + hh * 128; vcol = C_AV + hh * 128; ocol = hh * 128; }
    else { g = wid >> 1; qsub = wid & 1; qpb = 64; qcol = (VAR == 1 ? C_BQ : C_CQ) + (hh * 4 + g) * 64; kcol = (VAR == 1 ? C_BK : C_CK) + hh * 64; vcol = (VAR == 1 ? C_BV : C_CV) + hh * 64; ocol = (VAR == 1 ? 512 : 1024) + (hh * 4 + g) * 64; }
    const int q0w = qb * qpb + qsub * 32;
    const int latbase = b * SEQ, ctxbase = NLAT + b * CTXL;
    const int qrow0 = (ctxq ? ctxbase : latbase) + q0w;
    int NT, lt0 = 0;
    if (ctxq) NT = 4;
    else if (VAR == 2) { lt0 = qb - 2 < 0 ? 0 : qb - 2; const int lt1 = qb + 2 > 31 ? 31 : qb + 2; NT = 4 + (lt1 - lt0 + 1); }
    else NT = 36;
    auto tile_row0 = [&](int t) -> int {
        if (ctxq) return ctxbase + 64 * t;
        if (VAR == 2) return t < 4 ? ctxbase + 64 * t : latbase + 64 * (lt0 + t - 4);
        return t < 32 ? latbase + 64 * t : ctxbase + 64 * (t - 32);
    };
    const GAS bf16_t* Pg = (const GAS bf16_t*)ac.P;
    bf16x8 qr[4];
    { const GAS bf16_t* qp = Pg + (size_t)(qrow0 + r32) * PW + qcol + hi * 8;
#pragma unroll
      for (int d0 = 0; d0 < 4; ++d0) qr[d0] = *(const GAS bf16x8*)(qp + d0 * 16); }
    const GAS bf16_t* kdma = Pg + (size_t)lane * PW + kcol + 8 * wid;
    const GAS bf16_t* vdma = Pg + (size_t)(16 * (wid & 3) + (lane >> 2)) * PW + vcol + (wid >> 2) * 32 + (lane & 3) * 8;
    const unsigned lds0 = (unsigned)(uintptr_t)lds + (unsigned)wid * 1024u;
    auto gloadK = [&](int t, int slot) { const GAS bf16_t* rp = kdma + (size_t)tile_row0(t) * PW;
#pragma unroll
        for (int j = 0; j < NLD; ++j) glds16((const void*)(rp + 64 * j), (unsigned)__builtin_amdgcn_readfirstlane(lds0 + (unsigned)(slot * KB + j * 8192))); };
    auto gloadV = [&](int t, int slot) { const GAS bf16_t* rp = vdma + (size_t)tile_row0(t) * PW;
#pragma unroll
        for (int j = 0; j < NLD; ++j) glds16((const void*)(rp + 64 * j), (unsigned)__builtin_amdgcn_readfirstlane(lds0 + (unsigned)(VBASE + slot * VB + j * 8192))); };
    volatile LAS float* wsf = (volatile LAS float*)(lds + WSF_OFF + wid * 256);
    const int koff = (VAR == 0 ? map * 8192 : 0) + hi * 1024 + r32 * 16;
    const int vlane = (4 * hi + ((lane & 15) >> 2)) * 64 + ((lane >> 4) & 1) * 32 + (lane & 3) * 8;
    f32x16 o[NDB];
#pragma unroll
    for (int d = 0; d < NDB; ++d) o[d] = (f32x16){0.f, 0.f, 0.f, 0.f, 0.f, 0.f, 0.f, 0.f, 0.f, 0.f, 0.f, 0.f, 0.f, 0.f, 0.f, 0.f};
    float m_run = 0.f, l_run = 0.f;
    f32x16 negm = (f32x16){0.f, 0.f, 0.f, 0.f, 0.f, 0.f, 0.f, 0.f, 0.f, 0.f, 0.f, 0.f, 0.f, 0.f, 0.f, 0.f};
    const int tq = q0w + r32;
    f32x16 s0, s1;
    auto qk = [&](int slot) { const LAS unsigned char* bp = lds + slot * KB + koff;
        s0 = negm; s1 = negm;
        constexpr int KH = (VAR == 0) ? 2 : 4;
#pragma unroll
        for (int h = 0; h < 4; h += KH) {
            bf16x8 kf[2 * KH];
#pragma unroll
            for (int d0 = 0; d0 < KH; ++d0) { kf[2 * d0] = *(const LAS bf16x8*)(bp + (h + d0) * 2048); kf[2 * d0 + 1] = *(const LAS bf16x8*)(bp + (h + d0) * 2048 + 512); }
            __builtin_amdgcn_sched_barrier(0);
#pragma unroll
            for (int d0 = 0; d0 < KH; ++d0) {
                s0 = __builtin_amdgcn_mfma_f32_32x32x16_bf16(kf[2 * d0], qr[h + d0], s0, 0, 0, 0);
                s1 = __builtin_amdgcn_mfma_f32_32x32x16_bf16(kf[2 * d0 + 1], qr[h + d0], s1, 0, 0, 0); }
            if (h + KH < 4) __builtin_amdgcn_sched_barrier(0);
        } };
    gloadK(0, 0); gloadV(0, 0);
    if (NT > 1) gloadK(1, 1);
    asm volatile("s_waitcnt vmcnt(0)" ::: "memory"); ATT_BAR();
    if (NT > 2) gloadK(2, 2);
    if (NT > 1) gloadV(1, 1);
    qk(0);
    ATT_BAR();
    if (half == 1) ATT_BAR();
    int k0 = 0;
    for (int t = 0; t < NT; ++t) {
        const bool more1 = t + 1 < NT, more2 = t + 2 < NT, more3 = t + 3 < NT;
        const int k1 = k0 == 2 ? 0 : k0 + 1, k2 = k1 == 2 ? 0 : k1 + 1;
        if (VAR == 2 && !ctxq && t >= 4) {
            const int lt = lt0 + t - 4, kb = 64 * lt + 4 * hi - tq;
            if (lt == qb - 2) {
#pragma unroll
                for (int r = 0; r < 16; ++r) { const int d = kb + (r & 3) + 8 * (r >> 2); if (d < -128) s0[r] = -1e30f; if (d + 32 < -128) s1[r] = -1e30f; }
            } else if (lt == qb + 2) {
#pragma unroll
                for (int r = 0; r < 16; ++r) { const int d = kb + (r & 3) + 8 * (r >> 2); if (d > 128) s0[r] = -1e30f; if (d + 32 > 128) s1[r] = -1e30f; }
            }
        }
        float ma = max3f(s0[0], s0[1], s1[0]), mb = max3f(s0[2], s0[3], s1[1]); ma = max3f(ma, s1[2], s1[3]);
#pragma unroll
        for (int r = 4; r < 16; r += 4) { ma = max3f(ma, s0[r], s0[r + 1]); mb = max3f(mb, s0[r + 2], s0[r + 3]); ma = max3f(ma, s1[r], s1[r + 1]); mb = max3f(mb, s1[r + 2], s1[r + 3]); }
        float mx = fmaxf(ma, mb);
        { const auto rr = __builtin_amdgcn_permlane32_swap(__float_as_uint(mx), __float_as_uint(mx), false, false); mx = fmaxf(__uint_as_float(rr[0]), __uint_as_float(rr[1])); }
        if (t == 0 || __any(mx > ATT_THR)) {
            const float dl = (t == 0) ? mx : fmaxf(mx, 0.f);
            m_run += dl;
#pragma unroll
            for (int r = 0; r < 16; ++r) { s0[r] -= dl; s1[r] -= dl; negm[r] = -m_run; }
            const float f = fast_exp2(-dl);
            l_run *= f;
            if (hi == 0) wsf[r32] = f;
            LDS_WAIT();
#pragma unroll
            for (int r = 0; r < 16; ++r) { const float al = wsf[crow(r, hi)];
#pragma unroll
                for (int d = 0; d < NDB; ++d) o[d][r] *= al; }
        }
        float la = 0.f, lb = 0.f;
#pragma unroll
        for (int r = 0; r < 16; ++r) { s0[r] = fast_exp2(s0[r]); s1[r] = fast_exp2(s1[r]); la += s0[r]; lb += s1[r]; }
        l_run += la + lb;
        bf16x8 pa[4];
        { u32x4 w;
          w.x = cvt_pk_bf16(s0[0], s0[1]); w.y = cvt_pk_bf16(s0[2], s0[3]); w.z = cvt_pk_bf16(s0[4], s0[5]); w.w = cvt_pk_bf16(s0[6], s0[7]); pa[0] = __builtin_bit_cast(bf16x8, w);
          w.x = cvt_pk_bf16(s0[8], s0[9]); w.y = cvt_pk_bf16(s0[10], s0[11]); w.z = cvt_pk_bf16(s0[12], s0[13]); w.w = cvt_pk_bf16(s0[14], s0[15]); pa[1] = __builtin_bit_cast(bf16x8, w);
          w.x = cvt_pk_bf16(s1[0], s1[1]); w.y = cvt_pk_bf16(s1[2], s1[3]); w.z = cvt_pk_bf16(s1[4], s1[5]); w.w = cvt_pk_bf16(s1[6], s1[7]); pa[2] = __builtin_bit_cast(bf16x8, w);
          w.x = cvt_pk_bf16(s1[8], s1[9]); w.y = cvt_pk_bf16(s1[10], s1[11]); w.z = cvt_pk_bf16(s1[12], s1[13]); w.w = cvt_pk_bf16(s1[14], s1[15]); pa[3] = __builtin_bit_cast(bf16x8, w); }
        ATT_BAR();
        if (more3) gloadK(t + 3, k0);
        if (more2) gloadV(t + 2, k2);
        const LAS unsigned char* vp = lds + VBASE + k0 * VB + vlane;
        s16x4 va_lo[NDB], va_hi[NDB], vb_lo[NDB], vb_hi[NDB];
#define ATT_VLOAD(LO, HI, KS) do { _Pragma("unroll") for (int d = 0; d < NDB; ++d) { LO[d] = vtr(vp + d * 4096 + (KS) * 1024); HI[d] = vtr(vp + d * 4096 + (KS) * 1024 + 512); } } while (0)
#define ATT_VMMA(LO, HI, KS) do { _Pragma("unroll") for (int d = 0; d < NDB; ++d) { const bf16x8 vf = (bf16x8){LO[d][0], LO[d][1], LO[d][2], LO[d][3], HI[d][0], HI[d][1], HI[d][2], HI[d][3]}; \
            o[d] = __builtin_amdgcn_mfma_f32_32x32x16_bf16(pa[KS], vf, o[d], 0, 0, 0); } } while (0)
        ATT_VLOAD(va_lo, va_hi, 0); ATT_VLOAD(vb_lo, vb_hi, 1);
        __builtin_amdgcn_sched_barrier(0);
        ATT_VMMA(va_lo, va_hi, 0);
        __builtin_amdgcn_sched_barrier(0);
        ATT_VLOAD(va_lo, va_hi, 2);
        __builtin_amdgcn_sched_barrier(0);
        ATT_VMMA(vb_lo, vb_hi, 1);
        __builtin_amdgcn_sched_barrier(0);
        ATT_VLOAD(vb_lo, vb_hi, 3);
        __builtin_amdgcn_sched_barrier(0);
        ATT_VMMA(va_lo, va_hi, 2);
        ATT_VMMA(vb_lo, vb_hi, 3);
#undef ATT_VLOAD
#undef ATT_VMMA
        if (more1) qk(k1);
        if (more3) { if (NLD == 2) asm volatile("s_waitcnt vmcnt(4)" ::: "memory"); else asm volatile("s_waitcnt vmcnt(2)" ::: "memory"); }
        else if (more2) { if (NLD == 2) asm volatile("s_waitcnt vmcnt(2)" ::: "memory"); else asm volatile("s_waitcnt vmcnt(1)" ::: "memory"); }
        else asm volatile("s_waitcnt vmcnt(0)" ::: "memory");
        ATT_BAR();
        k0 = k1;
    }
    if (half == 0) ATT_BAR();
    { float l_tot; { const auto rr = __builtin_amdgcn_permlane32_swap(__float_as_uint(l_run), __float_as_uint(l_run), false, false); l_tot = __uint_as_float(rr[0]) + __uint_as_float(rr[1]); }
      if (VAR == 2) l_tot += fast_exp2(ac.sink[hh * 4 + g] * LOG2E - m_run);
      if (hi == 0) wsf[r32] = 1.0f / l_tot;
      LDS_WAIT();
#pragma unroll
      for (int r = 0; r < 16; ++r) { const float il = wsf[crow(r, hi)];
#pragma unroll
          for (int d = 0; d < NDB; ++d) o[d][r] *= il; } }
    GAS bf16_t* Og = (GAS bf16_t*)ac.O;
    if (VAR != 0) {
#pragma unroll
        for (int r = 0; r < 16; ++r) { GAS bf16_t* op = Og + (size_t)(qrow0 + crow(r, hi)) * OW + ocol + r32;
#pragma unroll
            for (int d = 0; d < NDB; ++d) op[d * 32] = f2bf(o[d][r]); }
    } else {
        LAS float* tile = (LAS float*)lds + ((wid & 3) * 2 + map) * (32 * 132);
#pragma unroll
        for (int r = 0; r < 16; ++r)
#pragma unroll
            for (int d = 0; d < NDB; ++d) tile[crow(r, hi) * 132 + d * 32 + r32] = o[d][r];
        __syncthreads();
        const int ql = (wid >> 2) * 16 + (lane >> 2), part = lane & 3;
        const LAS float* t0 = (const LAS float*)lds + ((wid & 3) * 2) * (32 * 132) + ql * 132 + part * 32;
        const LAS float* t1 = t0 + 32 * 132;
        f32x4 dv[8]; float ss = 0.f;
#pragma unroll
        for (int j = 0; j < 8; ++j) { const f32x4 a = *(const LAS f32x4*)(t0 + 4 * j), bq = *(const LAS f32x4*)(t1 + 4 * j); dv[j] = a - ac.lam * bq;
            ss += (dv[j][0] * dv[j][0] + dv[j][1] * dv[j][1]) + (dv[j][2] * dv[j][2] + dv[j][3] * dv[j][3]); }
        ss += __shfl_xor(ss, 1); ss += __shfl_xor(ss, 2);
        const float rs = ac.one_m_li / sqrtf(ss * (1.0f / 128.0f) + 1e-5f);
        const GAS float* gp = (const GAS float*)ac.subln_g + part * 32;
        GAS bf16_t* op = Og + (size_t)((ctxq ? ctxbase : latbase) + qb * qpb + (wid & 3) * 32 + ql) * OW + ocol + part * 32;
#pragma unroll
        for (int k = 0; k < 4; ++k) { const f32x4 g0 = *(const GAS f32x4*)(gp + 8 * k), g1 = *(const GAS f32x4*)(gp + 8 * k + 4);
            const f32x4 v0 = dv[2 * k] * g0 * rs, v1 = dv[2 * k + 1] * g1 * rs;
            u32x4 w; w.x = cvt_pk_bf16(v0[0], v0[1]); w.y = cvt_pk_bf16(v0[2], v0[3]); w.z = cvt_pk_bf16(v1[0], v1[1]); w.w = cvt_pk_bf16(v1[2], v1[3]);
            *(GAS u32x4*)(op + 8 * k) = w; }
    }
}

using pg8::Unit;
struct SchedInproj {
    int c, G, nM, ntot, nfz; const char* xn; const char* win; const char* wfz; char* p; char* zz; char* zzc; const char* rope; char* gates;
    __device__ __forceinline__ bool next(int i, Unit& u) const {
        const int L = i * G + c; if (L >= ntot + nfz) return false;
        u.aux = nullptr; u.aux2 = nullptr;
        if (L < ntot) { int pm, pn; pg8::tile_of(L, nM, 28, pm, pn);
            u.A = xn + (size_t)pm * 256 * DM * 2; u.B = win + (size_t)pn * 256 * DM * 2; if (pn < 12) { u.out = p + ((size_t)pm * 256 * PW + pn * 256) * 2; u.ldc = PW; } else { u.out = gates + ((size_t)pm * 256 * GW + (pn - 12) * 256); u.ldc = GW; }
            int fl = pm < 64 ? 16 : 0;
            if (pn >= 12) fl |= 1; else if (pn < 2) fl |= 2 | 8; else if (pn < 4) fl |= 2; else if (pn == 9 || pn == 10) fl |= 2 | 8; else if (pn == 11) fl |= 4;
            u.flag = fl; u.aux = rope + (size_t)((pm * 256) & 2047) * 64 * 4; }
        else { const int q = L - ntot;
            if (q < 256) { const int b = q >> 5, pm = (q >> 3) & 3, pn = q & 7;
                u.A = wfz + (size_t)pm * 256 * DM * 2; u.B = xn + (size_t)(b * SEQ + pn * 256) * DM * 2;
                u.out = zz + ((size_t)b * 512 * 4096 + (size_t)((pm & 1) * 256) * 4096 + (pm >> 1) * 2048 + pn * 256) * 2; u.ldc = 4096; u.flag = 0; }
            else { const int q2 = q - 256, b = q2 >> 2, pm = q2 & 3;
                u.A = wfz + (size_t)pm * 256 * DM * 2; u.B = xn + (size_t)(NLAT + b * CTXL) * DM * 2;
                u.out = zzc + ((size_t)b * 512 * 512 + (size_t)((pm & 1) * 256) * 512 + (pm >> 1) * 256) * 2; u.ldc = 512; u.flag = 0; } }
        return true;
    }
};
struct SchedDft {
    int c; const char* T; const char* zz; char* o;
    __device__ __forceinline__ bool next(int i, Unit& u) const {
        if (i > 0 || c >= 128) return false;
        const int b = c >> 4, pm = (c >> 1) & 7, pn = c & 1;
        u.A = T + (size_t)pm * 256 * 4096 * 2; u.B = zz + ((size_t)b * 512 + pn * 256) * 4096 * 2;
        u.out = o + ((size_t)(b * SEQ + pm * 256) * OW + 1536 + pn * 256) * 2; u.ldc = OW; u.flag = 0; u.aux = nullptr; u.aux2 = nullptr; return true;
    }
};
struct SchedDftCtx {
    int c; const char* T; const char* zzc; char* o;
    __device__ __forceinline__ bool next(int i, Unit& u) const {
        if (i > 0 || c < 128 || c >= 144) return false;
        const int q = c - 128, b = q >> 1, pn = q & 1;
        u.A = T; u.B = zzc + ((size_t)b * 512 + pn * 256) * 512 * 2;
        u.out = o + ((size_t)(NLAT + b * CTXL) * OW + 1536 + pn * 256) * 2; u.ldc = OW; u.flag = 0; u.aux = nullptr; u.aux2 = nullptr; return true;
    }
};
struct SchedBranch {
    int c, G, ntile; const char* o; const char* wbr; const char* p; char* merged;
    __device__ __forceinline__ bool next(int i, pg8::BUnit& u) const {
        const int xcd = c & 7, j = i * (G >> 3) + (c >> 3), pm = xcd + 8 * (j >> 3), pn2 = j & 7;
        if (pm * 8 >= ntile) return false;
        u.A = o + (size_t)pm * 256 * OW * 2; u.B = wbr + (size_t)pn2 * 128 * 2048 * 2;
        u.gate = p + ((size_t)pm * 256 * GW + pn2 * 128);
        u.out = merged + ((size_t)pm * 256 * 1024 + pn2 * 128) * 2; return true;
    }
};
struct SchedResid {
    int c, G, nM, K; const char* A; const char* B; char* xs; const char* modv; int goff; const char* xin; const char* cin;
    __device__ __forceinline__ bool next(int i, Unit& u) const {
        const int L = i * G + c; if (L >= nM * 4) return false;
        int pm, pn; pg8::tile_of(L, nM, 4, pm, pn);
        u.A = A + (size_t)pm * 256 * K * 2; u.B = B + (size_t)pn * 256 * K * 2; u.out = xs + ((size_t)pm * 256 * DM + pn * 256) * 2; u.ldc = DM;
        u.aux = modv + ((size_t)(pm < 64 ? (pm >> 3) : 8) * 6144 + goff + pn * 256) * 4; u.flag = xin ? 1 : 0;
        u.aux2 = xin ? (pm < 64 ? xin + ((size_t)pm * 256 * DM + pn * 256) * 4 : cin + ((size_t)(pm - 64) * 256 * DM + pn * 256) * 4) : (const char*)u.out; return true;
    }
};
struct SchedUp {
    int c, G, nM; const char* xn; const char* w; char* h;
    __device__ __forceinline__ bool next(int i, Unit& u) const {
        const int L = i * G + c; if (L >= nM * 22) return false;
        int pm, pn; pg8::tile_of(L, nM, 22, pm, pn);
        u.A = xn + (size_t)pm * 256 * DM * 2; u.B = w + (size_t)pn * 256 * DM * 2; u.out = h + ((size_t)pm * 256 * DFF + pn * 128) * 2; u.ldc = DFF; u.flag = 0; u.aux = nullptr; u.aux2 = nullptr; return true;
    }
};
struct SchedMoe {
    int c, G, NT, K, RT; MoeTiles mt; const char* A; const char* W; size_t wsub; char* out; int ldc, colw, esz;
    __device__ __forceinline__ bool next(int i, Unit& u) const {
        const int L0 = i * G + c, ntot = RT * NT; if (L0 >= ntot) return false;
        int L = L0; if (NT > 4) { const int q = ntot / 8, r = ntot % 8, xcd = L0 % 8, off = L0 / 8; L = (xcd < r ? xcd * (q + 1) : r * (q + 1) + (xcd - r) * q) + off; }
        const int gs = 8 * NT, g8 = L / gs, rem = L % gs, left = RT - 8 * g8, gsz = left < 8 ? left : 8;
        const int rt = 8 * g8 + rem % gsz, pn = rem / gsz;
        int e = 0;
#pragma unroll
        for (int k = 1; k < 8; ++k) e += (rt >= mt.tb[k]) ? 1 : 0;
        u.A = A + (size_t)rt * 256 * K * 2; u.B = W + (size_t)e * W_EXPERT + wsub + (size_t)pn * 256 * K * 2;
        u.out = out + ((size_t)rt * 256 * ldc + (size_t)pn * colw) * esz; u.ldc = ldc; u.flag = 0; u.aux = nullptr; u.aux2 = nullptr; return true;
    }
};

struct SchedMoeSplit {
    int c, G, RF, RT; MoeTiles mt; const char* A; const char* W; char* y0; char* y1;
    __device__ __forceinline__ bool next(int i, Unit& u) const {
        const int L = i * G + c; if (L >= (RT - RF) * 8) return false;
        const int ts = L >> 1, kh = L & 1, rt = RF + (ts >> 2), pn = ts & 3;
        int e = 0;
#pragma unroll
        for (int k = 1; k < 8; ++k) e += (rt >= mt.tb[k]) ? 1 : 0;
        u.A = A + ((size_t)rt * 256 * DFE + kh * (DFE / 2)) * 2; u.B = W + (size_t)e * W_EXPERT + W_MD + ((size_t)pn * 256 * DFE + kh * (DFE / 2)) * 2;
        u.out = kh ? y1 + ((size_t)(rt - RF) * 256 * DM + pn * 256) * 2 : y0 + ((size_t)rt * 256 * DM + pn * 256) * 2;
        u.ldc = DM; u.flag = 0; u.aux = nullptr; u.aux2 = nullptr; return true;
    }
};

#define LAUNDER_S(x) asm volatile("" : "+s"(x))
#define LAUNDER_V(x) asm volatile("" : "+v"(x))
constexpr int LDS_ARGOFF = LDS_CTLOFF + 512;
__device__ __forceinline__ const float* ARGP(LAS unsigned char* lds, int i) {
    unsigned off = LDS_ARGOFF + 8 * i; asm volatile("" : "+s"(off));
    volatile LAS unsigned* p = (volatile LAS unsigned*)(lds + off);
    const unsigned lo = __builtin_amdgcn_readfirstlane(p[0]), hi = __builtin_amdgcn_readfirstlane(p[1]);
    return (const float*)(((unsigned long long)hi << 32) | lo);
}
__device__ __forceinline__ void grid_barrier(LAS unsigned char* lds, int wv) {
    XcdBarrier b; b.bar = (unsigned*)((unsigned char*)ARGP(lds, 24) + WS_CTL) + CW_BAR; b.x = xb_xcc_id(); b.st = (volatile LAS unsigned*)(lds + LDS_CTLOFF);
    xcd_barrier(b, wv == 0 && lane_id() == 0);
}
struct Fr { LAS unsigned char* lds; unsigned char* ws; int tid, lane, wave, bid, G, gw, NGW; unsigned* ctl; };
__device__ __forceinline__ Fr make_frame(LAS unsigned char* lds, int wv) {
    Fr F; F.lds = lds;
    F.ws = (unsigned char*)ARGP(lds, 24); int t = wv * 64 + lane_id(); LAUNDER_V(t); F.tid = t; F.lane = t & 63; F.wave = wv;
    int b = blockIdx.x; LAUNDER_S(b); F.bid = b; int g = gridDim.x; LAUNDER_S(g); F.G = g; F.gw = b * 8 + F.wave; F.NGW = g * 8; F.ctl = (unsigned*)(F.ws + WS_CTL);
    return F;
}

constexpr int CV_PRO = 4 * CV_LAYER + 2 * CV_DENSE;
constexpr int CV_M1 = CV_PRO, CV_M3 = CV_PRO + 8 * CV_EXP;
constexpr int BG_BR = 192 * 8 * 6, BG_OUT = 224 * 8 * 4, BG_DD = 224 * 8 * 12;
static_assert(BG_BR + BG_OUT + BG_DD + BG_BR >= 8 * CV_EXP && BG_OUT + BG_BR + BG_OUT + BG_DD >= 8 * CV_EXP, "windows cover both expert sets");
__device__ __forceinline__ void convert_range(LAS unsigned char* lds, const Fr& F, int start, int end, int gwi, int nw) {
    Args a;
#pragma unroll
    for (int i = 0; i < 23; ++i) a.in[i] = ARGP(lds, i);
    a.out = nullptr; a.ws = F.ws;
    LAS float* scr = (LAS float*)(lds + F.wave * 8704);
    float ra[32], rb[32]; ConvDesc d, dn; int it = start + gwi; bool have = it < end;
    if (have) { d = conv_decode(a, it); conv_load(d, ra, F.lane); }
    while (have) {
        const int itn = it + nw; const bool hn = itn < end;
        if (hn) { dn = conv_decode(a, itn); conv_load(dn, rb, F.lane); }
        conv_store(d, ra, scr, F.lane);
        if (hn) {
#pragma unroll
            for (int i = 0; i < 32; ++i) ra[i] = rb[i];
            d = dn; }
        it = itn; have = hn;
    }
}
__device__ __forceinline__ void bg_window(int kind, int l, int& s, int& e) {
    s = 0; e = 0;
    const int m1a = CV_M1, m1b = m1a + BG_BR, m1c = m1b + BG_OUT, m1d = m1c + BG_DD, m1e = CV_M3;
    const int m3a = CV_M3, m3b = m3a + BG_OUT, m3c = m3b + BG_BR, m3d = m3c + BG_OUT, m3e = CV_TOTAL;
    if (kind == 0) { if (l == 0) { s = m1a; e = m1b; } else if (l == 1) { s = m1d; e = m1e; } else if (l == 2) { s = m3b; e = m3c; } }
    else if (kind == 1) { if (l == 0) { s = m1b; e = m1c; } else if (l == 1) { s = m3a; e = m3b; } else if (l == 2) { s = m3c; e = m3d; } }
    else { if (l == 0) { s = m1c; e = m1d; } else if (l == 2) { s = m3d; e = m3e; } }
}
__device__ __forceinline__ void phase_prologue(LAS unsigned char* lds, int wv) {
    const Fr F = make_frame(lds, wv);
    Args a;
#pragma unroll
    for (int i = 0; i < 23; ++i) a.in[i] = ARGP(lds, i);
    a.out = nullptr; a.ws = F.ws;
    if (F.bid < 24) mod_item(a, F.bid, lds, F.tid);
    for (int it = F.gw; it < 512; it += F.NGW) fzfold_item(a, it, F.lane);
    convert_range(lds, F, 0, CV_LAYER, F.gw, F.NGW);
    float* rope = (float*)(F.ws + WS_ROPE);
    for (int i = F.gw * 64 + F.lane; i < SEQ * 64; i += F.NGW * 64) { const int t = i >> 6, j = i & 63, ax = j >> 5, isin = (j >> 4) & 1, f = j & 15;
        const float pos = (float)(ax == 0 ? (t >> 6) : (t & 63));
        const float inv = powf(10000.0f, -(float)f / 16.0f); const float ang = pos * inv;
        rope[i] = isin ? sinf(ang) : cosf(ang); }
    bf16_t* T = (bf16_t*)(F.ws + WS_T);
    for (int i = F.gw * 64 + F.lane; i < 2048 * 2048; i += F.NGW * 64) { const int k = i >> 11, n = i & 2047; const float x = (float)((k * n) & 2047) * (1.0f / 1024.0f);
        T[(size_t)k * 4096 + n] = f2bf(cospif(x)); T[(size_t)k * 4096 + 2048 + n] = f2bf(-sinpif(x)); }
    bf16_t* T2 = (bf16_t*)(F.ws + WS_T256);
    for (int i = F.gw * 64 + F.lane; i < 256 * 256; i += F.NGW * 64) { const int k = i >> 8, n = i & 255; const float x = (float)((k * n) & 255) * (1.0f / 128.0f);
        T2[k * 512 + n] = f2bf(cospif(x)); T2[k * 512 + 256 + n] = f2bf(-sinpif(x)); }
}
__device__ __forceinline__ void phase_first_norm(LAS unsigned char* lds, int wv) {
    const Fr F = make_frame(lds, wv);
    const float* X = ARGP(lds, I_X); const float* CX = ARGP(lds, I_CTX); const float* n1g = ARGP(lds, I_N1G);
    float* xs = (float*)(F.ws + WS_XS); bf16_t* xn = (bf16_t*)(F.ws + WS_XN); const float* modv_all = (const float*)(F.ws + WS_MODV);
    for (int row = F.gw; row < NTOK; row += F.NGW) {
        const float* src = row < NLAT ? X + (size_t)row * DM : CX + (size_t)(row - NLAT) * DM;
        const RowV x = load_row_f32(src, F.lane);
        const float* mv = modv_all + (size_t)mod_row_of(row) * 6144;
        const RowV y = adaln_row(x, n1g, mv, mv + 1024, F.lane);
        store_row_bf16(xn + (size_t)row * DM, y, F.lane);
    }
}
__device__ __forceinline__ void phase_inproj(LAS unsigned char* lds, int wv, int l) {
    const Fr F = make_frame(lds, wv); unsigned char* ws = F.ws; const bool lastl = l == DEPTH - 1;
    SchedInproj S{F.bid, F.G, NTOK / 256, (NTOK / 256) * 28, lastl ? 256 : 288, (const char*)(ws + WS_XN), (const char*)w_layer(ws, l, W_IN), (const char*)w_layer(ws, l, W_FZ), (char*)(ws + WS_P), (char*)(ws + WS_ZZ), (char*)(ws + WS_ZZC), (const char*)(ws + WS_ROPE), (char*)(ws + WS_G)};
    pg8::EpiInproj E{};
    pg8::gemm_phase<pg8::EpiInproj, SchedInproj, true, true>(lds, F.tid, DM, DM, DM, S, E);
}
__device__ __forceinline__ void phase_post(LAS unsigned char* lds, int wv, int l) {
    const Fr F = make_frame(lds, wv);
    GAS bf16_t* P = (GAS bf16_t*)(F.ws + WS_P); const GAS float* rope = (const GAS float*)(F.ws + WS_ROPE);
    const GAS float* gq = (const GAS float*)ARGP(lds, I_QKG) + l * 128; const GAS float* gk = gq + 64;
    const int lane = F.lane, a = (lane & 7) >> 2, i0 = 4 * (lane & 3);
    float gqv[8], gkv[8];
#pragma unroll
    for (int e = 0; e < 8; ++e) { const int d = 32 * a + 16 * (e & 1) + i0 + (e >> 1); gqv[e] = gq[d]; gkv[e] = gk[d]; }
    for (int row = F.gw; row < NTOK; row += F.NGW) {
        GAS bf16_t* pr = P + (size_t)row * PW;
        const bool lat = row < NLAT;
        f32x4 cs = (f32x4){1.f, 1.f, 1.f, 1.f}, sn = (f32x4){0.f, 0.f, 0.f, 0.f};
        if (lat) { const GAS float* rt = rope + (size_t)(row & 2047) * 64 + a * 32 + i0; cs = *(const GAS f32x4*)rt; sn = *(const GAS f32x4*)(rt + 16); }
        const u32x4 qw = *(const GAS u32x4*)(pr + C_BQ + 8 * lane);
        u32x4 kw = (u32x4){0u, 0u, 0u, 0u};
        if (lane < 16) kw = *(const GAS u32x4*)(pr + C_BK + 8 * lane);
        float x[8], y[8];
        x[0] = bf_lo(qw.x); x[1] = bf_hi(qw.x); x[2] = bf_lo(qw.y); x[3] = bf_hi(qw.y); x[4] = bf_lo(qw.z); x[5] = bf_hi(qw.z); x[6] = bf_lo(qw.w); x[7] = bf_hi(qw.w);
        y[0] = bf_lo(kw.x); y[1] = bf_hi(kw.x); y[2] = bf_lo(kw.y); y[3] = bf_hi(kw.y); y[4] = bf_lo(kw.z); y[5] = bf_hi(kw.z); y[6] = bf_lo(kw.w); y[7] = bf_hi(kw.w);
        float sq = 0.f, sk = 0.f;
#pragma unroll
        for (int e = 0; e < 8; ++e) { sq += x[e] * x[e]; sk += y[e] * y[e]; }
        sq += __shfl_xor(sq, 1); sq += __shfl_xor(sq, 2); sq += __shfl_xor(sq, 4);
        sk += __shfl_xor(sk, 1); sk += __shfl_xor(sk, 2); sk += __shfl_xor(sk, 4);
        const float rq = 1.0f / sqrtf(sq * (1.0f / 64.0f) + 1e-6f), rk = 1.0f / sqrtf(sk * (1.0f / 64.0f) + 1e-6f);
#pragma unroll
        for (int e = 0; e < 8; ++e) { x[e] *= rq * gqv[e]; y[e] *= rk * gkv[e]; }
        float xo[8], yo[8];
#pragma unroll
        for (int p2 = 0; p2 < 4; ++p2) { const float c = cs[p2], s = sn[p2];
            xo[2 * p2] = (x[2 * p2] * c - x[2 * p2 + 1] * s) * C2; xo[2 * p2 + 1] = (x[2 * p2 + 1] * c + x[2 * p2] * s) * C2;
            yo[2 * p2] = y[2 * p2] * c - y[2 * p2 + 1] * s; yo[2 * p2 + 1] = y[2 * p2 + 1] * c + y[2 * p2] * s; }
        u32x4 ow; ow.x = cvt_pk_bf16(xo[0], xo[1]); ow.y = cvt_pk_bf16(xo[2], xo[3]); ow.z = cvt_pk_bf16(xo[4], xo[5]); ow.w = cvt_pk_bf16(xo[6], xo[7]);
        *(GAS u32x4*)(pr + C_BQ + 8 * lane) = ow;
        if (lane < 16) { u32x4 kk; kk.x = cvt_pk_bf16(yo[0], yo[1]); kk.y = cvt_pk_bf16(yo[2], yo[3]); kk.z = cvt_pk_bf16(yo[4], yo[5]); kk.w = cvt_pk_bf16(yo[6], yo[7]);
            *(GAS u32x4*)(pr + C_BK + 8 * lane) = kk; }
    }
}
constexpr int CVQ_BLK = 32, CVQ_UNITS = (CV_PRO - CV_LAYER) / (8 * CVQ_BLK);
static_assert(CVQ_UNITS * 8 * CVQ_BLK == CV_PRO - CV_LAYER, "conversion units tile the deferred block range");
__device__ __forceinline__ void phase_mix(LAS unsigned char* lds, int wv, int l, int rep) {
    const Fr F = make_frame(lds, wv); unsigned char* ws = F.ws; const bool lastl = l == DEPTH - 1;
    volatile LAS unsigned* LCTL = (volatile LAS unsigned*)(lds + LDS_CTLOFF);
    { SchedDft S{F.bid, (const char*)(ws + WS_T), (const char*)(ws + WS_ZZ), (char*)(ws + WS_O)}; pg8::EpiStore E{1.0f / 362.03867196751236f};
      pg8::gemm_phase<pg8::EpiStore, SchedDft, false, true>(lds, F.tid, 4096, 4096, 4096, S, E); }
    if (!lastl) { SchedDftCtx S{F.bid, (const char*)(ws + WS_T256), (const char*)(ws + WS_ZZC), (char*)(ws + WS_O)}; pg8::EpiStore E{1.0f / 128.0f};
      pg8::gemm_phase<pg8::EpiStore, SchedDftCtx, false, true>(lds, F.tid, 512, 512, 512, S, E); }
    float c08 = 0.8f; asm volatile("" : "+v"(c08));
    const float li = c08 - 0.6f * expf(-0.3f * (float)l);
    const float* lp = ARGP(lds, I_DLAM) + l * 256;
    float d01 = 0.f, d23 = 0.f;
    for (int k = 0; k < 64; ++k) { d01 += lp[k] * lp[64 + k]; d23 += lp[128 + k] * lp[192 + k]; }
    const float lam_u = __builtin_bit_cast(float, __builtin_amdgcn_readfirstlane(__builtin_bit_cast(int, expf(d01) - expf(d23) + li)));
    const float oml_u = __builtin_bit_cast(float, __builtin_amdgcn_readfirstlane(__builtin_bit_cast(int, 1.0f - li)));
    AttnCtx ac{(const bf16_t*)(ws + WS_P), (bf16_t*)(ws + WS_O), ARGP(lds, I_SUBLN) + l * 128, lam_u, oml_u, ARGP(lds, I_SINK) + l * 8};
    const int NUB = lastl ? 192 : 216;
    const int NCV = (l == 0 && rep == 0) ? 9 + CVQ_UNITS + 24 : 0;
    const int bq = F.bid & 7;
    unsigned* qc = F.ctl + CW_Q + 64 * (8 * (l + 4 * rep) + bq);
    for (;;) {
        __syncthreads();
        if (F.tid == 0) LCTL[2] = xb_add(qc, 1u);
        __syncthreads();
        const int u = __builtin_amdgcn_readfirstlane((int)LCTL[2]);
        if (u >= NUB + NCV) break;
        if (u >= NUB) {
            const int v = u - NUB;
            if (v < 9) { Args a;
#pragma unroll
                for (int i = 0; i < 23; ++i) a.in[i] = ARGP(lds, i);
                a.out = nullptr; a.ws = F.ws; mod_item(a, 24 + v * 8 + bq, lds, F.tid); }
            else if (v < 9 + CVQ_UNITS) { const int s = CV_LAYER + ((v - 9) * 8 + bq) * CVQ_BLK; convert_range(lds, F, s, s + CVQ_BLK, F.wave, 8); }
            else { Args a;
#pragma unroll
                for (int i = 0; i < 23; ++i) a.in[i] = ARGP(lds, i);
                a.out = nullptr; a.ws = F.ws; fzfold_item(a, 512 + ((v - 9 - CVQ_UNITS) * 8 + bq) * 8 + F.wave, F.lane); }
            continue; }
        int tl = F.tid; LAUNDER_V(tl);
        if (u < 64) attn_unit<0>(lds, tl, ac, bq, u >> 4, u & 15, false);
        else if (u < 128) { const int v = u - 64; attn_unit<1>(lds, tl, ac, bq, v >> 5, v & 31, false); }
        else if (u < 192) { const int v = u - 128; attn_unit<2>(lds, tl, ac, bq, v >> 5, v & 31, false); }
        else if (u < 200) { const int v = u - 192; attn_unit<0>(lds, tl, ac, bq, v >> 1, v & 1, true); }
        else if (u < 208) { const int v = u - 200; attn_unit<1>(lds, tl, ac, bq, v >> 2, v & 3, true); }
        else { const int v = u - 208; attn_unit<2>(lds, tl, ac, bq, v >> 2, v & 3, true); }
    }
}
__device__ __forceinline__ void phase_branch(LAS unsigned char* lds, int wv, int l) {
    const Fr F = make_frame(lds, wv); unsigned char* ws = F.ws; const int nMact = (l == DEPTH - 1) ? NLAT / 256 : NTOK / 256;
    SchedBranch S{F.bid, F.G, nMact * 8, (const char*)(ws + WS_O), (const char*)w_layer(ws, l, W_BR), (const char*)(ws + WS_G), (char*)(ws + WS_XN)};
    pg8::branch_phase<SchedBranch>(lds, F.tid, S);
    if (nMact == NTOK / 256 && (F.bid >> 3) >= 8) {
        int s, e; bg_window(0, l, s, e);
        if (e > s) convert_range(lds, F, s, e, ((F.bid & 7) * 24 + (F.bid >> 3) - 8) * 8 + F.wave, 192 * 8);
    }
}
__device__ __forceinline__ void phase_out(LAS unsigned char* lds, int wv, int l) {
    const Fr F = make_frame(lds, wv); unsigned char* ws = F.ws; const int nMact = (l == DEPTH - 1) ? NLAT / 256 : NTOK / 256;
    SchedResid S{F.bid, F.G, nMact, DM, (const char*)(ws + WS_XN), (const char*)w_layer(ws, l, W_OUT), (char*)(ws + WS_XS), (const char*)(ws + WS_MODV + (size_t)l * 9 * 6144 * 4), 2048, l == 0 ? (const char*)ARGP(lds, I_X) : nullptr, l == 0 ? (const char*)ARGP(lds, I_CTX) : nullptr};
    pg8::EpiResid E{};
    pg8::gemm_phase<pg8::EpiResid, SchedResid, true, true>(lds, F.tid, DM, DM, DM, S, E);
    if (nMact == NTOK / 256 && F.bid >= 32) {
        int s, e; bg_window(1, l, s, e);
        if (e > s) convert_range(lds, F, s, e, (F.bid - 32) * 8 + F.wave, 224 * 8);
    }
}
__device__ __forceinline__ void phase_norm2_dense(LAS unsigned char* lds, int wv, int l) {
    const Fr F = make_frame(lds, wv); const int nrows = (l == DEPTH - 1) ? NLAT : NTOK;
    const bf16_t* xs = (const bf16_t*)(F.ws + WS_XS); bf16_t* xn = (bf16_t*)(F.ws + WS_XN); const float* modv = (const float*)(F.ws + WS_MODV) + (size_t)l * 9 * 6144;
    const float* n2g = ARGP(lds, I_N2G) + l * DM;
    const int rpw = nrows / F.NGW, r0 = F.gw * rpw, r1 = r0 + rpw;
    AdaCoef co; co.mr = -1;
    for (int r = r0; r < r1; r += 3) {
        RowV x[3];
#pragma unroll
        for (int q = 0; q < 3; ++q) x[q] = load_row_bf16(xs + (size_t)(r + q < r1 ? r + q : r) * DM, F.lane);
#pragma unroll
        for (int q = 0; q < 3; ++q) if (r + q < r1) { ada_coef_update(co, r + q, n2g, modv, 3072, 4096, F.lane); store_row_bf16(xn + (size_t)(r + q) * DM, adaln_apply(x[q], co), F.lane); }
    }
}
__device__ __forceinline__ void phase_up_dense(LAS unsigned char* lds, int wv, int l) {
    const Fr F = make_frame(lds, wv); unsigned char* ws = F.ws; const int nMact = (l == DEPTH - 1) ? NLAT / 256 : NTOK / 256;
    SchedUp S{F.bid, F.G, nMact, (const char*)(ws + WS_XN), (const char*)w_dense(ws, l >> 1, W_DGU), (char*)(ws + WS_P)};
    pg8::EpiSwiglu E{};
    pg8::gemm_phase<pg8::EpiSwiglu, SchedUp, true, true>(lds, F.tid, DM, DM, DM, S, E);
}
__device__ __forceinline__ void phase_down_dense(LAS unsigned char* lds, int wv, int l) {
    const Fr F = make_frame(lds, wv); unsigned char* ws = F.ws; const int nMact = (l == DEPTH - 1) ? NLAT / 256 : NTOK / 256;
    SchedResid S{F.bid, F.G, nMact, DFF, (const char*)(ws + WS_P), (const char*)w_dense(ws, l >> 1, W_DD), (char*)(ws + WS_XS), (const char*)(ws + WS_MODV + (size_t)l * 9 * 6144 * 4), 5120, nullptr, nullptr};
    pg8::EpiResid E{};
    pg8::gemm_phase<pg8::EpiResid, SchedResid, true, true>(lds, F.tid, DFF, DFF, DFF, S, E);
    if (nMact == NTOK / 256 && F.bid >= 32) {
        int s, e; bg_window(2, l, s, e);
        if (e > s) convert_range(lds, F, s, e, (F.bid - 32) * 8 + F.wave, 224 * 8);
    }
}
__device__ __forceinline__ void phase_norm2_moe(LAS unsigned char* lds, int wv, int l) {
    const Fr F = make_frame(lds, wv); const int nrows = (l == DEPTH - 1) ? NLAT : NTOK; const int mi = l >> 1;
    volatile LAS unsigned* LCTL = (volatile LAS unsigned*)(lds + LDS_CTLOFF);
    const bf16_t* xs = (const bf16_t*)(F.ws + WS_XS); bf16_t* xn = (bf16_t*)(F.ws + WS_XN); const float* modv = (const float*)(F.ws + WS_MODV) + (size_t)l * 9 * 6144;
    const float* n2g = ARGP(lds, I_N2G) + l * DM;
    int* toklist = (int*)(F.ws + WS_MOE); int* rec = toklist + 8 * NTOK;
    const int rpb = nrows / F.G;
    const int tid = F.tid, lane = F.lane;
    LAS int* lrec = (LAS int*)(lds + 1024);
    const float* rw = ARGP(lds, I_RW) + (size_t)mi * DM * 8;
    for (int rr = F.wave; rr < rpb; rr += 8) {
        const int row = F.bid * rpb + rr;
        const RowV x = load_row_bf16(xs + (size_t)row * DM, lane);
        const float* mv = modv + (size_t)mod_row_of(row) * 6144;
        const RowV y = adaln_row(x, n2g, mv + 3072, mv + 4096, lane);
        float lg[8];
#pragma unroll
        for (int e = 0; e < 8; ++e) lg[e] = 0.f;
#pragma unroll
        for (int j = 0; j < 4; ++j)
#pragma unroll
            for (int cc = 0; cc < 4; ++cc) { const float* wp = rw + (size_t)(256 * j + 4 * lane + cc) * 8; const f32x4 w0 = *(const f32x4*)wp, w1 = *(const f32x4*)(wp + 4); const float hv = y.v[j][cc];
                lg[0] += hv * w0[0]; lg[1] += hv * w0[1]; lg[2] += hv * w0[2]; lg[3] += hv * w0[3]; lg[4] += hv * w1[0]; lg[5] += hv * w1[1]; lg[6] += hv * w1[2]; lg[7] += hv * w1[3]; }
#pragma unroll
        for (int e = 0; e < 8; ++e) lg[e] = wave_sum(lg[e]);
        int i0 = 0; float v0 = lg[0];
#pragma unroll
        for (int e = 1; e < 8; ++e) if (lg[e] > v0) { v0 = lg[e]; i0 = e; }
        int i1 = -1; float v1 = -3.0e38f;
#pragma unroll
        for (int e = 0; e < 8; ++e) if (e != i0 && lg[e] > v1) { v1 = lg[e]; i1 = e; }
        if (lane == 0) {
            const float w0 = 1.0f / (1.0f + expf(v1 - v0)), w1 = 1.0f - w0;
            lrec[rr * 6 + 0] = i0; lrec[rr * 6 + 2] = __float_as_int(w0); lrec[rr * 6 + 3] = i1; lrec[rr * 6 + 5] = __float_as_int(w1);
        }
    }
    __syncthreads();
    { const int e = F.wave; int cnt = 0;
      for (int a0 = 0; a0 < 2 * rpb; a0 += 64) { const int a = a0 + lane; const bool valid = a < 2 * rpb; const int rr = a >> 1, k3 = 3 * (a & 1);
          const bool match = valid && lrec[rr * 6 + k3] == e;
          const unsigned long long bal = __ballot(match);
          if (match) lrec[rr * 6 + k3 + 1] = cnt + (int)__popcll(bal & ((1ull << lane) - 1ull));
          cnt += (int)__popcll(bal); }
      if (lane == 0) { toklist[F.bid * 8 + e] = cnt;
          (void)xb_add(F.ctl + CW_CNT + 64 * (8 * mi + e), (unsigned)cnt); } }
    __syncthreads();
    for (int rr = tid; rr < rpb; rr += 512) {
        const int row = F.bid * rpb + rr;
        int* rc = rec + (size_t)row * 8;
        rc[0] = lrec[rr * 6 + 0]; rc[1] = lrec[rr * 6 + 1]; rc[2] = lrec[rr * 6 + 2]; rc[3] = lrec[rr * 6 + 3]; rc[4] = lrec[rr * 6 + 4]; rc[5] = lrec[rr * 6 + 5];
    }
}
__device__ __forceinline__ void phase_moe_gather(LAS unsigned char* lds, int wv, int l) {
    const Fr F = make_frame(lds, wv); const int mi = l >> 1; const int nrows = (l == DEPTH - 1) ? NLAT : NTOK; const int rpb = nrows / F.G;
    volatile LAS unsigned* LCTL = (volatile LAS unsigned*)(lds + LDS_CTLOFF);
    const MoeTiles mt = moe_tiles(F.ctl, mi);
    const GAS bf16_t* xn = (const GAS bf16_t*)(F.ws + WS_XN); GAS bf16_t* hs = (GAS bf16_t*)(F.ws + WS_HY);
    const GAS int* blkcnt = (const GAS int*)(F.ws + WS_MOE); GAS int* rec = (GAS int*)(F.ws + WS_MOE) + 8 * NTOK;
    LAS int* red = (LAS int*)(lds + 1024);
    { const int e = F.tid & 7, ch = F.tid >> 3; int s = 0;
#pragma unroll
      for (int j = 0; j < 4; ++j) { const int bb = ch * 4 + j; if (bb < F.bid) s += blkcnt[bb * 8 + e]; }
      red[e * 64 + ch] = s; }
    __syncthreads();
    if (F.tid < 8) { int s = 0; for (int ch = 0; ch < 64; ++ch) s += red[F.tid * 64 + ch]; LCTL[16 + F.tid] = (unsigned)s; }
    __syncthreads();
    LAS int* sl = (LAS int*)(lds + 4096);
    for (int rr = F.tid; rr < rpb; rr += 512) {
        GAS int* rc = rec + (size_t)(F.bid * rpb + rr) * 8;
        const int e0 = rc[0], e1 = rc[3];
        const int p0 = rc[1] + (int)LCTL[16 + e0], p1 = rc[4] + (int)LCTL[16 + e1];
        int t0 = 0, t1 = 0;
#pragma unroll
        for (int k = 0; k < 8; ++k) { t0 = (e0 == k) ? mt.tb[k] : t0; t1 = (e1 == k) ? mt.tb[k] : t1; }
        sl[rr * 2] = t0 * 256 + p0; sl[rr * 2 + 1] = t1 * 256 + p1;
        rc[1] = p0; rc[4] = p1;
    }
    __syncthreads();
    const bf16_t* xs = (const bf16_t*)(F.ws + WS_XS); const float* modv = (const float*)(F.ws + WS_MODV) + (size_t)l * 9 * 6144; const float* n2g = ARGP(lds, I_N2G) + l * DM;
    AdaCoef co; co.mr = -1;
    for (int r0 = F.wave * (rpb >> 3); r0 < (F.wave + 1) * (rpb >> 3); r0 += 3) {
        RowV x[3]; int s[3][2];
#pragma unroll
        for (int q = 0; q < 3; ++q) { const int rr = r0 + q; const bool ok = rr < (F.wave + 1) * (rpb >> 3);
            x[q] = load_row_bf16(xs + (size_t)(F.bid * rpb + (ok ? rr : r0)) * DM, F.lane);
            s[q][0] = ok ? sl[rr * 2] : -1; s[q][1] = ok ? sl[rr * 2 + 1] : -1; }
#pragma unroll
        for (int q = 0; q < 3; ++q) if (s[q][0] >= 0) { const int row = F.bid * rpb + r0 + q;
            ada_coef_update(co, row, n2g, modv, 3072, 4096, F.lane);
            const RowV y = adaln_apply(x[q], co);
            store_row_bf16((bf16_t*)hs + (size_t)s[q][0] * DM, y, F.lane); store_row_bf16((bf16_t*)hs + (size_t)s[q][1] * DM, y, F.lane); }
    }
    for (int idx = F.gw; idx < 8 * 256; idx += F.NGW) { const int e = idx >> 8, j = idx & 255;
        const int cnt = __builtin_amdgcn_readfirstlane((int)__hip_atomic_load(F.ctl + CW_CNT + 64 * (8 * mi + e), __ATOMIC_RELAXED, __HIP_MEMORY_SCOPE_AGENT));
        const int pad = ((cnt + 255) & ~255) - cnt; int tbe = 0;
#pragma unroll
        for (int k = 0; k < 8; ++k) tbe = (e == k) ? mt.tb[k] : tbe;
        if (j < pad) { GAS u32x4* dp = (GAS u32x4*)(hs + (size_t)(tbe * 256 + cnt + j) * DM) + F.lane; dp[0] = (u32x4){0u, 0u, 0u, 0u}; dp[64] = (u32x4){0u, 0u, 0u, 0u}; } }
}
__device__ __forceinline__ void phase_up_moe(LAS unsigned char* lds, int wv, int l) {
    const Fr F = make_frame(lds, wv); unsigned char* ws = F.ws; const int mi = l >> 1;
    const MoeTiles mt = moe_tiles(F.ctl, mi);
    SchedMoe S{F.bid, F.G, 28, DM, mt.tb[8], mt, (const char*)(ws + WS_HY), (const char*)w_moe(ws, mi, 0, 0), W_MGU, (char*)(ws + WS_P), DFE, 128, 2};
    pg8::EpiSwiglu E{};
    pg8::gemm_phase<pg8::EpiSwiglu, SchedMoe, true, true>(lds, F.tid, DM, DM, DM, S, E);
}
__device__ __forceinline__ void phase_down_moe(LAS unsigned char* lds, int wv, int l) {
    const Fr F = make_frame(lds, wv); unsigned char* ws = F.ws; const int mi = l >> 1;
    const MoeTiles mt = moe_tiles(F.ctl, mi);
    const int RT = mt.tb[8], RF = RT < MOE_RF ? RT : MOE_RF;
    pg8::EpiStore E{1.0f};
    { SchedMoe S{F.bid, F.G, 4, DFE, RF, mt, (const char*)(ws + WS_P), (const char*)w_moe(ws, mi, 0, 0), W_MD, (char*)(ws + WS_HY), DM, 256, 2};
      pg8::gemm_phase<pg8::EpiStore, SchedMoe, true, true>(lds, F.tid, DFE, DFE, DFE, S, E); }
    if (RT > RF) {
        SchedMoeSplit S2{F.bid, F.G, RF, RT, mt, (const char*)(ws + WS_P), (const char*)w_moe(ws, mi, 0, 0), (char*)(ws + WS_HY), (char*)(ws + WS_Y1)};
        pg8::gemm_phase<pg8::EpiStore, SchedMoeSplit, true, true>(lds, F.tid, DFE / 2, DFE, DFE, S2, E);
    }
}
__device__ __forceinline__ void phase_next_norm(LAS unsigned char* lds, int wv, int l) {
    const Fr F = make_frame(lds, wv); const bool lastl = l == DEPTH - 1; const int nrows = lastl ? NLAT : NTOK; const int mi = l >> 1;
    const bool moe = (l & 1) != 0;
    MoeTiles mt; if (moe) mt = moe_tiles(F.ctl, mi); else {
#pragma unroll
        for (int k = 0; k < 9; ++k) mt.tb[k] = 0; }
    bf16_t* xs = (bf16_t*)(F.ws + WS_XS); bf16_t* xn = (bf16_t*)(F.ws + WS_XN);
    const bf16_t* yb = (const bf16_t*)(F.ws + WS_HY); const bf16_t* yb1 = (const bf16_t*)(F.ws + WS_Y1); const int* rec = (const int*)(F.ws + WS_MOE) + 8 * NTOK;
    const float* modv = (const float*)(F.ws + WS_MODV) + (size_t)l * 9 * 6144;
    const float* modn = modv + 9 * 6144;
    const float* n1g = ARGP(lds, I_N1G) + (lastl ? 0 : (l + 1) * DM); const float* fg = ARGP(lds, I_FINALG); float* outp = (float*)ARGP(lds, 23);
    const int lane = F.lane;
    for (int row = F.gw; row < nrows; row += F.NGW) {
        RowV x = load_row_bf16(xs + (size_t)row * DM, lane);
        if (moe) {
            const int* rc = rec + (size_t)row * 8;
            const int e0 = rc[0], p0 = rc[1], e1 = rc[3], p1 = rc[4]; const float w0 = __int_as_float(rc[2]), w1 = __int_as_float(rc[5]);
            int t0 = 0, t1 = 0;
#pragma unroll
            for (int k = 0; k < 8; ++k) { t0 = (e0 == k) ? mt.tb[k] : t0; t1 = (e1 == k) ? mt.tb[k] : t1; }
            RowV y0 = load_row_bf16(yb + (size_t)(t0 * 256 + p0) * DM, lane), y1 = load_row_bf16(yb + (size_t)(t1 * 256 + p1) * DM, lane);
            { const int rt0 = t0 + (p0 >> 8), rt1 = t1 + (p1 >> 8);
              if (rt0 >= MOE_RF) { const RowV z = load_row_bf16(yb1 + (size_t)((rt0 - MOE_RF) * 256 + (p0 & 255)) * DM, lane);
#pragma unroll
                  for (int j = 0; j < 4; ++j) y0.v[j] += z.v[j]; }
              if (rt1 >= MOE_RF) { const RowV z = load_row_bf16(yb1 + (size_t)((rt1 - MOE_RF) * 256 + (p1 & 255)) * DM, lane);
#pragma unroll
                  for (int j = 0; j < 4; ++j) y1.v[j] += z.v[j]; } }
            const RowV g2 = load_row_f32(modv + (size_t)mod_row_of(row) * 6144 + 5120, lane);
#pragma unroll
            for (int j = 0; j < 4; ++j) x.v[j] += g2.v[j] * (w0 * y0.v[j] + w1 * y1.v[j]);
            if (!lastl) store_row_bf16(xs + (size_t)row * DM, x, lane);
        }
        if (!lastl) {
            const float* mv = modn + (size_t)mod_row_of(row) * 6144;
            const RowV y = adaln_row(x, n1g, mv, mv + 1024, lane);
            store_row_bf16(xn + (size_t)row * DM, y, lane);
        } else {
            float ss = 0.f;
#pragma unroll
            for (int j = 0; j < 4; ++j) ss += (x.v[j][0] * x.v[j][0] + x.v[j][1] * x.v[j][1]) + (x.v[j][2] * x.v[j][2] + x.v[j][3] * x.v[j][3]);
            const float rstd = 1.0f / sqrtf(wave_sum(ss) * (1.0f / DM) + 1e-6f);
            const RowV gv = load_row_f32(fg, lane);
            RowV y;
#pragma unroll
            for (int j = 0; j < 4; ++j) y.v[j] = x.v[j] * rstd * gv.v[j];
            store_row_f32(outp + (size_t)row * DM, y, lane);
        }
    }
}

__global__ void __launch_bounds__(512, 2) mega_fwd(Args a) {
    extern __shared__ __attribute__((aligned(16))) unsigned char lds_raw[];
    LAS unsigned char* lds = (LAS unsigned char*)lds_raw;
    volatile LAS unsigned* LCTL = (volatile LAS unsigned*)(lds + LDS_CTLOFF);
    const int wv = __builtin_amdgcn_readfirstlane((int)(threadIdx.x >> 6));
    {
        const int tid = threadIdx.x;
        for (int u = tid; u < 64; u += 512) LCTL[u] = 0u;
        if (tid == 0) { LAS unsigned long long* ap = (LAS unsigned long long*)(lds + LDS_ARGOFF);
#pragma unroll
            for (int i = 0; i < 23; ++i) ap[i] = (unsigned long long)a.in[i];
            ap[23] = (unsigned long long)a.out; ap[24] = (unsigned long long)a.ws; }
        __syncthreads();
    }
    (void)xcd_barrier_post((unsigned*)(a.ws + WS_CTL) + CW_BAR, LCTL);
    phase_prologue(lds, wv);
    grid_barrier(lds, wv);
#if DUP_PRO
    phase_prologue(lds, wv);
    grid_barrier(lds, wv);
#endif
    phase_first_norm(lds, wv);
    grid_barrier(lds, wv);
    for (int l = 0; l < DEPTH; ++l) {
        phase_inproj(lds, wv, l);  grid_barrier(lds, wv);
#if DUP_INPROJ
        phase_inproj(lds, wv, l);  grid_barrier(lds, wv);
#endif
        phase_post(lds, wv, l);    grid_barrier(lds, wv);
        phase_mix(lds, wv, l, 0);  grid_barrier(lds, wv);
#if DUP_MIX
        phase_mix(lds, wv, l, 1);  grid_barrier(lds, wv);
#endif
        phase_branch(lds, wv, l);  grid_barrier(lds, wv);
#if DUP_BRANCH
        phase_branch(lds, wv, l);  grid_barrier(lds, wv);
#endif
        phase_out(lds, wv, l);     grid_barrier(lds, wv);
        if ((l & 1) == 0) {
            phase_norm2_dense(lds, wv, l); grid_barrier(lds, wv);
#if DUP_N2D
            phase_norm2_dense(lds, wv, l); grid_barrier(lds, wv);
#endif
            phase_up_dense(lds, wv, l);    grid_barrier(lds, wv);
#if DUP_UPD
            phase_up_dense(lds, wv, l);    grid_barrier(lds, wv);
#endif
            phase_down_dense(lds, wv, l);  grid_barrier(lds, wv);
        } else {
            phase_norm2_moe(lds, wv, l);   grid_barrier(lds, wv);
            phase_moe_gather(lds, wv, l);  grid_barrier(lds, wv);
#if DUP_GATH
            phase_moe_gather(lds, wv, l);  grid_barrier(lds, wv);
#endif
            phase_up_moe(lds, wv, l);      grid_barrier(lds, wv);
#if DUP_MOEG == 1
            phase_up_moe(lds, wv, l);      grid_barrier(lds, wv);
#endif
            phase_down_moe(lds, wv, l);    grid_barrier(lds, wv);
#if DUP_MOEG == 2
            phase_down_moe(lds, wv, l);    grid_barrier(lds, wv);
#endif
        }
        phase_next_norm(lds, wv, l);
        if (l != DEPTH - 1) grid_barrier(lds, wv);
    }
}

extern "C" void kernel_launch(void* const* d_in, const int* in_sizes, int n_in, void* d_out, int out_size, void* d_ws, size_t ws_size, hipStream_t stream) {
    static int grid = 0;
    if (grid == 0) {
        if (n_in != 23 || out_size != NLAT * DM || ws_size < WS_END) { fprintf(stderr, "kernel_launch: unexpected problem (n_in %d out %d ws %zu need %zu)\n", n_in, out_size, ws_size, (size_t)WS_END); grid = -1; return; }
        int dev = 0, cus = 0, per_cu = 0;
        if (hipGetDevice(&dev) != hipSuccess || hipDeviceGetAttribute(&cus, hipDeviceAttributeMultiprocessorCount, dev) != hipSuccess) { grid = -1; return; }
        if (hipFuncSetAttribute((const void*)mega_fwd, hipFuncAttributeMaxDynamicSharedMemorySize, LDS_BYTES) != hipSuccess) { fprintf(stderr, "kernel_launch: hipFuncSetAttribute failed\n"); grid = -1; return; }
        if (hipOccupancyMaxActiveBlocksPerMultiprocessor(&per_cu, (const void*)mega_fwd, 512, LDS_BYTES) != hipSuccess || per_cu < 1) { fprintf(stderr, "kernel_launch: occupancy query says %d\n", per_cu); }
        (void)hipGetLastError();
        grid = cus;
        if (grid != 256) fprintf(stderr, "kernel_launch: %d CUs (built for 256)\n", grid);
    }
    if (grid < 0) return;
    (void)hipMemsetAsync((char*)d_ws + WS_CTL, 0, CTL_ZERO_BYTES, stream);
    Args a{};
    for (int i = 0; i < 23; ++i) a.in[i] = (const float*)d_in[i];
    a.out = (float*)d_out; a.ws = (unsigned char*)d_ws;
    hipLaunchKernelGGL(mega_fwd, dim3(grid), dim3(512), LDS_BYTES, stream, a);
}
```

```cpp
#include <hip/hip_runtime.h>
#include <cstdio>
#include <cstdint>

#ifndef DUP_MIX
#define DUP_MIX 0
#endif
#ifndef DUP_PRO
#define DUP_PRO 0
#endif
#ifndef DUP_BRANCH
#define DUP_BRANCH 0
#endif
#ifndef DUP_MOEG
#define DUP_MOEG 0
#endif
#ifndef DUP_UPD
#define DUP_UPD 0
#endif
#ifndef DUP_N2D
#define DUP_N2D 0
#endif
#ifndef DUP_GATH
#define DUP_GATH 0
#endif
#ifndef DUP_INPROJ
#define DUP_INPROJ 0
#endif
#define LAS __attribute__((address_space(3)))
#define GAS __attribute__((address_space(1)))
typedef unsigned short bf16_t;
typedef short bf16x8 __attribute__((ext_vector_type(8)));
typedef short s16x4 __attribute__((ext_vector_type(4)));
typedef float f32x4 __attribute__((ext_vector_type(4)));
typedef float f32x16 __attribute__((ext_vector_type(16)));
typedef unsigned u32x4 __attribute__((ext_vector_type(4)));
typedef unsigned u32x2 __attribute__((ext_vector_type(2)));

constexpr int NB = 8, SEQ = 2048, DM = 1024, DEPTH = 4, CTXL = 256;
constexpr int NLAT = NB * SEQ, NCTX = NB * CTXL, NTOK = NLAT + NCTX;
constexpr int DIN = 7680, PW = 3072, GW = 4096;
constexpr int C_AQ = 0, C_AK = 512, C_AV = 1024, C_BQ = 1536, C_BK = 2048, C_BV = 2176, C_CQ = 2304, C_CK = 2816, C_CV = 2944;
constexpr int DFF = 2816, DFE = 3584, NEXP = 8;
constexpr int OW = 2048;
constexpr int MAXSLOT = 2 * NTOK + 2048;
constexpr float C2 = 0.125f * 1.4426950408889634f;
constexpr float LOG2E = 1.4426950408889634f;

constexpr size_t MiB = 1u << 20;
constexpr size_t WS_CTL = 0, CTL_ZERO_BYTES = 1 * MiB;
constexpr size_t WS_MODV = 1 * MiB;
constexpr size_t WS_ROPE = 2 * MiB;
constexpr size_t WS_T256 = 3 * MiB;
constexpr size_t WS_MOE = 4 * MiB;
constexpr size_t WS_T = 6 * MiB;
constexpr size_t WS_W = 22 * MiB;
constexpr size_t W_IN = 0, W_FZ = 14 * MiB, W_BR = 16 * MiB, W_OUT = 20 * MiB, W_LAYER = 22 * MiB;
constexpr size_t W_DENSE0 = 4 * W_LAYER, W_DGU = 0, W_DD = 11 * MiB, W_DENSE = 33 * MiB / 2;
constexpr size_t W_MOE0 = W_DENSE0 + 2 * W_DENSE, W_MGU = 0, W_MD = 14 * MiB, W_EXPERT = 21 * MiB, W_MOE = 8 * W_EXPERT;
constexpr size_t WS_XS = WS_W + W_MOE0 + 2 * W_MOE;
constexpr size_t WS_XN = WS_XS + 72 * MiB;
constexpr size_t WS_P = WS_XN + 36 * MiB;
constexpr size_t WS_G = WS_P + 108 * MiB;
constexpr size_t WS_ZZ = WS_P + 252 * MiB;
constexpr size_t WS_ZZC = WS_ZZ + 32 * MiB;
constexpr size_t WS_O = WS_ZZC + 4 * MiB;
constexpr size_t WS_HY = WS_O + 72 * MiB;
constexpr size_t WS_Y1 = WS_HY + 76 * MiB;
constexpr size_t WS_END = WS_Y1 + 16 * MiB;
constexpr int MOE_RF = 128;
static_assert(WS_W + W_MOE0 + 2 * W_MOE == 479 * MiB, "weights");
static_assert((size_t)MAXSLOT * DFE * 2 <= 288 * MiB, "moe hidden fits p+zz");
static_assert((size_t)MAXSLOT * 1024 * 2 <= 76 * MiB, "hs fits");
static_assert(WS_END <= 1074 * MiB, "workspace");

constexpr int CW_BAR = 4096;
constexpr int CW_Q = 16384;
constexpr int CW_CNT = 24576;

constexpr int LDS_CTLOFF = 141312;
constexpr int LDS_BYTES = 147456;

typedef float f32x2_t __attribute__((ext_vector_type(2))); typedef __bf16 bf16x2_t __attribute__((ext_vector_type(2)));
__device__ __forceinline__ unsigned cvt_pk_bf16(float lo, float hi) { f32x2_t v = {lo, hi}; bf16x2_t b = __builtin_convertvector(v, bf16x2_t); return __builtin_bit_cast(unsigned, b); }
__device__ __forceinline__ float bf_lo(unsigned w) { return __uint_as_float(w << 16); }
__device__ __forceinline__ float bf_hi(unsigned w) { return __uint_as_float(w & 0xffff0000u); }
__device__ __forceinline__ float bf2f(bf16_t h) { return __uint_as_float(((unsigned)h) << 16); }
__device__ __forceinline__ bf16_t f2bf(float f) { unsigned u = __float_as_uint(f); u += 0x7fffu + ((u >> 16) & 1u); return (bf16_t)(u >> 16); }
__device__ __forceinline__ float fast_exp2(float x) { return __builtin_amdgcn_exp2f(x); }
__device__ __forceinline__ float fast_rcp(float x) { return __builtin_amdgcn_rcpf(x); }
__device__ __forceinline__ float sigmoidf_(float x) { return fast_rcp(1.0f + fast_exp2(-x * LOG2E)); }
__device__ __forceinline__ float siluf_(float x) { return x * sigmoidf_(x); }
__device__ __forceinline__ float wave_sum(float v) {
#pragma unroll
    for (int o = 1; o < 64; o <<= 1) v += __shfl_xor(v, o);
    return v;
}
#define LDS_WAIT() asm volatile("s_waitcnt lgkmcnt(0)" ::: "memory")
__device__ __forceinline__ int lane_id() { int l; asm volatile("v_mbcnt_lo_u32_b32 %0, -1, 0\n\tv_mbcnt_hi_u32_b32 %0, -1, %0" : "=v"(l)); return l; }

namespace pg8 {
constexpr int BM = 256, BK = 64, HALF = 128, HTB = HALF * BK * 2, STAGE_BYTES = 8 * HTB, NXCD = 8, WGM = 8;
__host__ __device__ __forceinline__ int lds_byte(int r, int c) { const int st = (r >> 4) * 2 + (c >> 5), rr = r & 15, cc = c & 31, ob = rr * 64 + cc * 2; return st * 1024 + (ob ^ (((ob >> 9) & 1) << 5)); }
__host__ __device__ __forceinline__ void stage_rc(int b, int& R, int& C) { const int st = b / 1024, sb = b % 1024, swz = sb ^ (((sb >> 9) & 1) << 5); R = (st >> 1) * 16 + swz / 64; C = (st & 1) * 32 + (swz % 64) / 2; }
__host__ __device__ __forceinline__ int perm32(int rho) { const int n = rho >> 4, i = rho & 15; return 8 * (i >> 2) + 4 * n + (i & 3); }

struct Unit { const char* A; const char* B; char* out; const char* aux; const char* aux2; int ldc; int flag; };

__device__ __forceinline__ void tile_of(int L, int nM, int nN, int& pm, int& pn) {
    const int nwg = nM * nN; int wgid = L;
    { const int q = nwg / NXCD, r = nwg % NXCD, xcd = wgid % NXCD, off = wgid / NXCD; wgid = (xcd < r ? xcd * (q + 1) : r * (q + 1) + (xcd - r) * q) + off; }
    const int nig = WGM * nN, gid = wgid / nig, fm = gid * WGM, gsz = (nM - fm) < WGM ? (nM - fm) : WGM;
    pm = fm + ((wgid % nig) % gsz); pn = (wgid % nig) / gsz;
}

template <class Epi, class Sched, bool ALIGN_EPI, bool SP2>
__device__ __forceinline__ void gemm_phase(LAS unsigned char* lds, const int tid, const int K, const int lda, const int ldb, const Sched& S, const Epi& E) {
    const int wid = __builtin_amdgcn_readfirstlane(tid >> 6), lane = tid & 63, wr = wid >> 2, wc = wid & 3, fr = lane & 15, fq = lane >> 4;
    const int nt = K / BK;
    unsigned voffA[2], voffB[2];
#pragma unroll
    for (int i = 0; i < 2; ++i) { int R, C; stage_rc(tid * 16 + i * 8192, R, C); const int Rb = Epi::PERM ? ((R & ~31) + perm32(R & 31)) : R;
        voffA[i] = (unsigned)(R * lda + C) * 2u; voffB[i] = (unsigned)(Rb * ldb + C) * 2u; }
    const size_t kstep = (size_t)(BK * 2);
    const size_t hstepA = (size_t)HALF * lda * 2, hstepB = (size_t)HALF * ldb * 2;
    const unsigned ldsw = (unsigned)wid * 1024u;
    const int aoff = lds_byte(wr * 64 + fr, fq * 8), boff = lds_byte(wc * 32 + fr, fq * 8);
#define PG8_SA(b, h) (((b) * 2 + (h)) * HTB)
#define PG8_SB(b, h) ((4 + (b) * 2 + (h)) * HTB)
#define PG8_STAGE(bufoff, gbase, voff) do { _Pragma("unroll") for (int _i = 0; _i < 2; ++_i) \
        __builtin_amdgcn_global_load_lds((const unsigned*)((const char*)(gbase) + (voff)[_i]), (LAS unsigned*)(lds + (bufoff) + ldsw + _i * 8192), 16, 0, 0); } while (0)
#define PG8_LDA(dst, b, h) do { _Pragma("unroll") for (int m = 0; m < 4; ++m) _Pragma("unroll") for (int k = 0; k < 2; ++k) dst[m][k] = *(const LAS bf16x8*)(lds + PG8_SA(b, h) + aoff + m * 2048 + k * 1024); } while (0)
#define PG8_LDB(dst, b, h) do { _Pragma("unroll") for (int n = 0; n < 2; ++n) _Pragma("unroll") for (int k = 0; k < 2; ++k) dst[n][k] = *(const LAS bf16x8*)(lds + PG8_SB(b, h) + boff + n * 2048 + k * 1024); } while (0)
#define PG8_MMA(ai, bj, At, Bt) do { __builtin_amdgcn_s_setprio(1); _Pragma("unroll") for (int m = 0; m < 4; ++m) _Pragma("unroll") for (int n = 0; n < 2; ++n) _Pragma("unroll") for (int k = 0; k < 2; ++k) \
        acc[ai][bj][m][n] = __builtin_amdgcn_mfma_f32_16x16x32_bf16(Bt[n][k], At[m][k], acc[ai][bj][m][n], 0, 0, 0); __builtin_amdgcn_s_setprio(0); } while (0)
#define PG8_WAIT_V(n) asm volatile("s_waitcnt vmcnt(" #n ")" ::: "memory")
#define PG8_WAIT_L(n) asm volatile("s_waitcnt lgkmcnt(" #n ")" ::: "memory")
#define PG8_BAR __builtin_amdgcn_s_barrier()
#define PG8_SCHED __builtin_amdgcn_sched_barrier(0)
    Unit cur, nxt; int ui = 0;
    if (!S.next(0, cur)) return;
    f32x4 acc[2][2][4][2];
#pragma unroll
    for (int a = 0; a < 2; ++a)
#pragma unroll
        for (int b = 0; b < 2; ++b)
#pragma unroll
            for (int m = 0; m < 4; ++m)
#pragma unroll
                for (int n = 0; n < 2; ++n) acc[a][b][m][n] = (f32x4){0.f, 0.f, 0.f, 0.f};
    bf16x8 At[4][2], B0[2][2], B1[2][2];
    const char* cA = cur.A; const char* cB = cur.B;
    if constexpr (SP2) {
        PG8_STAGE(PG8_SB(0, 0), cB, voffB); PG8_STAGE(PG8_SB(0, 1), cB + hstepB, voffB); PG8_STAGE(PG8_SA(0, 0), cA, voffA); PG8_STAGE(PG8_SA(0, 1), cA + hstepA, voffA);
        if (wr == 1) PG8_BAR;
        PG8_WAIT_V(2); PG8_BAR;
        PG8_STAGE(PG8_SB(1, 0), cB + kstep, voffB); PG8_STAGE(PG8_SA(1, 0), cA + kstep, voffA); PG8_STAGE(PG8_SB(1, 1), cB + hstepB + kstep, voffB);
        PG8_WAIT_V(6); PG8_BAR;
    } else {
        PG8_STAGE(PG8_SB(0, 0), cB, voffB); PG8_STAGE(PG8_SA(0, 0), cA, voffA); PG8_STAGE(PG8_SB(0, 1), cB + hstepB, voffB); PG8_STAGE(PG8_SA(0, 1), cA + hstepA, voffA);
        if (wr == 1) PG8_BAR;
        PG8_WAIT_V(4); PG8_BAR;
        PG8_STAGE(PG8_SB(1, 0), cB + kstep, voffB); PG8_STAGE(PG8_SA(1, 0), cA + kstep, voffA); PG8_STAGE(PG8_SB(1, 1), cB + hstepB + kstep, voffB);
        PG8_WAIT_V(6); PG8_BAR;
    }
    for (;;) {
        const bool has_next = S.next(ui + 1, nxt);
        const char* nA = has_next ? nxt.A : cA; const char* nB = has_next ? nxt.B : cB;
        for (int t = 0; t < nt; t += 2) {
            const bool last = (t == nt - 2);
            const char* a1 = cA + (size_t)(t + 1) * kstep;
            const char* a2 = last ? nA : cA + (size_t)(t + 2) * kstep; const char* b2 = last ? nB : cB + (size_t)(t + 2) * kstep;
            const char* a3 = a2 + kstep; const char* b3 = b2 + kstep;
            if constexpr (SP2) {
            PG8_LDB(B0, 0, 0); PG8_LDB(B1, 0, 1); PG8_SCHED; PG8_LDA(At, 0, 0); PG8_STAGE(PG8_SA(1, 1), a1 + hstepA, voffA);
            PG8_WAIT_V(8); PG8_WAIT_L(0); PG8_BAR; PG8_MMA(0, 0, At, B0); PG8_MMA(0, 1, At, B1); PG8_BAR; PG8_SCHED;
            PG8_LDA(At, 0, 1); PG8_STAGE(PG8_SB(0, 0), b2, voffB); PG8_STAGE(PG8_SB(0, 1), b2 + hstepB, voffB); PG8_STAGE(PG8_SA(0, 0), a2, voffA);
            PG8_WAIT_V(8); PG8_WAIT_L(0); PG8_BAR; PG8_MMA(1, 0, At, B0); PG8_MMA(1, 1, At, B1); PG8_BAR; PG8_SCHED;
            PG8_LDB(B0, 1, 0); PG8_LDB(B1, 1, 1); PG8_SCHED; PG8_LDA(At, 1, 0); PG8_STAGE(PG8_SA(0, 1), a2 + hstepA, voffA);
            PG8_WAIT_V(8); PG8_WAIT_L(0); PG8_BAR; PG8_MMA(0, 0, At, B0); PG8_MMA(0, 1, At, B1); PG8_BAR; PG8_SCHED;
            PG8_LDA(At, 1, 1); PG8_STAGE(PG8_SB(1, 0), b3, voffB); PG8_STAGE(PG8_SB(1, 1), b3 + hstepB, voffB); PG8_STAGE(PG8_SA(1, 0), a3, voffA);
            PG8_WAIT_V(8); PG8_WAIT_L(0); PG8_BAR; PG8_MMA(1, 0, At, B0); PG8_MMA(1, 1, At, B1); PG8_BAR; PG8_SCHED;
            } else {
            PG8_LDB(B0, 0, 0); PG8_SCHED; PG8_LDA(At, 0, 0); PG8_STAGE(PG8_SA(1, 1), a1 + hstepA, voffA);
            PG8_WAIT_L(8); PG8_BAR; PG8_WAIT_L(0); PG8_MMA(0, 0, At, B0); PG8_BAR; PG8_SCHED;
            PG8_LDB(B1, 0, 1); PG8_STAGE(PG8_SB(0, 0), b2, voffB);
            PG8_BAR; PG8_WAIT_L(0); PG8_MMA(0, 1, At, B1); PG8_BAR;
            PG8_LDA(At, 0, 1); PG8_STAGE(PG8_SA(0, 0), a2, voffA);
            PG8_BAR; PG8_WAIT_L(0); PG8_MMA(1, 0, At, B0); PG8_BAR; PG8_SCHED;
            PG8_STAGE(PG8_SB(0, 1), b2 + hstepB, voffB);
            PG8_WAIT_V(6); PG8_BAR; PG8_MMA(1, 1, At, B1); PG8_BAR;
            PG8_LDB(B0, 1, 0); PG8_SCHED; PG8_LDA(At, 1, 0); PG8_STAGE(PG8_SA(0, 1), a2 + hstepA, voffA);
            PG8_WAIT_L(8); PG8_BAR; PG8_WAIT_L(0); PG8_MMA(0, 0, At, B0); PG8_BAR; PG8_SCHED;
            PG8_LDB(B1, 1, 1); PG8_STAGE(PG8_SB(1, 0), b3, voffB);
            PG8_BAR; PG8_WAIT_L(0); PG8_MMA(0, 1, At, B1); PG8_BAR;
            PG8_LDA(At, 1, 1); PG8_STAGE(PG8_SA(1, 0), a3, voffA);
            PG8_BAR; PG8_WAIT_L(0); PG8_MMA(1, 0, At, B0); PG8_BAR; PG8_SCHED;
            PG8_STAGE(PG8_SB(1, 1), b3 + hstepB, voffB);
            PG8_WAIT_V(6); PG8_BAR; PG8_MMA(1, 1, At, B1); PG8_BAR;
            }
        }
        if constexpr (ALIGN_EPI) { if (wr == 0) PG8_BAR; }
        E(acc, cur, wr, wc, fr, fq);
        if (!has_next) break;
#pragma unroll
        for (int a = 0; a < 2; ++a)
#pragma unroll
            for (int b = 0; b < 2; ++b)
#pragma unroll
                for (int m = 0; m < 4; ++m)
#pragma unroll
                    for (int n = 0; n < 2; ++n) acc[a][b][m][n] = (f32x4){0.f, 0.f, 0.f, 0.f};
        cur = nxt; cA = nA; cB = nB; ++ui;
        if constexpr (ALIGN_EPI) { if (wr == 1) PG8_BAR; }
    }
    PG8_WAIT_V(0);
    if constexpr (!ALIGN_EPI) { if (wr == 0) PG8_BAR; }
    PG8_BAR;
#undef PG8_SA
#undef PG8_SB
#undef PG8_STAGE
#undef PG8_LDA
#undef PG8_LDB
#undef PG8_MMA
#undef PG8_WAIT_V
#undef PG8_WAIT_L
#undef PG8_BAR
#undef PG8_SCHED
}

struct EpiStore {
    static constexpr bool PERM = true;
    float scale;
    __device__ __forceinline__ void operator()(const f32x4 (&acc)[2][2][4][2], const Unit& u, int wr, int wc, int fr, int fq) const {
        bf16_t* base = (bf16_t*)u.out + (size_t)(wr * 64 + fr) * u.ldc + wc * 32 + 8 * fq;
        const bool sg = u.flag == 1;
#pragma unroll
        for (int ai = 0; ai < 2; ++ai)
#pragma unroll
            for (int m = 0; m < 4; ++m) { bf16_t* rowp = base + (size_t)(ai * HALF + m * 16) * u.ldc;
#pragma unroll
                for (int bj = 0; bj < 2; ++bj) { f32x4 v0 = acc[ai][bj][m][0] * scale, v1 = acc[ai][bj][m][1] * scale;
                    if (sg) {
#pragma unroll
                        for (int j = 0; j < 4; ++j) { v0[j] = sigmoidf_(v0[j]); v1[j] = sigmoidf_(v1[j]); } }
                    u32x4 w; w.x = cvt_pk_bf16(v0[0], v0[1]); w.y = cvt_pk_bf16(v0[2], v0[3]); w.z = cvt_pk_bf16(v1[0], v1[1]); w.w = cvt_pk_bf16(v1[2], v1[3]);
                    *(u32x4*)(rowp + bj * HALF) = w; } }
    }
};
struct EpiInproj {
    static constexpr bool PERM = true;
    __device__ __forceinline__ void operator()(const f32x4 (&acc)[2][2][4][2], const Unit& u, int wr, int wc, int fr, int fq) const {
        GAS bf16_t* base = (GAS bf16_t*)u.out + (size_t)(wr * 64 + fr) * u.ldc + wc * 32 + 8 * fq;
        const bool sg = (u.flag & 1) != 0, lat = (u.flag & 16) != 0, r0 = lat && (u.flag & 6) != 0, r1 = lat && (u.flag & 2) != 0;
        const float qs = (u.flag & 8) ? C2 : 1.0f;
        const GAS float* rp = (const GAS float*)u.aux + (size_t)(wr * 64 + fr) * 64 + (wc & 1) * 32 + 4 * fq;
#pragma unroll
        for (int ai = 0; ai < 2; ++ai)
#pragma unroll
            for (int m = 0; m < 4; ++m) { GAS bf16_t* rowp = base + (size_t)(ai * HALF + m * 16) * u.ldc;
                f32x4 cs = (f32x4){1.f, 1.f, 1.f, 1.f}, sn = (f32x4){0.f, 0.f, 0.f, 0.f};
                if (r0) { const GAS float* rt = rp + (size_t)(ai * HALF + m * 16) * 64; cs = *(const GAS f32x4*)rt; sn = *(const GAS f32x4*)(rt + 16); }
#pragma unroll
                for (int bj = 0; bj < 2; ++bj) { f32x4 v0 = acc[ai][bj][m][0], v1 = acc[ai][bj][m][1];
                    if (bj == 0 ? r0 : r1) {
                        const float a0 = v0[0] * cs[0] - v0[1] * sn[0], a1 = v0[1] * cs[0] + v0[0] * sn[0], a2 = v0[2] * cs[1] - v0[3] * sn[1], a3 = v0[3] * cs[1] + v0[2] * sn[1];
                        const float b0 = v1[0] * cs[2] - v1[1] * sn[2], b1 = v1[1] * cs[2] + v1[0] * sn[2], b2 = v1[2] * cs[3] - v1[3] * sn[3], b3 = v1[3] * cs[3] + v1[2] * sn[3];
                        v0 = (f32x4){a0, a1, a2, a3}; v1 = (f32x4){b0, b1, b2, b3}; }
                    v0 *= qs; v1 *= qs;
                    if (sg) {
                        unsigned q[8];
#pragma unroll
                        for (int j = 0; j < 4; ++j) { q[j] = (unsigned)(sigmoidf_(v0[j]) * 255.0f + 0.5f); q[4 + j] = (unsigned)(sigmoidf_(v1[j]) * 255.0f + 0.5f); }
                        u32x2 w8; w8.x = q[0] | (q[1] << 8) | (q[2] << 16) | (q[3] << 24); w8.y = q[4] | (q[5] << 8) | (q[6] << 16) | (q[7] << 24);
                        *(GAS u32x2*)((GAS unsigned char*)u.out + (size_t)(wr * 64 + fr + ai * HALF + m * 16) * GW + wc * 32 + 8 * fq + bj * HALF) = w8;
                    } else {
                    u32x4 w; w.x = cvt_pk_bf16(v0[0], v0[1]); w.y = cvt_pk_bf16(v0[2], v0[3]); w.z = cvt_pk_bf16(v1[0], v1[1]); w.w = cvt_pk_bf16(v1[2], v1[3]);
                    *(GAS u32x4*)(rowp + bj * HALF) = w; } } }
    }
};
struct EpiSwiglu {
    static constexpr bool PERM = true;
    __device__ __forceinline__ void operator()(const f32x4 (&acc)[2][2][4][2], const Unit& u, int wr, int wc, int fr, int fq) const {
        bf16_t* base = (bf16_t*)u.out + (size_t)(wr * 64 + fr) * u.ldc + wc * 32 + 8 * fq;
#pragma unroll
        for (int ai = 0; ai < 2; ++ai)
#pragma unroll
            for (int m = 0; m < 4; ++m) { bf16_t* rowp = base + (size_t)(ai * HALF + m * 16) * u.ldc;
                f32x4 g0 = acc[ai][0][m][0], g1 = acc[ai][0][m][1]; const f32x4 u0 = acc[ai][1][m][0], u1 = acc[ai][1][m][1];
#pragma unroll
                for (int j = 0; j < 4; ++j) { g0[j] = siluf_(g0[j]) * u0[j]; g1[j] = siluf_(g1[j]) * u1[j]; }
                u32x4 w; w.x = cvt_pk_bf16(g0[0], g0[1]); w.y = cvt_pk_bf16(g0[2], g0[3]); w.z = cvt_pk_bf16(g1[0], g1[1]); w.w = cvt_pk_bf16(g1[2], g1[3]);
                *(u32x4*)rowp = w; }
    }
};
struct EpiResid {
    static constexpr bool PERM = true;
    __device__ __forceinline__ void operator()(const f32x4 (&acc)[2][2][4][2], const Unit& u, int wr, int wc, int fr, int fq) const {
        GAS bf16_t* base = (GAS bf16_t*)u.out + (size_t)(wr * 64 + fr) * u.ldc + wc * 32 + 8 * fq;
        const size_t roff = (size_t)(wr * 64 + fr) * u.ldc + wc * 32 + 8 * fq;
        const bool srcf = u.flag == 1;
        const GAS float* g = (const GAS float*)u.aux + wc * 32 + 8 * fq;
        f32x4 gv[2][2];
#pragma unroll
        for (int bj = 0; bj < 2; ++bj)
#pragma unroll
            for (int n = 0; n < 2; ++n) gv[bj][n] = *(const GAS f32x4*)(g + bj * HALF + n * 4);
#pragma unroll
        for (int ai = 0; ai < 2; ++ai)
#pragma unroll
            for (int m = 0; m < 4; ++m) { const size_t ro = (size_t)(ai * HALF + m * 16) * u.ldc;
#pragma unroll
                for (int bj = 0; bj < 2; ++bj) {
                    f32x4 r0, r1;
                    if (srcf) { const GAS float* sp = (const GAS float*)u.aux2 + roff + ro + bj * HALF; r0 = *(const GAS f32x4*)sp; r1 = *(const GAS f32x4*)(sp + 4); }
                    else { const u32x4 w = *(const GAS u32x4*)((const GAS bf16_t*)u.aux2 + roff + ro + bj * HALF);
                        r0 = (f32x4){bf_lo(w.x), bf_hi(w.x), bf_lo(w.y), bf_hi(w.y)}; r1 = (f32x4){bf_lo(w.z), bf_hi(w.z), bf_lo(w.w), bf_hi(w.w)}; }
                    const f32x4 v0 = r0 + gv[bj][0] * acc[ai][bj][m][0], v1 = r1 + gv[bj][1] * acc[ai][bj][m][1];
                    u32x4 o; o.x = cvt_pk_bf16(v0[0], v0[1]); o.y = cvt_pk_bf16(v0[2], v0[3]); o.z = cvt_pk_bf16(v1[0], v1[1]); o.w = cvt_pk_bf16(v1[2], v1[3]);
                    *(GAS u32x4*)(base + ro + bj * HALF) = o; }
                asm volatile("" ::: "memory"); }
    }
};
struct BUnit { const char* A; const char* B; const char* gate; char* out; };
__device__ __forceinline__ void gload8_async(u32x2& dst, const void* p) { asm volatile("global_load_dwordx2 %0, %1, off" : "=&v"(dst) : "v"(p) : "memory"); }
template <class Sched>
__device__ __forceinline__ void branch_phase(LAS unsigned char* lds, const int tid, const Sched& S) {
    const int wid = __builtin_amdgcn_readfirstlane(tid >> 6), lane = tid & 63, wr = wid >> 2, wc = wid & 3, fr = lane & 15, fq = lane >> 4;
    constexpr int K = 2048, nt = K / BK, lda = 2048, ldb = 2048;
    unsigned voffA[2], voffB[2];
#pragma unroll
    for (int i = 0; i < 2; ++i) { int R, C; stage_rc(tid * 16 + i * 8192, R, C); const int Rb = (R & ~31) + perm32(R & 31);
        voffA[i] = (unsigned)(R * lda + C) * 2u; voffB[i] = (unsigned)(Rb * ldb + C) * 2u; }
    const size_t kstep = (size_t)(BK * 2);
    const size_t hstepA = (size_t)HALF * lda * 2;
    const unsigned ldsw = (unsigned)wid * 1024u;
    const int aoff = lds_byte(wr * 64 + fr, fq * 8), boff = lds_byte(wc * 32 + fr, fq * 8);
#define BR_SA(b, h) (((b) * 2 + (h)) * HTB)
#define BR_SB(b) ((4 + (b) * 2) * HTB)
#define BR_STAGE(bufoff, gbase, voff) do { _Pragma("unroll") for (int _i = 0; _i < 2; ++_i) \
        __builtin_amdgcn_global_load_lds((const unsigned*)((const char*)(gbase) + (voff)[_i]), (LAS unsigned*)(lds + (bufoff) + ldsw + _i * 8192), 16, 0, 0); } while (0)
#define BR_LDA(dst, b, h) do { _Pragma("unroll") for (int m = 0; m < 4; ++m) _Pragma("unroll") for (int k = 0; k < 2; ++k) dst[m][k] = *(const LAS bf16x8*)(lds + BR_SA(b, h) + aoff + m * 2048 + k * 1024); } while (0)
#define BR_LDB(dst, b) do { _Pragma("unroll") for (int n = 0; n < 2; ++n) _Pragma("unroll") for (int k = 0; k < 2; ++k) dst[n][k] = *(const LAS bf16x8*)(lds + BR_SB(b) + boff + n * 2048 + k * 1024); } while (0)
#define BR_MMA(ai) do { __builtin_amdgcn_s_setprio(1); _Pragma("unroll") for (int m = 0; m < 4; ++m) _Pragma("unroll") for (int n = 0; n < 2; ++n) _Pragma("unroll") for (int k = 0; k < 2; ++k) \
        acc[ai][m][n] = __builtin_amdgcn_mfma_f32_16x16x32_bf16(B0[n][k], At[m][k], acc[ai][m][n], 0, 0, 0); __builtin_amdgcn_s_setprio(0); } while (0)
#define BR_WAIT_V(n) asm volatile("s_waitcnt vmcnt(" #n ")" ::: "memory")
#define BR_WAIT_L0 asm volatile("s_waitcnt lgkmcnt(0)" ::: "memory")
#define BR_BAR __builtin_amdgcn_s_barrier()
#define BR_SCHED __builtin_amdgcn_sched_barrier(0)
    BUnit cur, nxt; int ui = 0;
    if (!S.next(0, cur)) return;
    f32x4 acc[2][4][2], macc[2][4][2];
#pragma unroll
    for (int a = 0; a < 2; ++a)
#pragma unroll
        for (int m = 0; m < 4; ++m)
#pragma unroll
            for (int n = 0; n < 2; ++n) { acc[a][m][n] = (f32x4){0.f, 0.f, 0.f, 0.f}; macc[a][m][n] = (f32x4){0.f, 0.f, 0.f, 0.f}; }
    bf16x8 At[4][2], B0[2][2];
    const char* cA = cur.A; const char* cB = cur.B;
    BR_STAGE(BR_SB(0), cB, voffB); BR_STAGE(BR_SA(0, 0), cA, voffA); BR_STAGE(BR_SA(0, 1), cA + hstepA, voffA);
    if (wr == 1) BR_BAR;
    BR_WAIT_V(2); BR_BAR;
    BR_STAGE(BR_SB(1), cB + kstep, voffB); BR_STAGE(BR_SA(1, 0), cA + kstep, voffA);
    BR_WAIT_V(4); BR_BAR;
    const size_t rowoff = (size_t)(wr * 64 + fr), coloff = (size_t)(wc * 32 + 8 * fq);
    for (;;) {
        const bool has_next = S.next(ui + 1, nxt);
        const char* nA = has_next ? nxt.A : cA; const char* nB = has_next ? nxt.B : cB;
        const char* gbase = cur.gate + (rowoff * GW + coloff);
        u32x2 g[8];
        for (int t = 0; t < nt; t += 2) {
            const bool last = (t == nt - 2);
            const bool hook = (t & 6) == 6;
            const char* a1 = cA + (size_t)(t + 1) * kstep;
            const char* a2 = last ? nA : cA + (size_t)(t + 2) * kstep; const char* b2 = last ? nB : cB + (size_t)(t + 2) * kstep;
            const char* a3 = a2 + kstep; const char* b3 = b2 + kstep;
            if (hook) {
                const char* gp = gbase + (size_t)(t >> 3) * 1024;
#pragma unroll
                for (int q = 0; q < 8; ++q) gload8_async(g[q], gp + (size_t)((q >> 2) * HALF + (q & 3) * 16) * GW);
            }
            BR_LDB(B0, 0); BR_SCHED; BR_LDA(At, 0, 0); BR_STAGE(BR_SA(1, 1), a1 + hstepA, voffA);
            if (hook) BR_WAIT_V(14); else BR_WAIT_V(6);
            BR_WAIT_L0; BR_BAR; BR_MMA(0); BR_BAR; BR_SCHED;
            BR_LDA(At, 0, 1); BR_STAGE(BR_SB(0), b2, voffB); BR_STAGE(BR_SA(0, 0), a2, voffA);
            if (hook) BR_WAIT_V(14); else BR_WAIT_V(6);
            BR_WAIT_L0; BR_BAR; BR_MMA(1); BR_BAR; BR_SCHED;
            BR_LDB(B0, 1); BR_SCHED; BR_LDA(At, 1, 0); BR_STAGE(BR_SA(0, 1), a2 + hstepA, voffA);
            BR_WAIT_V(6); BR_WAIT_L0; BR_BAR; BR_MMA(0); BR_BAR; BR_SCHED;
            BR_LDA(At, 1, 1); BR_STAGE(BR_SB(1), b3, voffB); BR_STAGE(BR_SA(1, 0), a3, voffA);
            BR_WAIT_V(6); BR_WAIT_L0; BR_BAR; BR_MMA(1); BR_BAR; BR_SCHED;
            if (hook) {
                asm volatile("s_waitcnt vmcnt(10)" : "+v"(g[0]), "+v"(g[1]), "+v"(g[2]), "+v"(g[3]), "+v"(g[4]), "+v"(g[5]), "+v"(g[6]), "+v"(g[7]) :: "memory");
#pragma unroll
                for (int ai = 0; ai < 2; ++ai)
#pragma unroll
                    for (int m = 0; m < 4; ++m) { const u32x2 gw = g[ai * 4 + m];
                        const f32x4 g0 = (f32x4){(float)(gw.x & 255u), (float)((gw.x >> 8) & 255u), (float)((gw.x >> 16) & 255u), (float)(gw.x >> 24)};
                        const f32x4 g1 = (f32x4){(float)(gw.y & 255u), (float)((gw.y >> 8) & 255u), (float)((gw.y >> 16) & 255u), (float)(gw.y >> 24)};
                        macc[ai][m][0] += acc[ai][m][0] * g0; macc[ai][m][1] += acc[ai][m][1] * g1;
                        acc[ai][m][0] = (f32x4){0.f, 0.f, 0.f, 0.f}; acc[ai][m][1] = (f32x4){0.f, 0.f, 0.f, 0.f}; }
            }
        }
        {
            GAS bf16_t* op = (GAS bf16_t*)cur.out + rowoff * 1024 + coloff;
#pragma unroll
            for (int ai = 0; ai < 2; ++ai)
#pragma unroll
                for (int m = 0; m < 4; ++m) { const f32x4 v0 = macc[ai][m][0] * (1.0f / 255.0f), v1 = macc[ai][m][1] * (1.0f / 255.0f);
                    u32x4 w; w.x = cvt_pk_bf16(v0[0], v0[1]); w.y = cvt_pk_bf16(v0[2], v0[3]); w.z = cvt_pk_bf16(v1[0], v1[1]); w.w = cvt_pk_bf16(v1[2], v1[3]);
                    *(GAS u32x4*)(op + (size_t)(ai * HALF + m * 16) * 1024) = w;
                    macc[ai][m][0] = (f32x4){0.f, 0.f, 0.f, 0.f}; macc[ai][m][1] = (f32x4){0.f, 0.f, 0.f, 0.f}; }
        }
        if (!has_next) break;
        cur = nxt; cA = nA; cB = nB; ++ui;
    }
    BR_WAIT_V(0);
    if (wr == 0) BR_BAR;
    BR_BAR;
#undef BR_SA
#undef BR_SB
#undef BR_STAGE
#undef BR_LDA
#undef BR_LDB
#undef BR_MMA
#undef BR_WAIT_V
#undef BR_WAIT_L0
#undef BR_BAR
#undef BR_SCHED
}
}

#define XB_TMO      128
#define XB_XCNT(j)  (256  + 64 * (j))
#define XB_XSUB(j)  (1280 + 64 * (j))
#define XB_XGEN(j)  (2304 + 64 * (j))
#define XB_TOP      3328
#define XB_TOPGEN   3392
#define XCD_BAR_WORDS 3456
#define XB_SPIN_CAP (1u << 20)

__device__ __forceinline__ unsigned xb_ld(unsigned* p)              { return __hip_atomic_load(p, __ATOMIC_RELAXED, __HIP_MEMORY_SCOPE_AGENT); }
__device__ __forceinline__ unsigned xb_add(unsigned* p, unsigned v) { return __hip_atomic_fetch_add(p, v, __ATOMIC_RELAXED, __HIP_MEMORY_SCOPE_AGENT); }
__device__ __forceinline__ unsigned xb_xcc_id() { return (unsigned)__builtin_amdgcn_s_getreg((3 << 11) | 20) & 0xFu; }
#define XB_SPIN(cond, bar) do { unsigned _sp = 0; while (cond) { __builtin_amdgcn_s_sleep(1); \
    if ((++_sp & 255u) == 0u) { if (xb_ld(&(bar)[XB_TMO])) break; if (_sp > XB_SPIN_CAP) { atomicAdd(&(bar)[XB_TMO], 1u); break; } } } } while (0)

struct XcdBarrier { unsigned* bar; unsigned x; volatile LAS unsigned* st; };

__device__ __forceinline__ XcdBarrier xcd_barrier_post(unsigned* bar, volatile LAS unsigned* st) {
    XcdBarrier b; b.bar = bar; b.x = xb_xcc_id(); b.st = st;
    if (threadIdx.x == 0) (void)xb_add(&bar[XB_XCNT(b.x)], 1u);
    return b;
}
__device__ __forceinline__ void xcd_barrier_complete(unsigned* bar, unsigned x, unsigned& nloc, unsigned& nx) {
    const unsigned G = gridDim.x * gridDim.y * gridDim.z;
    unsigned sum, cnt, mine, sp = 0u;
    for (;;) {
        sum = 0u; cnt = 0u; mine = 0u;
#pragma unroll
        for (unsigned j = 0; j < 16; ++j) { const unsigned c = xb_ld(&bar[XB_XCNT(j)]); sum += c; cnt += (c > 0u) ? 1u : 0u; mine = (j == x) ? c : mine; }
        if (sum == G) break;
        __builtin_amdgcn_s_sleep(1);
        if ((++sp & 255u) == 0u) { if (xb_ld(&bar[XB_TMO])) break; if (sp > XB_SPIN_CAP) { atomicAdd(&bar[XB_TMO], 1u); break; } }
    }
    nloc = mine > 0u ? mine : 1u; nx = cnt > 0u ? cnt : 1u;
}
__device__ __forceinline__ void xcd_barrier(const XcdBarrier& b, const bool leader) {
    asm volatile("s_waitcnt vmcnt(0)" ::: "memory");
    __syncthreads();
    unsigned* bar = b.bar; asm volatile("" : "+v"(bar));
    if (leader) {
        __builtin_amdgcn_s_waitcnt(0);
        unsigned nloc = b.st[0], nx = b.st[1];
        if (nloc == 0u) { xcd_barrier_complete(bar, b.x, nloc, nx); b.st[0] = nloc; b.st[1] = nx; }
        const unsigned old = xb_add(&bar[XB_XSUB(b.x)], 1u);
        const unsigned gen = old / nloc;
        if (old + 1u == (gen + 1u) * nloc) {
            __builtin_amdgcn_fence(__ATOMIC_RELEASE, "agent");
            asm volatile("s_waitcnt vmcnt(0)" ::: "memory");
            const unsigned og = xb_add(&bar[XB_TOP], 1u);
            const unsigned tg = og / nx;
            if (og + 1u == (tg + 1u) * nx) xb_add(&bar[XB_TOPGEN], 1u);
            else XB_SPIN(xb_ld(&bar[XB_TOPGEN]) == tg, bar);
            __builtin_amdgcn_fence(__ATOMIC_ACQUIRE, "agent");
            xb_add(&bar[XB_XGEN(b.x)], 1u);
            asm volatile("s_waitcnt vmcnt(0)" ::: "memory");
        } else {
            XB_SPIN(xb_ld(&bar[XB_XGEN(b.x)]) == gen, bar);
            __builtin_amdgcn_fence(__ATOMIC_ACQUIRE, "agent");
            asm volatile("s_waitcnt vmcnt(0)" ::: "memory");
        }
    }
    __syncthreads();
}

struct Args { const float* in[23]; float* out; unsigned char* ws; };
enum { I_X = 0, I_C, I_CTX, I_CCTX, I_WMOD, I_BMOD, I_N1G, I_N2G, I_WIN, I_DLAM, I_SUBLN, I_QKG, I_SINK, I_WBR, I_WOUT, I_FG, I_FU, I_FD, I_RW, I_MG, I_MU, I_MD, I_FINALG };

__device__ __forceinline__ bf16_t* w_layer(unsigned char* ws, int l, size_t off) { return (bf16_t*)(ws + WS_W + (size_t)l * W_LAYER + off); }
__device__ __forceinline__ bf16_t* w_dense(unsigned char* ws, int i, size_t off) { return (bf16_t*)(ws + WS_W + W_DENSE0 + (size_t)i * W_DENSE + off); }
__device__ __forceinline__ bf16_t* w_moe(unsigned char* ws, int i, int e, size_t off) { return (bf16_t*)(ws + WS_W + W_MOE0 + (size_t)i * W_MOE + (size_t)e * W_EXPERT + off); }

constexpr int CV_LAYER = 1536 + 2048 + 1024 + 512;
constexpr int CV_DENSE = 3 * 1408;
constexpr int CV_EXP = 3 * 1792;
constexpr int CV_TOTAL = 4 * CV_LAYER + 2 * CV_DENSE + 16 * CV_EXP;
struct ConvDesc { const float* src; bf16_t* dst; int ldsrc, lddst, perm; };
__device__ __forceinline__ ConvDesc conv_decode(const Args& a, int it) {
    unsigned char* ws = a.ws;
    const float* src; int ldsrc, K, c0, ncols, mode = 0, drow0 = 0, blk, ldd = 0; bf16_t* dst; bool win = false;
    if (it < 4 * CV_LAYER) { const int l = it / CV_LAYER, r = it % CV_LAYER;
        if (r < 1536) { blk = r; src = a.in[I_WIN] + (size_t)l * DM * DIN; ldsrc = DIN; K = DM; c0 = 0; ncols = 3072; dst = w_layer(ws, l, W_IN); drow0 = 0; win = true; }
        else if (r < 3584) { blk = r - 1536; src = a.in[I_WIN] + (size_t)l * DM * DIN; ldsrc = DIN; K = DM; c0 = 3584; ncols = 4096; dst = w_layer(ws, l, W_IN); drow0 = 3072; }
        else if (r < 4608) { const int q = r - 3584, rr = q / 256; blk = q % 256; src = a.in[I_WBR] + (size_t)(l * 4 + rr) * 512 * DM; ldsrc = DM; K = 512; c0 = 0; ncols = DM; dst = w_layer(ws, l, W_BR) + (size_t)rr * 512; ldd = 2048; }
        else { blk = r - 4608; src = a.in[I_WOUT] + (size_t)l * DM * DM; ldsrc = DM; K = DM; c0 = 0; ncols = DM; dst = w_layer(ws, l, W_OUT); }
    } else if (it < 4 * CV_LAYER + 2 * CV_DENSE) { const int q = it - 4 * CV_LAYER, i = q / CV_DENSE, r = q % CV_DENSE, which = r / 1408; blk = r % 1408;
        if (which < 2) { src = a.in[which == 0 ? I_FG : I_FU] + (size_t)i * DM * DFF; ldsrc = DFF; K = DM; c0 = 0; ncols = DFF; dst = w_dense(ws, i, W_DGU); mode = 1 + which; }
        else { src = a.in[I_FD] + (size_t)i * DFF * DM; ldsrc = DM; K = DFF; c0 = 0; ncols = DM; dst = w_dense(ws, i, W_DD); }
    } else { const int q = it - 4 * CV_LAYER - 2 * CV_DENSE, ie = q / CV_EXP, r = q % CV_EXP, which = r / 1792, i = ie >> 3, e = ie & 7; blk = r % 1792;
        if (which < 2) { src = a.in[which == 0 ? I_MG : I_MU] + (size_t)ie * DM * DFE; ldsrc = DFE; K = DM; c0 = 0; ncols = DFE; dst = w_moe(ws, i, e, W_MGU); mode = 1 + which; }
        else { src = a.in[I_MD] + (size_t)ie * DFE * DM; ldsrc = DM; K = DFE; c0 = 0; ncols = DM; dst = w_moe(ws, i, e, W_MD); }
    }
    const int nbn = ncols / 32, kb = blk / nbn, nb = blk % nbn, n = 32 * nb;
    const int drow = mode == 0 ? drow0 + n : 256 * (n >> 7) + (n & 127) + (mode == 2 ? 128 : 0);
    const bool perm = win && (n < 1024 || (n >= 1536 && n < 2176) || (n >= 2304 && n < 2944));
    ConvDesc d; d.src = src + (size_t)(64 * kb) * ldsrc + c0 + n; if (ldd == 0) ldd = K;
    d.dst = dst + (size_t)drow * ldd + 64 * kb; d.ldsrc = ldsrc; d.lddst = ldd; d.perm = perm ? 1 : 0;
    return d;
}
__device__ __forceinline__ void conv_load(const ConvDesc& d, float (&r)[32], int lane) {
    const GAS float* s = (const GAS float*)d.src + (size_t)(lane >> 5) * d.ldsrc + (lane & 31);
#pragma unroll
    for (int i = 0; i < 32; ++i) r[i] = __builtin_nontemporal_load(s + (size_t)(2 * i) * d.ldsrc);
}
__device__ __forceinline__ void conv_store(const ConvDesc& d, const float (&r)[32], LAS float* scr, int lane) {
#pragma unroll
    for (int i = 0; i < 32; ++i) scr[(2 * i + (lane >> 5)) * 33 + (lane & 31)] = r[i];
    LDS_WAIT(); asm volatile("" ::: "memory");
    const int c = lane & 7;
#pragma unroll
    for (int j = 0; j < 4; ++j) { const int n = (lane >> 3) + 8 * j; const LAS float* s = scr + (8 * c) * 33 + n;
        u32x4 o; o.x = cvt_pk_bf16(s[0 * 33], s[1 * 33]); o.y = cvt_pk_bf16(s[2 * 33], s[3 * 33]); o.z = cvt_pk_bf16(s[4 * 33], s[5 * 33]); o.w = cvt_pk_bf16(s[6 * 33], s[7 * 33]);
        const int dn = d.perm ? 2 * (n & 15) + (n >> 4) : n;
        __builtin_nontemporal_store(o, (GAS u32x4*)(d.dst + (size_t)dn * d.lddst + 8 * c)); }
    LDS_WAIT(); asm volatile("" ::: "memory");
}
__device__ __forceinline__ void fzfold_item(const Args& a, int it, int lane) {
    const int mq = it & 3, kb = (it >> 2) & 15, g = (it >> 6) & 7, l = it >> 9, k0 = 64 * kb;
    const GAS f32x4* src = (const GAS f32x4*)(a.in[I_WIN] + (size_t)l * DM * DIN + (size_t)(k0 + lane) * DIN + 3072 + g * 64);
    float w[64];
#pragma unroll
    for (int i = 0; i < 16; ++i) { const f32x4 v = src[i]; w[4 * i] = v[0]; w[4 * i + 1] = v[1]; w[4 * i + 2] = v[2]; w[4 * i + 3] = v[3]; }
    const float cv = cospif((float)lane * (1.0f / 32.0f)), sv = sinpif((float)lane * (1.0f / 32.0f));
    GAS bf16_t* dst = (GAS bf16_t*)w_layer(a.ws, l, W_FZ);
    for (int m = 16 * mq; m < 16 * mq + 16; ++m) {
        float sc = 0.f, ss = 0.f;
#pragma unroll
        for (int c = 0; c < 64; ++c) { const int j = (c * m) & 63;
            const float cj = __builtin_bit_cast(float, __builtin_amdgcn_readlane(__builtin_bit_cast(int, cv), j)), sj = __builtin_bit_cast(float, __builtin_amdgcn_readlane(__builtin_bit_cast(int, sv), j));
            sc += w[c] * cj; ss += w[c] * sj; }
        dst[(size_t)(g * 64 + m) * DM + k0 + lane] = f2bf(sc);
        dst[(size_t)(512 + g * 64 + m) * DM + k0 + lane] = f2bf(ss);
    }
}
__device__ __forceinline__ void mod_item(const Args& a, int item, LAS unsigned char* lds, int tid) {
    const int l = item / 24, chunk = item % 24, wid = tid >> 6, lane = tid & 63;
    LAS float* sc = (LAS float*)lds;
    LAS float* red = (LAS float*)(lds + 36864);
    for (int i = tid; i < 9 * 1024; i += 512) { const float v = i < 8192 ? a.in[I_C][i] : a.in[I_CCTX][i - 8192]; sc[i] = siluf_(v); }
    __syncthreads();
    const float* w = a.in[I_WMOD] + (size_t)l * DM * 6144 + chunk * 256 + lane * 4;
    f32x4 acc[9];
#pragma unroll
    for (int r = 0; r < 9; ++r) acc[r] = (f32x4){0.f, 0.f, 0.f, 0.f};
    const int kb = wid * 128;
#pragma unroll 8
    for (int k = 0; k < 128; ++k) { const f32x4 wv = *(const GAS f32x4*)(w + (size_t)(kb + k) * 6144);
#pragma unroll
        for (int r = 0; r < 9; ++r) acc[r] += wv * sc[r * 1024 + kb + k]; }
#pragma unroll
    for (int r = 0; r < 9; ++r) *(LAS f32x4*)(red + (wid * 9 + r) * 256 + lane * 4) = acc[r];
    __syncthreads();
    float* modv = (float*)(a.ws + WS_MODV) + (size_t)l * 9 * 6144;
    for (int i = tid; i < 9 * 256; i += 512) { const int r = i >> 8, c = i & 255; float s = 0.f;
#pragma unroll
        for (int w8 = 0; w8 < 8; ++w8) s += red[(w8 * 9 + r) * 256 + c];
        modv[r * 6144 + chunk * 256 + c] = s + a.in[I_BMOD][l * 6144 + chunk * 256 + c]; }
    __syncthreads();
}

struct RowV { f32x4 v[4]; };
__device__ __forceinline__ RowV load_row_f32(const float* p, int lane) { RowV r; const f32x4* q = (const f32x4*)p + lane;
#pragma unroll
    for (int j = 0; j < 4; ++j) r.v[j] = q[64 * j];
    return r; }
__device__ __forceinline__ void store_row_f32(float* p, const RowV& r, int lane) { f32x4* q = (f32x4*)p + lane;
#pragma unroll
    for (int j = 0; j < 4; ++j) q[64 * j] = r.v[j]; }
__device__ __forceinline__ RowV load_row_bf16(const bf16_t* p, int lane) { RowV r; const u32x2* q = (const u32x2*)p + lane;
#pragma unroll
    for (int j = 0; j < 4; ++j) { const u32x2 w = q[64 * j]; r.v[j] = (f32x4){bf_lo(w.x), bf_hi(w.x), bf_lo(w.y), bf_hi(w.y)}; }
    return r; }
__device__ __forceinline__ void store_row_bf16(bf16_t* p, const RowV& r, int lane) { u32x2* q = (u32x2*)p + lane;
#pragma unroll
    for (int j = 0; j < 4; ++j) { u32x2 w; w.x = cvt_pk_bf16(r.v[j][0], r.v[j][1]); w.y = cvt_pk_bf16(r.v[j][2], r.v[j][3]); q[64 * j] = w; } }
__device__ __forceinline__ RowV adaln_row(const RowV& x, const float* g, const float* shift, const float* scale, int lane) {
    float ss = 0.f;
#pragma unroll
    for (int j = 0; j < 4; ++j) ss += (x.v[j][0] * x.v[j][0] + x.v[j][1] * x.v[j][1]) + (x.v[j][2] * x.v[j][2] + x.v[j][3] * x.v[j][3]);
    const float rstd = 1.0f / sqrtf(wave_sum(ss) * (1.0f / DM) + 1e-6f);
    const RowV gv = load_row_f32(g, lane), sh = load_row_f32(shift, lane), sc = load_row_f32(scale, lane);
    RowV y;
#pragma unroll
    for (int j = 0; j < 4; ++j) y.v[j] = x.v[j] * rstd * gv.v[j] * (1.0f + sc.v[j]) + sh.v[j];
    return y;
}
__device__ __forceinline__ int mod_row_of(int row) { return row < NLAT ? (row >> 11) : 8; }
struct AdaCoef { RowV A, B; int mr; };
__device__ __forceinline__ void ada_coef_update(AdaCoef& c, int row, const float* g, const float* modbase, int shift_off, int scale_off, int lane) {
    const int mr = mod_row_of(row);
    if (mr != c.mr) { c.mr = mr; const float* mv = modbase + (size_t)mr * 6144;
        const RowV gv = load_row_f32(g, lane), sh = load_row_f32(mv + shift_off, lane), sc = load_row_f32(mv + scale_off, lane);
#pragma unroll
        for (int j = 0; j < 4; ++j) { c.A.v[j] = gv.v[j] * (1.0f + sc.v[j]); c.B.v[j] = sh.v[j]; } }
}
__device__ __forceinline__ RowV adaln_apply(const RowV& x, const AdaCoef& c) {
    float ss = 0.f;
#pragma unroll
    for (int j = 0; j < 4; ++j) ss += (x.v[j][0] * x.v[j][0] + x.v[j][1] * x.v[j][1]) + (x.v[j][2] * x.v[j][2] + x.v[j][3] * x.v[j][3]);
    const float rstd = 1.0f / sqrtf(wave_sum(ss) * (1.0f / DM) + 1e-6f);
    RowV y;
#pragma unroll
    for (int j = 0; j < 4; ++j) y.v[j] = x.v[j] * rstd * c.A.v[j] + c.B.v[j];
    return y;
}

struct MoeTiles { int tb[9]; };
__device__ __forceinline__ MoeTiles moe_tiles(unsigned* ctl, int i) { MoeTiles t; int s = 0;
#pragma unroll
    for (int e = 0; e < 8; ++e) { t.tb[e] = s; const unsigned c = (unsigned)__builtin_amdgcn_readfirstlane((int)__hip_atomic_load(ctl + CW_CNT + 64 * (8 * i + e), __ATOMIC_RELAXED, __HIP_MEMORY_SCOPE_AGENT)); s += (int)((c + 255u) >> 8); }
    t.tb[8] = s; return t; }

__device__ __forceinline__ float max3f(float a, float b, float c) { return __builtin_fmaxf(__builtin_fmaxf(a, b), c); }
__device__ __forceinline__ int crow(int r, int hi) { return (r & 3) + 8 * (r >> 2) + 4 * hi; }
typedef short v4i16_t __attribute__((ext_vector_type(4)));
__device__ __forceinline__ s16x4 vtr(const LAS unsigned char* p) { return __builtin_bit_cast(s16x4, __builtin_amdgcn_ds_read_tr16_b64_v4i16((LAS v4i16_t*)p)); }

struct AttnCtx { const bf16_t* P; bf16_t* O; const float* subln_g; float lam, one_m_li; const float* sink; };

constexpr float ATT_THR = 8.0f;
__device__ __forceinline__ void glds16(const void* gsrc, unsigned lds_dst) { unsigned keep;
    asm volatile("s_mov_b32 %0, m0\n\ts_mov_b32 m0, %2\n\ts_nop 0\n\tglobal_load_lds_dwordx4 %1, off\n\ts_mov_b32 m0, %0" : "=&s"(keep) : "v"(gsrc), "s"(lds_dst) : "memory"); }
#define ATT_BAR() do { __builtin_amdgcn_sched_barrier(0); asm volatile("s_waitcnt lgkmcnt(0)" ::: "memory"); __builtin_amdgcn_s_barrier(); asm volatile("" ::: "memory"); __builtin_amdgcn_sched_barrier(0); } while (0)
template <int VAR>
__device__ __forceinline__ void attn_unit(LAS unsigned char* lds, const int tid, const AttnCtx& ac, int b, int hh, int qb, bool ctxq) {
    constexpr int NDB = (VAR == 0) ? 4 : 2;
    constexpr int NLD = (VAR == 0) ? 2 : 1;
    constexpr int KB = (VAR == 0) ? 16384 : 8192;
    constexpr int VB = (VAR == 0) ? 16384 : 8192;
    constexpr int VBASE = 3 * KB;
    constexpr int WSF_OFF = 135168;
    const int lane = tid & 63, r32 = lane & 31, hi = lane >> 5; const int wid = __builtin_amdgcn_readfirstlane(tid >> 6);
    const int half = wid >> 2;
    int map = 0, g = 0, qsub, qcol, kcol, vcol, ocol, qpb;
    if (VAR == 0) { map = wid >> 2; qsub = wid & 3; qpb = 128; qcol = C_AQ + hh * 128 + map * 64; kcol = C_AK + hh * 128; vcol = C_AV + hh * 128; ocol = hh * 128; }
    else { g = wid >> 1; qsub = wid & 1; qpb = 64; qcol = (VAR == 1 ? C_BQ : C_CQ) + (hh * 4 + g) * 64; kcol = (VAR == 1 ? C_BK : C_CK) + hh * 64; vcol = (VAR == 1 ? C_BV : C_CV) + hh * 64; ocol = (VAR == 1 ? 512 : 1024) + (hh * 4 + g) * 64; }
    const int q0w = qb * qpb + qsub * 32;
    const int latbase = b * SEQ, ctxbase = NLAT + b * CTXL;
    const int qrow0 = (ctxq ? ctxbase : latbase) + q0w;
    int NT, lt0 = 0;
    if (ctxq) NT = 4;
    else if (VAR == 2) { lt0 = qb - 2 < 0 ? 0 : qb - 2; const int lt1 = qb + 2 > 31 ? 31 : qb + 2; NT = 4 + (lt1 - lt0 + 1); }
    else NT = 36;
    auto tile_row0 = [&](int t) -> int {
        if (ctxq) return ctxbase + 64 * t;
        if (VAR == 2) return t < 4 ? ctxbase + 64 * t : latbase + 64 * (lt0 + t - 4);
        return t < 32 ? latbase + 64 * t : ctxbase + 64 * (t - 32);
    };
    const GAS bf16_t* Pg = (const GAS bf16_t*)ac.P;
    bf16x8 qr[4];
    { const GAS bf16_t* qp = Pg + (size_t)(qrow0 + r32) * PW + qcol + hi * 8;
#pragma unroll
      for (int d0 = 0; d0 < 4; ++d0) qr[d0] = *(const GAS bf16x8*)(qp + d0 * 16); }
    const GAS bf16_t* kdma = Pg + (size_t)lane * PW + kcol + 8 * wid;
    const GAS bf16_t* vdma = Pg + (size_t)(16 * (wid & 3) + (lane >> 2)) * PW + vcol + (wid >> 2) * 32 + (lane & 3) * 8;
    const unsigned lds0 = (unsigned)(uintptr_t)lds + (unsigned)wid * 1024u;
    auto gloadK = [&](int t, int slot) { const GAS bf16_t* rp = kdma + (size_t)tile_row0(t) * PW;
#pragma unroll
        for (int j = 0; j < NLD; ++j) glds16((const void*)(rp + 64 * j), (unsigned)__builtin_amdgcn_readfirstlane(lds0 + (unsigned)(slot * KB + j * 8192))); };
    auto gloadV = [&](int t, int slot) { const GAS bf16_t* rp = vdma + (size_t)tile_row0(t) * PW;
#pragma unroll
        for (int j = 0; j < NLD; ++j) glds16((const void*)(rp + 64 * j), (unsigned)__builtin_amdgcn_readfirstlane(lds0 + (unsigned)(VBASE + slot * VB + j * 8192))); };
    volatile LAS float* wsf = (volatile LAS float*)(lds + WSF_OFF + wid * 256);
    const int koff = (VAR == 0 ? map * 8192 : 0) + hi * 1024 + r32 * 16;
    const int vlane = (4 * hi + ((lane & 15) >> 2)) * 64 + ((lane >> 4) & 1) * 32 + (lane & 3) * 8;
    f32x16 o[NDB];
#pragma unroll
    for (int d = 0; d < NDB; ++d) o[d] = (f32x16){0.f, 0.f, 0.f, 0.f, 0.f, 0.f, 0.f, 0.f, 0.f, 0.f, 0.f, 0.f, 0.f, 0.f, 0.f, 0.f};
    float m_run = 0.f, l_run = 0.f;
    f32x16 negm = (f32x16){0.f, 0.f, 0.f, 0.f, 0.f, 0.f, 0.f, 0.f, 0.f, 0.f, 0.f, 0.f, 0.f, 0.f, 0.f, 0.f};
    const int tq = q0w + r32;
    f32x16 s0, s1;
    auto qk = [&](int slot) { const LAS unsigned char* bp = lds + slot * KB + koff;
        s0 = negm; s1 = negm;
        constexpr int KH = (VAR == 0) ? 2 : 4;
#pragma unroll
        for (int h = 0; h < 4; h += KH) {
            bf16x8 kf[2 * KH];
#pragma unroll
            for (int d0 = 0; d0 < KH; ++d0) { kf[2 * d0] = *(const LAS bf16x8*)(bp + (h + d0) * 2048); kf[2 * d0 + 1] = *(const LAS bf16x8*)(bp + (h + d0) * 2048 + 512); }
            __builtin_amdgcn_sched_barrier(0);
#pragma unroll
            for (int d0 = 0; d0 < KH; ++d0) {
                s0 = __builtin_amdgcn_mfma_f32_32x32x16_bf16(kf[2 * d0], qr[h + d0], s0, 0, 0, 0);
                s1 = __builtin_amdgcn_mfma_f32_32x32x16_bf16(kf[2 * d0 + 1], qr[h + d0], s1, 0, 0, 0); }
            if (h + KH < 4) __builtin_amdgcn_sched_barrier(0);
        } };
    gloadK(0, 0); gloadV(0, 0);
    if (NT > 1) gloadK(1, 1);
    asm volatile("s_waitcnt vmcnt(0)" ::: "memory"); ATT_BAR();
    if (NT > 2) gloadK(2, 2);
    if (NT > 1) gloadV(1, 1);
    qk(0);
    ATT_BAR();
    if (half == 1) ATT_BAR();
    int k0 = 0;
    for (int t = 0; t < NT; ++t) {
        const bool more1 = t + 1 < NT, more2 = t + 2 < NT, more3 = t + 3 < NT;
        const int k1 = k0 == 2 ? 0 : k0 + 1, k2 = k1 == 2 ? 0 : k1 + 1;
        if (VAR == 2 && !ctxq && t >= 4) {
            const int lt = lt0 + t - 4, kb = 64 * lt + 4 * hi - tq;
            if (lt == qb - 2) {
#pragma unroll
                for (int r = 0; r < 16; ++r) { const int d = kb + (r & 3) + 8 * (r >> 2); if (d < -128) s0[r] = -1e30f; if (d + 32 < -128) s1[r] = -1e30f; }
            } else if (lt == qb + 2) {
#pragma unroll
                for (int r = 0; r < 16; ++r) { const int d = kb + (r & 3) + 8 * (r >> 2); if (d > 128) s0[r] = -1e30f; if (d + 32 > 128) s1[r] = -1e30f; }
            }
        }
        float ma = max3f(s0[0], s0[1], s1[0]), mb = max3f(s0[2], s0[3], s1[1]); ma = max3f(ma, s1[2], s1[3]);
#pragma unroll
        for (int r = 4; r < 16; r += 4) { ma = max3f(ma, s0[r], s0[r + 1]); mb = max3f(mb, s0[r + 2], s0[r + 3]); ma = max3f(ma, s1[r], s1[r + 1]); mb = max3f(mb, s1[r + 2], s1[r + 3]); }
        float mx = fmaxf(ma, mb);
        { const auto rr = __builtin_amdgcn_permlane32_swap(__float_as_uint(mx), __float_as_uint(mx), false, false); mx = fmaxf(__uint_as_float(rr[0]), __uint_as_float(rr[1])); }
        if (t == 0 || __any(mx > ATT_THR)) {
            const float dl = (t == 0) ? mx : fmaxf(mx, 0.f);
            m_run += dl;
#pragma unroll
            for (int r = 0; r < 16; ++r) { s0[r] -= dl; s1[r] -= dl; negm[r] = -m_run; }
            const float f = fast_exp2(-dl);
            l_run *= f;
            if (hi == 0) wsf[r32] = f;
            LDS_WAIT();
#pragma unroll
            for (int r = 0; r < 16; ++r) { const float al = wsf[crow(r, hi)];
#pragma unroll
                for (int d = 0; d < NDB; ++d) o[d][r] *= al; }
        }
        float la = 0.f, lb = 0.f;
#pragma unroll
        for (int r = 0; r < 16; ++r) { s0[r] = fast_exp2(s0[r]); s1[r] = fast_exp2(s1[r]); la += s0[r]; lb += s1[r]; }
        l_run += la + lb;
        bf16x8 pa[4];
        { u32x4 w;
          w.x = cvt_pk_bf16(s0[0], s0[1]); w.y = cvt_pk_bf16(s0[2], s0[3]); w.z = cvt_pk_bf16(s0[4], s0[5]); w.w = cvt_pk_bf16(s0[6], s0[7]); pa[0] = __builtin_bit_cast(bf16x8, w);
          w.x = cvt_pk_bf16(s0[8], s0[9]); w.y = cvt_pk_bf16(s0[10], s0[11]); w.z = cvt_pk_bf16(s0[12], s0[13]); w.w = cvt_pk_bf16(s0[14], s0[15]); pa[1] = __builtin_bit_cast(bf16x8, w);
          w.x = cvt_pk_bf16(s1[0], s1[1]); w.y = cvt_pk_bf16(s1[2], s1[3]); w.z = cvt_pk_bf16(s1[4], s1[5]); w.w = cvt_pk_bf16(s1[6], s1[7]); pa[2] = __builtin_bit_cast(bf16x8, w);
          w.x = cvt_pk_bf16(s1[8], s1[9]); w.y = cvt_pk_bf16(s1[10], s1[11]); w.z = cvt_pk_bf16(s1[12], s1[13]); w.w = cvt_pk_bf16(s1[14], s1[15]); pa[3] = __builtin_bit_cast(bf16x8, w); }
        ATT_BAR();
        if (more3) gloadK(t + 3, k0);
        if (more2) gloadV(t + 2, k2);
        const LAS unsigned char* vp = lds + VBASE + k0 * VB + vlane;
        s16x4 va_lo[NDB], va_hi[NDB], vb_lo[NDB], vb_hi[NDB];
#define ATT_VLOAD(LO, HI, KS) do { _Pragma("unroll") for (int d = 0; d < NDB; ++d) { LO[d] = vtr(vp + d * 4096 + (KS) * 1024); HI[d] = vtr(vp + d * 4096 + (KS) * 1024 + 512); } } while (0)
#define ATT_VMMA(LO, HI, KS) do { _Pragma("unroll") for (int d = 0; d < NDB; ++d) { const bf16x8 vf = (bf16x8){LO[d][0], LO[d][1], LO[d][2], LO[d][3], HI[d][0], HI[d][1], HI[d][2], HI[d][3]}; \
            o[d] = __builtin_amdgcn_mfma_f32_32x32x16_bf16(pa[KS], vf, o[d], 0, 0, 0); } } while (0)
        ATT_VLOAD(va_lo, va_hi, 0); ATT_VLOAD(vb_lo, vb_hi, 1);
        __builtin_amdgcn_sched_barrier(0);
        ATT_VMMA(va_lo, va_hi, 0);
        __builtin_amdgcn_sched_barrier(0);
        ATT_VLOAD(va_lo, va_hi, 2);
        __builtin_amdgcn_sched_barrier(0);
        ATT_VMMA(vb_lo, vb_hi, 1);
        __builtin_amdgcn_sched_barrier(0);
        ATT_VLOAD(vb_lo, vb_hi, 3);
        __builtin_amdgcn_sched_barrier(0);
        ATT_VMMA(va_lo, va_hi, 2);
        ATT_VMMA(vb_lo, vb_hi, 3);
#undef ATT_VLOAD
#undef ATT_VMMA
        if (more1) qk(k1);
        if (more3) { if (NLD == 2) asm volatile("s_waitcnt vmcnt(4)" ::: "memory"); else asm volatile("s_waitcnt vmcnt(2)" ::: "memory"); }
        else if (more2) { if (NLD == 2) asm volatile("s_waitcnt vmcnt(2)" ::: "memory"); else asm volatile("s_waitcnt vmcnt(1)" ::: "memory"); }
        else asm volatile("s_waitcnt vmcnt(0)" ::: "memory");
        ATT_BAR();
        k0 = k1;
    }
    if (half == 0) ATT_BAR();
    { float l_tot; { const auto rr = __builtin_amdgcn_permlane32_swap(__float_as_uint(l_run), __float_as_uint(l_run), false, false); l_tot = __uint_as_float(rr[0]) + __uint_as_float(rr[1]); }
      if (VAR == 2) l_tot += fast_exp2(ac.sink[hh * 4 + g] * LOG2E - m_run);
      if (hi == 0) wsf[r32] = 1.0f / l_tot;
      LDS_WAIT();
#pragma unroll
      for (int r = 0; r < 16; ++r) { const float il = wsf[crow(r, hi)];
#pragma unroll
          for (int d = 0; d < NDB; ++d) o[d][r] *= il; } }
    GAS bf16_t* Og = (GAS bf16_t*)ac.O;
    if (VAR != 0) {
#pragma unroll
        for (int r = 0; r < 16; ++r) { GAS bf16_t* op = Og + (size_t)(qrow0 + crow(r, hi)) * OW + ocol + r32;
#pragma unroll
            for (int d = 0; d < NDB; ++d) op[d * 32] = f2bf(o[d][r]); }
    } else {
        LAS float* tile = (LAS float*)lds + ((wid & 3) * 2 + map) * (32 * 132);
#pragma unroll
        for (int r = 0; r < 16; ++r)
#pragma unroll
            for (int d = 0; d < NDB; ++d) tile[crow(r, hi) * 132 + d * 32 + r32] = o[d][r];
        __syncthreads();
        const int ql = (wid >> 2) * 16 + (lane >> 2), part = lane & 3;
        const LAS float* t0 = (const LAS float*)lds + ((wid & 3) * 2) * (32 * 132) + ql * 132 + part * 32;
        const LAS float* t1 = t0 + 32 * 132;
        f32x4 dv[8]; float ss = 0.f;
#pragma unroll
        for (int j = 0; j < 8; ++j) { const f32x4 a = *(const LAS f32x4*)(t0 + 4 * j), bq = *(const LAS f32x4*)(t1 + 4 * j); dv[j] = a - ac.lam * bq;
            ss += (dv[j][0] * dv[j][0] + dv[j][1] * dv[j][1]) + (dv[j][2] * dv[j][2] + dv[j][3] * dv[j][3]); }
        ss += __shfl_xor(ss, 1); ss += __shfl_xor(ss, 2);
        const float rs = ac.one_m_li / sqrtf(ss * (1.0f / 128.0f) + 1e-5f);
        const GAS float* gp = (const GAS float*)ac.subln_g + part * 32;
        GAS bf16_t* op = Og + (size_t)((ctxq ? ctxbase : latbase) + qb * qpb + (wid & 3) * 32 + ql) * OW + ocol + part * 32;
#pragma unroll
        for (int k = 0; k < 4; ++k) { const f32x4 g0 = *(const GAS f32x4*)(gp + 8 * k), g1 = *(const GAS f32x4*)(gp + 8 * k + 4);
            const f32x4 v0 = dv[2 * k] * g0 * rs, v1 = dv[2 * k + 1] * g1 * rs;
            u32x4 w; w.x = cvt_pk_bf16(v0[0], v0[1]); w.y = cvt_pk_bf16(v0[2], v0[3]); w.z = cvt_pk_bf16(v1[0], v1[1]); w.w = cvt_pk_bf16(v1[2], v1[3]);
            *(GAS u32x4*)(op + 8 * k) = w; }
    }
}

using pg8::Unit;
struct SchedInproj {
    int c, G, nM, ntot, nfz; const char* xn; const char* win; const char* wfz; char* p; char* zz; char* zzc; const char* rope; char* gates;
    __device__ __forceinline__ bool next(int i, Unit& u) const {
        const int L = i * G + c; if (L >= ntot + nfz) return false;
        u.aux = nullptr; u.aux2 = nullptr;
        if (L < ntot) { int pm, pn; pg8::tile_of(L, nM, 28, pm, pn);
            u.A = xn + (size_t)pm * 256 * DM * 2; u.B = win + (size_t)pn * 256 * DM * 2; if (pn < 12) { u.out = p + ((size_t)pm * 256 * PW + pn * 256) * 2; u.ldc = PW; } else { u.out = gates + ((size_t)pm * 256 * GW + (pn - 12) * 256); u.ldc = GW; }
            int fl = pm < 64 ? 16 : 0;
            if (pn >= 12) fl |= 1; else if (pn < 2) fl |= 2 | 8; else if (pn < 4) fl |= 2; else if (pn == 9 || pn == 10) fl |= 2 | 8; else if (pn == 11) fl |= 4;
            u.flag = fl; u.aux = rope + (size_t)((pm * 256) & 2047) * 64 * 4; }
        else { const int q = L - ntot;
            if (q < 256) { const int b = q >> 5, pm = (q >> 3) & 3, pn = q & 7;
                u.A = wfz + (size_t)pm * 256 * DM * 2; u.B = xn + (size_t)(b * SEQ + pn * 256) * DM * 2;
                u.out = zz + ((size_t)b * 512 * 4096 + (size_t)((pm & 1) * 256) * 4096 + (pm >> 1) * 2048 + pn * 256) * 2; u.ldc = 4096; u.flag = 0; }
            else { const int q2 = q - 256, b = q2 >> 2, pm = q2 & 3;
                u.A = wfz + (size_t)pm * 256 * DM * 2; u.B = xn + (size_t)(NLAT + b * CTXL) * DM * 2;
                u.out = zzc + ((size_t)b * 512 * 512 + (size_t)((pm & 1) * 256) * 512 + (pm >> 1) * 256) * 2; u.ldc = 512; u.flag = 0; } }
        return true;
    }
};
struct SchedDft {
    int c; const char* T; const char* zz; char* o;
    __device__ __forceinline__ bool next(int i, Unit& u) const {
        if (i > 0 || c >= 128) return false;
        const int b = c >> 4, pm = (c >> 1) & 7, pn = c & 1;
        u.A = T + (size_t)pm * 256 * 4096 * 2; u.B = zz + ((size_t)b * 512 + pn * 256) * 4096 * 2;
        u.out = o + ((size_t)(b * SEQ + pm * 256) * OW + 1536 + pn * 256) * 2; u.ldc = OW; u.flag = 0; u.aux = nullptr; u.aux2 = nullptr; return true;
    }
};
struct SchedDftCtx {
    int c; const char* T; const char* zzc; char* o;
    __device__ __forceinline__ bool next(int i, Unit& u) const {
        if (i > 0 || c < 128 || c >= 144) return false;
        const int q = c - 128, b = q >> 1, pn = q & 1;
        u.A = T; u.B = zzc + ((size_t)b * 512 + pn * 256) * 512 * 2;
        u.out = o + ((size_t)(NLAT + b * CTXL) * OW + 1536 + pn * 256) * 2; u.ldc = OW; u.flag = 0; u.aux = nullptr; u.aux2 = nullptr; return true;
    }
};
struct SchedBranch {
    int c, G, ntile; const char* o; const char* wbr; const char* p; char* merged;
    __device__ __forceinline__ bool next(int i, pg8::BUnit& u) const {
        const int xcd = c & 7, j = i * (G >> 3) + (c >> 3), pm = xcd + 8 * (j >> 3), pn2 = j & 7;
        if (pm * 8 >= ntile) return false;
        u.A = o + (size_t)pm * 256 * OW * 2; u.B = wbr + (size_t)pn2 * 128 * 2048 * 2;
        u.gate = p + ((size_t)pm * 256 * GW + pn2 * 128);
        u.out = merged + ((size_t)pm * 256 * 1024 + pn2 * 128) * 2; return true;
    }
};
struct SchedResid {
    int c, G, nM, K; const char* A; const char* B; char* xs; const char* modv; int goff; const char* xin; const char* cin;
    __device__ __forceinline__ bool next(int i, Unit& u) const {
        const int L = i * G + c; if (L >= nM * 4) return false;
        int pm, pn; pg8::tile_of(L, nM, 4, pm, pn);
        u.A = A + (size_t)pm * 256 * K * 2; u.B = B + (size_t)pn * 256 * K * 2; u.out = xs + ((size_t)pm * 256 * DM + pn * 256) * 2; u.ldc = DM;
        u.aux = modv + ((size_t)(pm < 64 ? (pm >> 3) : 8) * 6144 + goff + pn * 256) * 4; u.flag = xin ? 1 : 0;
        u.aux2 = xin ? (pm < 64 ? xin + ((size_t)pm * 256 * DM + pn * 256) * 4 : cin + ((size_t)(pm - 64) * 256 * DM + pn * 256) * 4) : (const char*)u.out; return true;
    }
};
struct SchedUp {
    int c, G, nM; const char* xn; const char* w; char* h;
    __device__ __forceinline__ bool next(int i, Unit& u) const {
        const int L = i * G + c; if (L >= nM * 22) return false;
        int pm, pn; pg8::tile_of(L, nM, 22, pm, pn);
        u.A = xn + (size_t)pm * 256 * DM * 2; u.B = w + (size_t)pn * 256 * DM * 2; u.out = h + ((size_t)pm * 256 * DFF + pn * 128) * 2; u.ldc = DFF; u.flag = 0; u.aux = nullptr; u.aux2 = nullptr; return true;
    }
};
struct SchedMoe {
    int c, G, NT, K, RT; MoeTiles mt; const char* A; const char* W; size_t wsub; char* out; int ldc, colw, esz;
    __device__ __forceinline__ bool next(int i, Unit& u) const {
        const int L0 = i * G + c, ntot = RT * NT; if (L0 >= ntot) return false;
        int L = L0; if (NT > 4) { const int q = ntot / 8, r = ntot % 8, xcd = L0 % 8, off = L0 / 8; L = (xcd < r ? xcd * (q + 1) : r * (q + 1) + (xcd - r) * q) + off; }
        const int gs = 8 * NT, g8 = L / gs, rem = L % gs, left = RT - 8 * g8, gsz = left < 8 ? left : 8;
        const int rt = 8 * g8 + rem % gsz, pn = rem / gsz;
        int e = 0;
#pragma unroll
        for (int k = 1; k < 8; ++k) e += (rt >= mt.tb[k]) ? 1 : 0;
        u.A = A + (size_t)rt * 256 * K * 2; u.B = W + (size_t)e * W_EXPERT + wsub + (size_t)pn * 256 * K * 2;
        u.out = out + ((size_t)rt * 256 * ldc + (size_t)pn * colw) * esz; u.ldc = ldc; u.flag = 0; u.aux = nullptr; u.aux2 = nullptr; return true;
    }
};

struct SchedMoeSplit {
    int c, G, RF, RT; MoeTiles mt; const char* A; const char* W; char* y0; char* y1;
    __device__ __forceinline__ bool next(int i, Unit& u) const {
        const int L = i * G + c; if (L >= (RT - RF) * 8) return false;
        const int ts = L >> 1, kh = L & 1, rt = RF + (ts >> 2), pn = ts & 3;
        int e = 0;
#pragma unroll
        for (int k = 1; k < 8; ++k) e += (rt >= mt.tb[k]) ? 1 : 0;
        u.A = A + ((size_t)rt * 256 * DFE + kh * (DFE / 2)) * 2; u.B = W + (size_t)e * W_EXPERT + W_MD + ((size_t)pn * 256 * DFE + kh * (DFE / 2)) * 2;
        u.out = kh ? y1 + ((size_t)(rt - RF) * 256 * DM + pn * 256) * 2 : y0 + ((size_t)rt * 256 * DM + pn * 256) * 2;
        u.ldc = DM; u.flag = 0; u.aux = nullptr; u.aux2 = nullptr; return true;
    }
};

#define LAUNDER_S(x) asm volatile("" : "+s"(x))
#define LAUNDER_V(x) asm volatile("" : "+v"(x))
constexpr int LDS_ARGOFF = LDS_CTLOFF + 512;
__device__ __forceinline__ const float* ARGP(LAS unsigned char* lds, int i) {
    unsigned off = LDS_ARGOFF + 8 * i; asm volatile("" : "+s"(off));
    volatile LAS unsigned* p = (volatile LAS unsigned*)(lds + off);
    const unsigned lo = __builtin_amdgcn_readfirstlane(p[0]), hi = __builtin_amdgcn_readfirstlane(p[1]);
    return (const float*)(((unsigned long long)hi << 32) | lo);
}
__device__ __forceinline__ void grid_barrier(LAS unsigned char* lds, int wv) {
    XcdBarrier b; b.bar = (unsigned*)((unsigned char*)ARGP(lds, 24) + WS_CTL) + CW_BAR; b.x = xb_xcc_id(); b.st = (volatile LAS unsigned*)(lds + LDS_CTLOFF);
    xcd_barrier(b, wv == 0 && lane_id() == 0);
}
struct Fr { LAS unsigned char* lds; unsigned char* ws; int tid, lane, wave, bid, G, gw, NGW; unsigned* ctl; };
__device__ __forceinline__ Fr make_frame(LAS unsigned char* lds, int wv) {
    Fr F; F.lds = lds;
    F.ws = (unsigned char*)ARGP(lds, 24); int t = wv * 64 + lane_id(); LAUNDER_V(t); F.tid = t; F.lane = t & 63; F.wave = wv;
    int b = blockIdx.x; LAUNDER_S(b); F.bid = b; int g = gridDim.x; LAUNDER_S(g); F.G = g; F.gw = b * 8 + F.wave; F.NGW = g * 8; F.ctl = (unsigned*)(F.ws + WS_CTL);
    return F;
}

constexpr int CV_PRO = 4 * CV_LAYER + 2 * CV_DENSE;
constexpr int CV_M1 = CV_PRO, CV_M3 = CV_PRO + 8 * CV_EXP;
#ifndef BG_BRW
#define BG_BRW 4
#endif
#ifndef BG_DDW
#define BG_DDW 7
#endif
constexpr int BG_BR = 192 * 8 * BG_BRW, BG_OUT = 224 * 8 * 4, BG_DD = 224 * 8 * BG_DDW;
constexpr int CVQ_BLK = 32;
constexpr int MQ1_S = CV_M1 + BG_BR + BG_OUT + BG_DD + BG_BR, MQ1_E = CV_M3, MQ2_S = CV_M3 + BG_OUT + BG_BR + BG_OUT + BG_DD, MQ2_E = CV_TOTAL;
static_assert(MQ1_S <= MQ1_E && MQ2_S <= MQ2_E && (MQ1_E - MQ1_S) % (8 * CVQ_BLK) == 0 && (MQ2_E - MQ2_S) % (8 * CVQ_BLK) == 0, "queue conversion ranges are whole units per XCD queue");
__device__ __forceinline__ void convert_range(LAS unsigned char* lds, const Fr& F, int start, int end, int gwi, int nw) {
    Args a;
#pragma unroll
    for (int i = 0; i < 23; ++i) a.in[i] = ARGP(lds, i);
    a.out = nullptr; a.ws = F.ws;
    LAS float* scr = (LAS float*)(lds + F.wave * 8704);
    float ra[32], rb[32]; ConvDesc d, dn; int it = start + gwi; bool have = it < end;
    if (have) { d = conv_decode(a, it); conv_load(d, ra, F.lane); }
    while (have) {
        const int itn = it + nw; const bool hn = itn < end;
        if (hn) { dn = conv_decode(a, itn); conv_load(dn, rb, F.lane); }
        conv_store(d, ra, scr, F.lane);
        if (hn) {
#pragma unroll
            for (int i = 0; i < 32; ++i) ra[i] = rb[i];
            d = dn; }
        it = itn; have = hn;
    }
}
__device__ __forceinline__ void bg_window(int kind, int l, int& s, int& e) {
    s = 0; e = 0;
    const int m1a = CV_M1, m1b = m1a + BG_BR, m1c = m1b + BG_OUT, m1d = m1c + BG_DD, m1e = MQ1_S;
    const int m3a = CV_M3, m3b = m3a + BG_OUT, m3c = m3b + BG_BR, m3d = m3c + BG_OUT, m3e = MQ2_S;
    if (kind == 0) { if (l == 0) { s = m1a; e = m1b; } else if (l == 1) { s = m1d; e = m1e; } else if (l == 2) { s = m3b; e = m3c; } }
    else if (kind == 1) { if (l == 0) { s = m1b; e = m1c; } else if (l == 1) { s = m3a; e = m3b; } else if (l == 2) { s = m3c; e = m3d; } }
    else { if (l == 0) { s = m1c; e = m1d; } else if (l == 2) { s = m3d; e = m3e; } }
}
__device__ __forceinline__ void phase_prologue(LAS unsigned char* lds, int wv) {
    const Fr F = make_frame(lds, wv);
    Args a;
#pragma unroll
    for (int i = 0; i < 23; ++i) a.in[i] = ARGP(lds, i);
    a.out = nullptr; a.ws = F.ws;
    if (F.bid < 96) mod_item(a, F.bid, lds, F.tid);
    for (int it = F.gw; it < 2048; it += F.NGW) fzfold_item(a, it, F.lane);
    convert_range(lds, F, 0, CV_LAYER, F.gw, F.NGW);
    float* rope = (float*)(F.ws + WS_ROPE);
    for (int i = F.gw * 64 + F.lane; i < SEQ * 64; i += F.NGW * 64) { const int t = i >> 6, j = i & 63, ax = j >> 5, isin = (j >> 4) & 1, f = j & 15;
        const float pos = (float)(ax == 0 ? (t >> 6) : (t & 63));
        const float inv = powf(10000.0f, -(float)f / 16.0f); const float ang = pos * inv;
        rope[i] = isin ? sinf(ang) : cosf(ang); }
    bf16_t* T = (bf16_t*)(F.ws + WS_T);
    for (int i = F.gw * 64 + F.lane; i < 2048 * 2048; i += F.NGW * 64) { const int k = i >> 11, n = i & 2047; const float x = (float)((k * n) & 2047) * (1.0f / 1024.0f);
        T[(size_t)k * 4096 + n] = f2bf(cospif(x)); T[(size_t)k * 4096 + 2048 + n] = f2bf(-sinpif(x)); }
    bf16_t* T2 = (bf16_t*)(F.ws + WS_T256);
    for (int i = F.gw * 64 + F.lane; i < 256 * 256; i += F.NGW * 64) { const int k = i >> 8, n = i & 255; const float x = (float)((k * n) & 255) * (1.0f / 128.0f);
        T2[k * 512 + n] = f2bf(cospif(x)); T2[k * 512 + 256 + n] = f2bf(-sinpif(x)); }
}
__device__ __forceinline__ void phase_first_norm(LAS unsigned char* lds, int wv) {
    const Fr F = make_frame(lds, wv);
    const float* X = ARGP(lds, I_X); const float* CX = ARGP(lds, I_CTX); const float* n1g = ARGP(lds, I_N1G);
    float* xs = (float*)(F.ws + WS_XS); bf16_t* xn = (bf16_t*)(F.ws + WS_XN); const float* modv_all = (const float*)(F.ws + WS_MODV);
    for (int row = F.gw; row < NTOK; row += F.NGW) {
        const float* src = row < NLAT ? X + (size_t)row * DM : CX + (size_t)(row - NLAT) * DM;
        const RowV x = load_row_f32(src, F.lane);
        const float* mv = modv_all + (size_t)mod_row_of(row) * 6144;
        const RowV y = adaln_row(x, n1g, mv, mv + 1024, F.lane);
        store_row_bf16(xn + (size_t)row * DM, y, F.lane);
    }
}
__device__ __forceinline__ void phase_inproj(LAS unsigned char* lds, int wv, int l) {
    const Fr F = make_frame(lds, wv); unsigned char* ws = F.ws; const bool lastl = l == DEPTH - 1;
    SchedInproj S{F.bid, F.G, NTOK / 256, (NTOK / 256) * 28, lastl ? 256 : 288, (const char*)(ws + WS_XN), (const char*)w_layer(ws, l, W_IN), (const char*)w_layer(ws, l, W_FZ), (char*)(ws + WS_P), (char*)(ws + WS_ZZ), (char*)(ws + WS_ZZC), (const char*)(ws + WS_ROPE), (char*)(ws + WS_G)};
    pg8::EpiInproj E{};
    pg8::gemm_phase<pg8::EpiInproj, SchedInproj, true, true>(lds, F.tid, DM, DM, DM, S, E);
}
__device__ __forceinline__ void phase_post(LAS unsigned char* lds, int wv, int l) {
    const Fr F = make_frame(lds, wv);
    GAS bf16_t* P = (GAS bf16_t*)(F.ws + WS_P); const GAS float* rope = (const GAS float*)(F.ws + WS_ROPE);
    const GAS float* gq = (const GAS float*)ARGP(lds, I_QKG) + l * 128; const GAS float* gk = gq + 64;
    const int lane = F.lane, a = (lane & 7) >> 2, i0 = 4 * (lane & 3);
    float gqv[8], gkv[8];
#pragma unroll
    for (int e = 0; e < 8; ++e) { const int d = 32 * a + 16 * (e & 1) + i0 + (e >> 1); gqv[e] = gq[d]; gkv[e] = gk[d]; }
    for (int row = F.gw; row < NTOK; row += F.NGW) {
        GAS bf16_t* pr = P + (size_t)row * PW;
        const bool lat = row < NLAT;
        f32x4 cs = (f32x4){1.f, 1.f, 1.f, 1.f}, sn = (f32x4){0.f, 0.f, 0.f, 0.f};
        if (lat) { const GAS float* rt = rope + (size_t)(row & 2047) * 64 + a * 32 + i0; cs = *(const GAS f32x4*)rt; sn = *(const GAS f32x4*)(rt + 16); }
        const u32x4 qw = *(const GAS u32x4*)(pr + C_BQ + 8 * lane);
        u32x4 kw = (u32x4){0u, 0u, 0u, 0u};
        if (lane < 16) kw = *(const GAS u32x4*)(pr + C_BK + 8 * lane);
        float x[8], y[8];
        x[0] = bf_lo(qw.x); x[1] = bf_hi(qw.x); x[2] = bf_lo(qw.y); x[3] = bf_hi(qw.y); x[4] = bf_lo(qw.z); x[5] = bf_hi(qw.z); x[6] = bf_lo(qw.w); x[7] = bf_hi(qw.w);
        y[0] = bf_lo(kw.x); y[1] = bf_hi(kw.x); y[2] = bf_lo(kw.y); y[3] = bf_hi(kw.y); y[4] = bf_lo(kw.z); y[5] = bf_hi(kw.z); y[6] = bf_lo(kw.w); y[7] = bf_hi(kw.w);
        float sq = 0.f, sk = 0.f;
#pragma unroll
        for (int e = 0; e < 8; ++e) { sq += x[e] * x[e]; sk += y[e] * y[e]; }
        sq += __shfl_xor(sq, 1); sq += __shfl_xor(sq, 2); sq += __shfl_xor(sq, 4);
        sk += __shfl_xor(sk, 1); sk += __shfl_xor(sk, 2); sk += __shfl_xor(sk, 4);
        const float rq = 1.0f / sqrtf(sq * (1.0f / 64.0f) + 1e-6f), rk = 1.0f / sqrtf(sk * (1.0f / 64.0f) + 1e-6f);
#pragma unroll
        for (int e = 0; e < 8; ++e) { x[e] *= rq * gqv[e]; y[e] *= rk * gkv[e]; }
        float xo[8], yo[8];
#pragma unroll
        for (int p2 = 0; p2 < 4; ++p2) { const float c = cs[p2], s = sn[p2];
            xo[2 * p2] = (x[2 * p2] * c - x[2 * p2 + 1] * s) * C2; xo[2 * p2 + 1] = (x[2 * p2 + 1] * c + x[2 * p2] * s) * C2;
            yo[2 * p2] = y[2 * p2] * c - y[2 * p2 + 1] * s; yo[2 * p2 + 1] = y[2 * p2 + 1] * c + y[2 * p2] * s; }
        u32x4 ow; ow.x = cvt_pk_bf16(xo[0], xo[1]); ow.y = cvt_pk_bf16(xo[2], xo[3]); ow.z = cvt_pk_bf16(xo[4], xo[5]); ow.w = cvt_pk_bf16(xo[6], xo[7]);
        *(GAS u32x4*)(pr + C_BQ + 8 * lane) = ow;
        if (lane < 16) { u32x4 kk; kk.x = cvt_pk_bf16(yo[0], yo[1]); kk.y = cvt_pk_bf16(yo[2], yo[3]); kk.z = cvt_pk_bf16(yo[4], yo[5]); kk.w = cvt_pk_bf16(yo[6], yo[7]);
            *(GAS u32x4*)(pr + C_BK + 8 * lane) = kk; }
    }
}
constexpr int CVQ_UNITS = (CV_PRO - CV_LAYER) / (8 * CVQ_BLK);
static_assert(CVQ_UNITS * 8 * CVQ_BLK == CV_PRO - CV_LAYER, "conversion units tile the deferred block range");
__device__ __forceinline__ void phase_mix(LAS unsigned char* lds, int wv, int l, int rep) {
    const Fr F = make_frame(lds, wv); unsigned char* ws = F.ws; const bool lastl = l == DEPTH - 1;
    volatile LAS unsigned* LCTL = (volatile LAS unsigned*)(lds + LDS_CTLOFF);
    { SchedDft S{F.bid, (const char*)(ws + WS_T), (const char*)(ws + WS_ZZ), (char*)(ws + WS_O)}; pg8::EpiStore E{1.0f / 362.03867196751236f};
      pg8::gemm_phase<pg8::EpiStore, SchedDft, false, true>(lds, F.tid, 4096, 4096, 4096, S, E); }
    if (!lastl) { SchedDftCtx S{F.bid, (const char*)(ws + WS_T256), (const char*)(ws + WS_ZZC), (char*)(ws + WS_O)}; pg8::EpiStore E{1.0f / 128.0f};
      pg8::gemm_phase<pg8::EpiStore, SchedDftCtx, false, true>(lds, F.tid, 512, 512, 512, S, E); }
    float c08 = 0.8f; asm volatile("" : "+v"(c08));
    const float li = c08 - 0.6f * expf(-0.3f * (float)l);
    const float* lp = ARGP(lds, I_DLAM) + l * 256;
    float d01 = 0.f, d23 = 0.f;
    for (int k = 0; k < 64; ++k) { d01 += lp[k] * lp[64 + k]; d23 += lp[128 + k] * lp[192 + k]; }
    const float lam_u = __builtin_bit_cast(float, __builtin_amdgcn_readfirstlane(__builtin_bit_cast(int, expf(d01) - expf(d23) + li)));
    const float oml_u = __builtin_bit_cast(float, __builtin_amdgcn_readfirstlane(__builtin_bit_cast(int, 1.0f - li)));
    AttnCtx ac{(const bf16_t*)(ws + WS_P), (bf16_t*)(ws + WS_O), ARGP(lds, I_SUBLN) + l * 128, lam_u, oml_u, ARGP(lds, I_SINK) + l * 8};
    const int NUB = lastl ? 192 : 216;
    int NCV = 0, cvbase = 0;
    if (rep == 0) { if (l == 0) { NCV = CVQ_UNITS; cvbase = CV_LAYER; } else if (l == 1) { NCV = (MQ1_E - MQ1_S) / (8 * CVQ_BLK); cvbase = MQ1_S; } else if (l == 2) { NCV = (MQ2_E - MQ2_S) / (8 * CVQ_BLK); cvbase = MQ2_S; } }
    const int bq = F.bid & 7;
    unsigned* qc = F.ctl + CW_Q + 64 * (8 * (l + 4 * rep) + bq);
    for (;;) {
        __syncthreads();
        if (F.tid == 0) LCTL[2] = xb_add(qc, 1u);
        __syncthreads();
        const int u = __builtin_amdgcn_readfirstlane((int)LCTL[2]);
        if (u >= NUB + NCV) break;
        if (u >= NUB) { const int s = cvbase + ((u - NUB) * 8 + bq) * CVQ_BLK; convert_range(lds, F, s, s + CVQ_BLK, F.wave, 8); continue; }
        int tl = F.tid; LAUNDER_V(tl);
        if (u < 64) attn_unit<0>(lds, tl, ac, bq, u >> 4, u & 15, false);
        else if (u < 128) { const int v = u - 64; attn_unit<1>(lds, tl, ac, bq, v >> 5, v & 31, false); }
        else if (u < 192) { const int v = u - 128; attn_unit<2>(lds, tl, ac, bq, v >> 5, v & 31, false); }
        else if (u < 200) { const int v = u - 192; attn_unit<0>(lds, tl, ac, bq, v >> 1, v & 1, true); }
        else if (u < 208) { const int v = u - 200; attn_unit<1>(lds, tl, ac, bq, v >> 2, v & 3, true); }
        else { const int v = u - 208; attn_unit<2>(lds, tl, ac, bq, v >> 2, v & 3, true); }
    }
}
__device__ __forceinline__ void phase_branch(LAS unsigned char* lds, int wv, int l) {
    const Fr F = make_frame(lds, wv); unsigned char* ws = F.ws; const int nMact = (l == DEPTH - 1) ? NLAT / 256 : NTOK / 256;
    SchedBranch S{F.bid, F.G, nMact * 8, (const char*)(ws + WS_O), (const char*)w_layer(ws, l, W_BR), (const char*)(ws + WS_G), (char*)(ws + WS_XN)};
    pg8::branch_phase<SchedBranch>(lds, F.tid, S);
    if (nMact == NTOK / 256 && (F.bid >> 3) >= 8) {
        int s, e; bg_window(0, l, s, e);
        if (e > s) convert_range(lds, F, s, e, ((F.bid & 7) * 24 + (F.bid >> 3) - 8) * 8 + F.wave, 192 * 8);
    }
}
__device__ __forceinline__ void phase_out(LAS unsigned char* lds, int wv, int l) {
    const Fr F = make_frame(lds, wv); unsigned char* ws = F.ws; const int nMact = (l == DEPTH - 1) ? NLAT / 256 : NTOK / 256;
    SchedResid S{F.bid, F.G, nMact, DM, (const char*)(ws + WS_XN), (const char*)w_layer(ws, l, W_OUT), (char*)(ws + WS_XS), (const char*)(ws + WS_MODV + (size_t)l * 9 * 6144 * 4), 2048, l == 0 ? (const char*)ARGP(lds, I_X) : nullptr, l == 0 ? (const char*)ARGP(lds, I_CTX) : nullptr};
    pg8::EpiResid E{};
    pg8::gemm_phase<pg8::EpiResid, SchedResid, true, true>(lds, F.tid, DM, DM, DM, S, E);
    if (nMact == NTOK / 256 && F.bid >= 32) {
        int s, e; bg_window(1, l, s, e);
        if (e > s) convert_range(lds, F, s, e, (F.bid - 32) * 8 + F.wave, 224 * 8);
    }
}
__device__ __forceinline__ void phase_norm2_dense(LAS unsigned char* lds, int wv, int l) {
    const Fr F = make_frame(lds, wv); const int nrows = (l == DEPTH - 1) ? NLAT : NTOK;
    const bf16_t* xs = (const bf16_t*)(F.ws + WS_XS); bf16_t* xn = (bf16_t*)(F.ws + WS_XN); const float* modv = (const float*)(F.ws + WS_MODV) + (size_t)l * 9 * 6144;
    const float* n2g = ARGP(lds, I_N2G) + l * DM;
    const int rpw = nrows / F.NGW, r0 = F.gw * rpw, r1 = r0 + rpw;
    AdaCoef co; co.mr = -1;
    for (int r = r0; r < r1; r += 3) {
        RowV x[3];
#pragma unroll
        for (int q = 0; q < 3; ++q) x[q] = load_row_bf16(xs + (size_t)(r + q < r1 ? r + q : r) * DM, F.lane);
#pragma unroll
        for (int q = 0; q < 3; ++q) if (r + q < r1) { ada_coef_update(co, r + q, n2g, modv, 3072, 4096, F.lane); store_row_bf16(xn + (size_t)(r + q) * DM, adaln_apply(x[q], co), F.lane); }
    }
}
__device__ __forceinline__ void phase_up_dense(LAS unsigned char* lds, int wv, int l) {
    const Fr F = make_frame(lds, wv); unsigned char* ws = F.ws; const int nMact = (l == DEPTH - 1) ? NLAT / 256 : NTOK / 256;
    SchedUp S{F.bid, F.G, nMact, (const char*)(ws + WS_XN), (const char*)w_dense(ws, l >> 1, W_DGU), (char*)(ws + WS_P)};
    pg8::EpiSwiglu E{};
    pg8::gemm_phase<pg8::EpiSwiglu, SchedUp, true, true>(lds, F.tid, DM, DM, DM, S, E);
}
__device__ __forceinline__ void phase_down_dense(LAS unsigned char* lds, int wv, int l) {
    const Fr F = make_frame(lds, wv); unsigned char* ws = F.ws; const int nMact = (l == DEPTH - 1) ? NLAT / 256 : NTOK / 256;
    SchedResid S{F.bid, F.G, nMact, DFF, (const char*)(ws + WS_P), (const char*)w_dense(ws, l >> 1, W_DD), (char*)(ws + WS_XS), (const char*)(ws + WS_MODV + (size_t)l * 9 * 6144 * 4), 5120, nullptr, nullptr};
    pg8::EpiResid E{};
    pg8::gemm_phase<pg8::EpiResid, SchedResid, true, true>(lds, F.tid, DFF, DFF, DFF, S, E);
    if (nMact == NTOK / 256 && F.bid >= 32) {
        int s, e; bg_window(2, l, s, e);
        if (e > s) convert_range(lds, F, s, e, (F.bid - 32) * 8 + F.wave, 224 * 8);
    }
}
__device__ __forceinline__ void phase_norm2_moe(LAS unsigned char* lds, int wv, int l) {
    const Fr F = make_frame(lds, wv); const int nrows = (l == DEPTH - 1) ? NLAT : NTOK; const int mi = l >> 1;
    volatile LAS unsigned* LCTL = (volatile LAS unsigned*)(lds + LDS_CTLOFF);
    const bf16_t* xs = (const bf16_t*)(F.ws + WS_XS); bf16_t* xn = (bf16_t*)(F.ws + WS_XN); const float* modv = (const float*)(F.ws + WS_MODV) + (size_t)l * 9 * 6144;
    const float* n2g = ARGP(lds, I_N2G) + l * DM;
    int* toklist = (int*)(F.ws + WS_MOE); int* rec = toklist + 8 * NTOK;
    const int rpb = nrows / F.G;
    const int tid = F.tid, lane = F.lane;
    LAS int* lrec = (LAS int*)(lds + 1024);
    const float* rw = ARGP(lds, I_RW) + (size_t)mi * DM * 8;
    for (int rr = F.wave; rr < rpb; rr += 8) {
        const int row = F.bid * rpb + rr;
        const RowV x = load_row_bf16(xs + (size_t)row * DM, lane);
        const float* mv = modv + (size_t)mod_row_of(row) * 6144;
        const RowV y = adaln_row(x, n2g, mv + 3072, mv + 4096, lane);
        float lg[8];
#pragma unroll
        for (int e = 0; e < 8; ++e) lg[e] = 0.f;
#pragma unroll
        for (int j = 0; j < 4; ++j)
#pragma unroll
            for (int cc = 0; cc < 4; ++cc) { const float* wp = rw + (size_t)(256 * j + 4 * lane + cc) * 8; const f32x4 w0 = *(const f32x4*)wp, w1 = *(const f32x4*)(wp + 4); const float hv = y.v[j][cc];
                lg[0] += hv * w0[0]; lg[1] += hv * w0[1]; lg[2] += hv * w0[2]; lg[3] += hv * w0[3]; lg[4] += hv * w1[0]; lg[5] += hv * w1[1]; lg[6] += hv * w1[2]; lg[7] += hv * w1[3]; }
#pragma unroll
        for (int e = 0; e < 8; ++e) lg[e] = wave_sum(lg[e]);
        int i0 = 0; float v0 = lg[0];
#pragma unroll
        for (int e = 1; e < 8; ++e) if (lg[e] > v0) { v0 = lg[e]; i0 = e; }
        int i1 = -1; float v1 = -3.0e38f;
#pragma unroll
        for (int e = 0; e < 8; ++e) if (e != i0 && lg[e] > v1) { v1 = lg[e]; i1 = e; }
        if (lane == 0) {
            const float w0 = 1.0f / (1.0f + expf(v1 - v0)), w1 = 1.0f - w0;
            lrec[rr * 6 + 0] = i0; lrec[rr * 6 + 2] = __float_as_int(w0); lrec[rr * 6 + 3] = i1; lrec[rr * 6 + 5] = __float_as_int(w1);
        }
    }
    __syncthreads();
    { const int e = F.wave; int cnt = 0;
      for (int a0 = 0; a0 < 2 * rpb; a0 += 64) { const int a = a0 + lane; const bool valid = a < 2 * rpb; const int rr = a >> 1, k3 = 3 * (a & 1);
          const bool match = valid && lrec[rr * 6 + k3] == e;
          const unsigned long long bal = __ballot(match);
          if (match) lrec[rr * 6 + k3 + 1] = cnt + (int)__popcll(bal & ((1ull << lane) - 1ull));
          cnt += (int)__popcll(bal); }
      if (lane == 0) { toklist[F.bid * 8 + e] = cnt;
          (void)xb_add(F.ctl + CW_CNT + 64 * (8 * mi + e), (unsigned)cnt); } }
    __syncthreads();
    for (int rr = tid; rr < rpb; rr += 512) {
        const int row = F.bid * rpb + rr;
        int* rc = rec + (size_t)row * 8;
        rc[0] = lrec[rr * 6 + 0]; rc[1] = lrec[rr * 6 + 1]; rc[2] = lrec[rr * 6 + 2]; rc[3] = lrec[rr * 6 + 3]; rc[4] = lrec[rr * 6 + 4]; rc[5] = lrec[rr * 6 + 5];
    }
}
__device__ __forceinline__ void phase_moe_gather(LAS unsigned char* lds, int wv, int l) {
    const Fr F = make_frame(lds, wv); const int mi = l >> 1; const int nrows = (l == DEPTH - 1) ? NLAT : NTOK; const int rpb = nrows / F.G;
    volatile LAS unsigned* LCTL = (volatile LAS unsigned*)(lds + LDS_CTLOFF);
    const MoeTiles mt = moe_tiles(F.ctl, mi);
    const GAS bf16_t* xn = (const GAS bf16_t*)(F.ws + WS_XN); GAS bf16_t* hs = (GAS bf16_t*)(F.ws + WS_HY);
    const GAS int* blkcnt = (const GAS int*)(F.ws + WS_MOE); GAS int* rec = (GAS int*)(F.ws + WS_MOE) + 8 * NTOK;
    LAS int* red = (LAS int*)(lds + 1024);
    { const int e = F.tid & 7, ch = F.tid >> 3; int s = 0;
#pragma unroll
      for (int j = 0; j < 4; ++j) { const int bb = ch * 4 + j; if (bb < F.bid) s += blkcnt[bb * 8 + e]; }
      red[e * 64 + ch] = s; }
    __syncthreads();
    if (F.tid < 8) { int s = 0; for (int ch = 0; ch < 64; ++ch) s += red[F.tid * 64 + ch]; LCTL[16 + F.tid] = (unsigned)s; }
    __syncthreads();
    LAS int* sl = (LAS int*)(lds + 4096);
    for (int rr = F.tid; rr < rpb; rr += 512) {
        GAS int* rc = rec + (size_t)(F.bid * rpb + rr) * 8;
        const int e0 = rc[0], e1 = rc[3];
        const int p0 = rc[1] + (int)LCTL[16 + e0], p1 = rc[4] + (int)LCTL[16 + e1];
        int t0 = 0, t1 = 0;
#pragma unroll
        for (int k = 0; k < 8; ++k) { t0 = (e0 == k) ? mt.tb[k] : t0; t1 = (e1 == k) ? mt.tb[k] : t1; }
        sl[rr * 2] = t0 * 256 + p0; sl[rr * 2 + 1] = t1 * 256 + p1;
        rc[1] = p0; rc[4] = p1;
    }
    __syncthreads();
    const bf16_t* xs = (const bf16_t*)(F.ws + WS_XS); const float* modv = (const float*)(F.ws + WS_MODV) + (size_t)l * 9 * 6144; const float* n2g = ARGP(lds, I_N2G) + l * DM;
    AdaCoef co; co.mr = -1;
    for (int r0 = F.wave * (rpb >> 3); r0 < (F.wave + 1) * (rpb >> 3); r0 += 3) {
        RowV x[3]; int s[3][2];
#pragma unroll
        for (int q = 0; q < 3; ++q) { const int rr = r0 + q; const bool ok = rr < (F.wave + 1) * (rpb >> 3);
            x[q] = load_row_bf16(xs + (size_t)(F.bid * rpb + (ok ? rr : r0)) * DM, F.lane);
            s[q][0] = ok ? sl[rr * 2] : -1; s[q][1] = ok ? sl[rr * 2 + 1] : -1; }
#pragma unroll
        for (int q = 0; q < 3; ++q) if (s[q][0] >= 0) { const int row = F.bid * rpb + r0 + q;
            ada_coef_update(co, row, n2g, modv, 3072, 4096, F.lane);
            const RowV y = adaln_apply(x[q], co);
            store_row_bf16((bf16_t*)hs + (size_t)s[q][0] * DM, y, F.lane); store_row_bf16((bf16_t*)hs + (size_t)s[q][1] * DM, y, F.lane); }
    }
    for (int idx = F.gw; idx < 8 * 256; idx += F.NGW) { const int e = idx >> 8, j = idx & 255;
        const int cnt = __builtin_amdgcn_readfirstlane((int)__hip_atomic_load(F.ctl + CW_CNT + 64 * (8 * mi + e), __ATOMIC_RELAXED, __HIP_MEMORY_SCOPE_AGENT));
        const int pad = ((cnt + 255) & ~255) - cnt; int tbe = 0;
#pragma unroll
        for (int k = 0; k < 8; ++k) tbe = (e == k) ? mt.tb[k] : tbe;
        if (j < pad) { GAS u32x4* dp = (GAS u32x4*)(hs + (size_t)(tbe * 256 + cnt + j) * DM) + F.lane; dp[0] = (u32x4){0u, 0u, 0u, 0u}; dp[64] = (u32x4){0u, 0u, 0u, 0u}; } }
}
__device__ __forceinline__ void phase_up_moe(LAS unsigned char* lds, int wv, int l) {
    const Fr F = make_frame(lds, wv); unsigned char* ws = F.ws; const int mi = l >> 1;
    const MoeTiles mt = moe_tiles(F.ctl, mi);
    SchedMoe S{F.bid, F.G, 28, DM, mt.tb[8], mt, (const char*)(ws + WS_HY), (const char*)w_moe(ws, mi, 0, 0), W_MGU, (char*)(ws + WS_P), DFE, 128, 2};
    pg8::EpiSwiglu E{};
    pg8::gemm_phase<pg8::EpiSwiglu, SchedMoe, true, true>(lds, F.tid, DM, DM, DM, S, E);
}
__device__ __forceinline__ void phase_down_moe(LAS unsigned char* lds, int wv, int l) {
    const Fr F = make_frame(lds, wv); unsigned char* ws = F.ws; const int mi = l >> 1;
    const MoeTiles mt = moe_tiles(F.ctl, mi);
    const int RT = mt.tb[8], RF = RT < MOE_RF ? RT : MOE_RF;
    pg8::EpiStore E{1.0f};
    { SchedMoe S{F.bid, F.G, 4, DFE, RF, mt, (const char*)(ws + WS_P), (const char*)w_moe(ws, mi, 0, 0), W_MD, (char*)(ws + WS_HY), DM, 256, 2};
      pg8::gemm_phase<pg8::EpiStore, SchedMoe, true, true>(lds, F.tid, DFE, DFE, DFE, S, E); }
    if (RT > RF) {
        SchedMoeSplit S2{F.bid, F.G, RF, RT, mt, (const char*)(ws + WS_P), (const char*)w_moe(ws, mi, 0, 0), (char*)(ws + WS_HY), (char*)(ws + WS_Y1)};
        pg8::gemm_phase<pg8::EpiStore, SchedMoeSplit, true, true>(lds, F.tid, DFE / 2, DFE, DFE, S2, E);
    }
}
__device__ __forceinline__ void phase_next_norm(LAS unsigned char* lds, int wv, int l) {
    const Fr F = make_frame(lds, wv); const bool lastl = l == DEPTH - 1; const int nrows = lastl ? NLAT : NTOK; const int mi = l >> 1;
    const bool moe = (l & 1) != 0;
    MoeTiles mt; if (moe) mt = moe_tiles(F.ctl, mi); else {
#pragma unroll
        for (int k = 0; k < 9; ++k) mt.tb[k] = 0; }
    bf16_t* xs = (bf16_t*)(F.ws + WS_XS); bf16_t* xn = (bf16_t*)(F.ws + WS_XN);
    const bf16_t* yb = (const bf16_t*)(F.ws + WS_HY); const bf16_t* yb1 = (const bf16_t*)(F.ws + WS_Y1); const int* rec = (const int*)(F.ws + WS_MOE) + 8 * NTOK;
    const float* modv = (const float*)(F.ws + WS_MODV) + (size_t)l * 9 * 6144;
    const float* modn = modv + 9 * 6144;
    const float* n1g = ARGP(lds, I_N1G) + (lastl ? 0 : (l + 1) * DM); const float* fg = ARGP(lds, I_FINALG); float* outp = (float*)ARGP(lds, 23);
    const int lane = F.lane;
    for (int row = F.gw; row < nrows; row += F.NGW) {
        RowV x = load_row_bf16(xs + (size_t)row * DM, lane);
        if (moe) {
            const int* rc = rec + (size_t)row * 8;
            const int e0 = rc[0], p0 = rc[1], e1 = rc[3], p1 = rc[4]; const float w0 = __int_as_float(rc[2]), w1 = __int_as_float(rc[5]);
            int t0 = 0, t1 = 0;
#pragma unroll
            for (int k = 0; k < 8; ++k) { t0 = (e0 == k) ? mt.tb[k] : t0; t1 = (e1 == k) ? mt.tb[k] : t1; }
            RowV y0 = load_row_bf16(yb + (size_t)(t0 * 256 + p0) * DM, lane), y1 = load_row_bf16(yb + (size_t)(t1 * 256 + p1) * DM, lane);
            { const int rt0 = t0 + (p0 >> 8), rt1 = t1 + (p1 >> 8);
              if (rt0 >= MOE_RF) { const RowV z = load_row_bf16(yb1 + (size_t)((rt0 - MOE_RF) * 256 + (p0 & 255)) * DM, lane);
#pragma unroll
                  for (int j = 0; j < 4; ++j) y0.v[j] += z.v[j]; }
              if (rt1 >= MOE_RF) { const RowV z = load_row_bf16(yb1 + (size_t)((rt1 - MOE_RF) * 256 + (p1 & 255)) * DM, lane);
#pragma unroll
                  for (int j = 0; j < 4; ++j) y1.v[j] += z.v[j]; } }
            const RowV g2 = load_row_f32(modv + (size_t)mod_row_of(row) * 6144 + 5120, lane);
#pragma unroll
            for (int j = 0; j < 4; ++j) x.v[j] += g2.v[j] * (w0 * y0.v[j] + w1 * y1.v[j]);
            if (!lastl) store_row_bf16(xs + (size_t)row * DM, x, lane);
        }
        if (!lastl) {
            const float* mv = modn + (size_t)mod_row_of(row) * 6144;
            const RowV y = adaln_row(x, n1g, mv, mv + 1024, lane);
            store_row_bf16(xn + (size_t)row * DM, y, lane);
        } else {
            float ss = 0.f;
#pragma unroll
            for (int j = 0; j < 4; ++j) ss += (x.v[j][0] * x.v[j][0] + x.v[j][1] * x.v[j][1]) + (x.v[j][2] * x.v[j][2] + x.v[j][3] * x.v[j][3]);
            const float rstd = 1.0f / sqrtf(wave_sum(ss) * (1.0f / DM) + 1e-6f);
            const RowV gv = load_row_f32(fg, lane);
            RowV y;
#pragma unroll
            for (int j = 0; j < 4; ++j) y.v[j] = x.v[j] * rstd * gv.v[j];
            store_row_f32(outp + (size_t)row * DM, y, lane);
        }
    }
}

__global__ void __launch_bounds__(512, 2) mega_fwd(Args a) {
    extern __shared__ __attribute__((aligned(16))) unsigned char lds_raw[];
    LAS unsigned char* lds = (LAS unsigned char*)lds_raw;
    volatile LAS unsigned* LCTL = (volatile LAS unsigned*)(lds + LDS_CTLOFF);
    const int wv = __builtin_amdgcn_readfirstlane((int)(threadIdx.x >> 6));
    {
        const int tid = threadIdx.x;
        for (int u = tid; u < 64; u += 512) LCTL[u] = 0u;
        if (tid == 0) { LAS unsigned long long* ap = (LAS unsigned long long*)(lds + LDS_ARGOFF);
#pragma unroll
            for (int i = 0; i < 23; ++i) ap[i] = (unsigned long long)a.in[i];
            ap[23] = (unsigned long long)a.out; ap[24] = (unsigned long long)a.ws; }
        __syncthreads();
    }
    (void)xcd_barrier_post((unsigned*)(a.ws + WS_CTL) + CW_BAR, LCTL);
    phase_prologue(lds, wv);
    grid_barrier(lds, wv);
#if DUP_PRO
    phase_prologue(lds, wv);
    grid_barrier(lds, wv);
#endif
    phase_first_norm(lds, wv);
    grid_barrier(lds, wv);
    for (int l = 0; l < DEPTH; ++l) {
        phase_inproj(lds, wv, l);  grid_barrier(lds, wv);
#if DUP_INPROJ
        phase_inproj(lds, wv, l);  grid_barrier(lds, wv);
#endif
        phase_post(lds, wv, l);    grid_barrier(lds, wv);
        phase_mix(lds, wv, l, 0);  grid_barrier(lds, wv);
#if DUP_MIX
        phase_mix(lds, wv, l, 1);  grid_barrier(lds, wv);
#endif
        phase_branch(lds, wv, l);  grid_barrier(lds, wv);
#if DUP_BRANCH
        phase_branch(lds, wv, l);  grid_barrier(lds, wv);
#endif
        phase_out(lds, wv, l);     grid_barrier(lds, wv);
        if ((l & 1) == 0) {
            phase_norm2_dense(lds, wv, l); grid_barrier(lds, wv);
#if DUP_N2D
            phase_norm2_dense(lds, wv, l); grid_barrier(lds, wv);
#endif
            phase_up_dense(lds, wv, l);    grid_barrier(lds, wv);
#if DUP_UPD
            phase_up_dense(lds, wv, l);    grid_barrier(lds, wv);
#endif
            phase_down_dense(lds, wv, l);  grid_barrier(lds, wv);
        } else {
            phase_norm2_moe(lds, wv, l);   grid_barrier(lds, wv);
            phase_moe_gather(lds, wv, l);  grid_barrier(lds, wv);
#if DUP_GATH
            phase_moe_gather(lds, wv, l);  grid_barrier(lds, wv);
#endif
            phase_up_moe(lds, wv, l);      grid_barrier(lds, wv);
#if DUP_MOEG == 1
            phase_up_moe(lds, wv, l);      grid_barrier(lds, wv);
#endif
            phase_down_moe(lds, wv, l);    grid_barrier(lds, wv);
#if DUP_MOEG == 2
            phase_down_moe(lds, wv, l);    grid_barrier(lds, wv);
#endif
        }
        phase_next_norm(lds, wv, l);
        if (l != DEPTH - 1) grid_barrier(lds, wv);
    }
}

extern "C" void kernel_launch(void* const* d_in, const int* in_sizes, int n_in, void* d_out, int out_size, void* d_ws, size_t ws_size, hipStream_t stream) {
    static int grid = 0;
    if (grid == 0) {
        if (n_in != 23 || out_size != NLAT * DM || ws_size < WS_END) { fprintf(stderr, "kernel_launch: unexpected problem (n_in %d out %d ws %zu need %zu)\n", n_in, out_size, ws_size, (size_t)WS_END); grid = -1; return; }
        int dev = 0, cus = 0, per_cu = 0;
        if (hipGetDevice(&dev) != hipSuccess || hipDeviceGetAttribute(&cus, hipDeviceAttributeMultiprocessorCount, dev) != hipSuccess) { grid = -1; return; }
        if (hipFuncSetAttribute((const void*)mega_fwd, hipFuncAttributeMaxDynamicSharedMemorySize, LDS_BYTES) != hipSuccess) { fprintf(stderr, "kernel_launch: hipFuncSetAttribute failed\n"); grid = -1; return; }
        if (hipOccupancyMaxActiveBlocksPerMultiprocessor(&per_cu, (const void*)mega_fwd, 512, LDS_BYTES) != hipSuccess || per_cu < 1) { fprintf(stderr, "kernel_launch: occupancy query says %d\n", per_cu); }
        (void)hipGetLastError();
        grid = cus;
        if (grid != 256) fprintf(stderr, "kernel_launch: %d CUs (built for 256)\n", grid);
    }
    if (grid < 0) return;
    (void)hipMemsetAsync((char*)d_ws + WS_CTL, 0, CTL_ZERO_BYTES, stream);
    Args a{};
    for (int i = 0; i < 23; ++i) a.in[i] = (const float*)d_in[i];
    a.out = (float*)d_out; a.ws = (unsigned char*)d_ws;
    hipLaunchKernelGGL(mega_fwd, dim3(grid), dim3(512), LDS_BYTES, stream, a);
}
```

```cpp
#include <hip/hip_runtime.h>
#include <cstdio>
#include <cstdint>

#ifndef DUP_MIX
#define DUP_MIX 0
#endif
#ifndef DUP_PRO
#define DUP_PRO 0
#endif
#ifndef DUP_BRANCH
#define DUP_BRANCH 0
#endif
#ifndef DUP_MOEG
#define DUP_MOEG 0
#endif
#ifndef DUP_UPD
#define DUP_UPD 0
#endif
#ifndef DUP_N2D
#define DUP_N2D 0
#endif
#ifndef DUP_GATH
#define DUP_GATH 0
#endif
#ifndef DUP_INPROJ
#define DUP_INPROJ 0
#endif
#define LAS __attribute__((address_space(3)))
#define GAS __attribute__((address_space(1)))
typedef unsigned short bf16_t;
typedef short bf16x8 __attribute__((ext_vector_type(8)));
typedef short s16x4 __attribute__((ext_vector_type(4)));
typedef float f32x4 __attribute__((ext_vector_type(4)));
typedef float f32x16 __attribute__((ext_vector_type(16)));
typedef unsigned u32x4 __attribute__((ext_vector_type(4)));
typedef unsigned u32x2 __attribute__((ext_vector_type(2)));
typedef int i32x4 __attribute__((ext_vector_type(4)));
typedef int i32x8 __attribute__((ext_vector_type(8)));

constexpr int NB = 8, SEQ = 2048, DM = 1024, DEPTH = 4, CTXL = 256;
constexpr int NLAT = NB * SEQ, NCTX = NB * CTXL, NTOK = NLAT + NCTX;
constexpr int DIN = 7680, PW = 3072, GW = 4096;
constexpr int C_AQ = 0, C_AK = 512, C_AV = 1024, C_BQ = 1536, C_BK = 2048, C_BV = 2176, C_CQ = 2304, C_CK = 2816, C_CV = 2944;
constexpr int DFF = 2816, DFE = 3584, NEXP = 8;
constexpr int OW = 2048;
constexpr int MAXSLOT = 2 * NTOK + 2048;
constexpr float C2 = 0.125f * 1.4426950408889634f;
constexpr float LOG2E = 1.4426950408889634f;

constexpr size_t MiB = 1u << 20;
constexpr size_t WS_CTL = 0, CTL_ZERO_BYTES = 1 * MiB;
constexpr size_t WS_MODV = 1 * MiB;
constexpr size_t WS_ROPE = 2 * MiB;
constexpr size_t WS_T256 = 3 * MiB;
constexpr size_t WS_MOE = 4 * MiB;
constexpr size_t WS_T = 6 * MiB;
constexpr size_t WS_W = 22 * MiB;
constexpr size_t W_IN = 0, W_FZ = 14 * MiB, W_BR = 16 * MiB, W_OUT = 20 * MiB, W_LAYER = 22 * MiB;
constexpr size_t W_DENSE0 = 4 * W_LAYER, W_DGU = 0, W_DD = 11 * MiB, W_DENSE = 33 * MiB / 2;
constexpr size_t W_MOE0 = W_DENSE0 + 2 * W_DENSE, W_MGU = 0, W_MD = 14 * MiB, W_EXPERT = 21 * MiB, W_MOE = 8 * W_EXPERT;
constexpr size_t WS_XS = WS_W + W_MOE0 + 2 * W_MOE;
constexpr size_t WS_XN = WS_XS + 72 * MiB;
constexpr size_t WS_P = WS_XN + 36 * MiB;
constexpr size_t WS_G = WS_P + 108 * MiB;
constexpr size_t WS_ZZ = WS_P + 252 * MiB;
constexpr size_t WS_ZZC = WS_ZZ + 32 * MiB;
constexpr size_t WS_O = WS_ZZC + 4 * MiB;
constexpr size_t WS_HY = WS_O + 72 * MiB;
constexpr size_t WS_Y1 = WS_HY + 76 * MiB;
constexpr size_t WS_END = WS_Y1 + 16 * MiB;
constexpr int MOE_RF = 128;
static_assert(WS_W + W_MOE0 + 2 * W_MOE == 479 * MiB, "weights");
static_assert((size_t)MAXSLOT * DFE * 2 <= 288 * MiB, "moe hidden fits p+zz");
static_assert((size_t)MAXSLOT * 1024 * 2 <= 76 * MiB, "hs fits");
static_assert(WS_END <= 1074 * MiB, "workspace");

constexpr int CW_BAR = 4096;
constexpr int CW_Q = 16384;
constexpr int CW_CNT = 24576;

constexpr int LDS_CTLOFF = 141312;
constexpr int LDS_BYTES = 147456;

typedef float f32x2_t __attribute__((ext_vector_type(2))); typedef __bf16 bf16x2_t __attribute__((ext_vector_type(2)));
__device__ __forceinline__ unsigned cvt_pk_bf16(float lo, float hi) { f32x2_t v = {lo, hi}; bf16x2_t b = __builtin_convertvector(v, bf16x2_t); return __builtin_bit_cast(unsigned, b); }
__device__ __forceinline__ float clamp_f8(float v) { return __builtin_amdgcn_fmed3f(v, -448.0f, 448.0f); }
__device__ __forceinline__ unsigned cvt4_fp8(float a, float b, float c, float d) { int w = 0; w = __builtin_amdgcn_cvt_pk_fp8_f32(clamp_f8(a), clamp_f8(b), w, false); w = __builtin_amdgcn_cvt_pk_fp8_f32(clamp_f8(c), clamp_f8(d), w, true); return (unsigned)w; }
__device__ __forceinline__ float bf_lo(unsigned w) { return __uint_as_float(w << 16); }
__device__ __forceinline__ float bf_hi(unsigned w) { return __uint_as_float(w & 0xffff0000u); }
__device__ __forceinline__ float bf2f(bf16_t h) { return __uint_as_float(((unsigned)h) << 16); }
__device__ __forceinline__ bf16_t f2bf(float f) { unsigned u = __float_as_uint(f); u += 0x7fffu + ((u >> 16) & 1u); return (bf16_t)(u >> 16); }
__device__ __forceinline__ float fast_exp2(float x) { return __builtin_amdgcn_exp2f(x); }
__device__ __forceinline__ float fast_rcp(float x) { return __builtin_amdgcn_rcpf(x); }
__device__ __forceinline__ float sigmoidf_(float x) { return fast_rcp(1.0f + fast_exp2(-x * LOG2E)); }
__device__ __forceinline__ float siluf_(float x) { return x * sigmoidf_(x); }
__device__ __forceinline__ float wave_sum(float v) {
#pragma unroll
    for (int o = 1; o < 64; o <<= 1) v += __shfl_xor(v, o);
    return v;
}
#define LDS_WAIT() asm volatile("s_waitcnt lgkmcnt(0)" ::: "memory")
__device__ __forceinline__ int lane_id() { int l; asm volatile("v_mbcnt_lo_u32_b32 %0, -1, 0\n\tv_mbcnt_hi_u32_b32 %0, -1, %0" : "=v"(l)); return l; }

namespace pg8 {
constexpr int BM = 256, BK = 64, HALF = 128, HTB = HALF * BK * 2, STAGE_BYTES = 8 * HTB, NXCD = 8, WGM = 8;
__host__ __device__ __forceinline__ int lds_byte(int r, int c) { const int st = (r >> 4) * 2 + (c >> 5), rr = r & 15, cc = c & 31, ob = rr * 64 + cc * 2; return st * 1024 + (ob ^ (((ob >> 9) & 1) << 5)); }
__host__ __device__ __forceinline__ void stage_rc(int b, int& R, int& C) { const int st = b / 1024, sb = b % 1024, swz = sb ^ (((sb >> 9) & 1) << 5); R = (st >> 1) * 16 + swz / 64; C = (st & 1) * 32 + (swz % 64) / 2; }
__host__ __device__ __forceinline__ int perm32(int rho) { const int n = rho >> 4, i = rho & 15; return 8 * (i >> 2) + 4 * n + (i & 3); }

struct Unit { const char* A; const char* B; char* out; const char* aux; const char* aux2; int ldc; int flag; };

__device__ __forceinline__ void tile_of(int L, int nM, int nN, int& pm, int& pn) {
    const int nwg = nM * nN; int wgid = L;
    { const int q = nwg / NXCD, r = nwg % NXCD, xcd = wgid % NXCD, off = wgid / NXCD; wgid = (xcd < r ? xcd * (q + 1) : r * (q + 1) + (xcd - r) * q) + off; }
    const int nig = WGM * nN, gid = wgid / nig, fm = gid * WGM, gsz = (nM - fm) < WGM ? (nM - fm) : WGM;
    pm = fm + ((wgid % nig) % gsz); pn = (wgid % nig) / gsz;
}

__device__ __forceinline__ i32x8 cat8(const bf16x8 a, const bf16x8 b) { return __builtin_shufflevector(__builtin_bit_cast(i32x4, a), __builtin_bit_cast(i32x4, b), 0, 1, 2, 3, 4, 5, 6, 7); }
template <class Epi, class Sched, bool ALIGN_EPI, bool SP2, bool FP8 = false>
__device__ __forceinline__ void gemm_phase(LAS unsigned char* lds, const int tid, const int K, const int lda, const int ldb, const Sched& S, const Epi& E, const int wsc = 127) {
    const int wid = __builtin_amdgcn_readfirstlane(tid >> 6), lane = tid & 63, wr = wid >> 2, wc = wid & 3, fr = lane & 15, fq = lane >> 4;
    const int nt = K / BK;
    unsigned voffA[2], voffB[2];
#pragma unroll
    for (int i = 0; i < 2; ++i) { int R, C; stage_rc(tid * 16 + i * 8192, R, C); const int Rb = Epi::PERM ? ((R & ~31) + perm32(R & 31)) : R;
        voffA[i] = (unsigned)(R * lda + C) * 2u; voffB[i] = (unsigned)(Rb * ldb + C) * 2u; }
    const size_t kstep = (size_t)(BK * 2);
    const size_t hstepA = (size_t)HALF * lda * 2, hstepB = (size_t)HALF * ldb * 2;
    const unsigned ldsw = (unsigned)wid * 1024u;
    const int aoff = lds_byte(wr * 64 + fr, fq * 8), boff = lds_byte(wc * 32 + fr, fq * 8);
#define PG8_SA(b, h) (((b) * 2 + (h)) * HTB)
#define PG8_SB(b, h) ((4 + (b) * 2 + (h)) * HTB)
#define PG8_STAGE(bufoff, gbase, voff) do { _Pragma("unroll") for (int _i = 0; _i < 2; ++_i) \
        __builtin_amdgcn_global_load_lds((const unsigned*)((const char*)(gbase) + (voff)[_i]), (LAS unsigned*)(lds + (bufoff) + ldsw + _i * 8192), 16, 0, 0); } while (0)
#define PG8_LDA(dst, b, h) do { _Pragma("unroll") for (int m = 0; m < 4; ++m) _Pragma("unroll") for (int k = 0; k < 2; ++k) dst[m][k] = *(const LAS bf16x8*)(lds + PG8_SA(b, h) + aoff + m * 2048 + k * 1024); } while (0)
#define PG8_LDB(dst, b, h) do { _Pragma("unroll") for (int n = 0; n < 2; ++n) _Pragma("unroll") for (int k = 0; k < 2; ++k) dst[n][k] = *(const LAS bf16x8*)(lds + PG8_SB(b, h) + boff + n * 2048 + k * 1024); } while (0)
#define PG8_MMA(ai, bj, At, Bt) do { __builtin_amdgcn_s_setprio(1); _Pragma("unroll") for (int m = 0; m < 4; ++m) _Pragma("unroll") for (int n = 0; n < 2; ++n) { \
        if constexpr (FP8) { acc[ai][bj][m][n] = __builtin_amdgcn_mfma_scale_f32_16x16x128_f8f6f4(cat8(Bt[n][0], Bt[n][1]), cat8(At[m][0], At[m][1]), acc[ai][bj][m][n], 0, 0, 0, wsc, 0, 127); \
            asm volatile("" : "+v"(acc[ai][bj][m][n]));   } \
        else { _Pragma("unroll") for (int k = 0; k < 2; ++k) acc[ai][bj][m][n] = __builtin_amdgcn_mfma_f32_16x16x32_bf16(Bt[n][k], At[m][k], acc[ai][bj][m][n], 0, 0, 0); } } __builtin_amdgcn_s_setprio(0); } while (0)
#define PG8_WAIT_V(n) asm volatile("s_waitcnt vmcnt(" #n ")" ::: "memory")
#define PG8_WAIT_L(n) asm volatile("s_waitcnt lgkmcnt(" #n ")" ::: "memory")
#define PG8_BAR __builtin_amdgcn_s_barrier()
#define PG8_SCHED __builtin_amdgcn_sched_barrier(0)
    Unit cur, nxt; int ui = 0;
    if (!S.next(0, cur)) return;
    f32x4 acc[2][2][4][2];
#pragma unroll
    for (int a = 0; a < 2; ++a)
#pragma unroll
        for (int b = 0; b < 2; ++b)
#pragma unroll
            for (int m = 0; m < 4; ++m)
#pragma unroll
                for (int n = 0; n < 2; ++n) acc[a][b][m][n] = (f32x4){0.f, 0.f, 0.f, 0.f};
    bf16x8 At[4][2], B0[2][2], B1[2][2];
    const char* cA = cur.A; const char* cB = cur.B;
    if constexpr (SP2) {
        PG8_STAGE(PG8_SB(0, 0), cB, voffB); PG8_STAGE(PG8_SB(0, 1), cB + hstepB, voffB); PG8_STAGE(PG8_SA(0, 0), cA, voffA); PG8_STAGE(PG8_SA(0, 1), cA + hstepA, voffA);
        if (wr == 1) PG8_BAR;
        PG8_WAIT_V(2); PG8_BAR;
        PG8_STAGE(PG8_SB(1, 0), cB + kstep, voffB); PG8_STAGE(PG8_SA(1, 0), cA + kstep, voffA); PG8_STAGE(PG8_SB(1, 1), cB + hstepB + kstep, voffB);
        PG8_WAIT_V(6); PG8_BAR;
    } else {
        PG8_STAGE(PG8_SB(0, 0), cB, voffB); PG8_STAGE(PG8_SA(0, 0), cA, voffA); PG8_STAGE(PG8_SB(0, 1), cB + hstepB, voffB); PG8_STAGE(PG8_SA(0, 1), cA + hstepA, voffA);
        if (wr == 1) PG8_BAR;
        PG8_WAIT_V(4); PG8_BAR;
        PG8_STAGE(PG8_SB(1, 0), cB + kstep, voffB); PG8_STAGE(PG8_SA(1, 0), cA + kstep, voffA); PG8_STAGE(PG8_SB(1, 1), cB + hstepB + kstep, voffB);
        PG8_WAIT_V(6); PG8_BAR;
    }
    for (;;) {
        const bool has_next = S.next(ui + 1, nxt);
        const char* nA = has_next ? nxt.A : cA; const char* nB = has_next ? nxt.B : cB;
        for (int t = 0; t < nt; t += 2) {
            const bool last = (t == nt - 2);
            const char* a1 = cA + (size_t)(t + 1) * kstep;
            const char* a2 = last ? nA : cA + (size_t)(t + 2) * kstep; const char* b2 = last ? nB : cB + (size_t)(t + 2) * kstep;
            const char* a3 = a2 + kstep; const char* b3 = b2 + kstep;
            if constexpr (SP2) {
            PG8_LDB(B0, 0, 0); PG8_LDB(B1, 0, 1); PG8_SCHED; PG8_LDA(At, 0, 0); PG8_STAGE(PG8_SA(1, 1), a1 + hstepA, voffA);
            PG8_WAIT_V(8); PG8_WAIT_L(0); PG8_BAR; PG8_MMA(0, 0, At, B0); PG8_MMA(0, 1, At, B1); PG8_BAR; PG8_SCHED;
            PG8_LDA(At, 0, 1); PG8_STAGE(PG8_SB(0, 0), b2, voffB); PG8_STAGE(PG8_SB(0, 1), b2 + hstepB, voffB); PG8_STAGE(PG8_SA(0, 0), a2, voffA);
            PG8_WAIT_V(8); PG8_WAIT_L(0); PG8_BAR; PG8_MMA(1, 0, At, B0); PG8_MMA(1, 1, At, B1); PG8_BAR; PG8_SCHED;
            PG8_LDB(B0, 1, 0); PG8_LDB(B1, 1, 1); PG8_SCHED; PG8_LDA(At, 1, 0); PG8_STAGE(PG8_SA(0, 1), a2 + hstepA, voffA);
            PG8_WAIT_V(8); PG8_WAIT_L(0); PG8_BAR; PG8_MMA(0, 0, At, B0); PG8_MMA(0, 1, At, B1); PG8_BAR; PG8_SCHED;
            PG8_LDA(At, 1, 1); PG8_STAGE(PG8_SB(1, 0), b3, voffB); PG8_STAGE(PG8_SB(1, 1), b3 + hstepB, voffB); PG8_STAGE(PG8_SA(1, 0), a3, voffA);
            PG8_WAIT_V(8); PG8_WAIT_L(0); PG8_BAR; PG8_MMA(1, 0, At, B0); PG8_MMA(1, 1, At, B1); PG8_BAR; PG8_SCHED;
            } else {
            PG8_LDB(B0, 0, 0); PG8_SCHED; PG8_LDA(At, 0, 0); PG8_STAGE(PG8_SA(1, 1), a1 + hstepA, voffA);
            PG8_WAIT_L(8); PG8_BAR; PG8_WAIT_L(0); PG8_MMA(0, 0, At, B0); PG8_BAR; PG8_SCHED;
            PG8_LDB(B1, 0, 1); PG8_STAGE(PG8_SB(0, 0), b2, voffB);
            PG8_BAR; PG8_WAIT_L(0); PG8_MMA(0, 1, At, B1); PG8_BAR;
            PG8_LDA(At, 0, 1); PG8_STAGE(PG8_SA(0, 0), a2, voffA);
            PG8_BAR; PG8_WAIT_L(0); PG8_MMA(1, 0, At, B0); PG8_BAR; PG8_SCHED;
            PG8_STAGE(PG8_SB(0, 1), b2 + hstepB, voffB);
            PG8_WAIT_V(6); PG8_BAR; PG8_MMA(1, 1, At, B1); PG8_BAR;
            PG8_LDB(B0, 1, 0); PG8_SCHED; PG8_LDA(At, 1, 0); PG8_STAGE(PG8_SA(0, 1), a2 + hstepA, voffA);
            PG8_WAIT_L(8); PG8_BAR; PG8_WAIT_L(0); PG8_MMA(0, 0, At, B0); PG8_BAR; PG8_SCHED;
            PG8_LDB(B1, 1, 1); PG8_STAGE(PG8_SB(1, 0), b3, voffB);
            PG8_BAR; PG8_WAIT_L(0); PG8_MMA(0, 1, At, B1); PG8_BAR;
            PG8_LDA(At, 1, 1); PG8_STAGE(PG8_SA(1, 0), a3, voffA);
            PG8_BAR; PG8_WAIT_L(0); PG8_MMA(1, 0, At, B0); PG8_BAR; PG8_SCHED;
            PG8_STAGE(PG8_SB(1, 1), b3 + hstepB, voffB);
            PG8_WAIT_V(6); PG8_BAR; PG8_MMA(1, 1, At, B1); PG8_BAR;
            }
        }
        if constexpr (ALIGN_EPI) { if (wr == 0) PG8_BAR; }
        E(acc, cur, wr, wc, fr, fq);
        if (!has_next) break;
#pragma unroll
        for (int a = 0; a < 2; ++a)
#pragma unroll
            for (int b = 0; b < 2; ++b)
#pragma unroll
                for (int m = 0; m < 4; ++m)
#pragma unroll
                    for (int n = 0; n < 2; ++n) acc[a][b][m][n] = (f32x4){0.f, 0.f, 0.f, 0.f};
        cur = nxt; cA = nA; cB = nB; ++ui;
        if constexpr (ALIGN_EPI) { if (wr == 1) PG8_BAR; }
    }
    PG8_WAIT_V(0);
    if constexpr (!ALIGN_EPI) { if (wr == 0) PG8_BAR; }
    PG8_BAR;
#undef PG8_SA
#undef PG8_SB
#undef PG8_STAGE
#undef PG8_LDA
#undef PG8_LDB
#undef PG8_MMA
#undef PG8_WAIT_V
#undef PG8_WAIT_L
#undef PG8_BAR
#undef PG8_SCHED
}

struct EpiStore {
    static constexpr bool PERM = true;
    float scale;
    __device__ __forceinline__ void operator()(const f32x4 (&acc)[2][2][4][2], const Unit& u, int wr, int wc, int fr, int fq) const {
        bf16_t* base = (bf16_t*)u.out + (size_t)(wr * 64 + fr) * u.ldc + wc * 32 + 8 * fq;
        const bool sg = u.flag == 1;
#pragma unroll
        for (int ai = 0; ai < 2; ++ai)
#pragma unroll
            for (int m = 0; m < 4; ++m) { bf16_t* rowp = base + (size_t)(ai * HALF + m * 16) * u.ldc;
#pragma unroll
                for (int bj = 0; bj < 2; ++bj) { f32x4 v0 = acc[ai][bj][m][0] * scale, v1 = acc[ai][bj][m][1] * scale;
                    if (sg) {
#pragma unroll
                        for (int j = 0; j < 4; ++j) { v0[j] = sigmoidf_(v0[j]); v1[j] = sigmoidf_(v1[j]); } }
                    u32x4 w; w.x = cvt_pk_bf16(v0[0], v0[1]); w.y = cvt_pk_bf16(v0[2], v0[3]); w.z = cvt_pk_bf16(v1[0], v1[1]); w.w = cvt_pk_bf16(v1[2], v1[3]);
                    *(u32x4*)(rowp + bj * HALF) = w; } }
    }
};
struct EpiInproj {
    static constexpr bool PERM = true;
    __device__ __forceinline__ void operator()(const f32x4 (&acc)[2][2][4][2], const Unit& u, int wr, int wc, int fr, int fq) const {
        GAS bf16_t* base = (GAS bf16_t*)u.out + (size_t)(wr * 64 + fr) * u.ldc + wc * 32 + 8 * fq;
        const bool sg = (u.flag & 1) != 0, lat = (u.flag & 16) != 0, r0 = lat && (u.flag & 6) != 0, r1 = lat && (u.flag & 2) != 0;
        const float qs = (u.flag & 8) ? C2 : 1.0f;
        const GAS float* rp = (const GAS float*)u.aux + (size_t)(wr * 64 + fr) * 64 + (wc & 1) * 32 + 4 * fq;
#pragma unroll
        for (int ai = 0; ai < 2; ++ai)
#pragma unroll
            for (int m = 0; m < 4; ++m) { GAS bf16_t* rowp = base + (size_t)(ai * HALF + m * 16) * u.ldc;
                f32x4 cs = (f32x4){1.f, 1.f, 1.f, 1.f}, sn = (f32x4){0.f, 0.f, 0.f, 0.f};
                if (r0) { const GAS float* rt = rp + (size_t)(ai * HALF + m * 16) * 64; cs = *(const GAS f32x4*)rt; sn = *(const GAS f32x4*)(rt + 16); }
#pragma unroll
                for (int bj = 0; bj < 2; ++bj) { f32x4 v0 = acc[ai][bj][m][0], v1 = acc[ai][bj][m][1];
                    if (bj == 0 ? r0 : r1) {
                        const float a0 = v0[0] * cs[0] - v0[1] * sn[0], a1 = v0[1] * cs[0] + v0[0] * sn[0], a2 = v0[2] * cs[1] - v0[3] * sn[1], a3 = v0[3] * cs[1] + v0[2] * sn[1];
                        const float b0 = v1[0] * cs[2] - v1[1] * sn[2], b1 = v1[1] * cs[2] + v1[0] * sn[2], b2 = v1[2] * cs[3] - v1[3] * sn[3], b3 = v1[3] * cs[3] + v1[2] * sn[3];
                        v0 = (f32x4){a0, a1, a2, a3}; v1 = (f32x4){b0, b1, b2, b3}; }
                    v0 *= qs; v1 *= qs;
                    if (sg) {
                        unsigned q[8];
#pragma unroll
                        for (int j = 0; j < 4; ++j) { q[j] = (unsigned)(sigmoidf_(v0[j]) * 255.0f + 0.5f); q[4 + j] = (unsigned)(sigmoidf_(v1[j]) * 255.0f + 0.5f); }
                        u32x2 w8; w8.x = q[0] | (q[1] << 8) | (q[2] << 16) | (q[3] << 24); w8.y = q[4] | (q[5] << 8) | (q[6] << 16) | (q[7] << 24);
                        *(GAS u32x2*)((GAS unsigned char*)u.out + (size_t)(wr * 64 + fr + ai * HALF + m * 16) * GW + wc * 32 + 8 * fq + bj * HALF) = w8;
                    } else {
                    u32x4 w; w.x = cvt_pk_bf16(v0[0], v0[1]); w.y = cvt_pk_bf16(v0[2], v0[3]); w.z = cvt_pk_bf16(v1[0], v1[1]); w.w = cvt_pk_bf16(v1[2], v1[3]);
                    *(GAS u32x4*)(rowp + bj * HALF) = w; } } }
    }
};
struct EpiSwiglu {
    static constexpr bool PERM = true;
    __device__ __forceinline__ void operator()(const f32x4 (&acc)[2][2][4][2], const Unit& u, int wr, int wc, int fr, int fq) const {
        bf16_t* base = (bf16_t*)u.out + (size_t)(wr * 64 + fr) * u.ldc + wc * 32 + 8 * fq;
#pragma unroll
        for (int ai = 0; ai < 2; ++ai)
#pragma unroll
            for (int m = 0; m < 4; ++m) { bf16_t* rowp = base + (size_t)(ai * HALF + m * 16) * u.ldc;
                f32x4 g0 = acc[ai][0][m][0], g1 = acc[ai][0][m][1]; const f32x4 u0 = acc[ai][1][m][0], u1 = acc[ai][1][m][1];
#pragma unroll
                for (int j = 0; j < 4; ++j) { g0[j] = siluf_(g0[j]) * u0[j]; g1[j] = siluf_(g1[j]) * u1[j]; }
                u32x4 w; w.x = cvt_pk_bf16(g0[0], g0[1]); w.y = cvt_pk_bf16(g0[2], g0[3]); w.z = cvt_pk_bf16(g1[0], g1[1]); w.w = cvt_pk_bf16(g1[2], g1[3]);
                *(u32x4*)rowp = w; }
    }
};
struct EpiSwigluF8 {
    static constexpr bool PERM = true;
    __device__ __forceinline__ void operator()(const f32x4 (&acc)[2][2][4][2], const Unit& u, int wr, int wc, int fr, int fq) const {
        GAS unsigned char* base = (GAS unsigned char*)u.out + (size_t)(wr * 64 + fr) * u.ldc + wc * 32 + 8 * fq;
#pragma unroll
        for (int ai = 0; ai < 2; ++ai)
#pragma unroll
            for (int m = 0; m < 4; ++m) { GAS unsigned char* rowp = base + (size_t)(ai * HALF + m * 16) * u.ldc;
                f32x4 g0 = acc[ai][0][m][0], g1 = acc[ai][0][m][1]; const f32x4 u0 = acc[ai][1][m][0], u1 = acc[ai][1][m][1];
#pragma unroll
                for (int j = 0; j < 4; ++j) { g0[j] = siluf_(g0[j]) * u0[j]; g1[j] = siluf_(g1[j]) * u1[j]; }
                u32x2 w; w.x = cvt4_fp8(g0[0], g0[1], g0[2], g0[3]); w.y = cvt4_fp8(g1[0], g1[1], g1[2], g1[3]);
                *(GAS u32x2*)rowp = w; }
    }
};
struct EpiResid {
    static constexpr bool PERM = true;
    __device__ __forceinline__ void operator()(const f32x4 (&acc)[2][2][4][2], const Unit& u, int wr, int wc, int fr, int fq) const {
        GAS bf16_t* base = (GAS bf16_t*)u.out + (size_t)(wr * 64 + fr) * u.ldc + wc * 32 + 8 * fq;
        const size_t roff = (size_t)(wr * 64 + fr) * u.ldc + wc * 32 + 8 * fq;
        const bool srcf = u.flag == 1;
        const GAS float* g = (const GAS float*)u.aux + wc * 32 + 8 * fq;
        f32x4 gv[2][2];
#pragma unroll
        for (int bj = 0; bj < 2; ++bj)
#pragma unroll
            for (int n = 0; n < 2; ++n) gv[bj][n] = *(const GAS f32x4*)(g + bj * HALF + n * 4);
#pragma unroll
        for (int ai = 0; ai < 2; ++ai)
#pragma unroll
            for (int m = 0; m < 4; ++m) { const size_t ro = (size_t)(ai * HALF + m * 16) * u.ldc;
#pragma unroll
                for (int bj = 0; bj < 2; ++bj) {
                    f32x4 r0, r1;
                    if (srcf) { const GAS float* sp = (const GAS float*)u.aux2 + roff + ro + bj * HALF; r0 = *(const GAS f32x4*)sp; r1 = *(const GAS f32x4*)(sp + 4); }
                    else { const u32x4 w = *(const GAS u32x4*)((const GAS bf16_t*)u.aux2 + roff + ro + bj * HALF);
                        r0 = (f32x4){bf_lo(w.x), bf_hi(w.x), bf_lo(w.y), bf_hi(w.y)}; r1 = (f32x4){bf_lo(w.z), bf_hi(w.z), bf_lo(w.w), bf_hi(w.w)}; }
                    const f32x4 v0 = r0 + gv[bj][0] * acc[ai][bj][m][0], v1 = r1 + gv[bj][1] * acc[ai][bj][m][1];
                    u32x4 o; o.x = cvt_pk_bf16(v0[0], v0[1]); o.y = cvt_pk_bf16(v0[2], v0[3]); o.z = cvt_pk_bf16(v1[0], v1[1]); o.w = cvt_pk_bf16(v1[2], v1[3]);
                    *(GAS u32x4*)(base + ro + bj * HALF) = o; }
                asm volatile("" ::: "memory"); }
    }
};
struct BUnit { const char* A; const char* B; const char* gate; char* out; };
__device__ __forceinline__ void gload8_async(u32x2& dst, const void* p) { asm volatile("global_load_dwordx2 %0, %1, off" : "=&v"(dst) : "v"(p) : "memory"); }
template <class Sched>
__device__ __forceinline__ void branch_phase(LAS unsigned char* lds, const int tid, const Sched& S) {
    const int wid = __builtin_amdgcn_readfirstlane(tid >> 6), lane = tid & 63, wr = wid >> 2, wc = wid & 3, fr = lane & 15, fq = lane >> 4;
    constexpr int K = 2048, nt = K / BK, lda = 2048, ldb = 2048;
    unsigned voffA[2], voffB[2];
#pragma unroll
    for (int i = 0; i < 2; ++i) { int R, C; stage_rc(tid * 16 + i * 8192, R, C); const int Rb = (R & ~31) + perm32(R & 31);
        voffA[i] = (unsigned)(R * lda + C) * 2u; voffB[i] = (unsigned)(Rb * ldb + C) * 2u; }
    const size_t kstep = (size_t)(BK * 2);
    const size_t hstepA = (size_t)HALF * lda * 2;
    const unsigned ldsw = (unsigned)wid * 1024u;
    const int aoff = lds_byte(wr * 64 + fr, fq * 8), boff = lds_byte(wc * 32 + fr, fq * 8);
#define BR_SA(b, h) (((b) * 2 + (h)) * HTB)
#define BR_SB(b) ((4 + (b) * 2) * HTB)
#define BR_STAGE(bufoff, gbase, voff) do { _Pragma("unroll") for (int _i = 0; _i < 2; ++_i) \
        __builtin_amdgcn_global_load_lds((const unsigned*)((const char*)(gbase) + (voff)[_i]), (LAS unsigned*)(lds + (bufoff) + ldsw + _i * 8192), 16, 0, 0); } while (0)
#define BR_LDA(dst, b, h) do { _Pragma("unroll") for (int m = 0; m < 4; ++m) _Pragma("unroll") for (int k = 0; k < 2; ++k) dst[m][k] = *(const LAS bf16x8*)(lds + BR_SA(b, h) + aoff + m * 2048 + k * 1024); } while (0)
#define BR_LDB(dst, b) do { _Pragma("unroll") for (int n = 0; n < 2; ++n) _Pragma("unroll") for (int k = 0; k < 2; ++k) dst[n][k] = *(const LAS bf16x8*)(lds + BR_SB(b) + boff + n * 2048 + k * 1024); } while (0)
#define BR_MMA(ai) do { __builtin_amdgcn_s_setprio(1); _Pragma("unroll") for (int m = 0; m < 4; ++m) _Pragma("unroll") for (int n = 0; n < 2; ++n) _Pragma("unroll") for (int k = 0; k < 2; ++k) \
        acc[ai][m][n] = __builtin_amdgcn_mfma_f32_16x16x32_bf16(B0[n][k], At[m][k], acc[ai][m][n], 0, 0, 0); __builtin_amdgcn_s_setprio(0); } while (0)
#define BR_WAIT_V(n) asm volatile("s_waitcnt vmcnt(" #n ")" ::: "memory")
#define BR_WAIT_L0 asm volatile("s_waitcnt lgkmcnt(0)" ::: "memory")
#define BR_BAR __builtin_amdgcn_s_barrier()
#define BR_SCHED __builtin_amdgcn_sched_barrier(0)
    BUnit cur, nxt; int ui = 0;
    if (!S.next(0, cur)) return;
    f32x4 acc[2][4][2], macc[2][4][2];
#pragma unroll
    for (int a = 0; a < 2; ++a)
#pragma unroll
        for (int m = 0; m < 4; ++m)
#pragma unroll
            for (int n = 0; n < 2; ++n) { acc[a][m][n] = (f32x4){0.f, 0.f, 0.f, 0.f}; macc[a][m][n] = (f32x4){0.f, 0.f, 0.f, 0.f}; }
    bf16x8 At[4][2], B0[2][2];
    const char* cA = cur.A; const char* cB = cur.B;
    BR_STAGE(BR_SB(0), cB, voffB); BR_STAGE(BR_SA(0, 0), cA, voffA); BR_STAGE(BR_SA(0, 1), cA + hstepA, voffA);
    if (wr == 1) BR_BAR;
    BR_WAIT_V(2); BR_BAR;
    BR_STAGE(BR_SB(1), cB + kstep, voffB); BR_STAGE(BR_SA(1, 0), cA + kstep, voffA);
    BR_WAIT_V(4); BR_BAR;
    const size_t rowoff = (size_t)(wr * 64 + fr), coloff = (size_t)(wc * 32 + 8 * fq);
    for (;;) {
        const bool has_next = S.next(ui + 1, nxt);
        const char* nA = has_next ? nxt.A : cA; const char* nB = has_next ? nxt.B : cB;
        const char* gbase = cur.gate + (rowoff * GW + coloff);
        u32x2 g[8];
        for (int t = 0; t < nt; t += 2) {
            const bool last = (t == nt - 2);
            const bool hook = (t & 6) == 6;
            const char* a1 = cA + (size_t)(t + 1) * kstep;
            const char* a2 = last ? nA : cA + (size_t)(t + 2) * kstep; const char* b2 = last ? nB : cB + (size_t)(t + 2) * kstep;
            const char* a3 = a2 + kstep; const char* b3 = b2 + kstep;
            if (hook) {
                const char* gp = gbase + (size_t)(t >> 3) * 1024;
#pragma unroll
                for (int q = 0; q < 8; ++q) gload8_async(g[q], gp + (size_t)((q >> 2) * HALF + (q & 3) * 16) * GW);
            }
            BR_LDB(B0, 0); BR_SCHED; BR_LDA(At, 0, 0); BR_STAGE(BR_SA(1, 1), a1 + hstepA, voffA);
            if (hook) BR_WAIT_V(14); else BR_WAIT_V(6);
            BR_WAIT_L0; BR_BAR; BR_MMA(0); BR_BAR; BR_SCHED;
            BR_LDA(At, 0, 1); BR_STAGE(BR_SB(0), b2, voffB); BR_STAGE(BR_SA(0, 0), a2, voffA);
            if (hook) BR_WAIT_V(14); else BR_WAIT_V(6);
            BR_WAIT_L0; BR_BAR; BR_MMA(1); BR_BAR; BR_SCHED;
            BR_LDB(B0, 1); BR_SCHED; BR_LDA(At, 1, 0); BR_STAGE(BR_SA(0, 1), a2 + hstepA, voffA);
            BR_WAIT_V(6); BR_WAIT_L0; BR_BAR; BR_MMA(0); BR_BAR; BR_SCHED;
            BR_LDA(At, 1, 1); BR_STAGE(BR_SB(1), b3, voffB); BR_STAGE(BR_SA(1, 0), a3, voffA);
            BR_WAIT_V(6); BR_WAIT_L0; BR_BAR; BR_MMA(1); BR_BAR; BR_SCHED;
            if (hook) {
                asm volatile("s_waitcnt vmcnt(10)" : "+v"(g[0]), "+v"(g[1]), "+v"(g[2]), "+v"(g[3]), "+v"(g[4]), "+v"(g[5]), "+v"(g[6]), "+v"(g[7]) :: "memory");
#pragma unroll
                for (int ai = 0; ai < 2; ++ai)
#pragma unroll
                    for (int m = 0; m < 4; ++m) { const u32x2 gw = g[ai * 4 + m];
                        const f32x4 g0 = (f32x4){(float)(gw.x & 255u), (float)((gw.x >> 8) & 255u), (float)((gw.x >> 16) & 255u), (float)(gw.x >> 24)};
                        const f32x4 g1 = (f32x4){(float)(gw.y & 255u), (float)((gw.y >> 8) & 255u), (float)((gw.y >> 16) & 255u), (float)(gw.y >> 24)};
                        macc[ai][m][0] += acc[ai][m][0] * g0; macc[ai][m][1] += acc[ai][m][1] * g1;
                        acc[ai][m][0] = (f32x4){0.f, 0.f, 0.f, 0.f}; acc[ai][m][1] = (f32x4){0.f, 0.f, 0.f, 0.f}; }
            }
        }
        {
            GAS bf16_t* op = (GAS bf16_t*)cur.out + rowoff * 1024 + coloff;
#pragma unroll
            for (int ai = 0; ai < 2; ++ai)
#pragma unroll
                for (int m = 0; m < 4; ++m) { const f32x4 v0 = macc[ai][m][0] * (1.0f / 255.0f), v1 = macc[ai][m][1] * (1.0f / 255.0f);
                    u32x4 w; w.x = cvt_pk_bf16(v0[0], v0[1]); w.y = cvt_pk_bf16(v0[2], v0[3]); w.z = cvt_pk_bf16(v1[0], v1[1]); w.w = cvt_pk_bf16(v1[2], v1[3]);
                    *(GAS u32x4*)(op + (size_t)(ai * HALF + m * 16) * 1024) = w;
                    macc[ai][m][0] = (f32x4){0.f, 0.f, 0.f, 0.f}; macc[ai][m][1] = (f32x4){0.f, 0.f, 0.f, 0.f}; }
        }
        if (!has_next) break;
        cur = nxt; cA = nA; cB = nB; ++ui;
    }
    BR_WAIT_V(0);
    if (wr == 0) BR_BAR;
    BR_BAR;
#undef BR_SA
#undef BR_SB
#undef BR_STAGE
#undef BR_LDA
#undef BR_LDB
#undef BR_MMA
#undef BR_WAIT_V
#undef BR_WAIT_L0
#undef BR_BAR
#undef BR_SCHED
}
}

#define XB_TMO      128
#define XB_XCNT(j)  (256  + 64 * (j))
#define XB_XSUB(j)  (1280 + 64 * (j))
#define XB_XGEN(j)  (2304 + 64 * (j))
#define XB_TOP      3328
#define XB_TOPGEN   3392
#define XCD_BAR_WORDS 3456
#define XB_SPIN_CAP (1u << 20)

__device__ __forceinline__ unsigned xb_ld(unsigned* p)              { return __hip_atomic_load(p, __ATOMIC_RELAXED, __HIP_MEMORY_SCOPE_AGENT); }
__device__ __forceinline__ unsigned xb_add(unsigned* p, unsigned v) { return __hip_atomic_fetch_add(p, v, __ATOMIC_RELAXED, __HIP_MEMORY_SCOPE_AGENT); }
__device__ __forceinline__ unsigned xb_xcc_id() { return (unsigned)__builtin_amdgcn_s_getreg((3 << 11) | 20) & 0xFu; }
#define XB_SPIN(cond, bar) do { unsigned _sp = 0; while (cond) { __builtin_amdgcn_s_sleep(1); \
    if ((++_sp & 255u) == 0u) { if (xb_ld(&(bar)[XB_TMO])) break; if (_sp > XB_SPIN_CAP) { atomicAdd(&(bar)[XB_TMO], 1u); break; } } } } while (0)

struct XcdBarrier { unsigned* bar; unsigned x; volatile LAS unsigned* st; };

__device__ __forceinline__ XcdBarrier xcd_barrier_post(unsigned* bar, volatile LAS unsigned* st) {
    XcdBarrier b; b.bar = bar; b.x = xb_xcc_id(); b.st = st;
    if (threadIdx.x == 0) (void)xb_add(&bar[XB_XCNT(b.x)], 1u);
    return b;
}
__device__ __forceinline__ void xcd_barrier_complete(unsigned* bar, unsigned x, unsigned& nloc, unsigned& nx) {
    const unsigned G = gridDim.x * gridDim.y * gridDim.z;
    unsigned sum, cnt, mine, sp = 0u;
    for (;;) {
        sum = 0u; cnt = 0u; mine = 0u;
#pragma unroll
        for (unsigned j = 0; j < 16; ++j) { const unsigned c = xb_ld(&bar[XB_XCNT(j)]); sum += c; cnt += (c > 0u) ? 1u : 0u; mine = (j == x) ? c : mine; }
        if (sum == G) break;
        __builtin_amdgcn_s_sleep(1);
        if ((++sp & 255u) == 0u) { if (xb_ld(&bar[XB_TMO])) break; if (sp > XB_SPIN_CAP) { atomicAdd(&bar[XB_TMO], 1u); break; } }
    }
    nloc = mine > 0u ? mine : 1u; nx = cnt > 0u ? cnt : 1u;
}
__device__ __forceinline__ void xcd_barrier(const XcdBarrier& b, const bool leader) {
    asm volatile("s_waitcnt vmcnt(0)" ::: "memory");
    __syncthreads();
    unsigned* bar = b.bar; asm volatile("" : "+v"(bar));
    if (leader) {
        __builtin_amdgcn_s_waitcnt(0);
        unsigned nloc = b.st[0], nx = b.st[1];
        if (nloc == 0u) { xcd_barrier_complete(bar, b.x, nloc, nx); b.st[0] = nloc; b.st[1] = nx; }
        const unsigned old = xb_add(&bar[XB_XSUB(b.x)], 1u);
        const unsigned gen = old / nloc;
        if (old + 1u == (gen + 1u) * nloc) {
            __builtin_amdgcn_fence(__ATOMIC_RELEASE, "agent");
            asm volatile("s_waitcnt vmcnt(0)" ::: "memory");
            const unsigned og = xb_add(&bar[XB_TOP], 1u);
            const unsigned tg = og / nx;
            if (og + 1u == (tg + 1u) * nx) xb_add(&bar[XB_TOPGEN], 1u);
            else XB_SPIN(xb_ld(&bar[XB_TOPGEN]) == tg, bar);
            __builtin_amdgcn_fence(__ATOMIC_ACQUIRE, "agent");
            xb_add(&bar[XB_XGEN(b.x)], 1u);
            asm volatile("s_waitcnt vmcnt(0)" ::: "memory");
        } else {
            XB_SPIN(xb_ld(&bar[XB_XGEN(b.x)]) == gen, bar);
            __builtin_amdgcn_fence(__ATOMIC_ACQUIRE, "agent");
            asm volatile("s_waitcnt vmcnt(0)" ::: "memory");
        }
    }
    __syncthreads();
}

struct Args { const float* in[23]; float* out; unsigned char* ws; };
enum { I_X = 0, I_C, I_CTX, I_CCTX, I_WMOD, I_BMOD, I_N1G, I_N2G, I_WIN, I_DLAM, I_SUBLN, I_QKG, I_SINK, I_WBR, I_WOUT, I_FG, I_FU, I_FD, I_RW, I_MG, I_MU, I_MD, I_FINALG };

__device__ __forceinline__ bf16_t* w_layer(unsigned char* ws, int l, size_t off) { return (bf16_t*)(ws + WS_W + (size_t)l * W_LAYER + off); }
__device__ __forceinline__ bf16_t* w_dense(unsigned char* ws, int i, size_t off) { return (bf16_t*)(ws + WS_W + W_DENSE0 + (size_t)i * W_DENSE + off); }
__device__ __forceinline__ bf16_t* w_moe(unsigned char* ws, int i, int e, size_t off) { return (bf16_t*)(ws + WS_W + W_MOE0 + (size_t)i * W_MOE + (size_t)e * W_EXPERT + off); }

constexpr int CV_LAYER = 1536 + 2048 + 1024 + 512;
constexpr int CV_DENSE = 3 * 1408;
constexpr int CV_EXP = 3 * 1792;
constexpr int CV_TOTAL = 4 * CV_LAYER + 2 * CV_DENSE + 16 * CV_EXP;
struct ConvDesc { const float* src; bf16_t* dst; int ldsrc, lddst, perm; float f8s; };
__device__ __forceinline__ ConvDesc conv_decode(const Args& a, int it) {
    unsigned char* ws = a.ws;
    const float* src; int ldsrc, K, c0, ncols, mode = 0, drow0 = 0, blk, ldd = 0; bf16_t* dst; bool win = false; float f8s = 0.f;
    if (it < 4 * CV_LAYER) { const int l = it / CV_LAYER, r = it % CV_LAYER;
        if (r < 1536) { blk = r; src = a.in[I_WIN] + (size_t)l * DM * DIN; ldsrc = DIN; K = DM; c0 = 0; ncols = 3072; dst = w_layer(ws, l, W_IN); drow0 = 0; win = true; }
        else if (r < 3584) { blk = r - 1536; src = a.in[I_WIN] + (size_t)l * DM * DIN; ldsrc = DIN; K = DM; c0 = 3584; ncols = 4096; dst = w_layer(ws, l, W_IN); drow0 = 3072; }
        else if (r < 4608) { const int q = r - 3584, rr = q / 256; blk = q % 256; src = a.in[I_WBR] + (size_t)(l * 4 + rr) * 512 * DM; ldsrc = DM; K = 512; c0 = 0; ncols = DM; dst = w_layer(ws, l, W_BR) + (size_t)rr * 512; ldd = 2048; }
        else { blk = r - 4608; src = a.in[I_WOUT] + (size_t)l * DM * DM; ldsrc = DM; K = DM; c0 = 0; ncols = DM; dst = w_layer(ws, l, W_OUT); }
    } else if (it < 4 * CV_LAYER + 2 * CV_DENSE) { const int q = it - 4 * CV_LAYER, i = q / CV_DENSE, r = q % CV_DENSE, which = r / 1408; blk = r % 1408;
        if (which < 2) { src = a.in[which == 0 ? I_FG : I_FU] + (size_t)i * DM * DFF; ldsrc = DFF; K = DM; c0 = 0; ncols = DFF; dst = w_dense(ws, i, W_DGU); mode = 1 + which; }
        else { src = a.in[I_FD] + (size_t)i * DFF * DM; ldsrc = DM; K = DFF; c0 = 0; ncols = DM; dst = w_dense(ws, i, W_DD); }
    } else { const int q = it - 4 * CV_LAYER - 2 * CV_DENSE, ie = q / CV_EXP, r = q % CV_EXP, which = r / 1792, i = ie >> 3, e = ie & 7; blk = r % 1792;
        if (which < 2) { src = a.in[which == 0 ? I_MG : I_MU] + (size_t)ie * DM * DFE; ldsrc = DFE; K = DM; c0 = 0; ncols = DFE; dst = w_moe(ws, i, e, W_MGU); mode = 1 + which; f8s = 128.0f; }
        else { src = a.in[I_MD] + (size_t)ie * DFE * DM; ldsrc = DM; K = DFE; c0 = 0; ncols = DM; dst = w_moe(ws, i, e, W_MD); f8s = 256.0f; }
    }
    const int nbn = ncols / 32, kb = blk / nbn, nb = blk % nbn, n = 32 * nb;
    const int drow = mode == 0 ? drow0 + n : 256 * (n >> 7) + (n & 127) + (mode == 2 ? 128 : 0);
    const bool perm = win && (n < 1024 || (n >= 1536 && n < 2176) || (n >= 2304 && n < 2944));
    ConvDesc d; d.src = src + (size_t)(64 * kb) * ldsrc + c0 + n; if (ldd == 0) ldd = K;
    d.dst = f8s != 0.f ? (bf16_t*)((unsigned char*)dst + (size_t)drow * ldd + 64 * kb) : dst + (size_t)drow * ldd + 64 * kb; d.ldsrc = ldsrc; d.lddst = ldd; d.perm = perm ? 1 : 0; d.f8s = f8s;
    return d;
}
__device__ __forceinline__ void conv_load(const ConvDesc& d, float (&r)[32], int lane) {
    const GAS float* s = (const GAS float*)d.src + (size_t)(lane >> 5) * d.ldsrc + (lane & 31);
#pragma unroll
    for (int i = 0; i < 32; ++i) r[i] = __builtin_nontemporal_load(s + (size_t)(2 * i) * d.ldsrc);
}
__device__ __forceinline__ void conv_store(const ConvDesc& d, const float (&r)[32], LAS float* scr, int lane) {
#pragma unroll
    for (int i = 0; i < 32; ++i) scr[(2 * i + (lane >> 5)) * 33 + (lane & 31)] = r[i];
    LDS_WAIT(); asm volatile("" ::: "memory");
    const int c = lane & 7;
    if (d.f8s != 0.f) { const float fs = d.f8s;
#pragma unroll
        for (int j = 0; j < 4; ++j) { const int n = (lane >> 3) + 8 * j; const LAS float* s = scr + (8 * c) * 33 + n;
            u32x2 o; o.x = cvt4_fp8(s[0 * 33] * fs, s[1 * 33] * fs, s[2 * 33] * fs, s[3 * 33] * fs); o.y = cvt4_fp8(s[4 * 33] * fs, s[5 * 33] * fs, s[6 * 33] * fs, s[7 * 33] * fs);
            __builtin_nontemporal_store(o, (GAS u32x2*)((GAS unsigned char*)d.dst + (size_t)n * d.lddst + 8 * c)); }
    } else {
#pragma unroll
    for (int j = 0; j < 4; ++j) { const int n = (lane >> 3) + 8 * j; const LAS float* s = scr + (8 * c) * 33 + n;
        u32x4 o; o.x = cvt_pk_bf16(s[0 * 33], s[1 * 33]); o.y = cvt_pk_bf16(s[2 * 33], s[3 * 33]); o.z = cvt_pk_bf16(s[4 * 33], s[5 * 33]); o.w = cvt_pk_bf16(s[6 * 33], s[7 * 33]);
        const int dn = d.perm ? 2 * (n & 15) + (n >> 4) : n;
        __builtin_nontemporal_store(o, (GAS u32x4*)(d.dst + (size_t)dn * d.lddst + 8 * c)); }
    }
    LDS_WAIT(); asm volatile("" ::: "memory");
}
__device__ __forceinline__ void fzfold_item(const Args& a, int it, int lane) {
    const int mq = it & 3, kb = (it >> 2) & 15, g = (it >> 6) & 7, l = it >> 9, k0 = 64 * kb;
    const GAS f32x4* src = (const GAS f32x4*)(a.in[I_WIN] + (size_t)l * DM * DIN + (size_t)(k0 + lane) * DIN + 3072 + g * 64);
    float w[64];
#pragma unroll
    for (int i = 0; i < 16; ++i) { const f32x4 v = src[i]; w[4 * i] = v[0]; w[4 * i + 1] = v[1]; w[4 * i + 2] = v[2]; w[4 * i + 3] = v[3]; }
    const float cv = cospif((float)lane * (1.0f / 32.0f)), sv = sinpif((float)lane * (1.0f / 32.0f));
    GAS bf16_t* dst = (GAS bf16_t*)w_layer(a.ws, l, W_FZ);
    for (int m = 16 * mq; m < 16 * mq + 16; ++m) {
        float sc = 0.f, ss = 0.f;
#pragma unroll
        for (int c = 0; c < 64; ++c) { const int j = (c * m) & 63;
            const float cj = __builtin_bit_cast(float, __builtin_amdgcn_readlane(__builtin_bit_cast(int, cv), j)), sj = __builtin_bit_cast(float, __builtin_amdgcn_readlane(__builtin_bit_cast(int, sv), j));
            sc += w[c] * cj; ss += w[c] * sj; }
        dst[(size_t)(g * 64 + m) * DM + k0 + lane] = f2bf(sc);
        dst[(size_t)(512 + g * 64 + m) * DM + k0 + lane] = f2bf(ss);
    }
}
__device__ __forceinline__ void mod_item(const Args& a, int item, LAS unsigned char* lds, int tid) {
    const int l = item / 24, chunk = item % 24, wid = tid >> 6, lane = tid & 63;
    LAS float* sc = (LAS float*)lds;
    LAS float* red = (LAS float*)(lds + 36864);
    for (int i = tid; i < 9 * 1024; i += 512) { const float v = i < 8192 ? a.in[I_C][i] : a.in[I_CCTX][i - 8192]; sc[i] = siluf_(v); }
    __syncthreads();
    const float* w = a.in[I_WMOD] + (size_t)l * DM * 6144 + chunk * 256 + lane * 4;
    f32x4 acc[9];
#pragma unroll
    for (int r = 0; r < 9; ++r) acc[r] = (f32x4){0.f, 0.f, 0.f, 0.f};
    const int kb = wid * 128;
#pragma unroll 8
    for (int k = 0; k < 128; ++k) { const f32x4 wv = *(const GAS f32x4*)(w + (size_t)(kb + k) * 6144);
#pragma unroll
        for (int r = 0; r < 9; ++r) acc[r] += wv * sc[r * 1024 + kb + k]; }
#pragma unroll
    for (int r = 0; r < 9; ++r) *(LAS f32x4*)(red + (wid * 9 + r) * 256 + lane * 4) = acc[r];
    __syncthreads();
    float* modv = (float*)(a.ws + WS_MODV) + (size_t)l * 9 * 6144;
    for (int i = tid; i < 9 * 256; i += 512) { const int r = i >> 8, c = i & 255; float s = 0.f;
#pragma unroll
        for (int w8 = 0; w8 < 8; ++w8) s += red[(w8 * 9 + r) * 256 + c];
        modv[r * 6144 + chunk * 256 + c] = s + a.in[I_BMOD][l * 6144 + chunk * 256 + c]; }
    __syncthreads();
}

struct RowV { f32x4 v[4]; };
__device__ __forceinline__ RowV load_row_f32(const float* p, int lane) { RowV r; const f32x4* q = (const f32x4*)p + lane;
#pragma unroll
    for (int j = 0; j < 4; ++j) r.v[j] = q[64 * j];
    return r; }
__device__ __forceinline__ void store_row_f32(float* p, const RowV& r, int lane) { f32x4* q = (f32x4*)p + lane;
#pragma unroll
    for (int j = 0; j < 4; ++j) q[64 * j] = r.v[j]; }
__device__ __forceinline__ RowV load_row_bf16(const bf16_t* p, int lane) { RowV r; const u32x2* q = (const u32x2*)p + lane;
#pragma unroll
    for (int j = 0; j < 4; ++j) { const u32x2 w = q[64 * j]; r.v[j] = (f32x4){bf_lo(w.x), bf_hi(w.x), bf_lo(w.y), bf_hi(w.y)}; }
    return r; }
__device__ __forceinline__ void store_row_bf16(bf16_t* p, const RowV& r, int lane) { u32x2* q = (u32x2*)p + lane;
#pragma unroll
    for (int j = 0; j < 4; ++j) { u32x2 w; w.x = cvt_pk_bf16(r.v[j][0], r.v[j][1]); w.y = cvt_pk_bf16(r.v[j][2], r.v[j][3]); q[64 * j] = w; } }
__device__ __forceinline__ void store_row_fp8(unsigned char* p, const RowV& r, int lane) { unsigned* q = (unsigned*)p + lane;
#pragma unroll
    for (int j = 0; j < 4; ++j) q[64 * j] = cvt4_fp8(r.v[j][0], r.v[j][1], r.v[j][2], r.v[j][3]); }
__device__ __forceinline__ RowV adaln_row(const RowV& x, const float* g, const float* shift, const float* scale, int lane) {
    float ss = 0.f;
#pragma unroll
    for (int j = 0; j < 4; ++j) ss += (x.v[j][0] * x.v[j][0] + x.v[j][1] * x.v[j][1]) + (x.v[j][2] * x.v[j][2] + x.v[j][3] * x.v[j][3]);
    const float rstd = 1.0f / sqrtf(wave_sum(ss) * (1.0f / DM) + 1e-6f);
    const RowV gv = load_row_f32(g, lane), sh = load_row_f32(shift, lane), sc = load_row_f32(scale, lane);
    RowV y;
#pragma unroll
    for (int j = 0; j < 4; ++j) y.v[j] = x.v[j] * rstd * gv.v[j] * (1.0f + sc.v[j]) + sh.v[j];
    return y;
}
__device__ __forceinline__ int mod_row_of(int row) { return row < NLAT ? (row >> 11) : 8; }
struct AdaCoef { RowV A, B; int mr; };
__device__ __forceinline__ void ada_coef_update(AdaCoef& c, int row, const float* g, const float* modbase, int shift_off, int scale_off, int lane) {
    const int mr = mod_row_of(row);
    if (mr != c.mr) { c.mr = mr; const float* mv = modbase + (size_t)mr * 6144;
        const RowV gv = load_row_f32(g, lane), sh = load_row_f32(mv + shift_off, lane), sc = load_row_f32(mv + scale_off, lane);
#pragma unroll
        for (int j = 0; j < 4; ++j) { c.A.v[j] = gv.v[j] * (1.0f + sc.v[j]); c.B.v[j] = sh.v[j]; } }
}
__device__ __forceinline__ RowV adaln_apply(const RowV& x, const AdaCoef& c) {
    float ss = 0.f;
#pragma unroll
    for (int j = 0; j < 4; ++j) ss += (x.v[j][0] * x.v[j][0] + x.v[j][1] * x.v[j][1]) + (x.v[j][2] * x.v[j][2] + x.v[j][3] * x.v[j][3]);
    const float rstd = 1.0f / sqrtf(wave_sum(ss) * (1.0f / DM) + 1e-6f);
    RowV y;
#pragma unroll
    for (int j = 0; j < 4; ++j) y.v[j] = x.v[j] * rstd * c.A.v[j] + c.B.v[j];
    return y;
}

struct MoeTiles { int tb[9]; };
__device__ __forceinline__ MoeTiles moe_tiles(unsigned* ctl, int i) { MoeTiles t; int s = 0;
#pragma unroll
    for (int e = 0; e < 8; ++e) { t.tb[e] = s; const unsigned c = (unsigned)__builtin_amdgcn_readfirstlane((int)__hip_atomic_load(ctl + CW_CNT + 64 * (8 * i + e), __ATOMIC_RELAXED, __HIP_MEMORY_SCOPE_AGENT)); s += (int)((c + 255u) >> 8); }
    t.tb[8] = s; return t; }

__device__ __forceinline__ float max3f(float a, float b, float c) { return __builtin_fmaxf(__builtin_fmaxf(a, b), c); }
__device__ __forceinline__ int crow(int r, int hi) { return (r & 3) + 8 * (r >> 2) + 4 * hi; }
typedef short v4i16_t __attribute__((ext_vector_type(4)));
__device__ __forceinline__ s16x4 vtr(const LAS unsigned char* p) { return __builtin_bit_cast(s16x4, __builtin_amdgcn_ds_read_tr16_b64_v4i16((LAS v4i16_t*)p)); }

struct AttnCtx { const bf16_t* P; bf16_t* O; const float* subln_g; float lam, one_m_li; const float* sink; };

constexpr float ATT_THR = 8.0f;
__device__ __forceinline__ void glds16(const void* gsrc, unsigned lds_dst) { unsigned keep;
    asm volatile("s_mov_b32 %0, m0\n\ts_mov_b32 m0, %2\n\ts_nop 0\n\tglobal_load_lds_dwordx4 %1, off\n\ts_mov_b32 m0, %0" : "=&s"(keep) : "v"(gsrc), "s"(lds_dst) : "memory"); }
#define ATT_BAR() do { __builtin_amdgcn_sched_barrier(0); asm volatile("s_waitcnt lgkmcnt(0)" ::: "memory"); __builtin_amdgcn_s_barrier(); asm volatile("" ::: "memory"); __builtin_amdgcn_sched_barrier(0); } while (0)
template <int VAR>
__device__ __forceinline__ void attn_unit(LAS unsigned char* lds, const int tid, const AttnCtx& ac, int b, int hh, int qb, bool ctxq) {
    constexpr int NDB = (VAR == 0) ? 4 : 2;
    constexpr int NLD = (VAR == 0) ? 2 : 1;
    constexpr int KB = (VAR == 0) ? 16384 : 8192;
    constexpr int VB = (VAR == 0) ? 16384 : 8192;
    constexpr int VBASE = 3 * KB;
    constexpr int WSF_OFF = 135168;
    const int lane = tid & 63, r32 = lane & 31, hi = lane >> 5; const int wid = __builtin_amdgcn_readfirstlane(tid >> 6);
    const int half = wid >> 2;
    int map = 0, g = 0, qsub, qcol, kcol, vcol, ocol, qpb;
    if (VAR == 0) { map = wid >> 2; qsub = wid & 3; qpb = 128; qcol = C_AQ + hh * 128 + map * 64; kcol = C_AK + hh * 128; vcol = C_AV + hh * 128; ocol = hh * 128; }
    else { g = wid >> 1; qsub = wid & 1; qpb = 64; qcol = (VAR == 1 ? C_BQ : C_CQ) + (hh * 4 + g) * 64; kcol = (VAR == 1 ? C_BK : C_CK) + hh * 64; vcol = (VAR == 1 ? C_BV : C_CV) + hh * 64; ocol = (VAR == 1 ? 512 : 1024) + (hh * 4 + g) * 64; }
    const int q0w = qb * qpb + qsub * 32;
    const int latbase = b * SEQ, ctxbase = NLAT + b * CTXL;
    const int qrow0 = (ctxq ? ctxbase : latbase) + q0w;
    int NT, lt0 = 0;
    if (ctxq) NT = 4;
    else if (VAR == 2) { lt0 = qb - 2 < 0 ? 0 : qb - 2; const int lt1 = qb + 2 > 31 ? 31 : qb + 2; NT = 4 + (lt1 - lt0 + 1); }
    else NT = 36;
    auto tile_row0 = [&](int t) -> int {
        if (ctxq) return ctxbase + 64 * t;
        if (VAR == 2) return t < 4 ? ctxbase + 64 * t : latbase + 64 * (lt0 + t - 4);
        return t < 32 ? latbase + 64 * t : ctxbase + 64 * (t - 32);
    };
    const GAS bf16_t* Pg = (const GAS bf16_t*)ac.P;
    bf16x8 qr[4];
    { const GAS bf16_t* qp = Pg + (size_t)(qrow0 + r32) * PW + qcol + hi * 8;
#pragma unroll
      for (int d0 = 0; d0 < 4; ++d0) qr[d0] = *(const GAS bf16x8*)(qp + d0 * 16); }
    const GAS bf16_t* kdma = Pg + (size_t)lane * PW + kcol + 8 * wid;
    const GAS bf16_t* vdma = Pg + (size_t)(16 * (wid & 3) + (lane >> 2)) * PW + vcol + (wid >> 2) * 32 + (lane & 3) * 8;
    const unsigned lds0 = (unsigned)(uintptr_t)lds + (unsigned)wid * 1024u;
    auto gloadK = [&](int t, int slot) { const GAS bf16_t* rp = kdma + (size_t)tile_row0(t) * PW;
#pragma unroll
        for (int j = 0; j < NLD; ++j) glds16((const void*)(rp + 64 * j), (unsigned)__builtin_amdgcn_readfirstlane(lds0 + (unsigned)(slot * KB + j * 8192))); };
    auto gloadV = [&](int t, int slot) { const GAS bf16_t* rp = vdma + (size_t)tile_row0(t) * PW;
#pragma unroll
        for (int j = 0; j < NLD; ++j) glds16((const void*)(rp + 64 * j), (unsigned)__builtin_amdgcn_readfirstlane(lds0 + (unsigned)(VBASE + slot * VB + j * 8192))); };
    volatile LAS float* wsf = (volatile LAS float*)(lds + WSF_OFF + wid * 256);
    const int koff = (VAR == 0 ? map * 8192 : 0) + hi * 1024 + r32 * 16;
    const int vlane = (4 * hi + ((lane & 15) >> 2)) * 64 + ((lane >> 4) & 1) * 32 + (lane & 3) * 8;
    f32x16 o[NDB];
#pragma unroll
    for (int d = 0; d < NDB; ++d) o[d] = (f32x16){0.f, 0.f, 0.f, 0.f, 0.f, 0.f, 0.f, 0.f, 0.f, 0.f, 0.f, 0.f, 0.f, 0.f, 0.f, 0.f};
    float m_run = 0.f, l_run = 0.f;
    f32x16 negm = (f32x16){0.f, 0.f, 0.f, 0.f, 0.f, 0.f, 0.f, 0.f, 0.f, 0.f, 0.f, 0.f, 0.f, 0.f, 0.f, 0.f};
    const int tq = q0w + r32;
    f32x16 s0, s1;
    auto qk = [&](int slot) { const LAS unsigned char* bp = lds + slot * KB + koff;
        s0 = negm; s1 = negm;
        constexpr int KH = (VAR == 0) ? 2 : 4;
#pragma unroll
        for (int h = 0; h < 4; h += KH) {
            bf16x8 kf[2 * KH];
#pragma unroll
            for (int d0 = 0; d0 < KH; ++d0) { kf[2 * d0] = *(const LAS bf16x8*)(bp + (h + d0) * 2048); kf[2 * d0 + 1] = *(const LAS bf16x8*)(bp + (h + d0) * 2048 + 512); }
            __builtin_amdgcn_sched_barrier(0);
#pragma unroll
            for (int d0 = 0; d0 < KH; ++d0) {
                s0 = __builtin_amdgcn_mfma_f32_32x32x16_bf16(kf[2 * d0], qr[h + d0], s0, 0, 0, 0);
                s1 = __builtin_amdgcn_mfma_f32_32x32x16_bf16(kf[2 * d0 + 1], qr[h + d0], s1, 0, 0, 0); }
            if (h + KH < 4) __builtin_amdgcn_sched_barrier(0);
        } };
    gloadK(0, 0); gloadV(0, 0);
    if (NT > 1) gloadK(1, 1);
    asm volatile("s_waitcnt vmcnt(0)" ::: "memory"); ATT_BAR();
    if (NT > 2) gloadK(2, 2);
    if (NT > 1) gloadV(1, 1);
    qk(0);
    ATT_BAR();
    if (half == 1) ATT_BAR();
    int k0 = 0;
    for (int t = 0; t < NT; ++t) {
        const bool more1 = t + 1 < NT, more2 = t + 2 < NT, more3 = t + 3 < NT;
        const int k1 = k0 == 2 ? 0 : k0 + 1, k2 = k1 == 2 ? 0 : k1 + 1;
        if (VAR == 2 && !ctxq && t >= 4) {
            const int lt = lt0 + t - 4, kb = 64 * lt + 4 * hi - tq;
            if (lt == qb - 2) {
#pragma unroll
                for (int r = 0; r < 16; ++r) { const int d = kb + (r & 3) + 8 * (r >> 2); if (d < -128) s0[r] = -1e30f; if (d + 32 < -128) s1[r] = -1e30f; }
            } else if (lt == qb + 2) {
#pragma unroll
                for (int r = 0; r < 16; ++r) { const int d = kb + (r & 3) + 8 * (r >> 2); if (d > 128) s0[r] = -1e30f; if (d + 32 > 128) s1[r] = -1e30f; }
            }
        }
        float ma = max3f(s0[0], s0[1], s1[0]), mb = max3f(s0[2], s0[3], s1[1]); ma = max3f(ma, s1[2], s1[3]);
#pragma unroll
        for (int r = 4; r < 16; r += 4) { ma = max3f(ma, s0[r], s0[r + 1]); mb = max3f(mb, s0[r + 2], s0[r + 3]); ma = max3f(ma, s1[r], s1[r + 1]); mb = max3f(mb, s1[r + 2], s1[r + 3]); }
        float mx = fmaxf(ma, mb);
        { const auto rr = __builtin_amdgcn_permlane32_swap(__float_as_uint(mx), __float_as_uint(mx), false, false); mx = fmaxf(__uint_as_float(rr[0]), __uint_as_float(rr[1])); }
        if (t == 0 || __any(mx > ATT_THR)) {
            const float dl = (t == 0) ? mx : fmaxf(mx, 0.f);
            m_run += dl;
#pragma unroll
            for (int r = 0; r < 16; ++r) { s0[r] -= dl; s1[r] -= dl; negm[r] = -m_run; }
            const float f = fast_exp2(-dl);
            l_run *= f;
            if (hi == 0) wsf[r32] = f;
            LDS_WAIT();
#pragma unroll
            for (int r = 0; r < 16; ++r) { const float al = wsf[crow(r, hi)];
#pragma unroll
                for (int d = 0; d < NDB; ++d) o[d][r] *= al; }
        }
        float la = 0.f, lb = 0.f;
#pragma unroll
        for (int r = 0; r < 16; ++r) { s0[r] = fast_exp2(s0[r]); s1[r] = fast_exp2(s1[r]); la += s0[r]; lb += s1[r]; }
        l_run += la + lb;
        bf16x8 pa[4];
        { u32x4 w;
          w.x = cvt_pk_bf16(s0[0], s0[1]); w.y = cvt_pk_bf16(s0[2], s0[3]); w.z = cvt_pk_bf16(s0[4], s0[5]); w.w = cvt_pk_bf16(s0[6], s0[7]); pa[0] = __builtin_bit_cast(bf16x8, w);
          w.x = cvt_pk_bf16(s0[8], s0[9]); w.y = cvt_pk_bf16(s0[10], s0[11]); w.z = cvt_pk_bf16(s0[12], s0[13]); w.w = cvt_pk_bf16(s0[14], s0[15]); pa[1] = __builtin_bit_cast(bf16x8, w);
          w.x = cvt_pk_bf16(s1[0], s1[1]); w.y = cvt_pk_bf16(s1[2], s1[3]); w.z = cvt_pk_bf16(s1[4], s1[5]); w.w = cvt_pk_bf16(s1[6], s1[7]); pa[2] = __builtin_bit_cast(bf16x8, w);
          w.x = cvt_pk_bf16(s1[8], s1[9]); w.y = cvt_pk_bf16(s1[10], s1[11]); w.z = cvt_pk_bf16(s1[12], s1[13]); w.w = cvt_pk_bf16(s1[14], s1[15]); pa[3] = __builtin_bit_cast(bf16x8, w); }
        ATT_BAR();
        if (more3) gloadK(t + 3, k0);
        if (more2) gloadV(t + 2, k2);
        const LAS unsigned char* vp = lds + VBASE + k0 * VB + vlane;
        s16x4 va_lo[NDB], va_hi[NDB], vb_lo[NDB], vb_hi[NDB];
#define ATT_VLOAD(LO, HI, KS) do { _Pragma("unroll") for (int d = 0; d < NDB; ++d) { LO[d] = vtr(vp + d * 4096 + (KS) * 1024); HI[d] = vtr(vp + d * 4096 + (KS) * 1024 + 512); } } while (0)
#define ATT_VMMA(LO, HI, KS) do { _Pragma("unroll") for (int d = 0; d < NDB; ++d) { const bf16x8 vf = (bf16x8){LO[d][0], LO[d][1], LO[d][2], LO[d][3], HI[d][0], HI[d][1], HI[d][2], HI[d][3]}; \
            o[d] = __builtin_amdgcn_mfma_f32_32x32x16_bf16(pa[KS], vf, o[d], 0, 0, 0); } } while (0)
        ATT_VLOAD(va_lo, va_hi, 0); ATT_VLOAD(vb_lo, vb_hi, 1);
        __builtin_amdgcn_sched_barrier(0);
        ATT_VMMA(va_lo, va_hi, 0);
        __builtin_amdgcn_sched_barrier(0);
        ATT_VLOAD(va_lo, va_hi, 2);
        __builtin_amdgcn_sched_barrier(0);
        ATT_VMMA(vb_lo, vb_hi, 1);
        __builtin_amdgcn_sched_barrier(0);
        ATT_VLOAD(vb_lo, vb_hi, 3);
        __builtin_amdgcn_sched_barrier(0);
        ATT_VMMA(va_lo, va_hi, 2);
        ATT_VMMA(vb_lo, vb_hi, 3);
#undef ATT_VLOAD
#undef ATT_VMMA
        if (more1) qk(k1);
        if (more3) { if (NLD == 2) asm volatile("s_waitcnt vmcnt(4)" ::: "memory"); else asm volatile("s_waitcnt vmcnt(2)" ::: "memory"); }
        else if (more2) { if (NLD == 2) asm volatile("s_waitcnt vmcnt(2)" ::: "memory"); else asm volatile("s_waitcnt vmcnt(1)" ::: "memory"); }
        else asm volatile("s_waitcnt vmcnt(0)" ::: "memory");
        ATT_BAR();
        k0 = k1;
    }
    if (half == 0) ATT_BAR();
    { float l_tot; { const auto rr = __builtin_amdgcn_permlane32_swap(__float_as_uint(l_run), __float_as_uint(l_run), false, false); l_tot = __uint_as_float(rr[0]) + __uint_as_float(rr[1]); }
      if (VAR == 2) l_tot += fast_exp2(ac.sink[hh * 4 + g] * LOG2E - m_run);
      if (hi == 0) wsf[r32] = 1.0f / l_tot;
      LDS_WAIT();
#pragma unroll
      for (int r = 0; r < 16; ++r) { const float il = wsf[crow(r, hi)];
#pragma unroll
          for (int d = 0; d < NDB; ++d) o[d][r] *= il; } }
    GAS bf16_t* Og = (GAS bf16_t*)ac.O;
    if (VAR != 0) {
#pragma unroll
        for (int r = 0; r < 16; ++r) { GAS bf16_t* op = Og + (size_t)(qrow0 + crow(r, hi)) * OW + ocol + r32;
#pragma unroll
            for (int d = 0; d < NDB; ++d) op[d * 32] = f2bf(o[d][r]); }
    } else {
        LAS float* tile = (LAS float*)lds + ((wid & 3) * 2 + map) * (32 * 132);
#pragma unroll
        for (int r = 0; r < 16; ++r)
#pragma unroll
            for (int d = 0; d < NDB; ++d) tile[crow(r, hi) * 132 + d * 32 + r32] = o[d][r];
        __syncthreads();
        const int ql = (wid >> 2) * 16 + (lane >> 2), part = lane & 3;
        const LAS float* t0 = (const LAS float*)lds + ((wid & 3) * 2) * (32 * 132) + ql * 132 + part * 32;
        const LAS float* t1 = t0 + 32 * 132;
        f32x4 dv[8]; float ss = 0.f;
#pragma unroll
        for (int j = 0; j < 8; ++j) { const f32x4 a = *(const LAS f32x4*)(t0 + 4 * j), bq = *(const LAS f32x4*)(t1 + 4 * j); dv[j] = a - ac.lam * bq;
            ss += (dv[j][0] * dv[j][0] + dv[j][1] * dv[j][1]) + (dv[j][2] * dv[j][2] + dv[j][3] * dv[j][3]); }
        ss += __shfl_xor(ss, 1); ss += __shfl_xor(ss, 2);
        const float rs = ac.one_m_li / sqrtf(ss * (1.0f / 128.0f) + 1e-5f);
        const GAS float* gp = (const GAS float*)ac.subln_g + part * 32;
        GAS bf16_t* op = Og + (size_t)((ctxq ? ctxbase : latbase) + qb * qpb + (wid & 3) * 32 + ql) * OW + ocol + part * 32;
#pragma unroll
        for (int k = 0; k < 4; ++k) { const f32x4 g0 = *(const GAS f32x4*)(gp + 8 * k), g1 = *(const GAS f32x4*)(gp + 8 * k + 4);
            const f32x4 v0 = dv[2 * k] * g0 * rs, v1 = dv[2 * k + 1] * g1 * rs;
            u32x4 w; w.x = cvt_pk_bf16(v0[0], v0[1]); w.y = cvt_pk_bf16(v0[2], v0[3]); w.z = cvt_pk_bf16(v1[0], v1[1]); w.w = cvt_pk_bf16(v1[2], v1[3]);
            *(GAS u32x4*)(op + 8 * k) = w; }
    }
}

using pg8::Unit;
struct SchedInproj {
    int c, G, nM, ntot, nfz; const char* xn; const char* win; const char* wfz; char* p; char* zz; char* zzc; const char* rope; char* gates;
    __device__ __forceinline__ bool next(int i, Unit& u) const {
        const int L = i * G + c; if (L >= ntot + nfz) return false;
        u.aux = nullptr; u.aux2 = nullptr;
        if (L < ntot) { int pm, pn; pg8::tile_of(L, nM, 28, pm, pn);
            u.A = xn + (size_t)pm * 256 * DM * 2; u.B = win + (size_t)pn * 256 * DM * 2; if (pn < 12) { u.out = p + ((size_t)pm * 256 * PW + pn * 256) * 2; u.ldc = PW; } else { u.out = gates + ((size_t)pm * 256 * GW + (pn - 12) * 256); u.ldc = GW; }
            int fl = pm < 64 ? 16 : 0;
            if (pn >= 12) fl |= 1; else if (pn < 2) fl |= 2 | 8; else if (pn < 4) fl |= 2; else if (pn == 9 || pn == 10) fl |= 2 | 8; else if (pn == 11) fl |= 4;
            u.flag = fl; u.aux = rope + (size_t)((pm * 256) & 2047) * 64 * 4; }
        else { const int q = L - ntot;
            if (q < 256) { const int b = q >> 5, pm = (q >> 3) & 3, pn = q & 7;
                u.A = wfz + (size_t)pm * 256 * DM * 2; u.B = xn + (size_t)(b * SEQ + pn * 256) * DM * 2;
                u.out = zz + ((size_t)b * 512 * 4096 + (size_t)((pm & 1) * 256) * 4096 + (pm >> 1) * 2048 + pn * 256) * 2; u.ldc = 4096; u.flag = 0; }
            else { const int q2 = q - 256, b = q2 >> 2, pm = q2 & 3;
                u.A = wfz + (size_t)pm * 256 * DM * 2; u.B = xn + (size_t)(NLAT + b * CTXL) * DM * 2;
                u.out = zzc + ((size_t)b * 512 * 512 + (size_t)((pm & 1) * 256) * 512 + (pm >> 1) * 256) * 2; u.ldc = 512; u.flag = 0; } }
        return true;
    }
};
struct SchedDft {
    int c; const char* T; const char* zz; char* o;
    __device__ __forceinline__ bool next(int i, Unit& u) const {
        if (i > 0 || c >= 128) return false;
        const int b = c >> 4, pm = (c >> 1) & 7, pn = c & 1;
        u.A = T + (size_t)pm * 256 * 4096 * 2; u.B = zz + ((size_t)b * 512 + pn * 256) * 4096 * 2;
        u.out = o + ((size_t)(b * SEQ + pm * 256) * OW + 1536 + pn * 256) * 2; u.ldc = OW; u.flag = 0; u.aux = nullptr; u.aux2 = nullptr; return true;
    }
};
struct SchedDftCtx {
    int c; const char* T; const char* zzc; char* o;
    __device__ __forceinline__ bool next(int i, Unit& u) const {
        if (i > 0 || c < 128 || c >= 144) return false;
        const int q = c - 128, b = q >> 1, pn = q & 1;
        u.A = T; u.B = zzc + ((size_t)b * 512 + pn * 256) * 512 * 2;
        u.out = o + ((size_t)(NLAT + b * CTXL) * OW + 1536 + pn * 256) * 2; u.ldc = OW; u.flag = 0; u.aux = nullptr; u.aux2 = nullptr; return true;
    }
};
struct SchedBranch {
    int c, G, ntile; const char* o; const char* wbr; const char* p; char* merged;
    __device__ __forceinline__ bool next(int i, pg8::BUnit& u) const {
        const int xcd = c & 7, j = i * (G >> 3) + (c >> 3), pm = xcd + 8 * (j >> 3), pn2 = j & 7;
        if (pm * 8 >= ntile) return false;
        u.A = o + (size_t)pm * 256 * OW * 2; u.B = wbr + (size_t)pn2 * 128 * 2048 * 2;
        u.gate = p + ((size_t)pm * 256 * GW + pn2 * 128);
        u.out = merged + ((size_t)pm * 256 * 1024 + pn2 * 128) * 2; return true;
    }
};
struct SchedResid {
    int c, G, nM, K; const char* A; const char* B; char* xs; const char* modv; int goff; const char* xin; const char* cin;
    __device__ __forceinline__ bool next(int i, Unit& u) const {
        const int L = i * G + c; if (L >= nM * 4) return false;
        int pm, pn; pg8::tile_of(L, nM, 4, pm, pn);
        u.A = A + (size_t)pm * 256 * K * 2; u.B = B + (size_t)pn * 256 * K * 2; u.out = xs + ((size_t)pm * 256 * DM + pn * 256) * 2; u.ldc = DM;
        u.aux = modv + ((size_t)(pm < 64 ? (pm >> 3) : 8) * 6144 + goff + pn * 256) * 4; u.flag = xin ? 1 : 0;
        u.aux2 = xin ? (pm < 64 ? xin + ((size_t)pm * 256 * DM + pn * 256) * 4 : cin + ((size_t)(pm - 64) * 256 * DM + pn * 256) * 4) : (const char*)u.out; return true;
    }
};
struct SchedUp {
    int c, G, nM; const char* xn; const char* w; char* h;
    __device__ __forceinline__ bool next(int i, Unit& u) const {
        const int L = i * G + c; if (L >= nM * 22) return false;
        int pm, pn; pg8::tile_of(L, nM, 22, pm, pn);
        u.A = xn + (size_t)pm * 256 * DM * 2; u.B = w + (size_t)pn * 256 * DM * 2; u.out = h + ((size_t)pm * 256 * DFF + pn * 128) * 2; u.ldc = DFF; u.flag = 0; u.aux = nullptr; u.aux2 = nullptr; return true;
    }
};
struct SchedMoe {
    int c, G, NT, K, RT; MoeTiles mt; const char* A; const char* W; size_t wsub; char* out; int ldc, colw, esz;
    __device__ __forceinline__ bool next(int i, Unit& u) const {
        const int L0 = i * G + c, ntot = RT * NT; if (L0 >= ntot) return false;
        int L = L0; if (NT > 4) { const int q = ntot / 8, r = ntot % 8, xcd = L0 % 8, off = L0 / 8; L = (xcd < r ? xcd * (q + 1) : r * (q + 1) + (xcd - r) * q) + off; }
        const int gs = 8 * NT, g8 = L / gs, rem = L % gs, left = RT - 8 * g8, gsz = left < 8 ? left : 8;
        const int rt = 8 * g8 + rem % gsz, pn = rem / gsz;
        int e = 0;
#pragma unroll
        for (int k = 1; k < 8; ++k) e += (rt >= mt.tb[k]) ? 1 : 0;
        u.A = A + (size_t)rt * 256 * K * 2; u.B = W + (size_t)e * W_EXPERT + wsub + (size_t)pn * 256 * K * 2;
        u.out = out + ((size_t)rt * 256 * ldc + (size_t)pn * colw) * esz; u.ldc = ldc; u.flag = 0; u.aux = nullptr; u.aux2 = nullptr; return true;
    }
};

struct SchedMoeSplit {
    int c, G, RF, RT; MoeTiles mt; const char* A; const char* W; char* y0; char* y1;
    __device__ __forceinline__ bool next(int i, Unit& u) const {
        const int L = i * G + c; if (L >= (RT - RF) * 8) return false;
        const int ts = L >> 1, kh = L & 1, rt = RF + (ts >> 2), pn = ts & 3;
        int e = 0;
#pragma unroll
        for (int k = 1; k < 8; ++k) e += (rt >= mt.tb[k]) ? 1 : 0;
        u.A = A + ((size_t)rt * 256 * DFE + kh * (DFE / 2)); u.B = W + (size_t)e * W_EXPERT + W_MD + ((size_t)pn * 256 * DFE + kh * (DFE / 2));
        u.out = kh ? y1 + ((size_t)(rt - RF) * 256 * DM + pn * 256) * 2 : y0 + ((size_t)rt * 256 * DM + pn * 256) * 2;
        u.ldc = DM; u.flag = 0; u.aux = nullptr; u.aux2 = nullptr; return true;
    }
};

#define LAUNDER_S(x) asm volatile("" : "+s"(x))
#define LAUNDER_V(x) asm volatile("" : "+v"(x))
constexpr int LDS_ARGOFF = LDS_CTLOFF + 512;
__device__ __forceinline__ const float* ARGP(LAS unsigned char* lds, int i) {
    unsigned off = LDS_ARGOFF + 8 * i; asm volatile("" : "+s"(off));
    volatile LAS unsigned* p = (volatile LAS unsigned*)(lds + off);
    const unsigned lo = __builtin_amdgcn_readfirstlane(p[0]), hi = __builtin_amdgcn_readfirstlane(p[1]);
    return (const float*)(((unsigned long long)hi << 32) | lo);
}
__device__ __forceinline__ void grid_barrier(LAS unsigned char* lds, int wv) {
    XcdBarrier b; b.bar = (unsigned*)((unsigned char*)ARGP(lds, 24) + WS_CTL) + CW_BAR; b.x = xb_xcc_id(); b.st = (volatile LAS unsigned*)(lds + LDS_CTLOFF);
    xcd_barrier(b, wv == 0 && lane_id() == 0);
}
struct Fr { LAS unsigned char* lds; unsigned char* ws; int tid, lane, wave, bid, G, gw, NGW; unsigned* ctl; };
__device__ __forceinline__ Fr make_frame(LAS unsigned char* lds, int wv) {
    Fr F; F.lds = lds;
    F.ws = (unsigned char*)ARGP(lds, 24); int t = wv * 64 + lane_id(); LAUNDER_V(t); F.tid = t; F.lane = t & 63; F.wave = wv;
    int b = blockIdx.x; LAUNDER_S(b); F.bid = b; int g = gridDim.x; LAUNDER_S(g); F.G = g; F.gw = b * 8 + F.wave; F.NGW = g * 8; F.ctl = (unsigned*)(F.ws + WS_CTL);
    return F;
}

constexpr int CV_PRO = 4 * CV_LAYER + 2 * CV_DENSE;
constexpr int CV_M1 = CV_PRO, CV_M3 = CV_PRO + 8 * CV_EXP;
#ifndef BG_BRW
#define BG_BRW 4
#endif
#ifndef BG_DDW
#define BG_DDW 7
#endif
constexpr int BG_BR = 192 * 8 * BG_BRW, BG_OUT = 224 * 8 * 4, BG_DD = 224 * 8 * BG_DDW;
constexpr int CVQ_BLK = 32;
constexpr int MQ1_S = CV_M1 + BG_BR + BG_OUT + BG_DD + BG_BR, MQ1_E = CV_M3, MQ2_S = CV_M3 + BG_OUT + BG_BR + BG_OUT + BG_DD, MQ2_E = CV_TOTAL;
static_assert(MQ1_S <= MQ1_E && MQ2_S <= MQ2_E && (MQ1_E - MQ1_S) % (8 * CVQ_BLK) == 0 && (MQ2_E - MQ2_S) % (8 * CVQ_BLK) == 0, "queue conversion ranges are whole units per XCD queue");
__device__ __forceinline__ void convert_range(LAS unsigned char* lds, const Fr& F, int start, int end, int gwi, int nw) {
    Args a;
#pragma unroll
    for (int i = 0; i < 23; ++i) a.in[i] = ARGP(lds, i);
    a.out = nullptr; a.ws = F.ws;
    LAS float* scr = (LAS float*)(lds + F.wave * 8704);
    float ra[32], rb[32]; ConvDesc d, dn; int it = start + gwi; bool have = it < end;
    if (have) { d = conv_decode(a, it); conv_load(d, ra, F.lane); }
    while (have) {
        const int itn = it + nw; const bool hn = itn < end;
        if (hn) { dn = conv_decode(a, itn); conv_load(dn, rb, F.lane); }
        conv_store(d, ra, scr, F.lane);
        if (hn) {
#pragma unroll
            for (int i = 0; i < 32; ++i) ra[i] = rb[i];
            d = dn; }
        it = itn; have = hn;
    }
}
__device__ __forceinline__ void bg_window(int kind, int l, int& s, int& e) {
    s = 0; e = 0;
    const int m1a = CV_M1, m1b = m1a + BG_BR, m1c = m1b + BG_OUT, m1d = m1c + BG_DD, m1e = MQ1_S;
    const int m3a = CV_M3, m3b = m3a + BG_OUT, m3c = m3b + BG_BR, m3d = m3c + BG_OUT, m3e = MQ2_S;
    if (kind == 0) { if (l == 0) { s = m1a; e = m1b; } else if (l == 1) { s = m1d; e = m1e; } else if (l == 2) { s = m3b; e = m3c; } }
    else if (kind == 1) { if (l == 0) { s = m1b; e = m1c; } else if (l == 1) { s = m3a; e = m3b; } else if (l == 2) { s = m3c; e = m3d; } }
    else { if (l == 0) { s = m1c; e = m1d; } else if (l == 2) { s = m3d; e = m3e; } }
}
__device__ __forceinline__ void phase_prologue(LAS unsigned char* lds, int wv) {
    const Fr F = make_frame(lds, wv);
    Args a;
#pragma unroll
    for (int i = 0; i < 23; ++i) a.in[i] = ARGP(lds, i);
    a.out = nullptr; a.ws = F.ws;
    if (F.bid < 96) mod_item(a, F.bid, lds, F.tid);
    for (int it = F.gw; it < 2048; it += F.NGW) fzfold_item(a, it, F.lane);
    convert_range(lds, F, 0, CV_LAYER, F.gw, F.NGW);
    float* rope = (float*)(F.ws + WS_ROPE);
    for (int i = F.gw * 64 + F.lane; i < SEQ * 64; i += F.NGW * 64) { const int t = i >> 6, j = i & 63, ax = j >> 5, isin = (j >> 4) & 1, f = j & 15;
        const float pos = (float)(ax == 0 ? (t >> 6) : (t & 63));
        const float inv = powf(10000.0f, -(float)f / 16.0f); const float ang = pos * inv;
        rope[i] = isin ? sinf(ang) : cosf(ang); }
    bf16_t* T = (bf16_t*)(F.ws + WS_T);
    for (int i = F.gw * 64 + F.lane; i < 2048 * 2048; i += F.NGW * 64) { const int k = i >> 11, n = i & 2047; const float x = (float)((k * n) & 2047) * (1.0f / 1024.0f);
        T[(size_t)k * 4096 + n] = f2bf(cospif(x)); T[(size_t)k * 4096 + 2048 + n] = f2bf(-sinpif(x)); }
    bf16_t* T2 = (bf16_t*)(F.ws + WS_T256);
    for (int i = F.gw * 64 + F.lane; i < 256 * 256; i += F.NGW * 64) { const int k = i >> 8, n = i & 255; const float x = (float)((k * n) & 255) * (1.0f / 128.0f);
        T2[k * 512 + n] = f2bf(cospif(x)); T2[k * 512 + 256 + n] = f2bf(-sinpif(x)); }
}
__device__ __forceinline__ void phase_first_norm(LAS unsigned char* lds, int wv) {
    const Fr F = make_frame(lds, wv);
    const float* X = ARGP(lds, I_X); const float* CX = ARGP(lds, I_CTX); const float* n1g = ARGP(lds, I_N1G);
    float* xs = (float*)(F.ws + WS_XS); bf16_t* xn = (bf16_t*)(F.ws + WS_XN); const float* modv_all = (const float*)(F.ws + WS_MODV);
    for (int row = F.gw; row < NTOK; row += F.NGW) {
        const float* src = row < NLAT ? X + (size_t)row * DM : CX + (size_t)(row - NLAT) * DM;
        const RowV x = load_row_f32(src, F.lane);
        const float* mv = modv_all + (size_t)mod_row_of(row) * 6144;
        const RowV y = adaln_row(x, n1g, mv, mv + 1024, F.lane);
        store_row_bf16(xn + (size_t)row * DM, y, F.lane);
    }
}
__device__ __forceinline__ void phase_inproj(LAS unsigned char* lds, int wv, int l) {
    const Fr F = make_frame(lds, wv); unsigned char* ws = F.ws; const bool lastl = l == DEPTH - 1;
    SchedInproj S{F.bid, F.G, NTOK / 256, (NTOK / 256) * 28, lastl ? 256 : 288, (const char*)(ws + WS_XN), (const char*)w_layer(ws, l, W_IN), (const char*)w_layer(ws, l, W_FZ), (char*)(ws + WS_P), (char*)(ws + WS_ZZ), (char*)(ws + WS_ZZC), (const char*)(ws + WS_ROPE), (char*)(ws + WS_G)};
    pg8::EpiInproj E{};
    pg8::gemm_phase<pg8::EpiInproj, SchedInproj, true, true>(lds, F.tid, DM, DM, DM, S, E);
}
__device__ __forceinline__ void phase_post(LAS unsigned char* lds, int wv, int l) {
    const Fr F = make_frame(lds, wv);
    GAS bf16_t* P = (GAS bf16_t*)(F.ws + WS_P); const GAS float* rope = (const GAS float*)(F.ws + WS_ROPE);
    const GAS float* gq = (const GAS float*)ARGP(lds, I_QKG) + l * 128; const GAS float* gk = gq + 64;
    const int lane = F.lane, a = (lane & 7) >> 2, i0 = 4 * (lane & 3);
    float gqv[8], gkv[8];
#pragma unroll
    for (int e = 0; e < 8; ++e) { const int d = 32 * a + 16 * (e & 1) + i0 + (e >> 1); gqv[e] = gq[d]; gkv[e] = gk[d]; }
    for (int row = F.gw; row < NTOK; row += F.NGW) {
        GAS bf16_t* pr = P + (size_t)row * PW;
        const bool lat = row < NLAT;
        f32x4 cs = (f32x4){1.f, 1.f, 1.f, 1.f}, sn = (f32x4){0.f, 0.f, 0.f, 0.f};
        if (lat) { const GAS float* rt = rope + (size_t)(row & 2047) * 64 + a * 32 + i0; cs = *(const GAS f32x4*)rt; sn = *(const GAS f32x4*)(rt + 16); }
        const u32x4 qw = *(const GAS u32x4*)(pr + C_BQ + 8 * lane);
        u32x4 kw = (u32x4){0u, 0u, 0u, 0u};
        if (lane < 16) kw = *(const GAS u32x4*)(pr + C_BK + 8 * lane);
        float x[8], y[8];
        x[0] = bf_lo(qw.x); x[1] = bf_hi(qw.x); x[2] = bf_lo(qw.y); x[3] = bf_hi(qw.y); x[4] = bf_lo(qw.z); x[5] = bf_hi(qw.z); x[6] = bf_lo(qw.w); x[7] = bf_hi(qw.w);
        y[0] = bf_lo(kw.x); y[1] = bf_hi(kw.x); y[2] = bf_lo(kw.y); y[3] = bf_hi(kw.y); y[4] = bf_lo(kw.z); y[5] = bf_hi(kw.z); y[6] = bf_lo(kw.w); y[7] = bf_hi(kw.w);
        float sq = 0.f, sk = 0.f;
#pragma unroll
        for (int e = 0; e < 8; ++e) { sq += x[e] * x[e]; sk += y[e] * y[e]; }
        sq += __shfl_xor(sq, 1); sq += __shfl_xor(sq, 2); sq += __shfl_xor(sq, 4);
        sk += __shfl_xor(sk, 1); sk += __shfl_xor(sk, 2); sk += __shfl_xor(sk, 4);
        const float rq = 1.0f / sqrtf(sq * (1.0f / 64.0f) + 1e-6f), rk = 1.0f / sqrtf(sk * (1.0f / 64.0f) + 1e-6f);
#pragma unroll
        for (int e = 0; e < 8; ++e) { x[e] *= rq * gqv[e]; y[e] *= rk * gkv[e]; }
        float xo[8], yo[8];
#pragma unroll
        for (int p2 = 0; p2 < 4; ++p2) { const float c = cs[p2], s = sn[p2];
            xo[2 * p2] = (x[2 * p2] * c - x[2 * p2 + 1] * s) * C2; xo[2 * p2 + 1] = (x[2 * p2 + 1] * c + x[2 * p2] * s) * C2;
            yo[2 * p2] = y[2 * p2] * c - y[2 * p2 + 1] * s; yo[2 * p2 + 1] = y[2 * p2 + 1] * c + y[2 * p2] * s; }
        u32x4 ow; ow.x = cvt_pk_bf16(xo[0], xo[1]); ow.y = cvt_pk_bf16(xo[2], xo[3]); ow.z = cvt_pk_bf16(xo[4], xo[5]); ow.w = cvt_pk_bf16(xo[6], xo[7]);
        *(GAS u32x4*)(pr + C_BQ + 8 * lane) = ow;
        if (lane < 16) { u32x4 kk; kk.x = cvt_pk_bf16(yo[0], yo[1]); kk.y = cvt_pk_bf16(yo[2], yo[3]); kk.z = cvt_pk_bf16(yo[4], yo[5]); kk.w = cvt_pk_bf16(yo[6], yo[7]);
            *(GAS u32x4*)(pr + C_BK + 8 * lane) = kk; }
    }
}
constexpr int CVQ_UNITS = (CV_PRO - CV_LAYER) / (8 * CVQ_BLK);
static_assert(CVQ_UNITS * 8 * CVQ_BLK == CV_PRO - CV_LAYER, "conversion units tile the deferred block range");
__device__ __forceinline__ void phase_mix(LAS unsigned char* lds, int wv, int l, int rep) {
    const Fr F = make_frame(lds, wv); unsigned char* ws = F.ws; const bool lastl = l == DEPTH - 1;
    volatile LAS unsigned* LCTL = (volatile LAS unsigned*)(lds + LDS_CTLOFF);
    { SchedDft S{F.bid, (const char*)(ws + WS_T), (const char*)(ws + WS_ZZ), (char*)(ws + WS_O)}; pg8::EpiStore E{1.0f / 362.03867196751236f};
      pg8::gemm_phase<pg8::EpiStore, SchedDft, false, true>(lds, F.tid, 4096, 4096, 4096, S, E); }
    if (!lastl) { SchedDftCtx S{F.bid, (const char*)(ws + WS_T256), (const char*)(ws + WS_ZZC), (char*)(ws + WS_O)}; pg8::EpiStore E{1.0f / 128.0f};
      pg8::gemm_phase<pg8::EpiStore, SchedDftCtx, false, true>(lds, F.tid, 512, 512, 512, S, E); }
    float c08 = 0.8f; asm volatile("" : "+v"(c08));
    const float li = c08 - 0.6f * expf(-0.3f * (float)l);
    const float* lp = ARGP(lds, I_DLAM) + l * 256;
    float d01 = 0.f, d23 = 0.f;
    for (int k = 0; k < 64; ++k) { d01 += lp[k] * lp[64 + k]; d23 += lp[128 + k] * lp[192 + k]; }
    const float lam_u = __builtin_bit_cast(float, __builtin_amdgcn_readfirstlane(__builtin_bit_cast(int, expf(d01) - expf(d23) + li)));
    const float oml_u = __builtin_bit_cast(float, __builtin_amdgcn_readfirstlane(__builtin_bit_cast(int, 1.0f - li)));
    AttnCtx ac{(const bf16_t*)(ws + WS_P), (bf16_t*)(ws + WS_O), ARGP(lds, I_SUBLN) + l * 128, lam_u, oml_u, ARGP(lds, I_SINK) + l * 8};
    const int NUB = lastl ? 192 : 216;
    int NCV = 0, cvbase = 0;
    if (rep == 0) { if (l == 0) { NCV = CVQ_UNITS; cvbase = CV_LAYER; } else if (l == 1) { NCV = (MQ1_E - MQ1_S) / (8 * CVQ_BLK); cvbase = MQ1_S; } else if (l == 2) { NCV = (MQ2_E - MQ2_S) / (8 * CVQ_BLK); cvbase = MQ2_S; } }
    const int bq = F.bid & 7;
    unsigned* qc = F.ctl + CW_Q + 64 * (8 * (l + 4 * rep) + bq);
    for (;;) {
        __syncthreads();
        if (F.tid == 0) LCTL[2] = xb_add(qc, 1u);
        __syncthreads();
        const int u = __builtin_amdgcn_readfirstlane((int)LCTL[2]);
        if (u >= NUB + NCV) break;
        if (u >= NUB) { const int s = cvbase + ((u - NUB) * 8 + bq) * CVQ_BLK; convert_range(lds, F, s, s + CVQ_BLK, F.wave, 8); continue; }
        int tl = F.tid; LAUNDER_V(tl);
        if (u < 64) attn_unit<0>(lds, tl, ac, bq, u >> 4, u & 15, false);
        else if (u < 128) { const int v = u - 64; attn_unit<1>(lds, tl, ac, bq, v >> 5, v & 31, false); }
        else if (u < 192) { const int v = u - 128; attn_unit<2>(lds, tl, ac, bq, v >> 5, v & 31, false); }
        else if (u < 200) { const int v = u - 192; attn_unit<0>(lds, tl, ac, bq, v >> 1, v & 1, true); }
        else if (u < 208) { const int v = u - 200; attn_unit<1>(lds, tl, ac, bq, v >> 2, v & 3, true); }
        else { const int v = u - 208; attn_unit<2>(lds, tl, ac, bq, v >> 2, v & 3, true); }
    }
}
__device__ __forceinline__ void phase_branch(LAS unsigned char* lds, int wv, int l) {
    const Fr F = make_frame(lds, wv); unsigned char* ws = F.ws; const int nMact = (l == DEPTH - 1) ? NLAT / 256 : NTOK / 256;
    SchedBranch S{F.bid, F.G, nMact * 8, (const char*)(ws + WS_O), (const char*)w_layer(ws, l, W_BR), (const char*)(ws + WS_G), (char*)(ws + WS_XN)};
    pg8::branch_phase<SchedBranch>(lds, F.tid, S);
    if (nMact == NTOK / 256 && (F.bid >> 3) >= 8) {
        int s, e; bg_window(0, l, s, e);
        if (e > s) convert_range(lds, F, s, e, ((F.bid & 7) * 24 + (F.bid >> 3) - 8) * 8 + F.wave, 192 * 8);
    }
}
__device__ __forceinline__ void phase_out(LAS unsigned char* lds, int wv, int l) {
    const Fr F = make_frame(lds, wv); unsigned char* ws = F.ws; const int nMact = (l == DEPTH - 1) ? NLAT / 256 : NTOK / 256;
    SchedResid S{F.bid, F.G, nMact, DM, (const char*)(ws + WS_XN), (const char*)w_layer(ws, l, W_OUT), (char*)(ws + WS_XS), (const char*)(ws + WS_MODV + (size_t)l * 9 * 6144 * 4), 2048, l == 0 ? (const char*)ARGP(lds, I_X) : nullptr, l == 0 ? (const char*)ARGP(lds, I_CTX) : nullptr};
    pg8::EpiResid E{};
    pg8::gemm_phase<pg8::EpiResid, SchedResid, true, true>(lds, F.tid, DM, DM, DM, S, E);
    if (nMact == NTOK / 256 && F.bid >= 32) {
        int s, e; bg_window(1, l, s, e);
        if (e > s) convert_range(lds, F, s, e, (F.bid - 32) * 8 + F.wave, 224 * 8);
    }
}
__device__ __forceinline__ void phase_norm2_dense(LAS unsigned char* lds, int wv, int l) {
    const Fr F = make_frame(lds, wv); const int nrows = (l == DEPTH - 1) ? NLAT : NTOK;
    const bf16_t* xs = (const bf16_t*)(F.ws + WS_XS); bf16_t* xn = (bf16_t*)(F.ws + WS_XN); const float* modv = (const float*)(F.ws + WS_MODV) + (size_t)l * 9 * 6144;
    const float* n2g = ARGP(lds, I_N2G) + l * DM;
    const int rpw = nrows / F.NGW, r0 = F.gw * rpw, r1 = r0 + rpw;
    AdaCoef co; co.mr = -1;
    for (int r = r0; r < r1; r += 3) {
        RowV x[3];
#pragma unroll
        for (int q = 0; q < 3; ++q) x[q] = load_row_bf16(xs + (size_t)(r + q < r1 ? r + q : r) * DM, F.lane);
#pragma unroll
        for (int q = 0; q < 3; ++q) if (r + q < r1) { ada_coef_update(co, r + q, n2g, modv, 3072, 4096, F.lane); store_row_bf16(xn + (size_t)(r + q) * DM, adaln_apply(x[q], co), F.lane); }
    }
}
__device__ __forceinline__ void phase_up_dense(LAS unsigned char* lds, int wv, int l) {
    const Fr F = make_frame(lds, wv); unsigned char* ws = F.ws; const int nMact = (l == DEPTH - 1) ? NLAT / 256 : NTOK / 256;
    SchedUp S{F.bid, F.G, nMact, (const char*)(ws + WS_XN), (const char*)w_dense(ws, l >> 1, W_DGU), (char*)(ws + WS_P)};
    pg8::EpiSwiglu E{};
    pg8::gemm_phase<pg8::EpiSwiglu, SchedUp, true, true>(lds, F.tid, DM, DM, DM, S, E);
}
__device__ __forceinline__ void phase_down_dense(LAS unsigned char* lds, int wv, int l) {
    const Fr F = make_frame(lds, wv); unsigned char* ws = F.ws; const int nMact = (l == DEPTH - 1) ? NLAT / 256 : NTOK / 256;
    SchedResid S{F.bid, F.G, nMact, DFF, (const char*)(ws + WS_P), (const char*)w_dense(ws, l >> 1, W_DD), (char*)(ws + WS_XS), (const char*)(ws + WS_MODV + (size_t)l * 9 * 6144 * 4), 5120, nullptr, nullptr};
    pg8::EpiResid E{};
    pg8::gemm_phase<pg8::EpiResid, SchedResid, true, true>(lds, F.tid, DFF, DFF, DFF, S, E);
    if (nMact == NTOK / 256 && F.bid >= 32) {
        int s, e; bg_window(2, l, s, e);
        if (e > s) convert_range(lds, F, s, e, (F.bid - 32) * 8 + F.wave, 224 * 8);
    }
}
__device__ __forceinline__ void phase_norm2_moe(LAS unsigned char* lds, int wv, int l) {
    const Fr F = make_frame(lds, wv); const int nrows = (l == DEPTH - 1) ? NLAT : NTOK; const int mi = l >> 1;
    volatile LAS unsigned* LCTL = (volatile LAS unsigned*)(lds + LDS_CTLOFF);
    const bf16_t* xs = (const bf16_t*)(F.ws + WS_XS); bf16_t* xn = (bf16_t*)(F.ws + WS_XN); const float* modv = (const float*)(F.ws + WS_MODV) + (size_t)l * 9 * 6144;
    const float* n2g = ARGP(lds, I_N2G) + l * DM;
    int* toklist = (int*)(F.ws + WS_MOE); int* rec = toklist + 8 * NTOK;
    const int rpb = nrows / F.G;
    const int tid = F.tid, lane = F.lane;
    LAS int* lrec = (LAS int*)(lds + 1024);
    const float* rw = ARGP(lds, I_RW) + (size_t)mi * DM * 8;
    for (int rr = F.wave; rr < rpb; rr += 8) {
        const int row = F.bid * rpb + rr;
        const RowV x = load_row_bf16(xs + (size_t)row * DM, lane);
        const float* mv = modv + (size_t)mod_row_of(row) * 6144;
        const RowV y = adaln_row(x, n2g, mv + 3072, mv + 4096, lane);
        float lg[8];
#pragma unroll
        for (int e = 0; e < 8; ++e) lg[e] = 0.f;
#pragma unroll
        for (int j = 0; j < 4; ++j)
#pragma unroll
            for (int cc = 0; cc < 4; ++cc) { const float* wp = rw + (size_t)(256 * j + 4 * lane + cc) * 8; const f32x4 w0 = *(const f32x4*)wp, w1 = *(const f32x4*)(wp + 4); const float hv = y.v[j][cc];
                lg[0] += hv * w0[0]; lg[1] += hv * w0[1]; lg[2] += hv * w0[2]; lg[3] += hv * w0[3]; lg[4] += hv * w1[0]; lg[5] += hv * w1[1]; lg[6] += hv * w1[2]; lg[7] += hv * w1[3]; }
#pragma unroll
        for (int e = 0; e < 8; ++e) lg[e] = wave_sum(lg[e]);
        int i0 = 0; float v0 = lg[0];
#pragma unroll
        for (int e = 1; e < 8; ++e) if (lg[e] > v0) { v0 = lg[e]; i0 = e; }
        int i1 = -1; float v1 = -3.0e38f;
#pragma unroll
        for (int e = 0; e < 8; ++e) if (e != i0 && lg[e] > v1) { v1 = lg[e]; i1 = e; }
        if (lane == 0) {
            const float w0 = 1.0f / (1.0f + expf(v1 - v0)), w1 = 1.0f - w0;
            lrec[rr * 6 + 0] = i0; lrec[rr * 6 + 2] = __float_as_int(w0); lrec[rr * 6 + 3] = i1; lrec[rr * 6 + 5] = __float_as_int(w1);
        }
    }
    __syncthreads();
    { const int e = F.wave; int cnt = 0;
      for (int a0 = 0; a0 < 2 * rpb; a0 += 64) { const int a = a0 + lane; const bool valid = a < 2 * rpb; const int rr = a >> 1, k3 = 3 * (a & 1);
          const bool match = valid && lrec[rr * 6 + k3] == e;
          const unsigned long long bal = __ballot(match);
          if (match) lrec[rr * 6 + k3 + 1] = cnt + (int)__popcll(bal & ((1ull << lane) - 1ull));
          cnt += (int)__popcll(bal); }
      if (lane == 0) { toklist[F.bid * 8 + e] = cnt;
          (void)xb_add(F.ctl + CW_CNT + 64 * (8 * mi + e), (unsigned)cnt); } }
    __syncthreads();
    for (int rr = tid; rr < rpb; rr += 512) {
        const int row = F.bid * rpb + rr;
        int* rc = rec + (size_t)row * 8;
        rc[0] = lrec[rr * 6 + 0]; rc[1] = lrec[rr * 6 + 1]; rc[2] = lrec[rr * 6 + 2]; rc[3] = lrec[rr * 6 + 3]; rc[4] = lrec[rr * 6 + 4]; rc[5] = lrec[rr * 6 + 5];
    }
}
__device__ __forceinline__ void phase_moe_gather(LAS unsigned char* lds, int wv, int l) {
    const Fr F = make_frame(lds, wv); const int mi = l >> 1; const int nrows = (l == DEPTH - 1) ? NLAT : NTOK; const int rpb = nrows / F.G;
    volatile LAS unsigned* LCTL = (volatile LAS unsigned*)(lds + LDS_CTLOFF);
    const MoeTiles mt = moe_tiles(F.ctl, mi);
    const GAS bf16_t* xn = (const GAS bf16_t*)(F.ws + WS_XN); GAS bf16_t* hs = (GAS bf16_t*)(F.ws + WS_HY);
    const GAS int* blkcnt = (const GAS int*)(F.ws + WS_MOE); GAS int* rec = (GAS int*)(F.ws + WS_MOE) + 8 * NTOK;
    LAS int* red = (LAS int*)(lds + 1024);
    { const int e = F.tid & 7, ch = F.tid >> 3; int s = 0;
#pragma unroll
      for (int j = 0; j < 4; ++j) { const int bb = ch * 4 + j; if (bb < F.bid) s += blkcnt[bb * 8 + e]; }
      red[e * 64 + ch] = s; }
    __syncthreads();
    if (F.tid < 8) { int s = 0; for (int ch = 0; ch < 64; ++ch) s += red[F.tid * 64 + ch]; LCTL[16 + F.tid] = (unsigned)s; }
    __syncthreads();
    LAS int* sl = (LAS int*)(lds + 4096);
    for (int rr = F.tid; rr < rpb; rr += 512) {
        GAS int* rc = rec + (size_t)(F.bid * rpb + rr) * 8;
        const int e0 = rc[0], e1 = rc[3];
        const int p0 = rc[1] + (int)LCTL[16 + e0], p1 = rc[4] + (int)LCTL[16 + e1];
        int t0 = 0, t1 = 0;
#pragma unroll
        for (int k = 0; k < 8; ++k) { t0 = (e0 == k) ? mt.tb[k] : t0; t1 = (e1 == k) ? mt.tb[k] : t1; }
        sl[rr * 2] = t0 * 256 + p0; sl[rr * 2 + 1] = t1 * 256 + p1;
        rc[1] = p0; rc[4] = p1;
    }
    __syncthreads();
    const bf16_t* xs = (const bf16_t*)(F.ws + WS_XS); const float* modv = (const float*)(F.ws + WS_MODV) + (size_t)l * 9 * 6144; const float* n2g = ARGP(lds, I_N2G) + l * DM;
    AdaCoef co; co.mr = -1;
    for (int r0 = F.wave * (rpb >> 3); r0 < (F.wave + 1) * (rpb >> 3); r0 += 3) {
        RowV x[3]; int s[3][2];
#pragma unroll
        for (int q = 0; q < 3; ++q) { const int rr = r0 + q; const bool ok = rr < (F.wave + 1) * (rpb >> 3);
            x[q] = load_row_bf16(xs + (size_t)(F.bid * rpb + (ok ? rr : r0)) * DM, F.lane);
            s[q][0] = ok ? sl[rr * 2] : -1; s[q][1] = ok ? sl[rr * 2 + 1] : -1; }
#pragma unroll
        for (int q = 0; q < 3; ++q) if (s[q][0] >= 0) { const int row = F.bid * rpb + r0 + q;
            ada_coef_update(co, row, n2g, modv, 3072, 4096, F.lane);
            const RowV y = adaln_apply(x[q], co);
            store_row_fp8((unsigned char*)hs + (size_t)s[q][0] * DM, y, F.lane); store_row_fp8((unsigned char*)hs + (size_t)s[q][1] * DM, y, F.lane); }
    }
    for (int idx = F.gw; idx < 8 * 256; idx += F.NGW) { const int e = idx >> 8, j = idx & 255;
        const int cnt = __builtin_amdgcn_readfirstlane((int)__hip_atomic_load(F.ctl + CW_CNT + 64 * (8 * mi + e), __ATOMIC_RELAXED, __HIP_MEMORY_SCOPE_AGENT));
        const int pad = ((cnt + 255) & ~255) - cnt; int tbe = 0;
#pragma unroll
        for (int k = 0; k < 8; ++k) tbe = (e == k) ? mt.tb[k] : tbe;
        if (j < pad) { unsigned z = 0u; asm volatile("" : "+v"(z));
            GAS u32x4* dp = (GAS u32x4*)((GAS unsigned char*)hs + (size_t)(tbe * 256 + cnt + j) * DM) + F.lane; dp[0] = (u32x4){z, z, z, z}; } }
}
__device__ __forceinline__ void phase_up_moe(LAS unsigned char* lds, int wv, int l) {
    const Fr F = make_frame(lds, wv); unsigned char* ws = F.ws; const int mi = l >> 1;
    const MoeTiles mt = moe_tiles(F.ctl, mi);
    SchedMoe S{F.bid, F.G, 28, DM / 2, mt.tb[8], mt, (const char*)(ws + WS_HY), (const char*)w_moe(ws, mi, 0, 0), W_MGU, (char*)(ws + WS_P), DFE, 128, 1};
    pg8::EpiSwigluF8 E{};
    pg8::gemm_phase<pg8::EpiSwigluF8, SchedMoe, true, true, true>(lds, F.tid, DM / 2, DM / 2, DM / 2, S, E, 120);
}
__device__ __forceinline__ void phase_down_moe(LAS unsigned char* lds, int wv, int l) {
    const Fr F = make_frame(lds, wv); unsigned char* ws = F.ws; const int mi = l >> 1;
    const MoeTiles mt = moe_tiles(F.ctl, mi);
    const int RT = mt.tb[8], RF = RT < MOE_RF ? RT : MOE_RF;
    pg8::EpiStore E{1.0f};
    { SchedMoe S{F.bid, F.G, 4, DFE / 2, RF, mt, (const char*)(ws + WS_P), (const char*)w_moe(ws, mi, 0, 0), W_MD, (char*)(ws + WS_HY), DM, 256, 2};
      pg8::gemm_phase<pg8::EpiStore, SchedMoe, true, true, true>(lds, F.tid, DFE / 2, DFE / 2, DFE / 2, S, E, 119); }
    if (RT > RF) {
        SchedMoeSplit S2{F.bid, F.G, RF, RT, mt, (const char*)(ws + WS_P), (const char*)w_moe(ws, mi, 0, 0), (char*)(ws + WS_HY), (char*)(ws + WS_Y1)};
        pg8::gemm_phase<pg8::EpiStore, SchedMoeSplit, true, true, true>(lds, F.tid, DFE / 4, DFE / 2, DFE / 2, S2, E, 119);
    }
}
__device__ __forceinline__ void phase_next_norm(LAS unsigned char* lds, int wv, int l) {
    const Fr F = make_frame(lds, wv); const bool lastl = l == DEPTH - 1; const int nrows = lastl ? NLAT : NTOK; const int mi = l >> 1;
    const bool moe = (l & 1) != 0;
    MoeTiles mt; if (moe) mt = moe_tiles(F.ctl, mi); else {
#pragma unroll
        for (int k = 0; k < 9; ++k) mt.tb[k] = 0; }
    bf16_t* xs = (bf16_t*)(F.ws + WS_XS); bf16_t* xn = (bf16_t*)(F.ws + WS_XN);
    const bf16_t* yb = (const bf16_t*)(F.ws + WS_HY); const bf16_t* yb1 = (const bf16_t*)(F.ws + WS_Y1); const int* rec = (const int*)(F.ws + WS_MOE) + 8 * NTOK;
    const float* modv = (const float*)(F.ws + WS_MODV) + (size_t)l * 9 * 6144;
    const float* modn = modv + 9 * 6144;
    const float* n1g = ARGP(lds, I_N1G) + (lastl ? 0 : (l + 1) * DM); const float* fg = ARGP(lds, I_FINALG); float* outp = (float*)ARGP(lds, 23);
    const int lane = F.lane;
    for (int row = F.gw; row < nrows; row += F.NGW) {
        RowV x = load_row_bf16(xs + (size_t)row * DM, lane);
        if (moe) {
            const int* rc = rec + (size_t)row * 8;
            const int e0 = rc[0], p0 = rc[1], e1 = rc[3], p1 = rc[4]; const float w0 = __int_as_float(rc[2]), w1 = __int_as_float(rc[5]);
            int t0 = 0, t1 = 0;
#pragma unroll
            for (int k = 0; k < 8; ++k) { t0 = (e0 == k) ? mt.tb[k] : t0; t1 = (e1 == k) ? mt.tb[k] : t1; }
            RowV y0 = load_row_bf16(yb + (size_t)(t0 * 256 + p0) * DM, lane), y1 = load_row_bf16(yb + (size_t)(t1 * 256 + p1) * DM, lane);
            { const int rt0 = t0 + (p0 >> 8), rt1 = t1 + (p1 >> 8);
              if (rt0 >= MOE_RF) { const RowV z = load_row_bf16(yb1 + (size_t)((rt0 - MOE_RF) * 256 + (p0 & 255)) * DM, lane);
#pragma unroll
                  for (int j = 0; j < 4; ++j) y0.v[j] += z.v[j]; }
              if (rt1 >= MOE_RF) { const RowV z = load_row_bf16(yb1 + (size_t)((rt1 - MOE_RF) * 256 + (p1 & 255)) * DM, lane);
#pragma unroll
                  for (int j = 0; j < 4; ++j) y1.v[j] += z.v[j]; } }
            const RowV g2 = load_row_f32(modv + (size_t)mod_row_of(row) * 6144 + 5120, lane);
#pragma unroll
            for (int j = 0; j < 4; ++j) x.v[j] += g2.v[j] * (w0 * y0.v[j] + w1 * y1.v[j]);
            if (!lastl) store_row_bf16(xs + (size_t)row * DM, x, lane);
        }
        if (!lastl) {
            const float* mv = modn + (size_t)mod_row_of(row) * 6144;
            const RowV y = adaln_row(x, n1g, mv, mv + 1024, lane);
            store_row_bf16(xn + (size_t)row * DM, y, lane);
        } else {
            float ss = 0.f;
#pragma unroll
            for (int j = 0; j < 4; ++j) ss += (x.v[j][0] * x.v[j][0] + x.v[j][1] * x.v[j][1]) + (x.v[j][2] * x.v[j][2] + x.v[j][3] * x.v[j][3]);
            const float rstd = 1.0f / sqrtf(wave_sum(ss) * (1.0f / DM) + 1e-6f);
            const RowV gv = load_row_f32(fg, lane);
            RowV y;
#pragma unroll
            for (int j = 0; j < 4; ++j) y.v[j] = x.v[j] * rstd * gv.v[j];
            store_row_f32(outp + (size_t)row * DM, y, lane);
        }
    }
}

__global__ void __launch_bounds__(512, 2) mega_fwd(Args a) {
    extern __shared__ __attribute__((aligned(16))) unsigned char lds_raw[];
    LAS unsigned char* lds = (LAS unsigned char*)lds_raw;
    volatile LAS unsigned* LCTL = (volatile LAS unsigned*)(lds + LDS_CTLOFF);
    const int wv = __builtin_amdgcn_readfirstlane((int)(threadIdx.x >> 6));
    {
        const int tid = threadIdx.x;
        for (int u = tid; u < 64; u += 512) LCTL[u] = 0u;
        if (tid == 0) { LAS unsigned long long* ap = (LAS unsigned long long*)(lds + LDS_ARGOFF);
#pragma unroll
            for (int i = 0; i < 23; ++i) ap[i] = (unsigned long long)a.in[i];
            ap[23] = (unsigned long long)a.out; ap[24] = (unsigned long long)a.ws; }
        __syncthreads();
    }
    (void)xcd_barrier_post((unsigned*)(a.ws + WS_CTL) + CW_BAR, LCTL);
    phase_prologue(lds, wv);
    grid_barrier(lds, wv);
#if DUP_PRO
    phase_prologue(lds, wv);
    grid_barrier(lds, wv);
#endif
    phase_first_norm(lds, wv);
    grid_barrier(lds, wv);
    for (int l = 0; l < DEPTH; ++l) {
        phase_inproj(lds, wv, l);  grid_barrier(lds, wv);
#if DUP_INPROJ
        phase_inproj(lds, wv, l);  grid_barrier(lds, wv);
#endif
        phase_post(lds, wv, l);    grid_barrier(lds, wv);
        phase_mix(lds, wv, l, 0);  grid_barrier(lds, wv);
#if DUP_MIX
        phase_mix(lds, wv, l, 1);  grid_barrier(lds, wv);
#endif
        phase_branch(lds, wv, l);  grid_barrier(lds, wv);
#if DUP_BRANCH
        phase_branch(lds, wv, l);  grid_barrier(lds, wv);
#endif
        phase_out(lds, wv, l);     grid_barrier(lds, wv);
        if ((l & 1) == 0) {
            phase_norm2_dense(lds, wv, l); grid_barrier(lds, wv);
#if DUP_N2D
            phase_norm2_dense(lds, wv, l); grid_barrier(lds, wv);
#endif
            phase_up_dense(lds, wv, l);    grid_barrier(lds, wv);
#if DUP_UPD
            phase_up_dense(lds, wv, l);    grid_barrier(lds, wv);
#endif
            phase_down_dense(lds, wv, l);  grid_barrier(lds, wv);
        } else {
            phase_norm2_moe(lds, wv, l);   grid_barrier(lds, wv);
            phase_moe_gather(lds, wv, l);  grid_barrier(lds, wv);
#if DUP_GATH
            phase_moe_gather(lds, wv, l);  grid_barrier(lds, wv);
#endif
            phase_up_moe(lds, wv, l);      grid_barrier(lds, wv);
#if DUP_MOEG == 1
            phase_up_moe(lds, wv, l);      grid_barrier(lds, wv);
#endif
            phase_down_moe(lds, wv, l);    grid_barrier(lds, wv);
#if DUP_MOEG == 2
            phase_down_moe(lds, wv, l);    grid_barrier(lds, wv);
#endif
        }
        phase_next_norm(lds, wv, l);
        if (l != DEPTH - 1) grid_barrier(lds, wv);
    }
}

extern "C" void kernel_launch(void* const* d_in, const int* in_sizes, int n_in, void* d_out, int out_size, void* d_ws, size_t ws_size, hipStream_t stream) {
    static int grid = 0;
    if (grid == 0) {
        if (n_in != 23 || out_size != NLAT * DM || ws_size < WS_END) { fprintf(stderr, "kernel_launch: unexpected problem (n_in %d out %d ws %zu need %zu)\n", n_in, out_size, ws_size, (size_t)WS_END); grid = -1; return; }
        int dev = 0, cus = 0, per_cu = 0;
        if (hipGetDevice(&dev) != hipSuccess || hipDeviceGetAttribute(&cus, hipDeviceAttributeMultiprocessorCount, dev) != hipSuccess) { grid = -1; return; }
        if (hipFuncSetAttribute((const void*)mega_fwd, hipFuncAttributeMaxDynamicSharedMemorySize, LDS_BYTES) != hipSuccess) { fprintf(stderr, "kernel_launch: hipFuncSetAttribute failed\n"); grid = -1; return; }
        if (hipOccupancyMaxActiveBlocksPerMultiprocessor(&per_cu, (const void*)mega_fwd, 512, LDS_BYTES) != hipSuccess || per_cu < 1) { fprintf(stderr, "kernel_launch: occupancy query says %d\n", per_cu); }
        (void)hipGetLastError();
        grid = cus;
        if (grid != 256) fprintf(stderr, "kernel_launch: %d CUs (built for 256)\n", grid);
    }
    if (grid < 0) return;
    (void)hipMemsetAsync((char*)d_ws + WS_CTL, 0, CTL_ZERO_BYTES, stream);
    Args a{};
    for (int i = 0; i < 23; ++i) a.in[i] = (const float*)d_in[i];
    a.out = (float*)d_out; a.ws = (unsigned char*)d_ws;
    hipLaunchKernelGGL(mega_fwd, dim3(grid), dim3(512), LDS_BYTES, stream, a);
}
```

```cpp
#include <hip/hip_runtime.h>
#include <cstdio>
#include <cstdint>

#ifndef DUP_MIX
#define DUP_MIX 0
#endif
#ifndef DUP_PRO
#define DUP_PRO 0
#endif
#ifndef DUP_BRANCH
#define DUP_BRANCH 0
#endif
#ifndef DUP_MOEG
#define DUP_MOEG 0
#endif
#ifndef DUP_UPD
#define DUP_UPD 0
#endif
#ifndef DUP_N2D
#define DUP_N2D 0
#endif
#ifndef DUP_GATH
#define DUP_GATH 0
#endif
#ifndef DUP_INPROJ
#define DUP_INPROJ 0
#endif
#ifndef DENSE_F8_MASK
#define DENSE_F8_MASK 0
#endif
#define LAS __attribute__((address_space(3)))
#define GAS __attribute__((address_space(1)))
typedef unsigned short bf16_t;
typedef short bf16x8 __attribute__((ext_vector_type(8)));
typedef short s16x4 __attribute__((ext_vector_type(4)));
typedef float f32x4 __attribute__((ext_vector_type(4)));
typedef float f32x16 __attribute__((ext_vector_type(16)));
typedef unsigned u32x4 __attribute__((ext_vector_type(4)));
typedef unsigned u32x2 __attribute__((ext_vector_type(2)));
typedef int i32x4 __attribute__((ext_vector_type(4)));
typedef int i32x8 __attribute__((ext_vector_type(8)));

constexpr int NB = 8, SEQ = 2048, DM = 1024, DEPTH = 4, CTXL = 256;
constexpr int NLAT = NB * SEQ, NCTX = NB * CTXL, NTOK = NLAT + NCTX;
constexpr int DIN = 7680, PW = 3072, GW = 4096;
constexpr int C_AQ = 0, C_AK = 512, C_AV = 1024, C_BQ = 1536, C_BK = 2048, C_BV = 2176, C_CQ = 2304, C_CK = 2816, C_CV = 2944;
constexpr int DFF = 2816, DFE = 3584, NEXP = 8;
constexpr int OW = 2048;
constexpr int MAXSLOT = 2 * NTOK + 2048;
constexpr float C2 = 0.125f * 1.4426950408889634f;
constexpr float LOG2E = 1.4426950408889634f;

constexpr size_t MiB = 1u << 20;
constexpr size_t WS_CTL = 0, CTL_ZERO_BYTES = 1 * MiB;
constexpr size_t WS_MODV = 1 * MiB;
constexpr size_t WS_ROPE = 2 * MiB;
constexpr size_t WS_T256 = 3 * MiB;
constexpr size_t WS_MOE = 4 * MiB;
constexpr size_t WS_T = 6 * MiB;
constexpr size_t WS_W = 22 * MiB;
constexpr size_t W_IN = 0, W_ING8 = 6 * MiB  , W_FZ = 14 * MiB, W_BR = 16 * MiB, W_OUT = 20 * MiB, W_LAYER = 22 * MiB;
constexpr size_t W_DENSE0 = 4 * W_LAYER, W_DGU = 0, W_DD = 11 * MiB, W_DENSE = 33 * MiB / 2;
constexpr size_t W_MOE0 = W_DENSE0 + 2 * W_DENSE, W_MGU = 0, W_MD = 14 * MiB, W_EXPERT = 21 * MiB, W_MOE = 8 * W_EXPERT;
constexpr size_t WS_XS = WS_W + W_MOE0 + 2 * W_MOE;
constexpr size_t WS_XN8 = WS_XS + 36 * MiB;
constexpr size_t WS_XN = WS_XS + 72 * MiB;
constexpr size_t WS_P = WS_XN + 36 * MiB;
constexpr size_t WS_G = WS_P + 108 * MiB;
constexpr size_t WS_ZZ = WS_P + 252 * MiB;
constexpr size_t WS_ZZC = WS_ZZ + 32 * MiB;
constexpr size_t WS_O = WS_ZZC + 4 * MiB;
constexpr size_t WS_HY = WS_O + 72 * MiB;
constexpr size_t WS_Y1 = WS_HY + 76 * MiB;
constexpr size_t WS_END = WS_Y1 + 16 * MiB;
constexpr int MOE_RF = 128;
static_assert(WS_W + W_MOE0 + 2 * W_MOE == 479 * MiB, "weights");
static_assert((size_t)MAXSLOT * DFE * 2 <= 288 * MiB, "moe hidden fits p+zz");
static_assert((size_t)MAXSLOT * 1024 * 2 <= 76 * MiB, "hs fits");
static_assert(WS_END <= 1074 * MiB, "workspace");

constexpr int CW_BAR = 4096;
constexpr int CW_Q = 16384;
constexpr int CW_CNT = 24576;

constexpr int LDS_CTLOFF = 141312;
constexpr int LDS_BYTES = 147456;

typedef float f32x2_t __attribute__((ext_vector_type(2))); typedef __bf16 bf16x2_t __attribute__((ext_vector_type(2)));
__device__ __forceinline__ unsigned cvt_pk_bf16(float lo, float hi) { f32x2_t v = {lo, hi}; bf16x2_t b = __builtin_convertvector(v, bf16x2_t); return __builtin_bit_cast(unsigned, b); }
__device__ __forceinline__ float clamp_f8(float v) { return __builtin_amdgcn_fmed3f(v, -448.0f, 448.0f); }
__device__ __forceinline__ unsigned cvt4_fp8(float a, float b, float c, float d) { int w = 0; w = __builtin_amdgcn_cvt_pk_fp8_f32(clamp_f8(a), clamp_f8(b), w, false); w = __builtin_amdgcn_cvt_pk_fp8_f32(clamp_f8(c), clamp_f8(d), w, true); return (unsigned)w; }
__device__ __forceinline__ float bf_lo(unsigned w) { return __uint_as_float(w << 16); }
__device__ __forceinline__ float bf_hi(unsigned w) { return __uint_as_float(w & 0xffff0000u); }
__device__ __forceinline__ float bf2f(bf16_t h) { return __uint_as_float(((unsigned)h) << 16); }
__device__ __forceinline__ bf16_t f2bf(float f) { unsigned u = __float_as_uint(f); u += 0x7fffu + ((u >> 16) & 1u); return (bf16_t)(u >> 16); }
__device__ __forceinline__ float fast_exp2(float x) { return __builtin_amdgcn_exp2f(x); }
__device__ __forceinline__ float fast_rcp(float x) { return __builtin_amdgcn_rcpf(x); }
__device__ __forceinline__ float sigmoidf_(float x) { return fast_rcp(1.0f + fast_exp2(-x * LOG2E)); }
__device__ __forceinline__ float siluf_(float x) { return x * sigmoidf_(x); }
__device__ __forceinline__ float wave_sum(float v) {
#pragma unroll
    for (int o = 1; o < 64; o <<= 1) v += __shfl_xor(v, o);
    return v;
}
#define LDS_WAIT() asm volatile("s_waitcnt lgkmcnt(0)" ::: "memory")
__device__ __forceinline__ int lane_id() { int l; asm volatile("v_mbcnt_lo_u32_b32 %0, -1, 0\n\tv_mbcnt_hi_u32_b32 %0, -1, %0" : "=v"(l)); return l; }

namespace pg8 {
constexpr int BM = 256, BK = 64, HALF = 128, HTB = HALF * BK * 2, STAGE_BYTES = 8 * HTB, NXCD = 8, WGM = 8;
__host__ __device__ __forceinline__ int lds_byte(int r, int c) { const int st = (r >> 4) * 2 + (c >> 5), rr = r & 15, cc = c & 31, ob = rr * 64 + cc * 2; return st * 1024 + (ob ^ (((ob >> 9) & 1) << 5)); }
__host__ __device__ __forceinline__ void stage_rc(int b, int& R, int& C) { const int st = b / 1024, sb = b % 1024, swz = sb ^ (((sb >> 9) & 1) << 5); R = (st >> 1) * 16 + swz / 64; C = (st & 1) * 32 + (swz % 64) / 2; }
__host__ __device__ __forceinline__ int perm32(int rho) { const int n = rho >> 4, i = rho & 15; return 8 * (i >> 2) + 4 * n + (i & 3); }

struct Unit { const char* A; const char* B; char* out; const char* aux; const char* aux2; int ldc; int flag; };

__device__ __forceinline__ void tile_of(int L, int nM, int nN, int& pm, int& pn) {
    const int nwg = nM * nN; int wgid = L;
    { const int q = nwg / NXCD, r = nwg % NXCD, xcd = wgid % NXCD, off = wgid / NXCD; wgid = (xcd < r ? xcd * (q + 1) : r * (q + 1) + (xcd - r) * q) + off; }
    const int nig = WGM * nN, gid = wgid / nig, fm = gid * WGM, gsz = (nM - fm) < WGM ? (nM - fm) : WGM;
    pm = fm + ((wgid % nig) % gsz); pn = (wgid % nig) / gsz;
}

__device__ __forceinline__ i32x8 cat8(const bf16x8 a, const bf16x8 b) { return __builtin_shufflevector(__builtin_bit_cast(i32x4, a), __builtin_bit_cast(i32x4, b), 0, 1, 2, 3, 4, 5, 6, 7); }
template <class Epi, class Sched, bool ALIGN_EPI, bool SP2, bool FP8 = false>
__device__ __forceinline__ void gemm_phase(LAS unsigned char* lds, const int tid, const int K, const int lda, const int ldb, const Sched& S, const Epi& E, const int wsc = 127) {
    const int wid = __builtin_amdgcn_readfirstlane(tid >> 6), lane = tid & 63, wr = wid >> 2, wc = wid & 3, fr = lane & 15, fq = lane >> 4;
    const int nt = K / BK;
    unsigned voffA[2], voffB[2];
#pragma unroll
    for (int i = 0; i < 2; ++i) { int R, C; stage_rc(tid * 16 + i * 8192, R, C); const int Rb = Epi::PERM ? ((R & ~31) + perm32(R & 31)) : R;
        voffA[i] = (unsigned)(R * lda + C) * 2u; voffB[i] = (unsigned)(Rb * ldb + C) * 2u; }
    const size_t kstep = (size_t)(BK * 2);
    const size_t hstepA = (size_t)HALF * lda * 2, hstepB = (size_t)HALF * ldb * 2;
    const unsigned ldsw = (unsigned)wid * 1024u;
    const int aoff = lds_byte(wr * 64 + fr, fq * 8), boff = lds_byte(wc * 32 + fr, fq * 8);
#define PG8_SA(b, h) (((b) * 2 + (h)) * HTB)
#define PG8_SB(b, h) ((4 + (b) * 2 + (h)) * HTB)
#define PG8_STAGE(bufoff, gbase, voff) do { _Pragma("unroll") for (int _i = 0; _i < 2; ++_i) \
        __builtin_amdgcn_global_load_lds((const unsigned*)((const char*)(gbase) + (voff)[_i]), (LAS unsigned*)(lds + (bufoff) + ldsw + _i * 8192), 16, 0, 0); } while (0)
#define PG8_LDA(dst, b, h) do { _Pragma("unroll") for (int m = 0; m < 4; ++m) _Pragma("unroll") for (int k = 0; k < 2; ++k) dst[m][k] = *(const LAS bf16x8*)(lds + PG8_SA(b, h) + aoff + m * 2048 + k * 1024); } while (0)
#define PG8_LDB(dst, b, h) do { _Pragma("unroll") for (int n = 0; n < 2; ++n) _Pragma("unroll") for (int k = 0; k < 2; ++k) dst[n][k] = *(const LAS bf16x8*)(lds + PG8_SB(b, h) + boff + n * 2048 + k * 1024); } while (0)
#define PG8_MMA(ai, bj, At, Bt) do { __builtin_amdgcn_s_setprio(1); _Pragma("unroll") for (int m = 0; m < 4; ++m) _Pragma("unroll") for (int n = 0; n < 2; ++n) { \
        if constexpr (FP8) { acc[ai][bj][m][n] = __builtin_amdgcn_mfma_scale_f32_16x16x128_f8f6f4(cat8(Bt[n][0], Bt[n][1]), cat8(At[m][0], At[m][1]), acc[ai][bj][m][n], 0, 0, 0, wsc, 0, 127); \
            asm volatile("" : "+v"(acc[ai][bj][m][n]));   } \
        else { _Pragma("unroll") for (int k = 0; k < 2; ++k) acc[ai][bj][m][n] = __builtin_amdgcn_mfma_f32_16x16x32_bf16(Bt[n][k], At[m][k], acc[ai][bj][m][n], 0, 0, 0); } } __builtin_amdgcn_s_setprio(0); } while (0)
#define PG8_WAIT_V(n) asm volatile("s_waitcnt vmcnt(" #n ")" ::: "memory")
#define PG8_WAIT_L(n) asm volatile("s_waitcnt lgkmcnt(" #n ")" ::: "memory")
#define PG8_BAR __builtin_amdgcn_s_barrier()
#define PG8_SCHED __builtin_amdgcn_sched_barrier(0)
    Unit cur, nxt; int ui = 0;
    if (!S.next(0, cur)) return;
    f32x4 acc[2][2][4][2];
#pragma unroll
    for (int a = 0; a < 2; ++a)
#pragma unroll
        for (int b = 0; b < 2; ++b)
#pragma unroll
            for (int m = 0; m < 4; ++m)
#pragma unroll
                for (int n = 0; n < 2; ++n) acc[a][b][m][n] = (f32x4){0.f, 0.f, 0.f, 0.f};
    bf16x8 At[4][2], B0[2][2], B1[2][2];
    const char* cA = cur.A; const char* cB = cur.B;
    if constexpr (SP2) {
        PG8_STAGE(PG8_SB(0, 0), cB, voffB); PG8_STAGE(PG8_SB(0, 1), cB + hstepB, voffB); PG8_STAGE(PG8_SA(0, 0), cA, voffA); PG8_STAGE(PG8_SA(0, 1), cA + hstepA, voffA);
        if (wr == 1) PG8_BAR;
        PG8_WAIT_V(2); PG8_BAR;
        PG8_STAGE(PG8_SB(1, 0), cB + kstep, voffB); PG8_STAGE(PG8_SA(1, 0), cA + kstep, voffA); PG8_STAGE(PG8_SB(1, 1), cB + hstepB + kstep, voffB);
        PG8_WAIT_V(6); PG8_BAR;
    } else {
        PG8_STAGE(PG8_SB(0, 0), cB, voffB); PG8_STAGE(PG8_SA(0, 0), cA, voffA); PG8_STAGE(PG8_SB(0, 1), cB + hstepB, voffB); PG8_STAGE(PG8_SA(0, 1), cA + hstepA, voffA);
        if (wr == 1) PG8_BAR;
        PG8_WAIT_V(4); PG8_BAR;
        PG8_STAGE(PG8_SB(1, 0), cB + kstep, voffB); PG8_STAGE(PG8_SA(1, 0), cA + kstep, voffA); PG8_STAGE(PG8_SB(1, 1), cB + hstepB + kstep, voffB);
        PG8_WAIT_V(6); PG8_BAR;
    }
    for (;;) {
        const bool has_next = S.next(ui + 1, nxt);
        const char* nA = has_next ? nxt.A : cA; const char* nB = has_next ? nxt.B : cB;
        for (int t = 0; t < nt; t += 2) {
            const bool last = (t == nt - 2);
            const char* a1 = cA + (size_t)(t + 1) * kstep;
            const char* a2 = last ? nA : cA + (size_t)(t + 2) * kstep; const char* b2 = last ? nB : cB + (size_t)(t + 2) * kstep;
            const char* a3 = a2 + kstep; const char* b3 = b2 + kstep;
            if constexpr (SP2) {
            PG8_LDB(B0, 0, 0); PG8_LDB(B1, 0, 1); PG8_SCHED; PG8_LDA(At, 0, 0); PG8_STAGE(PG8_SA(1, 1), a1 + hstepA, voffA);
            PG8_WAIT_V(8); PG8_WAIT_L(0); PG8_BAR; PG8_MMA(0, 0, At, B0); PG8_MMA(0, 1, At, B1); PG8_BAR; PG8_SCHED;
            PG8_LDA(At, 0, 1); PG8_STAGE(PG8_SB(0, 0), b2, voffB); PG8_STAGE(PG8_SB(0, 1), b2 + hstepB, voffB); PG8_STAGE(PG8_SA(0, 0), a2, voffA);
            PG8_WAIT_V(8); PG8_WAIT_L(0); PG8_BAR; PG8_MMA(1, 0, At, B0); PG8_MMA(1, 1, At, B1); PG8_BAR; PG8_SCHED;
            PG8_LDB(B0, 1, 0); PG8_LDB(B1, 1, 1); PG8_SCHED; PG8_LDA(At, 1, 0); PG8_STAGE(PG8_SA(0, 1), a2 + hstepA, voffA);
            PG8_WAIT_V(8); PG8_WAIT_L(0); PG8_BAR; PG8_MMA(0, 0, At, B0); PG8_MMA(0, 1, At, B1); PG8_BAR; PG8_SCHED;
            PG8_LDA(At, 1, 1); PG8_STAGE(PG8_SB(1, 0), b3, voffB); PG8_STAGE(PG8_SB(1, 1), b3 + hstepB, voffB); PG8_STAGE(PG8_SA(1, 0), a3, voffA);
            PG8_WAIT_V(8); PG8_WAIT_L(0); PG8_BAR; PG8_MMA(1, 0, At, B0); PG8_MMA(1, 1, At, B1); PG8_BAR; PG8_SCHED;
            } else {
            PG8_LDB(B0, 0, 0); PG8_SCHED; PG8_LDA(At, 0, 0); PG8_STAGE(PG8_SA(1, 1), a1 + hstepA, voffA);
            PG8_WAIT_L(8); PG8_BAR; PG8_WAIT_L(0); PG8_MMA(0, 0, At, B0); PG8_BAR; PG8_SCHED;
            PG8_LDB(B1, 0, 1); PG8_STAGE(PG8_SB(0, 0), b2, voffB);
            PG8_BAR; PG8_WAIT_L(0); PG8_MMA(0, 1, At, B1); PG8_BAR;
            PG8_LDA(At, 0, 1); PG8_STAGE(PG8_SA(0, 0), a2, voffA);
            PG8_BAR; PG8_WAIT_L(0); PG8_MMA(1, 0, At, B0); PG8_BAR; PG8_SCHED;
            PG8_STAGE(PG8_SB(0, 1), b2 + hstepB, voffB);
            PG8_WAIT_V(6); PG8_BAR; PG8_MMA(1, 1, At, B1); PG8_BAR;
            PG8_LDB(B0, 1, 0); PG8_SCHED; PG8_LDA(At, 1, 0); PG8_STAGE(PG8_SA(0, 1), a2 + hstepA, voffA);
            PG8_WAIT_L(8); PG8_BAR; PG8_WAIT_L(0); PG8_MMA(0, 0, At, B0); PG8_BAR; PG8_SCHED;
            PG8_LDB(B1, 1, 1); PG8_STAGE(PG8_SB(1, 0), b3, voffB);
            PG8_BAR; PG8_WAIT_L(0); PG8_MMA(0, 1, At, B1); PG8_BAR;
            PG8_LDA(At, 1, 1); PG8_STAGE(PG8_SA(1, 0), a3, voffA);
            PG8_BAR; PG8_WAIT_L(0); PG8_MMA(1, 0, At, B0); PG8_BAR; PG8_SCHED;
            PG8_STAGE(PG8_SB(1, 1), b3 + hstepB, voffB);
            PG8_WAIT_V(6); PG8_BAR; PG8_MMA(1, 1, At, B1); PG8_BAR;
            }
        }
        if constexpr (ALIGN_EPI) { if (wr == 0) PG8_BAR; }
        E(acc, cur, wr, wc, fr, fq);
        if (!has_next) break;
#pragma unroll
        for (int a = 0; a < 2; ++a)
#pragma unroll
            for (int b = 0; b < 2; ++b)
#pragma unroll
                for (int m = 0; m < 4; ++m)
#pragma unroll
                    for (int n = 0; n < 2; ++n) acc[a][b][m][n] = (f32x4){0.f, 0.f, 0.f, 0.f};
        cur = nxt; cA = nA; cB = nB; ++ui;
        if constexpr (ALIGN_EPI) { if (wr == 1) PG8_BAR; }
    }
    PG8_WAIT_V(0);
    if constexpr (!ALIGN_EPI) { if (wr == 0) PG8_BAR; }
    PG8_BAR;
#undef PG8_SA
#undef PG8_SB
#undef PG8_STAGE
#undef PG8_LDA
#undef PG8_LDB
#undef PG8_MMA
#undef PG8_WAIT_V
#undef PG8_WAIT_L
#undef PG8_BAR
#undef PG8_SCHED
}

struct EpiStore {
    static constexpr bool PERM = true;
    float scale;
    __device__ __forceinline__ void operator()(const f32x4 (&acc)[2][2][4][2], const Unit& u, int wr, int wc, int fr, int fq) const {
        bf16_t* base = (bf16_t*)u.out + (size_t)(wr * 64 + fr) * u.ldc + wc * 32 + 8 * fq;
        const bool sg = u.flag == 1;
#pragma unroll
        for (int ai = 0; ai < 2; ++ai)
#pragma unroll
            for (int m = 0; m < 4; ++m) { bf16_t* rowp = base + (size_t)(ai * HALF + m * 16) * u.ldc;
#pragma unroll
                for (int bj = 0; bj < 2; ++bj) { f32x4 v0 = acc[ai][bj][m][0] * scale, v1 = acc[ai][bj][m][1] * scale;
                    if (sg) {
#pragma unroll
                        for (int j = 0; j < 4; ++j) { v0[j] = sigmoidf_(v0[j]); v1[j] = sigmoidf_(v1[j]); } }
                    u32x4 w; w.x = cvt_pk_bf16(v0[0], v0[1]); w.y = cvt_pk_bf16(v0[2], v0[3]); w.z = cvt_pk_bf16(v1[0], v1[1]); w.w = cvt_pk_bf16(v1[2], v1[3]);
                    *(u32x4*)(rowp + bj * HALF) = w; } }
    }
};
struct EpiInproj {
    static constexpr bool PERM = true;
    __device__ __forceinline__ void operator()(const f32x4 (&acc)[2][2][4][2], const Unit& u, int wr, int wc, int fr, int fq) const {
        GAS bf16_t* base = (GAS bf16_t*)u.out + (size_t)(wr * 64 + fr) * u.ldc + wc * 32 + 8 * fq;
        const bool lat = (u.flag & 16) != 0, r0 = lat && (u.flag & 6) != 0, r1 = lat && (u.flag & 2) != 0;
        const float qs = (u.flag & 8) ? C2 : 1.0f;
        const GAS float* rp = (const GAS float*)u.aux + (size_t)(wr * 64 + fr) * 64 + (wc & 1) * 32 + 4 * fq;
#pragma unroll
        for (int ai = 0; ai < 2; ++ai)
#pragma unroll
            for (int m = 0; m < 4; ++m) { GAS bf16_t* rowp = base + (size_t)(ai * HALF + m * 16) * u.ldc;
                f32x4 cs = (f32x4){1.f, 1.f, 1.f, 1.f}, sn = (f32x4){0.f, 0.f, 0.f, 0.f};
                if (r0) { const GAS float* rt = rp + (size_t)(ai * HALF + m * 16) * 64; cs = *(const GAS f32x4*)rt; sn = *(const GAS f32x4*)(rt + 16); }
#pragma unroll
                for (int bj = 0; bj < 2; ++bj) { f32x4 v0 = acc[ai][bj][m][0], v1 = acc[ai][bj][m][1];
                    if (bj == 0 ? r0 : r1) {
                        const float a0 = v0[0] * cs[0] - v0[1] * sn[0], a1 = v0[1] * cs[0] + v0[0] * sn[0], a2 = v0[2] * cs[1] - v0[3] * sn[1], a3 = v0[3] * cs[1] + v0[2] * sn[1];
                        const float b0 = v1[0] * cs[2] - v1[1] * sn[2], b1 = v1[1] * cs[2] + v1[0] * sn[2], b2 = v1[2] * cs[3] - v1[3] * sn[3], b3 = v1[3] * cs[3] + v1[2] * sn[3];
                        v0 = (f32x4){a0, a1, a2, a3}; v1 = (f32x4){b0, b1, b2, b3}; }
                    v0 *= qs; v1 *= qs;
                    u32x4 w; w.x = cvt_pk_bf16(v0[0], v0[1]); w.y = cvt_pk_bf16(v0[2], v0[3]); w.z = cvt_pk_bf16(v1[0], v1[1]); w.w = cvt_pk_bf16(v1[2], v1[3]);
                    *(GAS u32x4*)(rowp + bj * HALF) = w; } }
    }
};
struct EpiGate {
    static constexpr bool PERM = true;
    __device__ __forceinline__ void operator()(const f32x4 (&acc)[2][2][4][2], const Unit& u, int wr, int wc, int fr, int fq) const {
        GAS unsigned char* base = (GAS unsigned char*)u.out + (size_t)(wr * 64 + fr) * GW + wc * 32 + 8 * fq;
#pragma unroll
        for (int ai = 0; ai < 2; ++ai)
#pragma unroll
            for (int m = 0; m < 4; ++m) { GAS unsigned char* rowp = base + (size_t)(ai * HALF + m * 16) * GW;
#pragma unroll
                for (int bj = 0; bj < 2; ++bj) { const f32x4 v0 = acc[ai][bj][m][0], v1 = acc[ai][bj][m][1];
                    unsigned q[8];
#pragma unroll
                    for (int j = 0; j < 4; ++j) { q[j] = (unsigned)(fast_rcp(1.0f + fast_exp2(v0[j])) * 255.0f + 0.5f); q[4 + j] = (unsigned)(fast_rcp(1.0f + fast_exp2(v1[j])) * 255.0f + 0.5f); }
                    u32x2 w8; w8.x = q[0] | (q[1] << 8) | (q[2] << 16) | (q[3] << 24); w8.y = q[4] | (q[5] << 8) | (q[6] << 16) | (q[7] << 24);
                    *(GAS u32x2*)(rowp + bj * HALF) = w8; } }
    }
};
struct EpiSwiglu {
    static constexpr bool PERM = true;
    __device__ __forceinline__ void operator()(const f32x4 (&acc)[2][2][4][2], const Unit& u, int wr, int wc, int fr, int fq) const {
        bf16_t* base = (bf16_t*)u.out + (size_t)(wr * 64 + fr) * u.ldc + wc * 32 + 8 * fq;
#pragma unroll
        for (int ai = 0; ai < 2; ++ai)
#pragma unroll
            for (int m = 0; m < 4; ++m) { bf16_t* rowp = base + (size_t)(ai * HALF + m * 16) * u.ldc;
                f32x4 g0 = acc[ai][0][m][0], g1 = acc[ai][0][m][1]; const f32x4 u0 = acc[ai][1][m][0], u1 = acc[ai][1][m][1];
#pragma unroll
                for (int j = 0; j < 4; ++j) { g0[j] = siluf_(g0[j]) * u0[j]; g1[j] = siluf_(g1[j]) * u1[j]; }
                u32x4 w; w.x = cvt_pk_bf16(g0[0], g0[1]); w.y = cvt_pk_bf16(g0[2], g0[3]); w.z = cvt_pk_bf16(g1[0], g1[1]); w.w = cvt_pk_bf16(g1[2], g1[3]);
                *(u32x4*)rowp = w; }
    }
};
struct EpiSwigluF8 {
    static constexpr bool PERM = true;
    __device__ __forceinline__ void operator()(const f32x4 (&acc)[2][2][4][2], const Unit& u, int wr, int wc, int fr, int fq) const {
        GAS unsigned char* base = (GAS unsigned char*)u.out + (size_t)(wr * 64 + fr) * u.ldc + wc * 32 + 8 * fq;
#pragma unroll
        for (int ai = 0; ai < 2; ++ai)
#pragma unroll
            for (int m = 0; m < 4; ++m) { GAS unsigned char* rowp = base + (size_t)(ai * HALF + m * 16) * u.ldc;
                f32x4 g0 = acc[ai][0][m][0], g1 = acc[ai][0][m][1]; const f32x4 u0 = acc[ai][1][m][0], u1 = acc[ai][1][m][1];
#pragma unroll
                for (int j = 0; j < 4; ++j) { g0[j] = siluf_(g0[j]) * u0[j]; g1[j] = siluf_(g1[j]) * u1[j]; }
                u32x2 w; w.x = cvt4_fp8(g0[0], g0[1], g0[2], g0[3]); w.y = cvt4_fp8(g1[0], g1[1], g1[2], g1[3]);
                *(GAS u32x2*)rowp = w; }
    }
};
struct EpiResid {
    static constexpr bool PERM = true;
    __device__ __forceinline__ void operator()(const f32x4 (&acc)[2][2][4][2], const Unit& u, int wr, int wc, int fr, int fq) const {
        GAS bf16_t* base = (GAS bf16_t*)u.out + (size_t)(wr * 64 + fr) * u.ldc + wc * 32 + 8 * fq;
        const size_t roff = (size_t)(wr * 64 + fr) * u.ldc + wc * 32 + 8 * fq;
        const bool srcf = u.flag == 1;
        const GAS float* g = (const GAS float*)u.aux + wc * 32 + 8 * fq;
        f32x4 gv[2][2];
#pragma unroll
        for (int bj = 0; bj < 2; ++bj)
#pragma unroll
            for (int n = 0; n < 2; ++n) gv[bj][n] = *(const GAS f32x4*)(g + bj * HALF + n * 4);
#pragma unroll
        for (int ai = 0; ai < 2; ++ai)
#pragma unroll
            for (int m = 0; m < 4; ++m) { const size_t ro = (size_t)(ai * HALF + m * 16) * u.ldc;
#pragma unroll
                for (int bj = 0; bj < 2; ++bj) {
                    f32x4 r0, r1;
                    if (srcf) { const GAS float* sp = (const GAS float*)u.aux2 + roff + ro + bj * HALF; r0 = *(const GAS f32x4*)sp; r1 = *(const GAS f32x4*)(sp + 4); }
                    else { const u32x4 w = *(const GAS u32x4*)((const GAS bf16_t*)u.aux2 + roff + ro + bj * HALF);
                        r0 = (f32x4){bf_lo(w.x), bf_hi(w.x), bf_lo(w.y), bf_hi(w.y)}; r1 = (f32x4){bf_lo(w.z), bf_hi(w.z), bf_lo(w.w), bf_hi(w.w)}; }
                    const f32x4 v0 = r0 + gv[bj][0] * acc[ai][bj][m][0], v1 = r1 + gv[bj][1] * acc[ai][bj][m][1];
                    u32x4 o; o.x = cvt_pk_bf16(v0[0], v0[1]); o.y = cvt_pk_bf16(v0[2], v0[3]); o.z = cvt_pk_bf16(v1[0], v1[1]); o.w = cvt_pk_bf16(v1[2], v1[3]);
                    *(GAS u32x4*)(base + ro + bj * HALF) = o; }
                asm volatile("" ::: "memory"); }
    }
};
struct BUnit { const char* A; const char* B; const char* gate; char* out; };
__device__ __forceinline__ void gload8_async(u32x2& dst, const void* p) { asm volatile("global_load_dwordx2 %0, %1, off" : "=&v"(dst) : "v"(p) : "memory"); }
template <class Sched>
__device__ __forceinline__ void branch_phase(LAS unsigned char* lds, const int tid, const Sched& S) {
    const int wid = __builtin_amdgcn_readfirstlane(tid >> 6), lane = tid & 63, wr = wid >> 2, wc = wid & 3, fr = lane & 15, fq = lane >> 4;
    constexpr int K = 2048, nt = K / BK, lda = 2048, ldb = 2048;
    unsigned voffA[2], voffB[2];
#pragma unroll
    for (int i = 0; i < 2; ++i) { int R, C; stage_rc(tid * 16 + i * 8192, R, C); const int Rb = (R & ~31) + perm32(R & 31);
        voffA[i] = (unsigned)(R * lda + C) * 2u; voffB[i] = (unsigned)(Rb * ldb + C) * 2u; }
    const size_t kstep = (size_t)(BK * 2);
    const size_t hstepA = (size_t)HALF * lda * 2;
    const unsigned ldsw = (unsigned)wid * 1024u;
    const int aoff = lds_byte(wr * 64 + fr, fq * 8), boff = lds_byte(wc * 32 + fr, fq * 8);
#define BR_SA(b, h) (((b) * 2 + (h)) * HTB)
#define BR_SB(b) ((4 + (b) * 2) * HTB)
#define BR_STAGE(bufoff, gbase, voff) do { _Pragma("unroll") for (int _i = 0; _i < 2; ++_i) \
        __builtin_amdgcn_global_load_lds((const unsigned*)((const char*)(gbase) + (voff)[_i]), (LAS unsigned*)(lds + (bufoff) + ldsw + _i * 8192), 16, 0, 0); } while (0)
#define BR_LDA(dst, b, h) do { _Pragma("unroll") for (int m = 0; m < 4; ++m) _Pragma("unroll") for (int k = 0; k < 2; ++k) dst[m][k] = *(const LAS bf16x8*)(lds + BR_SA(b, h) + aoff + m * 2048 + k * 1024); } while (0)
#define BR_LDB(dst, b) do { _Pragma("unroll") for (int n = 0; n < 2; ++n) _Pragma("unroll") for (int k = 0; k < 2; ++k) dst[n][k] = *(const LAS bf16x8*)(lds + BR_SB(b) + boff + n * 2048 + k * 1024); } while (0)
#define BR_MMA(ai) do { __builtin_amdgcn_s_setprio(1); _Pragma("unroll") for (int m = 0; m < 4; ++m) _Pragma("unroll") for (int n = 0; n < 2; ++n) _Pragma("unroll") for (int k = 0; k < 2; ++k) \
        acc[ai][m][n] = __builtin_amdgcn_mfma_f32_16x16x32_bf16(B0[n][k], At[m][k], acc[ai][m][n], 0, 0, 0); __builtin_amdgcn_s_setprio(0); } while (0)
#define BR_WAIT_V(n) asm volatile("s_waitcnt vmcnt(" #n ")" ::: "memory")
#define BR_WAIT_L0 asm volatile("s_waitcnt lgkmcnt(0)" ::: "memory")
#define BR_BAR __builtin_amdgcn_s_barrier()
#define BR_SCHED __builtin_amdgcn_sched_barrier(0)
    BUnit cur, nxt; int ui = 0;
    if (!S.next(0, cur)) return;
    f32x4 acc[2][4][2], macc[2][4][2];
#pragma unroll
    for (int a = 0; a < 2; ++a)
#pragma unroll
        for (int m = 0; m < 4; ++m)
#pragma unroll
            for (int n = 0; n < 2; ++n) { acc[a][m][n] = (f32x4){0.f, 0.f, 0.f, 0.f}; macc[a][m][n] = (f32x4){0.f, 0.f, 0.f, 0.f}; }
    bf16x8 At[4][2], B0[2][2];
    const char* cA = cur.A; const char* cB = cur.B;
    BR_STAGE(BR_SB(0), cB, voffB); BR_STAGE(BR_SA(0, 0), cA, voffA); BR_STAGE(BR_SA(0, 1), cA + hstepA, voffA);
    if (wr == 1) BR_BAR;
    BR_WAIT_V(2); BR_BAR;
    BR_STAGE(BR_SB(1), cB + kstep, voffB); BR_STAGE(BR_SA(1, 0), cA + kstep, voffA);
    BR_WAIT_V(4); BR_BAR;
    const size_t rowoff = (size_t)(wr * 64 + fr), coloff = (size_t)(wc * 32 + 8 * fq);
    for (;;) {
        const bool has_next = S.next(ui + 1, nxt);
        const char* nA = has_next ? nxt.A : cA; const char* nB = has_next ? nxt.B : cB;
        const char* gbase = cur.gate + (rowoff * GW + coloff);
        u32x2 g[8];
        for (int t = 0; t < nt; t += 2) {
            const bool last = (t == nt - 2);
            const bool hook = (t & 6) == 6;
            const char* a1 = cA + (size_t)(t + 1) * kstep;
            const char* a2 = last ? nA : cA + (size_t)(t + 2) * kstep; const char* b2 = last ? nB : cB + (size_t)(t + 2) * kstep;
            const char* a3 = a2 + kstep; const char* b3 = b2 + kstep;
            if (hook) {
                const char* gp = gbase + (size_t)(t >> 3) * 1024;
#pragma unroll
                for (int q = 0; q < 8; ++q) gload8_async(g[q], gp + (size_t)((q >> 2) * HALF + (q & 3) * 16) * GW);
            }
            BR_LDB(B0, 0); BR_SCHED; BR_LDA(At, 0, 0); BR_STAGE(BR_SA(1, 1), a1 + hstepA, voffA);
            if (hook) BR_WAIT_V(14); else BR_WAIT_V(6);
            BR_WAIT_L0; BR_BAR; BR_MMA(0); BR_BAR; BR_SCHED;
            BR_LDA(At, 0, 1); BR_STAGE(BR_SB(0), b2, voffB); BR_STAGE(BR_SA(0, 0), a2, voffA);
            if (hook) BR_WAIT_V(14); else BR_WAIT_V(6);
            BR_WAIT_L0; BR_BAR; BR_MMA(1); BR_BAR; BR_SCHED;
            BR_LDB(B0, 1); BR_SCHED; BR_LDA(At, 1, 0); BR_STAGE(BR_SA(0, 1), a2 + hstepA, voffA);
            BR_WAIT_V(6); BR_WAIT_L0; BR_BAR; BR_MMA(0); BR_BAR; BR_SCHED;
            BR_LDA(At, 1, 1); BR_STAGE(BR_SB(1), b3, voffB); BR_STAGE(BR_SA(1, 0), a3, voffA);
            BR_WAIT_V(6); BR_WAIT_L0; BR_BAR; BR_MMA(1); BR_BAR; BR_SCHED;
            if (hook) {
                asm volatile("s_waitcnt vmcnt(10)" : "+v"(g[0]), "+v"(g[1]), "+v"(g[2]), "+v"(g[3]), "+v"(g[4]), "+v"(g[5]), "+v"(g[6]), "+v"(g[7]) :: "memory");
#pragma unroll
                for (int ai = 0; ai < 2; ++ai)
#pragma unroll
                    for (int m = 0; m < 4; ++m) { const u32x2 gw = g[ai * 4 + m];
                        const f32x4 g0 = (f32x4){(float)(gw.x & 255u), (float)((gw.x >> 8) & 255u), (float)((gw.x >> 16) & 255u), (float)(gw.x >> 24)};
                        const f32x4 g1 = (f32x4){(float)(gw.y & 255u), (float)((gw.y >> 8) & 255u), (float)((gw.y >> 16) & 255u), (float)(gw.y >> 24)};
                        macc[ai][m][0] += acc[ai][m][0] * g0; macc[ai][m][1] += acc[ai][m][1] * g1;
                        acc[ai][m][0] = (f32x4){0.f, 0.f, 0.f, 0.f}; acc[ai][m][1] = (f32x4){0.f, 0.f, 0.f, 0.f}; }
            }
        }
        {
            GAS bf16_t* op = (GAS bf16_t*)cur.out + rowoff * 1024 + coloff;
#pragma unroll
            for (int ai = 0; ai < 2; ++ai)
#pragma unroll
                for (int m = 0; m < 4; ++m) { const f32x4 v0 = macc[ai][m][0] * (1.0f / 255.0f), v1 = macc[ai][m][1] * (1.0f / 255.0f);
                    u32x4 w; w.x = cvt_pk_bf16(v0[0], v0[1]); w.y = cvt_pk_bf16(v0[2], v0[3]); w.z = cvt_pk_bf16(v1[0], v1[1]); w.w = cvt_pk_bf16(v1[2], v1[3]);
                    *(GAS u32x4*)(op + (size_t)(ai * HALF + m * 16) * 1024) = w;
                    macc[ai][m][0] = (f32x4){0.f, 0.f, 0.f, 0.f}; macc[ai][m][1] = (f32x4){0.f, 0.f, 0.f, 0.f}; }
        }
        if (!has_next) break;
        cur = nxt; cA = nA; cB = nB; ++ui;
    }
    BR_WAIT_V(0);
    if (wr == 0) BR_BAR;
    BR_BAR;
#undef BR_SA
#undef BR_SB
#undef BR_STAGE
#undef BR_LDA
#undef BR_LDB
#undef BR_MMA
#undef BR_WAIT_V
#undef BR_WAIT_L0
#undef BR_BAR
#undef BR_SCHED
}
}

#define XB_TMO      128
#define XB_XCNT(j)  (256  + 64 * (j))
#define XB_XSUB(j)  (1280 + 64 * (j))
#define XB_XGEN(j)  (2304 + 64 * (j))
#define XB_TOP      3328
#define XB_TOPGEN   3392
#define XCD_BAR_WORDS 3456
#define XB_SPIN_CAP (1u << 20)

__device__ __forceinline__ unsigned xb_ld(unsigned* p)              { return __hip_atomic_load(p, __ATOMIC_RELAXED, __HIP_MEMORY_SCOPE_AGENT); }
__device__ __forceinline__ unsigned xb_add(unsigned* p, unsigned v) { return __hip_atomic_fetch_add(p, v, __ATOMIC_RELAXED, __HIP_MEMORY_SCOPE_AGENT); }
__device__ __forceinline__ unsigned xb_xcc_id() { return (unsigned)__builtin_amdgcn_s_getreg((3 << 11) | 20) & 0xFu; }
#define XB_SPIN(cond, bar) do { unsigned _sp = 0; while (cond) { __builtin_amdgcn_s_sleep(1); \
    if ((++_sp & 255u) == 0u) { if (xb_ld(&(bar)[XB_TMO])) break; if (_sp > XB_SPIN_CAP) { atomicAdd(&(bar)[XB_TMO], 1u); break; } } } } while (0)

struct XcdBarrier { unsigned* bar; unsigned x; volatile LAS unsigned* st; };

__device__ __forceinline__ XcdBarrier xcd_barrier_post(unsigned* bar, volatile LAS unsigned* st) {
    XcdBarrier b; b.bar = bar; b.x = xb_xcc_id(); b.st = st;
    if (threadIdx.x == 0) (void)xb_add(&bar[XB_XCNT(b.x)], 1u);
    return b;
}
__device__ __forceinline__ void xcd_barrier_complete(unsigned* bar, unsigned x, unsigned& nloc, unsigned& nx) {
    const unsigned G = gridDim.x * gridDim.y * gridDim.z;
    unsigned sum, cnt, mine, sp = 0u;
    for (;;) {
        sum = 0u; cnt = 0u; mine = 0u;
#pragma unroll
        for (unsigned j = 0; j < 16; ++j) { const unsigned c = xb_ld(&bar[XB_XCNT(j)]); sum += c; cnt += (c > 0u) ? 1u : 0u; mine = (j == x) ? c : mine; }
        if (sum == G) break;
        __builtin_amdgcn_s_sleep(1);
        if ((++sp & 255u) == 0u) { if (xb_ld(&bar[XB_TMO])) break; if (sp > XB_SPIN_CAP) { atomicAdd(&bar[XB_TMO], 1u); break; } }
    }
    nloc = mine > 0u ? mine : 1u; nx = cnt > 0u ? cnt : 1u;
}
__device__ __forceinline__ void xcd_barrier(const XcdBarrier& b, const bool leader) {
    asm volatile("s_waitcnt vmcnt(0)" ::: "memory");
    __syncthreads();
    unsigned* bar = b.bar; asm volatile("" : "+v"(bar));
    if (leader) {
        __builtin_amdgcn_s_waitcnt(0);
        unsigned nloc = b.st[0], nx = b.st[1];
        if (nloc == 0u) { xcd_barrier_complete(bar, b.x, nloc, nx); b.st[0] = nloc; b.st[1] = nx; }
        const unsigned old = xb_add(&bar[XB_XSUB(b.x)], 1u);
        const unsigned gen = old / nloc;
        if (old + 1u == (gen + 1u) * nloc) {
            __builtin_amdgcn_fence(__ATOMIC_RELEASE, "agent");
            asm volatile("s_waitcnt vmcnt(0)" ::: "memory");
            const unsigned og = xb_add(&bar[XB_TOP], 1u);
            const unsigned tg = og / nx;
            if (og + 1u == (tg + 1u) * nx) xb_add(&bar[XB_TOPGEN], 1u);
            else XB_SPIN(xb_ld(&bar[XB_TOPGEN]) == tg, bar);
            __builtin_amdgcn_fence(__ATOMIC_ACQUIRE, "agent");
            xb_add(&bar[XB_XGEN(b.x)], 1u);
            asm volatile("s_waitcnt vmcnt(0)" ::: "memory");
        } else {
            XB_SPIN(xb_ld(&bar[XB_XGEN(b.x)]) == gen, bar);
            __builtin_amdgcn_fence(__ATOMIC_ACQUIRE, "agent");
            asm volatile("s_waitcnt vmcnt(0)" ::: "memory");
        }
    }
    __syncthreads();
}

struct Args { const float* in[23]; float* out; unsigned char* ws; };
enum { I_X = 0, I_C, I_CTX, I_CCTX, I_WMOD, I_BMOD, I_N1G, I_N2G, I_WIN, I_DLAM, I_SUBLN, I_QKG, I_SINK, I_WBR, I_WOUT, I_FG, I_FU, I_FD, I_RW, I_MG, I_MU, I_MD, I_FINALG };

__device__ __forceinline__ bf16_t* w_layer(unsigned char* ws, int l, size_t off) { return (bf16_t*)(ws + WS_W + (size_t)l * W_LAYER + off); }
__device__ __forceinline__ bf16_t* w_dense(unsigned char* ws, int i, size_t off) { return (bf16_t*)(ws + WS_W + W_DENSE0 + (size_t)i * W_DENSE + off); }
__device__ __forceinline__ bf16_t* w_moe(unsigned char* ws, int i, int e, size_t off) { return (bf16_t*)(ws + WS_W + W_MOE0 + (size_t)i * W_MOE + (size_t)e * W_EXPERT + off); }

constexpr int CV_LAYER = 1536 + 2048 + 1024 + 512;
constexpr int CV_DENSE = 3 * 1408;
constexpr int CV_EXP = 3 * 1792;
constexpr int CV_TOTAL = 4 * CV_LAYER + 2 * CV_DENSE + 16 * CV_EXP;
struct ConvDesc { const float* src; bf16_t* dst; int ldsrc, lddst, perm; float f8s; };
__device__ __forceinline__ ConvDesc conv_decode(const Args& a, int it) {
    unsigned char* ws = a.ws;
    const float* src; int ldsrc, K, c0, ncols, mode = 0, drow0 = 0, blk, ldd = 0; bf16_t* dst; bool win = false; float f8s = 0.f;
    if (it < 4 * CV_LAYER) { const int l = it / CV_LAYER, r = it % CV_LAYER;
        if (r < 1536) { blk = r; src = a.in[I_WIN] + (size_t)l * DM * DIN; ldsrc = DIN; K = DM; c0 = 0; ncols = 3072; dst = w_layer(ws, l, W_IN); drow0 = 0; win = true; }
        else if (r < 3584) { blk = r - 1536; src = a.in[I_WIN] + (size_t)l * DM * DIN; ldsrc = DIN; K = DM; c0 = 3584; ncols = 4096; dst = w_layer(ws, l, W_ING8); f8s = -128.0f * LOG2E; }
        else if (r < 4608) { const int q = r - 3584, rr = q / 256; blk = q % 256; src = a.in[I_WBR] + (size_t)(l * 4 + rr) * 512 * DM; ldsrc = DM; K = 512; c0 = 0; ncols = DM; dst = w_layer(ws, l, W_BR) + (size_t)rr * 512; ldd = 2048; }
        else { blk = r - 4608; src = a.in[I_WOUT] + (size_t)l * DM * DM; ldsrc = DM; K = DM; c0 = 0; ncols = DM; dst = w_layer(ws, l, W_OUT); }
    } else if (it < 4 * CV_LAYER + 2 * CV_DENSE) { const int q = it - 4 * CV_LAYER, i = q / CV_DENSE, r = q % CV_DENSE, which = r / 1408; blk = r % 1408;
        if (which < 2) { src = a.in[which == 0 ? I_FG : I_FU] + (size_t)i * DM * DFF; ldsrc = DFF; K = DM; c0 = 0; ncols = DFF; dst = w_dense(ws, i, W_DGU); mode = 1 + which; f8s = ((DENSE_F8_MASK >> i) & 1) ? 128.0f : 0.f; }
        else { src = a.in[I_FD] + (size_t)i * DFF * DM; ldsrc = DM; K = DFF; c0 = 0; ncols = DM; dst = w_dense(ws, i, W_DD); f8s = ((DENSE_F8_MASK >> i) & 1) ? 256.0f : 0.f; }
    } else { const int q = it - 4 * CV_LAYER - 2 * CV_DENSE, ie = q / CV_EXP, r = q % CV_EXP, which = r / 1792, i = ie >> 3, e = ie & 7; blk = r % 1792;
        if (which < 2) { src = a.in[which == 0 ? I_MG : I_MU] + (size_t)ie * DM * DFE; ldsrc = DFE; K = DM; c0 = 0; ncols = DFE; dst = w_moe(ws, i, e, W_MGU); mode = 1 + which; f8s = 128.0f; }
        else { src = a.in[I_MD] + (size_t)ie * DFE * DM; ldsrc = DM; K = DFE; c0 = 0; ncols = DM; dst = w_moe(ws, i, e, W_MD); f8s = 256.0f; }
    }
    const int nbn = ncols / 32, kb = blk / nbn, nb = blk % nbn, n = 32 * nb;
    const int drow = mode == 0 ? drow0 + n : 256 * (n >> 7) + (n & 127) + (mode == 2 ? 128 : 0);
    const bool perm = win && (n < 1024 || (n >= 1536 && n < 2176) || (n >= 2304 && n < 2944));
    ConvDesc d; d.src = src + (size_t)(64 * kb) * ldsrc + c0 + n; if (ldd == 0) ldd = K;
    d.dst = f8s != 0.f ? (bf16_t*)((unsigned char*)dst + (size_t)drow * ldd + 64 * kb) : dst + (size_t)drow * ldd + 64 * kb; d.ldsrc = ldsrc; d.lddst = ldd; d.perm = perm ? 1 : 0; d.f8s = f8s;
    return d;
}
__device__ __forceinline__ void conv_load(const ConvDesc& d, float (&r)[32], int lane) {
    const GAS float* s = (const GAS float*)d.src + (size_t)(lane >> 5) * d.ldsrc + (lane & 31);
#pragma unroll
    for (int i = 0; i < 32; ++i) r[i] = __builtin_nontemporal_load(s + (size_t)(2 * i) * d.ldsrc);
}
__device__ __forceinline__ void conv_store(const ConvDesc& d, const float (&r)[32], LAS float* scr, int lane) {
#pragma unroll
    for (int i = 0; i < 32; ++i) scr[(2 * i + (lane >> 5)) * 33 + (lane & 31)] = r[i];
    LDS_WAIT(); asm volatile("" ::: "memory");
    const int c = lane & 7;
    if (d.f8s != 0.f) { const float fs = d.f8s;
#pragma unroll
        for (int j = 0; j < 4; ++j) { const int n = (lane >> 3) + 8 * j; const LAS float* s = scr + (8 * c) * 33 + n;
            u32x2 o; o.x = cvt4_fp8(s[0 * 33] * fs, s[1 * 33] * fs, s[2 * 33] * fs, s[3 * 33] * fs); o.y = cvt4_fp8(s[4 * 33] * fs, s[5 * 33] * fs, s[6 * 33] * fs, s[7 * 33] * fs);
            __builtin_nontemporal_store(o, (GAS u32x2*)((GAS unsigned char*)d.dst + (size_t)n * d.lddst + 8 * c)); }
    } else {
#pragma unroll
    for (int j = 0; j < 4; ++j) { const int n = (lane >> 3) + 8 * j; const LAS float* s = scr + (8 * c) * 33 + n;
        u32x4 o; o.x = cvt_pk_bf16(s[0 * 33], s[1 * 33]); o.y = cvt_pk_bf16(s[2 * 33], s[3 * 33]); o.z = cvt_pk_bf16(s[4 * 33], s[5 * 33]); o.w = cvt_pk_bf16(s[6 * 33], s[7 * 33]);
        const int dn = d.perm ? 2 * (n & 15) + (n >> 4) : n;
        __builtin_nontemporal_store(o, (GAS u32x4*)(d.dst + (size_t)dn * d.lddst + 8 * c)); }
    }
    LDS_WAIT(); asm volatile("" ::: "memory");
}
__device__ __forceinline__ void fzfold_item(const Args& a, int it, int lane) {
    const int mq = it & 3, kb = (it >> 2) & 15, g = (it >> 6) & 7, l = it >> 9, k0 = 64 * kb;
    const GAS f32x4* src = (const GAS f32x4*)(a.in[I_WIN] + (size_t)l * DM * DIN + (size_t)(k0 + lane) * DIN + 3072 + g * 64);
    float w[64];
#pragma unroll
    for (int i = 0; i < 16; ++i) { const f32x4 v = src[i]; w[4 * i] = v[0]; w[4 * i + 1] = v[1]; w[4 * i + 2] = v[2]; w[4 * i + 3] = v[3]; }
    const float cv = cospif((float)lane * (1.0f / 32.0f)), sv = sinpif((float)lane * (1.0f / 32.0f));
    GAS bf16_t* dst = (GAS bf16_t*)w_layer(a.ws, l, W_FZ);
    for (int m = 16 * mq; m < 16 * mq + 16; ++m) {
        float sc = 0.f, ss = 0.f;
#pragma unroll
        for (int c = 0; c < 64; ++c) { const int j = (c * m) & 63;
            const float cj = __builtin_bit_cast(float, __builtin_amdgcn_readlane(__builtin_bit_cast(int, cv), j)), sj = __builtin_bit_cast(float, __builtin_amdgcn_readlane(__builtin_bit_cast(int, sv), j));
            sc += w[c] * cj; ss += w[c] * sj; }
        dst[(size_t)(g * 64 + m) * DM + k0 + lane] = f2bf(sc);
        dst[(size_t)(512 + g * 64 + m) * DM + k0 + lane] = f2bf(ss);
    }
}
__device__ __forceinline__ void mod_item(const Args& a, int item, LAS unsigned char* lds, int tid) {
    const int l = item / 24, chunk = item % 24, wid = tid >> 6, lane = tid & 63;
    LAS float* sc = (LAS float*)lds;
    LAS float* red = (LAS float*)(lds + 36864);
    for (int i = tid; i < 9 * 1024; i += 512) { const float v = i < 8192 ? a.in[I_C][i] : a.in[I_CCTX][i - 8192]; sc[i] = siluf_(v); }
    __syncthreads();
    const float* w = a.in[I_WMOD] + (size_t)l * DM * 6144 + chunk * 256 + lane * 4;
    f32x4 acc[9];
#pragma unroll
    for (int r = 0; r < 9; ++r) acc[r] = (f32x4){0.f, 0.f, 0.f, 0.f};
    const int kb = wid * 128;
#pragma unroll 8
    for (int k = 0; k < 128; ++k) { const f32x4 wv = *(const GAS f32x4*)(w + (size_t)(kb + k) * 6144);
#pragma unroll
        for (int r = 0; r < 9; ++r) acc[r] += wv * sc[r * 1024 + kb + k]; }
#pragma unroll
    for (int r = 0; r < 9; ++r) *(LAS f32x4*)(red + (wid * 9 + r) * 256 + lane * 4) = acc[r];
    __syncthreads();
    float* modv = (float*)(a.ws + WS_MODV) + (size_t)l * 9 * 6144;
    for (int i = tid; i < 9 * 256; i += 512) { const int r = i >> 8, c = i & 255; float s = 0.f;
#pragma unroll
        for (int w8 = 0; w8 < 8; ++w8) s += red[(w8 * 9 + r) * 256 + c];
        modv[r * 6144 + chunk * 256 + c] = s + a.in[I_BMOD][l * 6144 + chunk * 256 + c]; }
    __syncthreads();
}

struct RowV { f32x4 v[4]; };
__device__ __forceinline__ RowV load_row_f32(const float* p, int lane) { RowV r; const f32x4* q = (const f32x4*)p + lane;
#pragma unroll
    for (int j = 0; j < 4; ++j) r.v[j] = q[64 * j];
    return r; }
__device__ __forceinline__ void store_row_f32(float* p, const RowV& r, int lane) { f32x4* q = (f32x4*)p + lane;
#pragma unroll
    for (int j = 0; j < 4; ++j) q[64 * j] = r.v[j]; }
__device__ __forceinline__ RowV load_row_bf16(const bf16_t* p, int lane) { RowV r; const u32x2* q = (const u32x2*)p + lane;
#pragma unroll
    for (int j = 0; j < 4; ++j) { const u32x2 w = q[64 * j]; r.v[j] = (f32x4){bf_lo(w.x), bf_hi(w.x), bf_lo(w.y), bf_hi(w.y)}; }
    return r; }
__device__ __forceinline__ void store_row_bf16(bf16_t* p, const RowV& r, int lane) { u32x2* q = (u32x2*)p + lane;
#pragma unroll
    for (int j = 0; j < 4; ++j) { u32x2 w; w.x = cvt_pk_bf16(r.v[j][0], r.v[j][1]); w.y = cvt_pk_bf16(r.v[j][2], r.v[j][3]); q[64 * j] = w; } }
__device__ __forceinline__ void store_row_fp8(unsigned char* p, const RowV& r, int lane) { unsigned* q = (unsigned*)p + lane;
#pragma unroll
    for (int j = 0; j < 4; ++j) q[64 * j] = cvt4_fp8(r.v[j][0], r.v[j][1], r.v[j][2], r.v[j][3]); }
__device__ __forceinline__ RowV adaln_row(const RowV& x, const float* g, const float* shift, const float* scale, int lane) {
    float ss = 0.f;
#pragma unroll
    for (int j = 0; j < 4; ++j) ss += (x.v[j][0] * x.v[j][0] + x.v[j][1] * x.v[j][1]) + (x.v[j][2] * x.v[j][2] + x.v[j][3] * x.v[j][3]);
    const float rstd = 1.0f / sqrtf(wave_sum(ss) * (1.0f / DM) + 1e-6f);
    const RowV gv = load_row_f32(g, lane), sh = load_row_f32(shift, lane), sc = load_row_f32(scale, lane);
    RowV y;
#pragma unroll
    for (int j = 0; j < 4; ++j) y.v[j] = x.v[j] * rstd * gv.v[j] * (1.0f + sc.v[j]) + sh.v[j];
    return y;
}
__device__ __forceinline__ int mod_row_of(int row) { return row < NLAT ? (row >> 11) : 8; }
struct AdaCoef { RowV A, B; int mr; };
__device__ __forceinline__ void ada_coef_update(AdaCoef& c, int row, const float* g, const float* modbase, int shift_off, int scale_off, int lane) {
    const int mr = mod_row_of(row);
    if (mr != c.mr) { c.mr = mr; const float* mv = modbase + (size_t)mr * 6144;
        const RowV gv = load_row_f32(g, lane), sh = load_row_f32(mv + shift_off, lane), sc = load_row_f32(mv + scale_off, lane);
#pragma unroll
        for (int j = 0; j < 4; ++j) { c.A.v[j] = gv.v[j] * (1.0f + sc.v[j]); c.B.v[j] = sh.v[j]; } }
}
__device__ __forceinline__ RowV adaln_apply(const RowV& x, const AdaCoef& c) {
    float ss = 0.f;
#pragma unroll
    for (int j = 0; j < 4; ++j) ss += (x.v[j][0] * x.v[j][0] + x.v[j][1] * x.v[j][1]) + (x.v[j][2] * x.v[j][2] + x.v[j][3] * x.v[j][3]);
    const float rstd = 1.0f / sqrtf(wave_sum(ss) * (1.0f / DM) + 1e-6f);
    RowV y;
#pragma unroll
    for (int j = 0; j < 4; ++j) y.v[j] = x.v[j] * rstd * c.A.v[j] + c.B.v[j];
    return y;
}

struct MoeTiles { int tb[9]; };
__device__ __forceinline__ MoeTiles moe_tiles(unsigned* ctl, int i) { MoeTiles t; int s = 0;
#pragma unroll
    for (int e = 0; e < 8; ++e) { t.tb[e] = s; const unsigned c = (unsigned)__builtin_amdgcn_readfirstlane((int)__hip_atomic_load(ctl + CW_CNT + 64 * (8 * i + e), __ATOMIC_RELAXED, __HIP_MEMORY_SCOPE_AGENT)); s += (int)((c + 255u) >> 8); }
    t.tb[8] = s; return t; }

__device__ __forceinline__ float max3f(float a, float b, float c) { return __builtin_fmaxf(__builtin_fmaxf(a, b), c); }
__device__ __forceinline__ int crow(int r, int hi) { return (r & 3) + 8 * (r >> 2) + 4 * hi; }
typedef short v4i16_t __attribute__((ext_vector_type(4)));
__device__ __forceinline__ s16x4 vtr(const LAS unsigned char* p) { return __builtin_bit_cast(s16x4, __builtin_amdgcn_ds_read_tr16_b64_v4i16((LAS v4i16_t*)p)); }

struct AttnCtx { const bf16_t* P; bf16_t* O; const float* subln_g; float lam, one_m_li; const float* sink; };

constexpr float ATT_THR = 8.0f;
__device__ __forceinline__ void glds16(const void* gsrc, unsigned lds_dst) { unsigned keep;
    asm volatile("s_mov_b32 %0, m0\n\ts_mov_b32 m0, %2\n\ts_nop 0\n\tglobal_load_lds_dwordx4 %1, off\n\ts_mov_b32 m0, %0" : "=&s"(keep) : "v"(gsrc), "s"(lds_dst) : "memory"); }
#define ATT_BAR() do { __builtin_amdgcn_sched_barrier(0); asm volatile("s_waitcnt lgkmcnt(0)" ::: "memory"); __builtin_amdgcn_s_barrier(); asm volatile("" ::: "memory"); __builtin_amdgcn_sched_barrier(0); } while (0)
template <int VAR>
__device__ __forceinline__ void attn_unit(LAS unsigned char* lds, const int tid, const AttnCtx& ac, int b, int hh, int qb, bool ctxq) {
    constexpr int NDB = (VAR == 0) ? 4 : 2;
    constexpr int NLD = (VAR == 0) ? 2 : 1;
    constexpr int KB = (VAR == 0) ? 16384 : 8192;
    constexpr int VB = (VAR == 0) ? 16384 : 8192;
    constexpr int VBASE = 3 * KB;
    constexpr int WSF_OFF = 135168;
    const int lane = tid & 63, r32 = lane & 31, hi = lane >> 5; const int wid = __builtin_amdgcn_readfirstlane(tid >> 6);
    const int half = wid >> 2;
    int map = 0, g = 0, qsub, qcol, kcol, vcol, ocol, qpb;
    if (VAR == 0) { map = wid >> 2; qsub = wid & 3; qpb = 128; qcol = C_AQ + hh * 128 + map * 64; kcol = C_AK + hh * 128; vcol = C_AV + hh * 128; ocol = hh * 128; }
    else { g = wid >> 1; qsub = wid & 1; qpb = 64; qcol = (VAR == 1 ? C_BQ : C_CQ) + (hh * 4 + g) * 64; kcol = (VAR == 1 ? C_BK : C_CK) + hh * 64; vcol = (VAR == 1 ? C_BV : C_CV) + hh * 64; ocol = (VAR == 1 ? 512 : 1024) + (hh * 4 + g) * 64; }
    const int q0w = qb * qpb + qsub * 32;
    const int latbase = b * SEQ, ctxbase = NLAT + b * CTXL;
    const int qrow0 = (ctxq ? ctxbase : latbase) + q0w;
    int NT, lt0 = 0;
    if (ctxq) NT = 4;
    else if (VAR == 2) { lt0 = qb - 2 < 0 ? 0 : qb - 2; const int lt1 = qb + 2 > 31 ? 31 : qb + 2; NT = 4 + (lt1 - lt0 + 1); }
    else NT = 36;
    auto tile_row0 = [&](int t) -> int {
        if (ctxq) return ctxbase + 64 * t;
        if (VAR == 2) return t < 4 ? ctxbase + 64 * t : latbase + 64 * (lt0 + t - 4);
        return t < 32 ? latbase + 64 * t : ctxbase + 64 * (t - 32);
    };
    const GAS bf16_t* Pg = (const GAS bf16_t*)ac.P;
    bf16x8 qr[4];
    { const GAS bf16_t* qp = Pg + (size_t)(qrow0 + r32) * PW + qcol + hi * 8;
#pragma unroll
      for (int d0 = 0; d0 < 4; ++d0) qr[d0] = *(const GAS bf16x8*)(qp + d0 * 16); }
    const GAS bf16_t* kdma = Pg + (size_t)lane * PW + kcol + 8 * wid;
    const GAS bf16_t* vdma = Pg + (size_t)(16 * (wid & 3) + (lane >> 2)) * PW + vcol + (wid >> 2) * 32 + (lane & 3) * 8;
    const unsigned lds0 = (unsigned)(uintptr_t)lds + (unsigned)wid * 1024u;
    auto gloadK = [&](int t, int slot) { const GAS bf16_t* rp = kdma + (size_t)tile_row0(t) * PW;
#pragma unroll
        for (int j = 0; j < NLD; ++j) glds16((const void*)(rp + 64 * j), (unsigned)__builtin_amdgcn_readfirstlane(lds0 + (unsigned)(slot * KB + j * 8192))); };
    auto gloadV = [&](int t, int slot) { const GAS bf16_t* rp = vdma + (size_t)tile_row0(t) * PW;
#pragma unroll
        for (int j = 0; j < NLD; ++j) glds16((const void*)(rp + 64 * j), (unsigned)__builtin_amdgcn_readfirstlane(lds0 + (unsigned)(VBASE + slot * VB + j * 8192))); };
    volatile LAS float* wsf = (volatile LAS float*)(lds + WSF_OFF + wid * 256);
    const int koff = (VAR == 0 ? map * 8192 : 0) + hi * 1024 + r32 * 16;
    const int vlane = (4 * hi + ((lane & 15) >> 2)) * 64 + ((lane >> 4) & 1) * 32 + (lane & 3) * 8;
    f32x16 o[NDB];
#pragma unroll
    for (int d = 0; d < NDB; ++d) o[d] = (f32x16){0.f, 0.f, 0.f, 0.f, 0.f, 0.f, 0.f, 0.f, 0.f, 0.f, 0.f, 0.f, 0.f, 0.f, 0.f, 0.f};
    float m_run = 0.f, l_run = 0.f;
    f32x16 negm = (f32x16){0.f, 0.f, 0.f, 0.f, 0.f, 0.f, 0.f, 0.f, 0.f, 0.f, 0.f, 0.f, 0.f, 0.f, 0.f, 0.f};
    const int tq = q0w + r32;
    f32x16 s0, s1;
    auto qk = [&](int slot) { const LAS unsigned char* bp = lds + slot * KB + koff;
        s0 = negm; s1 = negm;
        constexpr int KH = (VAR == 0) ? 2 : 4;
#pragma unroll
        for (int h = 0; h < 4; h += KH) {
            bf16x8 kf[2 * KH];
#pragma unroll
            for (int d0 = 0; d0 < KH; ++d0) { kf[2 * d0] = *(const LAS bf16x8*)(bp + (h + d0) * 2048); kf[2 * d0 + 1] = *(const LAS bf16x8*)(bp + (h + d0) * 2048 + 512); }
            __builtin_amdgcn_sched_barrier(0);
#pragma unroll
            for (int d0 = 0; d0 < KH; ++d0) {
                s0 = __builtin_amdgcn_mfma_f32_32x32x16_bf16(kf[2 * d0], qr[h + d0], s0, 0, 0, 0);
                s1 = __builtin_amdgcn_mfma_f32_32x32x16_bf16(kf[2 * d0 + 1], qr[h + d0], s1, 0, 0, 0); }
            if (h + KH < 4) __builtin_amdgcn_sched_barrier(0);
        } };
    gloadK(0, 0); gloadV(0, 0);
    if (NT > 1) gloadK(1, 1);
    asm volatile("s_waitcnt vmcnt(0)" ::: "memory"); ATT_BAR();
    if (NT > 2) gloadK(2, 2);
    if (NT > 1) gloadV(1, 1);
    qk(0);
    ATT_BAR();
    if (half == 1) ATT_BAR();
    int k0 = 0;
    for (int t = 0; t < NT; ++t) {
        const bool more1 = t + 1 < NT, more2 = t + 2 < NT, more3 = t + 3 < NT;
        const int k1 = k0 == 2 ? 0 : k0 + 1, k2 = k1 == 2 ? 0 : k1 + 1;
        if (VAR == 2 && !ctxq && t >= 4) {
            const int lt = lt0 + t - 4, kb = 64 * lt + 4 * hi - tq;
            if (lt == qb - 2) {
#pragma unroll
                for (int r = 0; r < 16; ++r) { const int d = kb + (r & 3) + 8 * (r >> 2); if (d < -128) s0[r] = -1e30f; if (d + 32 < -128) s1[r] = -1e30f; }
            } else if (lt == qb + 2) {
#pragma unroll
                for (int r = 0; r < 16; ++r) { const int d = kb + (r & 3) + 8 * (r >> 2); if (d > 128) s0[r] = -1e30f; if (d + 32 > 128) s1[r] = -1e30f; }
            }
        }
        float ma = max3f(s0[0], s0[1], s1[0]), mb = max3f(s0[2], s0[3], s1[1]); ma = max3f(ma, s1[2], s1[3]);
#pragma unroll
        for (int r = 4; r < 16; r += 4) { ma = max3f(ma, s0[r], s0[r + 1]); mb = max3f(mb, s0[r + 2], s0[r + 3]); ma = max3f(ma, s1[r], s1[r + 1]); mb = max3f(mb, s1[r + 2], s1[r + 3]); }
        float mx = fmaxf(ma, mb);
        { const auto rr = __builtin_amdgcn_permlane32_swap(__float_as_uint(mx), __float_as_uint(mx), false, false); mx = fmaxf(__uint_as_float(rr[0]), __uint_as_float(rr[1])); }
        if (t == 0 || __any(mx > ATT_THR)) {
            const float dl = (t == 0) ? mx : fmaxf(mx, 0.f);
            m_run += dl;
#pragma unroll
            for (int r = 0; r < 16; ++r) { s0[r] -= dl; s1[r] -= dl; negm[r] = -m_run; }
            const float f = fast_exp2(-dl);
            l_run *= f;
            if (hi == 0) wsf[r32] = f;
            LDS_WAIT();
#pragma unroll
            for (int r = 0; r < 16; ++r) { const float al = wsf[crow(r, hi)];
#pragma unroll
                for (int d = 0; d < NDB; ++d) o[d][r] *= al; }
        }
        float la = 0.f, lb = 0.f;
#pragma unroll
        for (int r = 0; r < 16; ++r) { s0[r] = fast_exp2(s0[r]); s1[r] = fast_exp2(s1[r]); la += s0[r]; lb += s1[r]; }
        l_run += la + lb;
        bf16x8 pa[4];
        { u32x4 w;
          w.x = cvt_pk_bf16(s0[0], s0[1]); w.y = cvt_pk_bf16(s0[2], s0[3]); w.z = cvt_pk_bf16(s0[4], s0[5]); w.w = cvt_pk_bf16(s0[6], s0[7]); pa[0] = __builtin_bit_cast(bf16x8, w);
          w.x = cvt_pk_bf16(s0[8], s0[9]); w.y = cvt_pk_bf16(s0[10], s0[11]); w.z = cvt_pk_bf16(s0[12], s0[13]); w.w = cvt_pk_bf16(s0[14], s0[15]); pa[1] = __builtin_bit_cast(bf16x8, w);
          w.x = cvt_pk_bf16(s1[0], s1[1]); w.y = cvt_pk_bf16(s1[2], s1[3]); w.z = cvt_pk_bf16(s1[4], s1[5]); w.w = cvt_pk_bf16(s1[6], s1[7]); pa[2] = __builtin_bit_cast(bf16x8, w);
          w.x = cvt_pk_bf16(s1[8], s1[9]); w.y = cvt_pk_bf16(s1[10], s1[11]); w.z = cvt_pk_bf16(s1[12], s1[13]); w.w = cvt_pk_bf16(s1[14], s1[15]); pa[3] = __builtin_bit_cast(bf16x8, w); }
        ATT_BAR();
        if (more3) gloadK(t + 3, k0);
        if (more2) gloadV(t + 2, k2);
        const LAS unsigned char* vp = lds + VBASE + k0 * VB + vlane;
        s16x4 va_lo[NDB], va_hi[NDB], vb_lo[NDB], vb_hi[NDB];
#define ATT_VLOAD(LO, HI, KS) do { _Pragma("unroll") for (int d = 0; d < NDB; ++d) { LO[d] = vtr(vp + d * 4096 + (KS) * 1024); HI[d] = vtr(vp + d * 4096 + (KS) * 1024 + 512); } } while (0)
#define ATT_VMMA(LO, HI, KS) do { _Pragma("unroll") for (int d = 0; d < NDB; ++d) { const bf16x8 vf = (bf16x8){LO[d][0], LO[d][1], LO[d][2], LO[d][3], HI[d][0], HI[d][1], HI[d][2], HI[d][3]}; \
            o[d] = __builtin_amdgcn_mfma_f32_32x32x16_bf16(pa[KS], vf, o[d], 0, 0, 0); } } while (0)
        ATT_VLOAD(va_lo, va_hi, 0); ATT_VLOAD(vb_lo, vb_hi, 1);
        __builtin_amdgcn_sched_barrier(0);
        ATT_VMMA(va_lo, va_hi, 0);
        __builtin_amdgcn_sched_barrier(0);
        ATT_VLOAD(va_lo, va_hi, 2);
        __builtin_amdgcn_sched_barrier(0);
        ATT_VMMA(vb_lo, vb_hi, 1);
        __builtin_amdgcn_sched_barrier(0);
        ATT_VLOAD(vb_lo, vb_hi, 3);
        __builtin_amdgcn_sched_barrier(0);
        ATT_VMMA(va_lo, va_hi, 2);
        ATT_VMMA(vb_lo, vb_hi, 3);
#undef ATT_VLOAD
#undef ATT_VMMA
        if (more1) qk(k1);
        if (more3) { if (NLD == 2) asm volatile("s_waitcnt vmcnt(4)" ::: "memory"); else asm volatile("s_waitcnt vmcnt(2)" ::: "memory"); }
        else if (more2) { if (NLD == 2) asm volatile("s_waitcnt vmcnt(2)" ::: "memory"); else asm volatile("s_waitcnt vmcnt(1)" ::: "memory"); }
        else asm volatile("s_waitcnt vmcnt(0)" ::: "memory");
        ATT_BAR();
        k0 = k1;
    }
    if (half == 0) ATT_BAR();
    { float l_tot; { const auto rr = __builtin_amdgcn_permlane32_swap(__float_as_uint(l_run), __float_as_uint(l_run), false, false); l_tot = __uint_as_float(rr[0]) + __uint_as_float(rr[1]); }
      if (VAR == 2) l_tot += fast_exp2(ac.sink[hh * 4 + g] * LOG2E - m_run);
      if (hi == 0) wsf[r32] = 1.0f / l_tot;
      LDS_WAIT();
#pragma unroll
      for (int r = 0; r < 16; ++r) { const float il = wsf[crow(r, hi)];
#pragma unroll
          for (int d = 0; d < NDB; ++d) o[d][r] *= il; } }
    GAS bf16_t* Og = (GAS bf16_t*)ac.O;
    if (VAR != 0) {
#pragma unroll
        for (int r = 0; r < 16; ++r) { GAS bf16_t* op = Og + (size_t)(qrow0 + crow(r, hi)) * OW + ocol + r32;
#pragma unroll
            for (int d = 0; d < NDB; ++d) op[d * 32] = f2bf(o[d][r]); }
    } else {
        LAS float* tile = (LAS float*)lds + ((wid & 3) * 2 + map) * (32 * 132);
#pragma unroll
        for (int r = 0; r < 16; ++r)
#pragma unroll
            for (int d = 0; d < NDB; ++d) tile[crow(r, hi) * 132 + d * 32 + r32] = o[d][r];
        __syncthreads();
        const int ql = (wid >> 2) * 16 + (lane >> 2), part = lane & 3;
        const LAS float* t0 = (const LAS float*)lds + ((wid & 3) * 2) * (32 * 132) + ql * 132 + part * 32;
        const LAS float* t1 = t0 + 32 * 132;
        f32x4 dv[8]; float ss = 0.f;
#pragma unroll
        for (int j = 0; j < 8; ++j) { const f32x4 a = *(const LAS f32x4*)(t0 + 4 * j), bq = *(const LAS f32x4*)(t1 + 4 * j); dv[j] = a - ac.lam * bq;
            ss += (dv[j][0] * dv[j][0] + dv[j][1] * dv[j][1]) + (dv[j][2] * dv[j][2] + dv[j][3] * dv[j][3]); }
        ss += __shfl_xor(ss, 1); ss += __shfl_xor(ss, 2);
        const float rs = ac.one_m_li / sqrtf(ss * (1.0f / 128.0f) + 1e-5f);
        const GAS float* gp = (const GAS float*)ac.subln_g + part * 32;
        GAS bf16_t* op = Og + (size_t)((ctxq ? ctxbase : latbase) + qb * qpb + (wid & 3) * 32 + ql) * OW + ocol + part * 32;
#pragma unroll
        for (int k = 0; k < 4; ++k) { const f32x4 g0 = *(const GAS f32x4*)(gp + 8 * k), g1 = *(const GAS f32x4*)(gp + 8 * k + 4);
            const f32x4 v0 = dv[2 * k] * g0 * rs, v1 = dv[2 * k + 1] * g1 * rs;
            u32x4 w; w.x = cvt_pk_bf16(v0[0], v0[1]); w.y = cvt_pk_bf16(v0[2], v0[3]); w.z = cvt_pk_bf16(v1[0], v1[1]); w.w = cvt_pk_bf16(v1[2], v1[3]);
            *(GAS u32x4*)(op + 8 * k) = w; }
    }
}

using pg8::Unit;
struct SchedInproj {
    int c, G, nM, ntot, nfz; const char* xn; const char* win; const char* wfz; char* p; char* zz; char* zzc; const char* rope;
    __device__ __forceinline__ bool next(int i, Unit& u) const {
        const int L = i * G + c; if (L >= ntot + nfz) return false;
        u.aux = nullptr; u.aux2 = nullptr;
        if (L < ntot) { int pm, pn; pg8::tile_of(L, nM, 12, pm, pn);
            u.A = xn + (size_t)pm * 256 * DM * 2; u.B = win + (size_t)pn * 256 * DM * 2; u.out = p + ((size_t)pm * 256 * PW + pn * 256) * 2; u.ldc = PW;
            int fl = pm < 64 ? 16 : 0;
            if (pn < 2) fl |= 2 | 8; else if (pn < 4) fl |= 2; else if (pn == 9 || pn == 10) fl |= 2 | 8; else if (pn == 11) fl |= 4;
            u.flag = fl; u.aux = rope + (size_t)((pm * 256) & 2047) * 64 * 4; }
        else { const int q = L - ntot;
            if (q < 256) { const int b = q >> 5, pm = (q >> 3) & 3, pn = q & 7;
                u.A = wfz + (size_t)pm * 256 * DM * 2; u.B = xn + (size_t)(b * SEQ + pn * 256) * DM * 2;
                u.out = zz + ((size_t)b * 512 * 4096 + (size_t)((pm & 1) * 256) * 4096 + (pm >> 1) * 2048 + pn * 256) * 2; u.ldc = 4096; u.flag = 0; }
            else { const int q2 = q - 256, b = q2 >> 2, pm = q2 & 3;
                u.A = wfz + (size_t)pm * 256 * DM * 2; u.B = xn + (size_t)(NLAT + b * CTXL) * DM * 2;
                u.out = zzc + ((size_t)b * 512 * 512 + (size_t)((pm & 1) * 256) * 512 + (pm >> 1) * 256) * 2; u.ldc = 512; u.flag = 0; } }
        return true;
    }
};
struct SchedGate {
    int c, G, nM; const char* xn8; const char* wg; char* gates;
    __device__ __forceinline__ bool next(int i, Unit& u) const {
        const int L = i * G + c; if (L >= nM * 16) return false;
        int pm, pn; pg8::tile_of(L, nM, 16, pm, pn);
        u.A = xn8 + (size_t)pm * 256 * DM; u.B = wg + (size_t)pn * 256 * DM; u.out = gates + ((size_t)pm * 256 * GW + pn * 256); u.ldc = GW; u.flag = 0; u.aux = nullptr; u.aux2 = nullptr; return true;
    }
};
struct SchedDft {
    int c; const char* T; const char* zz; char* o;
    __device__ __forceinline__ bool next(int i, Unit& u) const {
        if (i > 0 || c >= 128) return false;
        const int b = c >> 4, pm = (c >> 1) & 7, pn = c & 1;
        u.A = T + (size_t)pm * 256 * 4096 * 2; u.B = zz + ((size_t)b * 512 + pn * 256) * 4096 * 2;
        u.out = o + ((size_t)(b * SEQ + pm * 256) * OW + 1536 + pn * 256) * 2; u.ldc = OW; u.flag = 0; u.aux = nullptr; u.aux2 = nullptr; return true;
    }
};
struct SchedDftCtx {
    int c; const char* T; const char* zzc; char* o;
    __device__ __forceinline__ bool next(int i, Unit& u) const {
        if (i > 0 || c < 128 || c >= 144) return false;
        const int q = c - 128, b = q >> 1, pn = q & 1;
        u.A = T; u.B = zzc + ((size_t)b * 512 + pn * 256) * 512 * 2;
        u.out = o + ((size_t)(NLAT + b * CTXL) * OW + 1536 + pn * 256) * 2; u.ldc = OW; u.flag = 0; u.aux = nullptr; u.aux2 = nullptr; return true;
    }
};
struct SchedBranch {
    int c, G, ntile; const char* o; const char* wbr; const char* p; char* merged;
    __device__ __forceinline__ bool next(int i, pg8::BUnit& u) const {
        const int xcd = c & 7, j = i * (G >> 3) + (c >> 3), pm = xcd + 8 * (j >> 3), pn2 = j & 7;
        if (pm * 8 >= ntile) return false;
        u.A = o + (size_t)pm * 256 * OW * 2; u.B = wbr + (size_t)pn2 * 128 * 2048 * 2;
        u.gate = p + ((size_t)pm * 256 * GW + pn2 * 128);
        u.out = merged + ((size_t)pm * 256 * 1024 + pn2 * 128) * 2; return true;
    }
};
struct SchedResid {
    int c, G, nM, K; const char* A; const char* B; char* xs; const char* modv; int goff; const char* xin; const char* cin;
    __device__ __forceinline__ bool next(int i, Unit& u) const {
        const int L = i * G + c; if (L >= nM * 4) return false;
        int pm, pn; pg8::tile_of(L, nM, 4, pm, pn);
        u.A = A + (size_t)pm * 256 * K * 2; u.B = B + (size_t)pn * 256 * K * 2; u.out = xs + ((size_t)pm * 256 * DM + pn * 256) * 2; u.ldc = DM;
        u.aux = modv + ((size_t)(pm < 64 ? (pm >> 3) : 8) * 6144 + goff + pn * 256) * 4; u.flag = xin ? 1 : 0;
        u.aux2 = xin ? (pm < 64 ? xin + ((size_t)pm * 256 * DM + pn * 256) * 4 : cin + ((size_t)(pm - 64) * 256 * DM + pn * 256) * 4) : (const char*)u.out; return true;
    }
};
struct SchedUp {
    int c, G, nM; const char* xn; const char* w; char* h; int eb;
    __device__ __forceinline__ bool next(int i, Unit& u) const {
        const int L = i * G + c; if (L >= nM * 22) return false;
        int pm, pn; pg8::tile_of(L, nM, 22, pm, pn);
        u.A = xn + (size_t)pm * 256 * DM * eb; u.B = w + (size_t)pn * 256 * DM * eb; u.out = h + ((size_t)pm * 256 * DFF + pn * 128) * eb; u.ldc = DFF; u.flag = 0; u.aux = nullptr; u.aux2 = nullptr; return true;
    }
};
struct SchedMoe {
    int c, G, NT, K, RT; MoeTiles mt; const char* A; const char* W; size_t wsub; char* out; int ldc, colw, esz;
    __device__ __forceinline__ bool next(int i, Unit& u) const {
        const int L0 = i * G + c, ntot = RT * NT; if (L0 >= ntot) return false;
        int L = L0; if (NT > 4) { const int q = ntot / 8, r = ntot % 8, xcd = L0 % 8, off = L0 / 8; L = (xcd < r ? xcd * (q + 1) : r * (q + 1) + (xcd - r) * q) + off; }
        const int gs = 8 * NT, g8 = L / gs, rem = L % gs, left = RT - 8 * g8, gsz = left < 8 ? left : 8;
        const int rt = 8 * g8 + rem % gsz, pn = rem / gsz;
        int e = 0;
#pragma unroll
        for (int k = 1; k < 8; ++k) e += (rt >= mt.tb[k]) ? 1 : 0;
        u.A = A + (size_t)rt * 256 * K * 2; u.B = W + (size_t)e * W_EXPERT + wsub + (size_t)pn * 256 * K * 2;
        u.out = out + ((size_t)rt * 256 * ldc + (size_t)pn * colw) * esz; u.ldc = ldc; u.flag = 0; u.aux = nullptr; u.aux2 = nullptr; return true;
    }
};

struct SchedMoeSplit {
    int c, G, RF, RT; MoeTiles mt; const char* A; const char* W; char* y0; char* y1;
    __device__ __forceinline__ bool next(int i, Unit& u) const {
        const int L = i * G + c; if (L >= (RT - RF) * 8) return false;
        const int ts = L >> 1, kh = L & 1, rt = RF + (ts >> 2), pn = ts & 3;
        int e = 0;
#pragma unroll
        for (int k = 1; k < 8; ++k) e += (rt >= mt.tb[k]) ? 1 : 0;
        u.A = A + ((size_t)rt * 256 * DFE + kh * (DFE / 2)); u.B = W + (size_t)e * W_EXPERT + W_MD + ((size_t)pn * 256 * DFE + kh * (DFE / 2));
        u.out = kh ? y1 + ((size_t)(rt - RF) * 256 * DM + pn * 256) * 2 : y0 + ((size_t)rt * 256 * DM + pn * 256) * 2;
        u.ldc = DM; u.flag = 0; u.aux = nullptr; u.aux2 = nullptr; return true;
    }
};

#define LAUNDER_S(x) asm volatile("" : "+s"(x))
#define LAUNDER_V(x) asm volatile("" : "+v"(x))
constexpr int LDS_ARGOFF = LDS_CTLOFF + 512;
__device__ __forceinline__ const float* ARGP(LAS unsigned char* lds, int i) {
    unsigned off = LDS_ARGOFF + 8 * i; asm volatile("" : "+s"(off));
    volatile LAS unsigned* p = (volatile LAS unsigned*)(lds + off);
    const unsigned lo = __builtin_amdgcn_readfirstlane(p[0]), hi = __builtin_amdgcn_readfirstlane(p[1]);
    return (const float*)(((unsigned long long)hi << 32) | lo);
}
__device__ __forceinline__ void grid_barrier(LAS unsigned char* lds, int wv) {
    XcdBarrier b; b.bar = (unsigned*)((unsigned char*)ARGP(lds, 24) + WS_CTL) + CW_BAR; b.x = xb_xcc_id(); b.st = (volatile LAS unsigned*)(lds + LDS_CTLOFF);
    xcd_barrier(b, wv == 0 && lane_id() == 0);
}
struct Fr { LAS unsigned char* lds; unsigned char* ws; int tid, lane, wave, bid, G, gw, NGW; unsigned* ctl; };
__device__ __forceinline__ Fr make_frame(LAS unsigned char* lds, int wv) {
    Fr F; F.lds = lds;
    F.ws = (unsigned char*)ARGP(lds, 24); int t = wv * 64 + lane_id(); LAUNDER_V(t); F.tid = t; F.lane = t & 63; F.wave = wv;
    int b = blockIdx.x; LAUNDER_S(b); F.bid = b; int g = gridDim.x; LAUNDER_S(g); F.G = g; F.gw = b * 8 + F.wave; F.NGW = g * 8; F.ctl = (unsigned*)(F.ws + WS_CTL);
    return F;
}

constexpr int CV_PRO = 4 * CV_LAYER + 2 * CV_DENSE;
constexpr int CV_M1 = CV_PRO, CV_M3 = CV_PRO + 8 * CV_EXP;
#ifndef BG_BRW
#define BG_BRW 4
#endif
#ifndef BG_DDW
#define BG_DDW 7
#endif
constexpr int BG_BR = 192 * 8 * BG_BRW, BG_OUT = 224 * 8 * 4, BG_DD = 224 * 8 * BG_DDW;
constexpr int CVQ_BLK = 32;
constexpr int MQ1_S = CV_M1 + BG_BR + BG_OUT + BG_DD + BG_BR, MQ1_E = CV_M3, MQ2_S = CV_M3 + BG_OUT + BG_BR + BG_OUT + BG_DD, MQ2_E = CV_TOTAL;
static_assert(MQ1_S <= MQ1_E && MQ2_S <= MQ2_E && (MQ1_E - MQ1_S) % (8 * CVQ_BLK) == 0 && (MQ2_E - MQ2_S) % (8 * CVQ_BLK) == 0, "queue conversion ranges are whole units per XCD queue");
__device__ __forceinline__ void convert_range(LAS unsigned char* lds, const Fr& F, int start, int end, int gwi, int nw) {
    Args a;
#pragma unroll
    for (int i = 0; i < 23; ++i) a.in[i] = ARGP(lds, i);
    a.out = nullptr; a.ws = F.ws;
    LAS float* scr = (LAS float*)(lds + F.wave * 8704);
    float ra[32], rb[32]; ConvDesc d, dn; int it = start + gwi; bool have = it < end;
    if (have) { d = conv_decode(a, it); conv_load(d, ra, F.lane); }
    while (have) {
        const int itn = it + nw; const bool hn = itn < end;
        if (hn) { dn = conv_decode(a, itn); conv_load(dn, rb, F.lane); }
        conv_store(d, ra, scr, F.lane);
        if (hn) {
#pragma unroll
            for (int i = 0; i < 32; ++i) ra[i] = rb[i];
            d = dn; }
        it = itn; have = hn;
    }
}
__device__ __forceinline__ void bg_window(int kind, int l, int& s, int& e) {
    s = 0; e = 0;
    const int m1a = CV_M1, m1b = m1a + BG_BR, m1c = m1b + BG_OUT, m1d = m1c + BG_DD, m1e = MQ1_S;
    const int m3a = CV_M3, m3b = m3a + BG_OUT, m3c = m3b + BG_BR, m3d = m3c + BG_OUT, m3e = MQ2_S;
    if (kind == 0) { if (l == 0) { s = m1a; e = m1b; } else if (l == 1) { s = m1d; e = m1e; } else if (l == 2) { s = m3b; e = m3c; } }
    else if (kind == 1) { if (l == 0) { s = m1b; e = m1c; } else if (l == 1) { s = m3a; e = m3b; } else if (l == 2) { s = m3c; e = m3d; } }
    else { if (l == 0) { s = m1c; e = m1d; } else if (l == 2) { s = m3d; e = m3e; } }
}
__device__ __forceinline__ void phase_prologue(LAS unsigned char* lds, int wv) {
    const Fr F = make_frame(lds, wv);
    Args a;
#pragma unroll
    for (int i = 0; i < 23; ++i) a.in[i] = ARGP(lds, i);
    a.out = nullptr; a.ws = F.ws;
    if (F.bid < 96) mod_item(a, F.bid, lds, F.tid);
    for (int it = F.gw; it < 2048; it += F.NGW) fzfold_item(a, it, F.lane);
    convert_range(lds, F, 0, CV_LAYER, F.gw, F.NGW);
    float* rope = (float*)(F.ws + WS_ROPE);
    for (int i = F.gw * 64 + F.lane; i < SEQ * 64; i += F.NGW * 64) { const int t = i >> 6, j = i & 63, ax = j >> 5, isin = (j >> 4) & 1, f = j & 15;
        const float pos = (float)(ax == 0 ? (t >> 6) : (t & 63));
        const float inv = powf(10000.0f, -(float)f / 16.0f); const float ang = pos * inv;
        rope[i] = isin ? sinf(ang) : cosf(ang); }
    bf16_t* T = (bf16_t*)(F.ws + WS_T);
    for (int i = F.gw * 64 + F.lane; i < 2048 * 2048; i += F.NGW * 64) { const int k = i >> 11, n = i & 2047; const float x = (float)((k * n) & 2047) * (1.0f / 1024.0f);
        T[(size_t)k * 4096 + n] = f2bf(cospif(x)); T[(size_t)k * 4096 + 2048 + n] = f2bf(-sinpif(x)); }
    bf16_t* T2 = (bf16_t*)(F.ws + WS_T256);
    for (int i = F.gw * 64 + F.lane; i < 256 * 256; i += F.NGW * 64) { const int k = i >> 8, n = i & 255; const float x = (float)((k * n) & 255) * (1.0f / 128.0f);
        T2[k * 512 + n] = f2bf(cospif(x)); T2[k * 512 + 256 + n] = f2bf(-sinpif(x)); }
}
__device__ __forceinline__ void phase_first_norm(LAS unsigned char* lds, int wv) {
    const Fr F = make_frame(lds, wv);
    const float* X = ARGP(lds, I_X); const float* CX = ARGP(lds, I_CTX); const float* n1g = ARGP(lds, I_N1G);
    float* xs = (float*)(F.ws + WS_XS); bf16_t* xn = (bf16_t*)(F.ws + WS_XN); const float* modv_all = (const float*)(F.ws + WS_MODV);
    for (int row = F.gw; row < NTOK; row += F.NGW) {
        const float* src = row < NLAT ? X + (size_t)row * DM : CX + (size_t)(row - NLAT) * DM;
        const RowV x = load_row_f32(src, F.lane);
        const float* mv = modv_all + (size_t)mod_row_of(row) * 6144;
        const RowV y = adaln_row(x, n1g, mv, mv + 1024, F.lane);
        store_row_bf16(xn + (size_t)row * DM, y, F.lane);
        store_row_fp8(F.ws + WS_XN8 + (size_t)row * DM, y, F.lane);
    }
}
__device__ __forceinline__ void phase_inproj(LAS unsigned char* lds, int wv, int l) {
    const Fr F = make_frame(lds, wv); unsigned char* ws = F.ws; const bool lastl = l == DEPTH - 1;
    { SchedInproj S{F.bid, F.G, NTOK / 256, (NTOK / 256) * 12, lastl ? 256 : 288, (const char*)(ws + WS_XN), (const char*)w_layer(ws, l, W_IN), (const char*)w_layer(ws, l, W_FZ), (char*)(ws + WS_P), (char*)(ws + WS_ZZ), (char*)(ws + WS_ZZC), (const char*)(ws + WS_ROPE)};
      pg8::EpiInproj E{};
      pg8::gemm_phase<pg8::EpiInproj, SchedInproj, true, true>(lds, F.tid, DM, DM, DM, S, E); }
    { SchedGate S{(F.bid + (F.G >> 1)) % F.G, F.G, NTOK / 256, (const char*)(ws + WS_XN8), (const char*)w_layer(ws, l, W_ING8), (char*)(ws + WS_G)};
      pg8::EpiGate E{};
      int tl = F.tid; LAUNDER_V(tl);
      pg8::gemm_phase<pg8::EpiGate, SchedGate, true, true, true>(lds, tl, DM / 2, DM / 2, DM / 2, S, E, 120); }
}
__device__ __forceinline__ void phase_post(LAS unsigned char* lds, int wv, int l) {
    const Fr F = make_frame(lds, wv);
    GAS bf16_t* P = (GAS bf16_t*)(F.ws + WS_P); const GAS float* rope = (const GAS float*)(F.ws + WS_ROPE);
    const GAS float* gq = (const GAS float*)ARGP(lds, I_QKG) + l * 128; const GAS float* gk = gq + 64;
    const int lane = F.lane, a = (lane & 7) >> 2, i0 = 4 * (lane & 3);
    float gqv[8], gkv[8];
#pragma unroll
    for (int e = 0; e < 8; ++e) { const int d = 32 * a + 16 * (e & 1) + i0 + (e >> 1); gqv[e] = gq[d]; gkv[e] = gk[d]; }
    for (int row = F.gw; row < NTOK; row += F.NGW) {
        GAS bf16_t* pr = P + (size_t)row * PW;
        const bool lat = row < NLAT;
        f32x4 cs = (f32x4){1.f, 1.f, 1.f, 1.f}, sn = (f32x4){0.f, 0.f, 0.f, 0.f};
        if (lat) { const GAS float* rt = rope + (size_t)(row & 2047) * 64 + a * 32 + i0; cs = *(const GAS f32x4*)rt; sn = *(const GAS f32x4*)(rt + 16); }
        const u32x4 qw = *(const GAS u32x4*)(pr + C_BQ + 8 * lane);
        u32x4 kw = (u32x4){0u, 0u, 0u, 0u};
        if (lane < 16) kw = *(const GAS u32x4*)(pr + C_BK + 8 * lane);
        float x[8], y[8];
        x[0] = bf_lo(qw.x); x[1] = bf_hi(qw.x); x[2] = bf_lo(qw.y); x[3] = bf_hi(qw.y); x[4] = bf_lo(qw.z); x[5] = bf_hi(qw.z); x[6] = bf_lo(qw.w); x[7] = bf_hi(qw.w);
        y[0] = bf_lo(kw.x); y[1] = bf_hi(kw.x); y[2] = bf_lo(kw.y); y[3] = bf_hi(kw.y); y[4] = bf_lo(kw.z); y[5] = bf_hi(kw.z); y[6] = bf_lo(kw.w); y[7] = bf_hi(kw.w);
        float sq = 0.f, sk = 0.f;
#pragma unroll
        for (int e = 0; e < 8; ++e) { sq += x[e] * x[e]; sk += y[e] * y[e]; }
        sq += __shfl_xor(sq, 1); sq += __shfl_xor(sq, 2); sq += __shfl_xor(sq, 4);
        sk += __shfl_xor(sk, 1); sk += __shfl_xor(sk, 2); sk += __shfl_xor(sk, 4);
        const float rq = 1.0f / sqrtf(sq * (1.0f / 64.0f) + 1e-6f), rk = 1.0f / sqrtf(sk * (1.0f / 64.0f) + 1e-6f);
#pragma unroll
        for (int e = 0; e < 8; ++e) { x[e] *= rq * gqv[e]; y[e] *= rk * gkv[e]; }
        float xo[8], yo[8];
#pragma unroll
        for (int p2 = 0; p2 < 4; ++p2) { const float c = cs[p2], s = sn[p2];
            xo[2 * p2] = (x[2 * p2] * c - x[2 * p2 + 1] * s) * C2; xo[2 * p2 + 1] = (x[2 * p2 + 1] * c + x[2 * p2] * s) * C2;
            yo[2 * p2] = y[2 * p2] * c - y[2 * p2 + 1] * s; yo[2 * p2 + 1] = y[2 * p2 + 1] * c + y[2 * p2] * s; }
        u32x4 ow; ow.x = cvt_pk_bf16(xo[0], xo[1]); ow.y = cvt_pk_bf16(xo[2], xo[3]); ow.z = cvt_pk_bf16(xo[4], xo[5]); ow.w = cvt_pk_bf16(xo[6], xo[7]);
        *(GAS u32x4*)(pr + C_BQ + 8 * lane) = ow;
        if (lane < 16) { u32x4 kk; kk.x = cvt_pk_bf16(yo[0], yo[1]); kk.y = cvt_pk_bf16(yo[2], yo[3]); kk.z = cvt_pk_bf16(yo[4], yo[5]); kk.w = cvt_pk_bf16(yo[6], yo[7]);
            *(GAS u32x4*)(pr + C_BK + 8 * lane) = kk; }
    }
}
constexpr int CVQ_UNITS = (CV_PRO - CV_LAYER) / (8 * CVQ_BLK);
static_assert(CVQ_UNITS * 8 * CVQ_BLK == CV_PRO - CV_LAYER, "conversion units tile the deferred block range");
__device__ __forceinline__ void phase_mix(LAS unsigned char* lds, int wv, int l, int rep) {
    const Fr F = make_frame(lds, wv); unsigned char* ws = F.ws; const bool lastl = l == DEPTH - 1;
    volatile LAS unsigned* LCTL = (volatile LAS unsigned*)(lds + LDS_CTLOFF);
    { SchedDft S{F.bid, (const char*)(ws + WS_T), (const char*)(ws + WS_ZZ), (char*)(ws + WS_O)}; pg8::EpiStore E{1.0f / 362.03867196751236f};
      pg8::gemm_phase<pg8::EpiStore, SchedDft, false, true>(lds, F.tid, 4096, 4096, 4096, S, E); }
    if (!lastl) { SchedDftCtx S{F.bid, (const char*)(ws + WS_T256), (const char*)(ws + WS_ZZC), (char*)(ws + WS_O)}; pg8::EpiStore E{1.0f / 128.0f};
      pg8::gemm_phase<pg8::EpiStore, SchedDftCtx, false, true>(lds, F.tid, 512, 512, 512, S, E); }
    float c08 = 0.8f; asm volatile("" : "+v"(c08));
    const float li = c08 - 0.6f * expf(-0.3f * (float)l);
    const float* lp = ARGP(lds, I_DLAM) + l * 256;
    float d01 = 0.f, d23 = 0.f;
    for (int k = 0; k < 64; ++k) { d01 += lp[k] * lp[64 + k]; d23 += lp[128 + k] * lp[192 + k]; }
    const float lam_u = __builtin_bit_cast(float, __builtin_amdgcn_readfirstlane(__builtin_bit_cast(int, expf(d01) - expf(d23) + li)));
    const float oml_u = __builtin_bit_cast(float, __builtin_amdgcn_readfirstlane(__builtin_bit_cast(int, 1.0f - li)));
    AttnCtx ac{(const bf16_t*)(ws + WS_P), (bf16_t*)(ws + WS_O), ARGP(lds, I_SUBLN) + l * 128, lam_u, oml_u, ARGP(lds, I_SINK) + l * 8};
    const int NUB = lastl ? 192 : 216;
    int NCV = 0, cvbase = 0;
    if (rep == 0) { if (l == 0) { NCV = CVQ_UNITS; cvbase = CV_LAYER; } else if (l == 1) { NCV = (MQ1_E - MQ1_S) / (8 * CVQ_BLK); cvbase = MQ1_S; } else if (l == 2) { NCV = (MQ2_E - MQ2_S) / (8 * CVQ_BLK); cvbase = MQ2_S; } }
    const int bq = F.bid & 7;
    unsigned* qc = F.ctl + CW_Q + 64 * (8 * (l + 4 * rep) + bq);
    for (;;) {
        __syncthreads();
        if (F.tid == 0) LCTL[2] = xb_add(qc, 1u);
        __syncthreads();
        const int u = __builtin_amdgcn_readfirstlane((int)LCTL[2]);
        if (u >= NUB + NCV) break;
        if (u >= NUB) { const int s = cvbase + ((u - NUB) * 8 + bq) * CVQ_BLK; convert_range(lds, F, s, s + CVQ_BLK, F.wave, 8); continue; }
        int tl = F.tid; LAUNDER_V(tl);
        if (u < 64) attn_unit<0>(lds, tl, ac, bq, u >> 4, u & 15, false);
        else if (u < 128) { const int v = u - 64; attn_unit<1>(lds, tl, ac, bq, v >> 5, v & 31, false); }
        else if (u < 192) { const int v = u - 128; attn_unit<2>(lds, tl, ac, bq, v >> 5, v & 31, false); }
        else if (u < 200) { const int v = u - 192; attn_unit<0>(lds, tl, ac, bq, v >> 1, v & 1, true); }
        else if (u < 208) { const int v = u - 200; attn_unit<1>(lds, tl, ac, bq, v >> 2, v & 3, true); }
        else { const int v = u - 208; attn_unit<2>(lds, tl, ac, bq, v >> 2, v & 3, true); }
    }
}
__device__ __forceinline__ void phase_branch(LAS unsigned char* lds, int wv, int l) {
    const Fr F = make_frame(lds, wv); unsigned char* ws = F.ws; const int nMact = (l == DEPTH - 1) ? NLAT / 256 : NTOK / 256;
    SchedBranch S{F.bid, F.G, nMact * 8, (const char*)(ws + WS_O), (const char*)w_layer(ws, l, W_BR), (const char*)(ws + WS_G), (char*)(ws + WS_XN)};
    pg8::branch_phase<SchedBranch>(lds, F.tid, S);
    if (nMact == NTOK / 256 && (F.bid >> 3) >= 8) {
        int s, e; bg_window(0, l, s, e);
        if (e > s) convert_range(lds, F, s, e, ((F.bid & 7) * 24 + (F.bid >> 3) - 8) * 8 + F.wave, 192 * 8);
    }
}
__device__ __forceinline__ void phase_out(LAS unsigned char* lds, int wv, int l) {
    const Fr F = make_frame(lds, wv); unsigned char* ws = F.ws; const int nMact = (l == DEPTH - 1) ? NLAT / 256 : NTOK / 256;
    SchedResid S{F.bid, F.G, nMact, DM, (const char*)(ws + WS_XN), (const char*)w_layer(ws, l, W_OUT), (char*)(ws + WS_XS), (const char*)(ws + WS_MODV + (size_t)l * 9 * 6144 * 4), 2048, l == 0 ? (const char*)ARGP(lds, I_X) : nullptr, l == 0 ? (const char*)ARGP(lds, I_CTX) : nullptr};
    pg8::EpiResid E{};
    pg8::gemm_phase<pg8::EpiResid, SchedResid, true, true>(lds, F.tid, DM, DM, DM, S, E);
    if (nMact == NTOK / 256 && F.bid >= 32) {
        int s, e; bg_window(1, l, s, e);
        if (e > s) convert_range(lds, F, s, e, (F.bid - 32) * 8 + F.wave, 224 * 8);
    }
}
__device__ __forceinline__ void phase_norm2_dense(LAS unsigned char* lds, int wv, int l) {
    const Fr F = make_frame(lds, wv); const int nrows = (l == DEPTH - 1) ? NLAT : NTOK;
    const bf16_t* xs = (const bf16_t*)(F.ws + WS_XS); bf16_t* xn = (bf16_t*)(F.ws + WS_XN); const float* modv = (const float*)(F.ws + WS_MODV) + (size_t)l * 9 * 6144;
    const float* n2g = ARGP(lds, I_N2G) + l * DM;
    const int rpw = nrows / F.NGW, r0 = F.gw * rpw, r1 = r0 + rpw;
    AdaCoef co; co.mr = -1;
    for (int r = r0; r < r1; r += 3) {
        RowV x[3];
#pragma unroll
        for (int q = 0; q < 3; ++q) x[q] = load_row_bf16(xs + (size_t)(r + q < r1 ? r + q : r) * DM, F.lane);
#pragma unroll
        for (int q = 0; q < 3; ++q) if (r + q < r1) { ada_coef_update(co, r + q, n2g, modv, 3072, 4096, F.lane);
            if ((DENSE_F8_MASK >> (l >> 1)) & 1) store_row_fp8((unsigned char*)xn + (size_t)(r + q) * DM, adaln_apply(x[q], co), F.lane);
            else store_row_bf16(xn + (size_t)(r + q) * DM, adaln_apply(x[q], co), F.lane); }
    }
}
__device__ __forceinline__ void phase_up_dense(LAS unsigned char* lds, int wv, int l) {
    const Fr F = make_frame(lds, wv); unsigned char* ws = F.ws; const int nMact = (l == DEPTH - 1) ? NLAT / 256 : NTOK / 256;
    if ((DENSE_F8_MASK >> (l >> 1)) & 1) {
        SchedUp S{F.bid, F.G, nMact, (const char*)(ws + WS_XN), (const char*)w_dense(ws, l >> 1, W_DGU), (char*)(ws + WS_P), 1};
        pg8::EpiSwigluF8 E{};
        pg8::gemm_phase<pg8::EpiSwigluF8, SchedUp, true, true, true>(lds, F.tid, DM / 2, DM / 2, DM / 2, S, E, 120);
    } else {
        SchedUp S{F.bid, F.G, nMact, (const char*)(ws + WS_XN), (const char*)w_dense(ws, l >> 1, W_DGU), (char*)(ws + WS_P), 2};
        pg8::EpiSwiglu E{};
        pg8::gemm_phase<pg8::EpiSwiglu, SchedUp, true, true>(lds, F.tid, DM, DM, DM, S, E);
    }
}
__device__ __forceinline__ void phase_down_dense(LAS unsigned char* lds, int wv, int l) {
    const Fr F = make_frame(lds, wv); unsigned char* ws = F.ws; const int nMact = (l == DEPTH - 1) ? NLAT / 256 : NTOK / 256;
    pg8::EpiResid E{};
    if ((DENSE_F8_MASK >> (l >> 1)) & 1) {
        SchedResid S{F.bid, F.G, nMact, DFF / 2, (const char*)(ws + WS_P), (const char*)w_dense(ws, l >> 1, W_DD), (char*)(ws + WS_XS), (const char*)(ws + WS_MODV + (size_t)l * 9 * 6144 * 4), 5120, nullptr, nullptr};
        pg8::gemm_phase<pg8::EpiResid, SchedResid, true, true, true>(lds, F.tid, DFF / 2, DFF / 2, DFF / 2, S, E, 119);
    } else {
        SchedResid S{F.bid, F.G, nMact, DFF, (const char*)(ws + WS_P), (const char*)w_dense(ws, l >> 1, W_DD), (char*)(ws + WS_XS), (const char*)(ws + WS_MODV + (size_t)l * 9 * 6144 * 4), 5120, nullptr, nullptr};
        pg8::gemm_phase<pg8::EpiResid, SchedResid, true, true>(lds, F.tid, DFF, DFF, DFF, S, E);
    }
    if (nMact == NTOK / 256 && F.bid >= 32) {
        int s, e; bg_window(2, l, s, e);
        if (e > s) convert_range(lds, F, s, e, (F.bid - 32) * 8 + F.wave, 224 * 8);
    }
}
__device__ __forceinline__ void phase_norm2_moe(LAS unsigned char* lds, int wv, int l) {
    const Fr F = make_frame(lds, wv); const int nrows = (l == DEPTH - 1) ? NLAT : NTOK; const int mi = l >> 1;
    volatile LAS unsigned* LCTL = (volatile LAS unsigned*)(lds + LDS_CTLOFF);
    const bf16_t* xs = (const bf16_t*)(F.ws + WS_XS); bf16_t* xn = (bf16_t*)(F.ws + WS_XN); const float* modv = (const float*)(F.ws + WS_MODV) + (size_t)l * 9 * 6144;
    const float* n2g = ARGP(lds, I_N2G) + l * DM;
    int* toklist = (int*)(F.ws + WS_MOE); int* rec = toklist + 8 * NTOK;
    const int rpb = nrows / F.G;
    const int tid = F.tid, lane = F.lane;
    LAS int* lrec = (LAS int*)(lds + 1024);
    const float* rw = ARGP(lds, I_RW) + (size_t)mi * DM * 8;
    for (int rr = F.wave; rr < rpb; rr += 8) {
        const int row = F.bid * rpb + rr;
        const RowV x = load_row_bf16(xs + (size_t)row * DM, lane);
        const float* mv = modv + (size_t)mod_row_of(row) * 6144;
        const RowV y = adaln_row(x, n2g, mv + 3072, mv + 4096, lane);
        float lg[8];
#pragma unroll
        for (int e = 0; e < 8; ++e) lg[e] = 0.f;
#pragma unroll
        for (int j = 0; j < 4; ++j)
#pragma unroll
            for (int cc = 0; cc < 4; ++cc) { const float* wp = rw + (size_t)(256 * j + 4 * lane + cc) * 8; const f32x4 w0 = *(const f32x4*)wp, w1 = *(const f32x4*)(wp + 4); const float hv = y.v[j][cc];
                lg[0] += hv * w0[0]; lg[1] += hv * w0[1]; lg[2] += hv * w0[2]; lg[3] += hv * w0[3]; lg[4] += hv * w1[0]; lg[5] += hv * w1[1]; lg[6] += hv * w1[2]; lg[7] += hv * w1[3]; }
#pragma unroll
        for (int e = 0; e < 8; ++e) lg[e] = wave_sum(lg[e]);
        int i0 = 0; float v0 = lg[0];
#pragma unroll
        for (int e = 1; e < 8; ++e) if (lg[e] > v0) { v0 = lg[e]; i0 = e; }
        int i1 = -1; float v1 = -3.0e38f;
#pragma unroll
        for (int e = 0; e < 8; ++e) if (e != i0 && lg[e] > v1) { v1 = lg[e]; i1 = e; }
        if (lane == 0) {
            const float w0 = 1.0f / (1.0f + expf(v1 - v0)), w1 = 1.0f - w0;
            lrec[rr * 6 + 0] = i0; lrec[rr * 6 + 2] = __float_as_int(w0); lrec[rr * 6 + 3] = i1; lrec[rr * 6 + 5] = __float_as_int(w1);
        }
    }
    __syncthreads();
    { const int e = F.wave; int cnt = 0;
      for (int a0 = 0; a0 < 2 * rpb; a0 += 64) { const int a = a0 + lane; const bool valid = a < 2 * rpb; const int rr = a >> 1, k3 = 3 * (a & 1);
          const bool match = valid && lrec[rr * 6 + k3] == e;
          const unsigned long long bal = __ballot(match);
          if (match) lrec[rr * 6 + k3 + 1] = cnt + (int)__popcll(bal & ((1ull << lane) - 1ull));
          cnt += (int)__popcll(bal); }
      if (lane == 0) { toklist[F.bid * 8 + e] = cnt;
          (void)xb_add(F.ctl + CW_CNT + 64 * (8 * mi + e), (unsigned)cnt); } }
    __syncthreads();
    for (int rr = tid; rr < rpb; rr += 512) {
        const int row = F.bid * rpb + rr;
        int* rc = rec + (size_t)row * 8;
        rc[0] = lrec[rr * 6 + 0]; rc[1] = lrec[rr * 6 + 1]; rc[2] = lrec[rr * 6 + 2]; rc[3] = lrec[rr * 6 + 3]; rc[4] = lrec[rr * 6 + 4]; rc[5] = lrec[rr * 6 + 5];
    }
}
__device__ __forceinline__ void phase_moe_gather(LAS unsigned char* lds, int wv, int l) {
    const Fr F = make_frame(lds, wv); const int mi = l >> 1; const int nrows = (l == DEPTH - 1) ? NLAT : NTOK; const int rpb = nrows / F.G;
    volatile LAS unsigned* LCTL = (volatile LAS unsigned*)(lds + LDS_CTLOFF);
    const MoeTiles mt = moe_tiles(F.ctl, mi);
    const GAS bf16_t* xn = (const GAS bf16_t*)(F.ws + WS_XN); GAS bf16_t* hs = (GAS bf16_t*)(F.ws + WS_HY);
    const GAS int* blkcnt = (const GAS int*)(F.ws + WS_MOE); GAS int* rec = (GAS int*)(F.ws + WS_MOE) + 8 * NTOK;
    LAS int* red = (LAS int*)(lds + 1024);
    { const int e = F.tid & 7, ch = F.tid >> 3; int s = 0;
#pragma unroll
      for (int j = 0; j < 4; ++j) { const int bb = ch * 4 + j; if (bb < F.bid) s += blkcnt[bb * 8 + e]; }
      red[e * 64 + ch] = s; }
    __syncthreads();
    if (F.tid < 8) { int s = 0; for (int ch = 0; ch < 64; ++ch) s += red[F.tid * 64 + ch]; LCTL[16 + F.tid] = (unsigned)s; }
    __syncthreads();
    LAS int* sl = (LAS int*)(lds + 4096);
    for (int rr = F.tid; rr < rpb; rr += 512) {
        GAS int* rc = rec + (size_t)(F.bid * rpb + rr) * 8;
        const int e0 = rc[0], e1 = rc[3];
        const int p0 = rc[1] + (int)LCTL[16 + e0], p1 = rc[4] + (int)LCTL[16 + e1];
        int t0 = 0, t1 = 0;
#pragma unroll
        for (int k = 0; k < 8; ++k) { t0 = (e0 == k) ? mt.tb[k] : t0; t1 = (e1 == k) ? mt.tb[k] : t1; }
        sl[rr * 2] = t0 * 256 + p0; sl[rr * 2 + 1] = t1 * 256 + p1;
        rc[1] = p0; rc[4] = p1;
    }
    __syncthreads();
    const bf16_t* xs = (const bf16_t*)(F.ws + WS_XS); const float* modv = (const float*)(F.ws + WS_MODV) + (size_t)l * 9 * 6144; const float* n2g = ARGP(lds, I_N2G) + l * DM;
    AdaCoef co; co.mr = -1;
    for (int r0 = F.wave * (rpb >> 3); r0 < (F.wave + 1) * (rpb >> 3); r0 += 3) {
        RowV x[3]; int s[3][2];
#pragma unroll
        for (int q = 0; q < 3; ++q) { const int rr = r0 + q; const bool ok = rr < (F.wave + 1) * (rpb >> 3);
            x[q] = load_row_bf16(xs + (size_t)(F.bid * rpb + (ok ? rr : r0)) * DM, F.lane);
            s[q][0] = ok ? sl[rr * 2] : -1; s[q][1] = ok ? sl[rr * 2 + 1] : -1; }
#pragma unroll
        for (int q = 0; q < 3; ++q) if (s[q][0] >= 0) { const int row = F.bid * rpb + r0 + q;
            ada_coef_update(co, row, n2g, modv, 3072, 4096, F.lane);
            const RowV y = adaln_apply(x[q], co);
            store_row_fp8((unsigned char*)hs + (size_t)s[q][0] * DM, y, F.lane); store_row_fp8((unsigned char*)hs + (size_t)s[q][1] * DM, y, F.lane); }
    }
    for (int idx = F.gw; idx < 8 * 256; idx += F.NGW) { const int e = idx >> 8, j = idx & 255;
        const int cnt = __builtin_amdgcn_readfirstlane((int)__hip_atomic_load(F.ctl + CW_CNT + 64 * (8 * mi + e), __ATOMIC_RELAXED, __HIP_MEMORY_SCOPE_AGENT));
        const int pad = ((cnt + 255) & ~255) - cnt; int tbe = 0;
#pragma unroll
        for (int k = 0; k < 8; ++k) tbe = (e == k) ? mt.tb[k] : tbe;
        if (j < pad) { unsigned z = 0u; asm volatile("" : "+v"(z));
            GAS u32x4* dp = (GAS u32x4*)((GAS unsigned char*)hs + (size_t)(tbe * 256 + cnt + j) * DM) + F.lane; dp[0] = (u32x4){z, z, z, z}; } }
}
__device__ __forceinline__ void phase_up_moe(LAS unsigned char* lds, int wv, int l) {
    const Fr F = make_frame(lds, wv); unsigned char* ws = F.ws; const int mi = l >> 1;
    const MoeTiles mt = moe_tiles(F.ctl, mi);
    SchedMoe S{F.bid, F.G, 28, DM / 2, mt.tb[8], mt, (const char*)(ws + WS_HY), (const char*)w_moe(ws, mi, 0, 0), W_MGU, (char*)(ws + WS_P), DFE, 128, 1};
    pg8::EpiSwigluF8 E{};
    pg8::gemm_phase<pg8::EpiSwigluF8, SchedMoe, true, true, true>(lds, F.tid, DM / 2, DM / 2, DM / 2, S, E, 120);
}
__device__ __forceinline__ void phase_down_moe(LAS unsigned char* lds, int wv, int l) {
    const Fr F = make_frame(lds, wv); unsigned char* ws = F.ws; const int mi = l >> 1;
    const MoeTiles mt = moe_tiles(F.ctl, mi);
    const int RT = mt.tb[8], RF = RT < MOE_RF ? RT : MOE_RF;
    pg8::EpiStore E{1.0f};
    { SchedMoe S{F.bid, F.G, 4, DFE / 2, RF, mt, (const char*)(ws + WS_P), (const char*)w_moe(ws, mi, 0, 0), W_MD, (char*)(ws + WS_HY), DM, 256, 2};
      pg8::gemm_phase<pg8::EpiStore, SchedMoe, true, true, true>(lds, F.tid, DFE / 2, DFE / 2, DFE / 2, S, E, 119); }
    if (RT > RF) {
        SchedMoeSplit S2{F.bid, F.G, RF, RT, mt, (const char*)(ws + WS_P), (const char*)w_moe(ws, mi, 0, 0), (char*)(ws + WS_HY), (char*)(ws + WS_Y1)};
        pg8::gemm_phase<pg8::EpiStore, SchedMoeSplit, true, true, true>(lds, F.tid, DFE / 4, DFE / 2, DFE / 2, S2, E, 119);
    }
}
__device__ __forceinline__ void phase_next_norm(LAS unsigned char* lds, int wv, int l) {
    const Fr F = make_frame(lds, wv); const bool lastl = l == DEPTH - 1; const int nrows = lastl ? NLAT : NTOK; const int mi = l >> 1;
    const bool moe = (l & 1) != 0;
    MoeTiles mt; if (moe) mt = moe_tiles(F.ctl, mi); else {
#pragma unroll
        for (int k = 0; k < 9; ++k) mt.tb[k] = 0; }
    bf16_t* xs = (bf16_t*)(F.ws + WS_XS); bf16_t* xn = (bf16_t*)(F.ws + WS_XN);
    const bf16_t* yb = (const bf16_t*)(F.ws + WS_HY); const bf16_t* yb1 = (const bf16_t*)(F.ws + WS_Y1); const int* rec = (const int*)(F.ws + WS_MOE) + 8 * NTOK;
    const float* modv = (const float*)(F.ws + WS_MODV) + (size_t)l * 9 * 6144;
    const float* modn = modv + 9 * 6144;
    const float* n1g = ARGP(lds, I_N1G) + (lastl ? 0 : (l + 1) * DM); const float* fg = ARGP(lds, I_FINALG); float* outp = (float*)ARGP(lds, 23);
    const int lane = F.lane;
    for (int row = F.gw; row < nrows; row += F.NGW) {
        RowV x = load_row_bf16(xs + (size_t)row * DM, lane);
        if (moe) {
            const int* rc = rec + (size_t)row * 8;
            const int e0 = rc[0], p0 = rc[1], e1 = rc[3], p1 = rc[4]; const float w0 = __int_as_float(rc[2]), w1 = __int_as_float(rc[5]);
            int t0 = 0, t1 = 0;
#pragma unroll
            for (int k = 0; k < 8; ++k) { t0 = (e0 == k) ? mt.tb[k] : t0; t1 = (e1 == k) ? mt.tb[k] : t1; }
            RowV y0 = load_row_bf16(yb + (size_t)(t0 * 256 + p0) * DM, lane), y1 = load_row_bf16(yb + (size_t)(t1 * 256 + p1) * DM, lane);
            { const int rt0 = t0 + (p0 >> 8), rt1 = t1 + (p1 >> 8);
              if (rt0 >= MOE_RF) { const RowV z = load_row_bf16(yb1 + (size_t)((rt0 - MOE_RF) * 256 + (p0 & 255)) * DM, lane);
#pragma unroll
                  for (int j = 0; j < 4; ++j) y0.v[j] += z.v[j]; }
              if (rt1 >= MOE_RF) { const RowV z = load_row_bf16(yb1 + (size_t)((rt1 - MOE_RF) * 256 + (p1 & 255)) * DM, lane);
#pragma unroll
                  for (int j = 0; j < 4; ++j) y1.v[j] += z.v[j]; } }
            const RowV g2 = load_row_f32(modv + (size_t)mod_row_of(row) * 6144 + 5120, lane);
#pragma unroll
            for (int j = 0; j < 4; ++j) x.v[j] += g2.v[j] * (w0 * y0.v[j] + w1 * y1.v[j]);
            if (!lastl) store_row_bf16(xs + (size_t)row * DM, x, lane);
        }
        if (!lastl) {
            const float* mv = modn + (size_t)mod_row_of(row) * 6144;
            const RowV y = adaln_row(x, n1g, mv, mv + 1024, lane);
            store_row_bf16(xn + (size_t)row * DM, y, lane);
            store_row_fp8(F.ws + WS_XN8 + (size_t)row * DM, y, lane);
        } else {
            float ss = 0.f;
#pragma unroll
            for (int j = 0; j < 4; ++j) ss += (x.v[j][0] * x.v[j][0] + x.v[j][1] * x.v[j][1]) + (x.v[j][2] * x.v[j][2] + x.v[j][3] * x.v[j][3]);
            const float rstd = 1.0f / sqrtf(wave_sum(ss) * (1.0f / DM) + 1e-6f);
            const RowV gv = load_row_f32(fg, lane);
            RowV y;
#pragma unroll
            for (int j = 0; j < 4; ++j) y.v[j] = x.v[j] * rstd * gv.v[j];
            store_row_f32(outp + (size_t)row * DM, y, lane);
        }
    }
}

__global__ void __launch_bounds__(512, 2) mega_fwd(Args a) {
    extern __shared__ __attribute__((aligned(16))) unsigned char lds_raw[];
    LAS unsigned char* lds = (LAS unsigned char*)lds_raw;
    volatile LAS unsigned* LCTL = (volatile LAS unsigned*)(lds + LDS_CTLOFF);
    const int wv = __builtin_amdgcn_readfirstlane((int)(threadIdx.x >> 6));
    {
        const int tid = threadIdx.x;
        for (int u = tid; u < 64; u += 512) LCTL[u] = 0u;
        if (tid == 0) { LAS unsigned long long* ap = (LAS unsigned long long*)(lds + LDS_ARGOFF);
#pragma unroll
            for (int i = 0; i < 23; ++i) ap[i] = (unsigned long long)a.in[i];
            ap[23] = (unsigned long long)a.out; ap[24] = (unsigned long long)a.ws; }
        __syncthreads();
    }
    (void)xcd_barrier_post((unsigned*)(a.ws + WS_CTL) + CW_BAR, LCTL);
    phase_prologue(lds, wv);
    grid_barrier(lds, wv);
#if DUP_PRO
    phase_prologue(lds, wv);
    grid_barrier(lds, wv);
#endif
    phase_first_norm(lds, wv);
    grid_barrier(lds, wv);
    for (int l = 0; l < DEPTH; ++l) {
        phase_inproj(lds, wv, l);  grid_barrier(lds, wv);
#if DUP_INPROJ
        phase_inproj(lds, wv, l);  grid_barrier(lds, wv);
#endif
        phase_post(lds, wv, l);    grid_barrier(lds, wv);
        phase_mix(lds, wv, l, 0);  grid_barrier(lds, wv);
#if DUP_MIX
        phase_mix(lds, wv, l, 1);  grid_barrier(lds, wv);
#endif
        phase_branch(lds, wv, l);  grid_barrier(lds, wv);
#if DUP_BRANCH
        phase_branch(lds, wv, l);  grid_barrier(lds, wv);
#endif
        phase_out(lds, wv, l);     grid_barrier(lds, wv);
        if ((l & 1) == 0) {
            phase_norm2_dense(lds, wv, l); grid_barrier(lds, wv);
#if DUP_N2D
            phase_norm2_dense(lds, wv, l); grid_barrier(lds, wv);
#endif
            phase_up_dense(lds, wv, l);    grid_barrier(lds, wv);
#if DUP_UPD
            phase_up_dense(lds, wv, l);    grid_barrier(lds, wv);
#endif
            phase_down_dense(lds, wv, l);  grid_barrier(lds, wv);
        } else {
            phase_norm2_moe(lds, wv, l);   grid_barrier(lds, wv);
            phase_moe_gather(lds, wv, l);  grid_barrier(lds, wv);
#if DUP_GATH
            phase_moe_gather(lds, wv, l);  grid_barrier(lds, wv);
#endif
            phase_up_moe(lds, wv, l);      grid_barrier(lds, wv);
#if DUP_MOEG == 1
            phase_up_moe(lds, wv, l);      grid_barrier(lds, wv);
#endif
            phase_down_moe(lds, wv, l);    grid_barrier(lds, wv);
#if DUP_MOEG == 2
            phase_down_moe(lds, wv, l);    grid_barrier(lds, wv);
#endif
        }
        phase_next_norm(lds, wv, l);
        if (l != DEPTH - 1) grid_barrier(lds, wv);
    }
}

extern "C" void kernel_launch(void* const* d_in, const int* in_sizes, int n_in, void* d_out, int out_size, void* d_ws, size_t ws_size, hipStream_t stream) {
    static int grid = 0;
    if (grid == 0) {
        if (n_in != 23 || out_size != NLAT * DM || ws_size < WS_END) { fprintf(stderr, "kernel_launch: unexpected problem (n_in %d out %d ws %zu need %zu)\n", n_in, out_size, ws_size, (size_t)WS_END); grid = -1; return; }
        int dev = 0, cus = 0, per_cu = 0;
        if (hipGetDevice(&dev) != hipSuccess || hipDeviceGetAttribute(&cus, hipDeviceAttributeMultiprocessorCount, dev) != hipSuccess) { grid = -1; return; }
        if (hipFuncSetAttribute((const void*)mega_fwd, hipFuncAttributeMaxDynamicSharedMemorySize, LDS_BYTES) != hipSuccess) { fprintf(stderr, "kernel_launch: hipFuncSetAttribute failed\n"); grid = -1; return; }
        if (hipOccupancyMaxActiveBlocksPerMultiprocessor(&per_cu, (const void*)mega_fwd, 512, LDS_BYTES) != hipSuccess || per_cu < 1) { fprintf(stderr, "kernel_launch: occupancy query says %d\n", per_cu); }
        (void)hipGetLastError();
        grid = cus;
        if (grid != 256) fprintf(stderr, "kernel_launch: %d CUs (built for 256)\n", grid);
    }
    if (grid < 0) return;
    (void)hipMemsetAsync((char*)d_ws + WS_CTL, 0, CTL_ZERO_BYTES, stream);
    Args a{};
    for (int i = 0; i < 23; ++i) a.in[i] = (const float*)d_in[i];
    a.out = (float*)d_out; a.ws = (unsigned char*)d_ws;
    hipLaunchKernelGGL(mega_fwd, dim3(grid), dim3(512), LDS_BYTES, stream, a);
}
```

```cpp
#include <hip/hip_runtime.h>
#include <cstdio>
#include <cstdint>

#ifndef DUP_MIX
#define DUP_MIX 0
#endif
#ifndef DUP_PRO
#define DUP_PRO 0
#endif
#ifndef DUP_BRANCH
#define DUP_BRANCH 0
#endif
#ifndef DUP_MOEG
#define DUP_MOEG 0
#endif
#ifndef DUP_UPD
#define DUP_UPD 0
#endif
#ifndef DUP_N2D
#define DUP_N2D 0
#endif
#ifndef DUP_GATH
#define DUP_GATH 0
#endif
#ifndef DUP_INPROJ
#define DUP_INPROJ 0
#endif
#ifndef DENSE_F8_MASK
#define DENSE_F8_MASK 0
#endif
#define LAS __attribute__((address_space(3)))
#define GAS __attribute__((address_space(1)))
typedef unsigned short bf16_t;
typedef short bf16x8 __attribute__((ext_vector_type(8)));
typedef short s16x4 __attribute__((ext_vector_type(4)));
typedef float f32x4 __attribute__((ext_vector_type(4)));
typedef float f32x16 __attribute__((ext_vector_type(16)));
typedef unsigned u32x4 __attribute__((ext_vector_type(4)));
typedef unsigned u32x2 __attribute__((ext_vector_type(2)));
typedef int i32x4 __attribute__((ext_vector_type(4)));
typedef int i32x8 __attribute__((ext_vector_type(8)));

constexpr int NB = 8, SEQ = 2048, DM = 1024, DEPTH = 4, CTXL = 256;
constexpr int NLAT = NB * SEQ, NCTX = NB * CTXL, NTOK = NLAT + NCTX;
constexpr int DIN = 7680, PW = 3072, GW = 4096;
constexpr int C_AQ = 0, C_AK = 512, C_AV = 1024, C_BQ = 1536, C_BK = 2048, C_BV = 2176, C_CQ = 2304, C_CK = 2816, C_CV = 2944;
constexpr int DFF = 2816, DFE = 3584, NEXP = 8;
constexpr int OW = 2048;
constexpr int MAXSLOT = 2 * NTOK + 2048;
constexpr float C2 = 0.125f * 1.4426950408889634f;
constexpr float LOG2E = 1.4426950408889634f;

constexpr size_t MiB = 1u << 20;
constexpr size_t WS_CTL = 0, CTL_ZERO_BYTES = 1 * MiB;
constexpr size_t WS_MODV = 1 * MiB;
constexpr size_t WS_ROPE = 2 * MiB;
constexpr size_t WS_T256 = 3 * MiB;
constexpr size_t WS_MOE = 4 * MiB;
constexpr size_t WS_SSC = WS_MOE + 3 * MiB / 2;
constexpr size_t WS_RSC = WS_MOE + 7 * MiB / 4;
constexpr size_t WS_T = 6 * MiB;
constexpr size_t WS_W = 22 * MiB;
constexpr size_t W_IN = 0, W_ING8 = 6 * MiB  , W_FZ = 14 * MiB, W_BR = 16 * MiB, W_OUT = 20 * MiB, W_LAYER = 22 * MiB;
constexpr size_t W_DENSE0 = 4 * W_LAYER, W_DGU = 0, W_DD = 11 * MiB, W_DENSE = 33 * MiB / 2;
constexpr size_t W_MOE0 = W_DENSE0 + 2 * W_DENSE, W_MGU = 0, W_MD = 14 * MiB, W_EXPERT = 21 * MiB, W_MOE = 8 * W_EXPERT;
constexpr size_t WS_XS = WS_W + W_MOE0 + 2 * W_MOE;
constexpr size_t WS_XN8 = WS_XS + 36 * MiB;
constexpr size_t WS_XN = WS_XS + 72 * MiB;
constexpr size_t WS_P = WS_XN + 36 * MiB;
constexpr size_t WS_G = WS_P + 108 * MiB;
constexpr size_t WS_ZZ = WS_P + 252 * MiB;
constexpr size_t WS_ZZC = WS_ZZ + 32 * MiB;
constexpr size_t WS_O = WS_ZZC + 4 * MiB;
constexpr size_t WS_HY = WS_O + 72 * MiB;
constexpr size_t WS_Y1 = WS_HY + 76 * MiB;
constexpr size_t WS_END = WS_Y1 + 16 * MiB;
constexpr int MOE_RF = 128;
static_assert(WS_W + W_MOE0 + 2 * W_MOE == 479 * MiB, "weights");
static_assert((size_t)MAXSLOT * DFE * 2 <= 288 * MiB, "moe hidden fits p+zz");
static_assert((size_t)MAXSLOT * 1024 * 2 <= 76 * MiB, "hs fits");
static_assert(WS_END <= 1074 * MiB, "workspace");

constexpr int CW_BAR = 4096;
constexpr int CW_Q = 16384;
constexpr int CW_CNT = 24576;

constexpr int LDS_CTLOFF = 141312;
constexpr int LDS_BYTES = 147456;

typedef float f32x2_t __attribute__((ext_vector_type(2))); typedef __bf16 bf16x2_t __attribute__((ext_vector_type(2)));
__device__ __forceinline__ unsigned cvt_pk_bf16(float lo, float hi) { f32x2_t v = {lo, hi}; bf16x2_t b = __builtin_convertvector(v, bf16x2_t); return __builtin_bit_cast(unsigned, b); }
__device__ __forceinline__ float clamp_f8(float v) { return __builtin_amdgcn_fmed3f(v, -448.0f, 448.0f); }
__device__ __forceinline__ unsigned cvt4_fp8(float a, float b, float c, float d) { int w = 0; w = __builtin_amdgcn_cvt_pk_fp8_f32(clamp_f8(a), clamp_f8(b), w, false); w = __builtin_amdgcn_cvt_pk_fp8_f32(clamp_f8(c), clamp_f8(d), w, true); return (unsigned)w; }
__device__ __forceinline__ unsigned pack4_i8(float a, float b, float c, float d) {
    const int ia = (int)__builtin_rintf(__builtin_amdgcn_fmed3f(a, -127.0f, 127.0f)), ib = (int)__builtin_rintf(__builtin_amdgcn_fmed3f(b, -127.0f, 127.0f));
    const int ic = (int)__builtin_rintf(__builtin_amdgcn_fmed3f(c, -127.0f, 127.0f)), id = (int)__builtin_rintf(__builtin_amdgcn_fmed3f(d, -127.0f, 127.0f));
    return ((unsigned)ia & 255u) | (((unsigned)ib & 255u) << 8) | (((unsigned)ic & 255u) << 16) | ((unsigned)id << 24); }
constexpr float W8_GU = 127.0f * 32.0f / 6.0f;
__device__ __forceinline__ float bf_lo(unsigned w) { return __uint_as_float(w << 16); }
__device__ __forceinline__ float bf_hi(unsigned w) { return __uint_as_float(w & 0xffff0000u); }
__device__ __forceinline__ float bf2f(bf16_t h) { return __uint_as_float(((unsigned)h) << 16); }
__device__ __forceinline__ bf16_t f2bf(float f) { unsigned u = __float_as_uint(f); u += 0x7fffu + ((u >> 16) & 1u); return (bf16_t)(u >> 16); }
__device__ __forceinline__ float fast_exp2(float x) { return __builtin_amdgcn_exp2f(x); }
__device__ __forceinline__ float fast_rcp(float x) { return __builtin_amdgcn_rcpf(x); }
__device__ __forceinline__ float sigmoidf_(float x) { return fast_rcp(1.0f + fast_exp2(-x * LOG2E)); }
__device__ __forceinline__ float siluf_(float x) { return x * sigmoidf_(x); }
__device__ __forceinline__ float wave_sum(float v) {
#pragma unroll
    for (int o = 1; o < 64; o <<= 1) v += __shfl_xor(v, o);
    return v;
}
#define LDS_WAIT() asm volatile("s_waitcnt lgkmcnt(0)" ::: "memory")
__device__ __forceinline__ int lane_id() { int l; asm volatile("v_mbcnt_lo_u32_b32 %0, -1, 0\n\tv_mbcnt_hi_u32_b32 %0, -1, %0" : "=v"(l)); return l; }

namespace pg8 {
constexpr int BM = 256, BK = 64, HALF = 128, HTB = HALF * BK * 2, STAGE_BYTES = 8 * HTB, NXCD = 8, WGM = 8;
__host__ __device__ __forceinline__ int lds_byte(int r, int c) { const int st = (r >> 4) * 2 + (c >> 5), rr = r & 15, cc = c & 31, ob = rr * 64 + cc * 2; return st * 1024 + (ob ^ (((ob >> 9) & 1) << 5)); }
__host__ __device__ __forceinline__ void stage_rc(int b, int& R, int& C) { const int st = b / 1024, sb = b % 1024, swz = sb ^ (((sb >> 9) & 1) << 5); R = (st >> 1) * 16 + swz / 64; C = (st & 1) * 32 + (swz % 64) / 2; }
__host__ __device__ __forceinline__ int perm32(int rho) { const int n = rho >> 4, i = rho & 15; return 8 * (i >> 2) + 4 * n + (i & 3); }

struct Unit { const char* A; const char* B; char* out; const char* aux; const char* aux2; int ldc; int flag; };

__device__ __forceinline__ void tile_of(int L, int nM, int nN, int& pm, int& pn) {
    const int nwg = nM * nN; int wgid = L;
    { const int q = nwg / NXCD, r = nwg % NXCD, xcd = wgid % NXCD, off = wgid / NXCD; wgid = (xcd < r ? xcd * (q + 1) : r * (q + 1) + (xcd - r) * q) + off; }
    const int nig = WGM * nN, gid = wgid / nig, fm = gid * WGM, gsz = (nM - fm) < WGM ? (nM - fm) : WGM;
    pm = fm + ((wgid % nig) % gsz); pn = (wgid % nig) / gsz;
}

__device__ __forceinline__ i32x8 cat8(const bf16x8 a, const bf16x8 b) { return __builtin_shufflevector(__builtin_bit_cast(i32x4, a), __builtin_bit_cast(i32x4, b), 0, 1, 2, 3, 4, 5, 6, 7); }
template <class Epi, class Sched, bool ALIGN_EPI, bool SP2, int QM = 0>
__device__ __forceinline__ void gemm_phase(LAS unsigned char* lds, const int tid, const int K, const int lda, const int ldb, const Sched& S, const Epi& E, const int wsc = 127) {
    const int wid = __builtin_amdgcn_readfirstlane(tid >> 6), lane = tid & 63, wr = wid >> 2, wc = wid & 3, fr = lane & 15, fq = lane >> 4;
    const int nt = K / BK;
    unsigned voffA[2], voffB[2];
#pragma unroll
    for (int i = 0; i < 2; ++i) { int R, C; stage_rc(tid * 16 + i * 8192, R, C); const int Rb = Epi::PERM ? ((R & ~31) + perm32(R & 31)) : R;
        voffA[i] = (unsigned)(R * lda + C) * 2u; voffB[i] = (unsigned)(Rb * ldb + C) * 2u; }
    const size_t kstep = (size_t)(BK * 2);
    const size_t hstepA = (size_t)HALF * lda * 2, hstepB = (size_t)HALF * ldb * 2;
    const unsigned ldsw = (unsigned)wid * 1024u;
    const int aoff = lds_byte(wr * 64 + fr, fq * 8), boff = lds_byte(wc * 32 + fr, fq * 8);
#define PG8_SA(b, h) (((b) * 2 + (h)) * HTB)
#define PG8_SB(b, h) ((4 + (b) * 2 + (h)) * HTB)
#define PG8_STAGE(bufoff, gbase, voff) do { _Pragma("unroll") for (int _i = 0; _i < 2; ++_i) \
        __builtin_amdgcn_global_load_lds((const unsigned*)((const char*)(gbase) + (voff)[_i]), (LAS unsigned*)(lds + (bufoff) + ldsw + _i * 8192), 16, 0, 0); } while (0)
#define PG8_LDA(dst, b, h) do { _Pragma("unroll") for (int m = 0; m < 4; ++m) _Pragma("unroll") for (int k = 0; k < 2; ++k) dst[m][k] = *(const LAS bf16x8*)(lds + PG8_SA(b, h) + aoff + m * 2048 + k * 1024); } while (0)
#define PG8_LDB(dst, b, h) do { _Pragma("unroll") for (int n = 0; n < 2; ++n) _Pragma("unroll") for (int k = 0; k < 2; ++k) dst[n][k] = *(const LAS bf16x8*)(lds + PG8_SB(b, h) + boff + n * 2048 + k * 1024); } while (0)
#define PG8_MMA(ai, bj, At, Bt) do { __builtin_amdgcn_s_setprio(1); _Pragma("unroll") for (int m = 0; m < 4; ++m) _Pragma("unroll") for (int n = 0; n < 2; ++n) { \
        if constexpr (QM == 2) { _Pragma("unroll") for (int k = 0; k < 2; ++k) acc[ai][bj][m][n] = __builtin_bit_cast(f32x4, __builtin_amdgcn_mfma_i32_16x16x64_i8(__builtin_bit_cast(i32x4, Bt[n][k]), __builtin_bit_cast(i32x4, At[m][k]), __builtin_bit_cast(i32x4, acc[ai][bj][m][n]), 0, 0, 0)); \
            asm volatile("" : "+v"(acc[ai][bj][m][n])); } \
        else if constexpr (QM == 1) { acc[ai][bj][m][n] = __builtin_amdgcn_mfma_scale_f32_16x16x128_f8f6f4(cat8(Bt[n][0], Bt[n][1]), cat8(At[m][0], At[m][1]), acc[ai][bj][m][n], 0, 0, 0, wsc, 0, 127); \
            asm volatile("" : "+v"(acc[ai][bj][m][n]));   } \
        else { _Pragma("unroll") for (int k = 0; k < 2; ++k) acc[ai][bj][m][n] = __builtin_amdgcn_mfma_f32_16x16x32_bf16(Bt[n][k], At[m][k], acc[ai][bj][m][n], 0, 0, 0); } } __builtin_amdgcn_s_setprio(0); } while (0)
#define PG8_WAIT_V(n) asm volatile("s_waitcnt vmcnt(" #n ")" ::: "memory")
#define PG8_WAIT_L(n) asm volatile("s_waitcnt lgkmcnt(" #n ")" ::: "memory")
#define PG8_BAR __builtin_amdgcn_s_barrier()
#define PG8_SCHED __builtin_amdgcn_sched_barrier(0)
    Unit cur, nxt; int ui = 0;
    if (!S.next(0, cur)) return;
    f32x4 acc[2][2][4][2];
#pragma unroll
    for (int a = 0; a < 2; ++a)
#pragma unroll
        for (int b = 0; b < 2; ++b)
#pragma unroll
            for (int m = 0; m < 4; ++m)
#pragma unroll
                for (int n = 0; n < 2; ++n) acc[a][b][m][n] = (f32x4){0.f, 0.f, 0.f, 0.f};
    bf16x8 At[4][2], B0[2][2], B1[2][2];
    const char* cA = cur.A; const char* cB = cur.B;
    if constexpr (SP2) {
        PG8_STAGE(PG8_SB(0, 0), cB, voffB); PG8_STAGE(PG8_SB(0, 1), cB + hstepB, voffB); PG8_STAGE(PG8_SA(0, 0), cA, voffA); PG8_STAGE(PG8_SA(0, 1), cA + hstepA, voffA);
        if (wr == 1) PG8_BAR;
        PG8_WAIT_V(2); PG8_BAR;
        PG8_STAGE(PG8_SB(1, 0), cB + kstep, voffB); PG8_STAGE(PG8_SA(1, 0), cA + kstep, voffA); PG8_STAGE(PG8_SB(1, 1), cB + hstepB + kstep, voffB);
        PG8_WAIT_V(6); PG8_BAR;
    } else {
        PG8_STAGE(PG8_SB(0, 0), cB, voffB); PG8_STAGE(PG8_SA(0, 0), cA, voffA); PG8_STAGE(PG8_SB(0, 1), cB + hstepB, voffB); PG8_STAGE(PG8_SA(0, 1), cA + hstepA, voffA);
        if (wr == 1) PG8_BAR;
        PG8_WAIT_V(4); PG8_BAR;
        PG8_STAGE(PG8_SB(1, 0), cB + kstep, voffB); PG8_STAGE(PG8_SA(1, 0), cA + kstep, voffA); PG8_STAGE(PG8_SB(1, 1), cB + hstepB + kstep, voffB);
        PG8_WAIT_V(6); PG8_BAR;
    }
    for (;;) {
        const bool has_next = S.next(ui + 1, nxt);
        const char* nA = has_next ? nxt.A : cA; const char* nB = has_next ? nxt.B : cB;
        for (int t = 0; t < nt; t += 2) {
            const bool last = (t == nt - 2);
            const char* a1 = cA + (size_t)(t + 1) * kstep;
            const char* a2 = last ? nA : cA + (size_t)(t + 2) * kstep; const char* b2 = last ? nB : cB + (size_t)(t + 2) * kstep;
            const char* a3 = a2 + kstep; const char* b3 = b2 + kstep;
            if constexpr (SP2) {
            PG8_LDB(B0, 0, 0); PG8_LDB(B1, 0, 1); PG8_SCHED; PG8_LDA(At, 0, 0); PG8_STAGE(PG8_SA(1, 1), a1 + hstepA, voffA);
            PG8_WAIT_V(8); PG8_WAIT_L(0); PG8_BAR; PG8_MMA(0, 0, At, B0); PG8_MMA(0, 1, At, B1); PG8_BAR; PG8_SCHED;
            PG8_LDA(At, 0, 1); PG8_STAGE(PG8_SB(0, 0), b2, voffB); PG8_STAGE(PG8_SB(0, 1), b2 + hstepB, voffB); PG8_STAGE(PG8_SA(0, 0), a2, voffA);
            PG8_WAIT_V(8); PG8_WAIT_L(0); PG8_BAR; PG8_MMA(1, 0, At, B0); PG8_MMA(1, 1, At, B1); PG8_BAR; PG8_SCHED;
            PG8_LDB(B0, 1, 0); PG8_LDB(B1, 1, 1); PG8_SCHED; PG8_LDA(At, 1, 0); PG8_STAGE(PG8_SA(0, 1), a2 + hstepA, voffA);
            PG8_WAIT_V(8); PG8_WAIT_L(0); PG8_BAR; PG8_MMA(0, 0, At, B0); PG8_MMA(0, 1, At, B1); PG8_BAR; PG8_SCHED;
            PG8_LDA(At, 1, 1); PG8_STAGE(PG8_SB(1, 0), b3, voffB); PG8_STAGE(PG8_SB(1, 1), b3 + hstepB, voffB); PG8_STAGE(PG8_SA(1, 0), a3, voffA);
            PG8_WAIT_V(8); PG8_WAIT_L(0); PG8_BAR; PG8_MMA(1, 0, At, B0); PG8_MMA(1, 1, At, B1); PG8_BAR; PG8_SCHED;
            } else {
            PG8_LDB(B0, 0, 0); PG8_SCHED; PG8_LDA(At, 0, 0); PG8_STAGE(PG8_SA(1, 1), a1 + hstepA, voffA);
            PG8_WAIT_L(8); PG8_BAR; PG8_WAIT_L(0); PG8_MMA(0, 0, At, B0); PG8_BAR; PG8_SCHED;
            PG8_LDB(B1, 0, 1); PG8_STAGE(PG8_SB(0, 0), b2, voffB);
            PG8_BAR; PG8_WAIT_L(0); PG8_MMA(0, 1, At, B1); PG8_BAR;
            PG8_LDA(At, 0, 1); PG8_STAGE(PG8_SA(0, 0), a2, voffA);
            PG8_BAR; PG8_WAIT_L(0); PG8_MMA(1, 0, At, B0); PG8_BAR; PG8_SCHED;
            PG8_STAGE(PG8_SB(0, 1), b2 + hstepB, voffB);
            PG8_WAIT_V(6); PG8_BAR; PG8_MMA(1, 1, At, B1); PG8_BAR;
            PG8_LDB(B0, 1, 0); PG8_SCHED; PG8_LDA(At, 1, 0); PG8_STAGE(PG8_SA(0, 1), a2 + hstepA, voffA);
            PG8_WAIT_L(8); PG8_BAR; PG8_WAIT_L(0); PG8_MMA(0, 0, At, B0); PG8_BAR; PG8_SCHED;
            PG8_LDB(B1, 1, 1); PG8_STAGE(PG8_SB(1, 0), b3, voffB);
            PG8_BAR; PG8_WAIT_L(0); PG8_MMA(0, 1, At, B1); PG8_BAR;
            PG8_LDA(At, 1, 1); PG8_STAGE(PG8_SA(1, 0), a3, voffA);
            PG8_BAR; PG8_WAIT_L(0); PG8_MMA(1, 0, At, B0); PG8_BAR; PG8_SCHED;
            PG8_STAGE(PG8_SB(1, 1), b3 + hstepB, voffB);
            PG8_WAIT_V(6); PG8_BAR; PG8_MMA(1, 1, At, B1); PG8_BAR;
            }
        }
        if constexpr (ALIGN_EPI) { if (wr == 0) PG8_BAR; }
        E(acc, cur, wr, wc, fr, fq);
        if (!has_next) break;
#pragma unroll
        for (int a = 0; a < 2; ++a)
#pragma unroll
            for (int b = 0; b < 2; ++b)
#pragma unroll
                for (int m = 0; m < 4; ++m)
#pragma unroll
                    for (int n = 0; n < 2; ++n) acc[a][b][m][n] = (f32x4){0.f, 0.f, 0.f, 0.f};
        cur = nxt; cA = nA; cB = nB; ++ui;
        if constexpr (ALIGN_EPI) { if (wr == 1) PG8_BAR; }
    }
    PG8_WAIT_V(0);
    if constexpr (!ALIGN_EPI) { if (wr == 0) PG8_BAR; }
    PG8_BAR;
#undef PG8_SA
#undef PG8_SB
#undef PG8_STAGE
#undef PG8_LDA
#undef PG8_LDB
#undef PG8_MMA
#undef PG8_WAIT_V
#undef PG8_WAIT_L
#undef PG8_BAR
#undef PG8_SCHED
}

struct EpiStore {
    static constexpr bool PERM = true;
    float scale;
    __device__ __forceinline__ void operator()(const f32x4 (&acc)[2][2][4][2], const Unit& u, int wr, int wc, int fr, int fq) const {
        bf16_t* base = (bf16_t*)u.out + (size_t)(wr * 64 + fr) * u.ldc + wc * 32 + 8 * fq;
        const bool sg = u.flag == 1;
#pragma unroll
        for (int ai = 0; ai < 2; ++ai)
#pragma unroll
            for (int m = 0; m < 4; ++m) { bf16_t* rowp = base + (size_t)(ai * HALF + m * 16) * u.ldc;
#pragma unroll
                for (int bj = 0; bj < 2; ++bj) { f32x4 v0 = acc[ai][bj][m][0] * scale, v1 = acc[ai][bj][m][1] * scale;
                    if (sg) {
#pragma unroll
                        for (int j = 0; j < 4; ++j) { v0[j] = sigmoidf_(v0[j]); v1[j] = sigmoidf_(v1[j]); } }
                    u32x4 w; w.x = cvt_pk_bf16(v0[0], v0[1]); w.y = cvt_pk_bf16(v0[2], v0[3]); w.z = cvt_pk_bf16(v1[0], v1[1]); w.w = cvt_pk_bf16(v1[2], v1[3]);
                    *(u32x4*)(rowp + bj * HALF) = w; } }
    }
};
struct EpiInproj {
    static constexpr bool PERM = true;
    __device__ __forceinline__ void operator()(const f32x4 (&acc)[2][2][4][2], const Unit& u, int wr, int wc, int fr, int fq) const {
        GAS bf16_t* base = (GAS bf16_t*)u.out + (size_t)(wr * 64 + fr) * u.ldc + wc * 32 + 8 * fq;
        const bool lat = (u.flag & 16) != 0, r0 = lat && (u.flag & 6) != 0, r1 = lat && (u.flag & 2) != 0;
        const float qs = (u.flag & 8) ? C2 : 1.0f;
        const GAS float* rp = (const GAS float*)u.aux + (size_t)(wr * 64 + fr) * 64 + (wc & 1) * 32 + 4 * fq;
#pragma unroll
        for (int ai = 0; ai < 2; ++ai)
#pragma unroll
            for (int m = 0; m < 4; ++m) { GAS bf16_t* rowp = base + (size_t)(ai * HALF + m * 16) * u.ldc;
                f32x4 cs = (f32x4){1.f, 1.f, 1.f, 1.f}, sn = (f32x4){0.f, 0.f, 0.f, 0.f};
                if (r0) { const GAS float* rt = rp + (size_t)(ai * HALF + m * 16) * 64; cs = *(const GAS f32x4*)rt; sn = *(const GAS f32x4*)(rt + 16); }
#pragma unroll
                for (int bj = 0; bj < 2; ++bj) { f32x4 v0 = acc[ai][bj][m][0], v1 = acc[ai][bj][m][1];
                    if (bj == 0 ? r0 : r1) {
                        const float a0 = v0[0] * cs[0] - v0[1] * sn[0], a1 = v0[1] * cs[0] + v0[0] * sn[0], a2 = v0[2] * cs[1] - v0[3] * sn[1], a3 = v0[3] * cs[1] + v0[2] * sn[1];
                        const float b0 = v1[0] * cs[2] - v1[1] * sn[2], b1 = v1[1] * cs[2] + v1[0] * sn[2], b2 = v1[2] * cs[3] - v1[3] * sn[3], b3 = v1[3] * cs[3] + v1[2] * sn[3];
                        v0 = (f32x4){a0, a1, a2, a3}; v1 = (f32x4){b0, b1, b2, b3}; }
                    v0 *= qs; v1 *= qs;
                    u32x4 w; w.x = cvt_pk_bf16(v0[0], v0[1]); w.y = cvt_pk_bf16(v0[2], v0[3]); w.z = cvt_pk_bf16(v1[0], v1[1]); w.w = cvt_pk_bf16(v1[2], v1[3]);
                    *(GAS u32x4*)(rowp + bj * HALF) = w; } }
    }
};
struct EpiGate {
    static constexpr bool PERM = true;
    __device__ __forceinline__ void operator()(const f32x4 (&acc)[2][2][4][2], const Unit& u, int wr, int wc, int fr, int fq) const {
        GAS unsigned char* base = (GAS unsigned char*)u.out + (size_t)(wr * 64 + fr) * GW + wc * 32 + 8 * fq;
#pragma unroll
        for (int ai = 0; ai < 2; ++ai)
#pragma unroll
            for (int m = 0; m < 4; ++m) { GAS unsigned char* rowp = base + (size_t)(ai * HALF + m * 16) * GW;
#pragma unroll
                for (int bj = 0; bj < 2; ++bj) { const f32x4 v0 = acc[ai][bj][m][0], v1 = acc[ai][bj][m][1];
                    unsigned q[8];
#pragma unroll
                    for (int j = 0; j < 4; ++j) { q[j] = (unsigned)(fast_rcp(1.0f + fast_exp2(v0[j])) * 255.0f + 0.5f); q[4 + j] = (unsigned)(fast_rcp(1.0f + fast_exp2(v1[j])) * 255.0f + 0.5f); }
                    u32x2 w8; w8.x = q[0] | (q[1] << 8) | (q[2] << 16) | (q[3] << 24); w8.y = q[4] | (q[5] << 8) | (q[6] << 16) | (q[7] << 24);
                    *(GAS u32x2*)(rowp + bj * HALF) = w8; } }
    }
};
struct EpiSwiglu {
    static constexpr bool PERM = true;
    __device__ __forceinline__ void operator()(const f32x4 (&acc)[2][2][4][2], const Unit& u, int wr, int wc, int fr, int fq) const {
        bf16_t* base = (bf16_t*)u.out + (size_t)(wr * 64 + fr) * u.ldc + wc * 32 + 8 * fq;
#pragma unroll
        for (int ai = 0; ai < 2; ++ai)
#pragma unroll
            for (int m = 0; m < 4; ++m) { bf16_t* rowp = base + (size_t)(ai * HALF + m * 16) * u.ldc;
                f32x4 g0 = acc[ai][0][m][0], g1 = acc[ai][0][m][1]; const f32x4 u0 = acc[ai][1][m][0], u1 = acc[ai][1][m][1];
#pragma unroll
                for (int j = 0; j < 4; ++j) { g0[j] = siluf_(g0[j]) * u0[j]; g1[j] = siluf_(g1[j]) * u1[j]; }
                u32x4 w; w.x = cvt_pk_bf16(g0[0], g0[1]); w.y = cvt_pk_bf16(g0[2], g0[3]); w.z = cvt_pk_bf16(g1[0], g1[1]); w.w = cvt_pk_bf16(g1[2], g1[3]);
                *(u32x4*)rowp = w; }
    }
};
struct EpiSwigluF8 {
    static constexpr bool PERM = true;
    __device__ __forceinline__ void operator()(const f32x4 (&acc)[2][2][4][2], const Unit& u, int wr, int wc, int fr, int fq) const {
        GAS unsigned char* base = (GAS unsigned char*)u.out + (size_t)(wr * 64 + fr) * u.ldc + wc * 32 + 8 * fq;
#pragma unroll
        for (int ai = 0; ai < 2; ++ai)
#pragma unroll
            for (int m = 0; m < 4; ++m) { GAS unsigned char* rowp = base + (size_t)(ai * HALF + m * 16) * u.ldc;
                f32x4 g0 = acc[ai][0][m][0], g1 = acc[ai][0][m][1]; const f32x4 u0 = acc[ai][1][m][0], u1 = acc[ai][1][m][1];
#pragma unroll
                for (int j = 0; j < 4; ++j) { g0[j] = siluf_(g0[j]) * u0[j]; g1[j] = siluf_(g1[j]) * u1[j]; }
                u32x2 w; w.x = cvt4_fp8(g0[0], g0[1], g0[2], g0[3]); w.y = cvt4_fp8(g1[0], g1[1], g1[2], g1[3]);
                *(GAS u32x2*)rowp = w; }
    }
};
template <bool F8OUT> struct EpiSwigluI8 {
    static constexpr bool PERM = true;
    float wsc;
    __device__ __forceinline__ void operator()(const f32x4 (&acc)[2][2][4][2], const Unit& u, int wr, int wc, int fr, int fq) const {
        constexpr int EB = F8OUT ? 1 : 2;
        GAS unsigned char* base = (GAS unsigned char*)u.out + ((size_t)(wr * 64 + fr) * u.ldc + wc * 32 + 8 * fq) * EB;
        const GAS float* rs = (const GAS float*)u.aux + wr * 64 + fr;
        float sc[8];
#pragma unroll
        for (int q = 0; q < 8; ++q) sc[q] = rs[(q >> 2) * HALF + (q & 3) * 16] * wsc;
#pragma unroll
        for (int ai = 0; ai < 2; ++ai)
#pragma unroll
            for (int m = 0; m < 4; ++m) { GAS unsigned char* rowp = base + (size_t)(ai * HALF + m * 16) * u.ldc * EB; const float f = sc[ai * 4 + m];
                const i32x4 gi0 = __builtin_bit_cast(i32x4, acc[ai][0][m][0]), gi1 = __builtin_bit_cast(i32x4, acc[ai][0][m][1]), ui0 = __builtin_bit_cast(i32x4, acc[ai][1][m][0]), ui1 = __builtin_bit_cast(i32x4, acc[ai][1][m][1]);
                f32x4 g0, g1;
#pragma unroll
                for (int j = 0; j < 4; ++j) { const float a = (float)gi0[j] * f, b = (float)gi1[j] * f; g0[j] = siluf_(a) * ((float)ui0[j] * f); g1[j] = siluf_(b) * ((float)ui1[j] * f); }
                if constexpr (F8OUT) { u32x2 w; w.x = cvt4_fp8(g0[0], g0[1], g0[2], g0[3]); w.y = cvt4_fp8(g1[0], g1[1], g1[2], g1[3]); *(GAS u32x2*)rowp = w; }
                else { u32x4 w; w.x = cvt_pk_bf16(g0[0], g0[1]); w.y = cvt_pk_bf16(g0[2], g0[3]); w.z = cvt_pk_bf16(g1[0], g1[1]); w.w = cvt_pk_bf16(g1[2], g1[3]); *(GAS u32x4*)rowp = w; } }
    }
};
struct EpiResid {
    static constexpr bool PERM = true;
    __device__ __forceinline__ void operator()(const f32x4 (&acc)[2][2][4][2], const Unit& u, int wr, int wc, int fr, int fq) const {
        GAS bf16_t* base = (GAS bf16_t*)u.out + (size_t)(wr * 64 + fr) * u.ldc + wc * 32 + 8 * fq;
        const size_t roff = (size_t)(wr * 64 + fr) * u.ldc + wc * 32 + 8 * fq;
        const bool srcf = u.flag == 1;
        const GAS float* g = (const GAS float*)u.aux + wc * 32 + 8 * fq;
        f32x4 gv[2][2];
#pragma unroll
        for (int bj = 0; bj < 2; ++bj)
#pragma unroll
            for (int n = 0; n < 2; ++n) gv[bj][n] = *(const GAS f32x4*)(g + bj * HALF + n * 4);
#pragma unroll
        for (int ai = 0; ai < 2; ++ai)
#pragma unroll
            for (int m = 0; m < 4; ++m) { const size_t ro = (size_t)(ai * HALF + m * 16) * u.ldc;
#pragma unroll
                for (int bj = 0; bj < 2; ++bj) {
                    f32x4 r0, r1;
                    if (srcf) { const GAS float* sp = (const GAS float*)u.aux2 + roff + ro + bj * HALF; r0 = *(const GAS f32x4*)sp; r1 = *(const GAS f32x4*)(sp + 4); }
                    else { const u32x4 w = *(const GAS u32x4*)((const GAS bf16_t*)u.aux2 + roff + ro + bj * HALF);
                        r0 = (f32x4){bf_lo(w.x), bf_hi(w.x), bf_lo(w.y), bf_hi(w.y)}; r1 = (f32x4){bf_lo(w.z), bf_hi(w.z), bf_lo(w.w), bf_hi(w.w)}; }
                    const f32x4 v0 = r0 + gv[bj][0] * acc[ai][bj][m][0], v1 = r1 + gv[bj][1] * acc[ai][bj][m][1];
                    u32x4 o; o.x = cvt_pk_bf16(v0[0], v0[1]); o.y = cvt_pk_bf16(v0[2], v0[3]); o.z = cvt_pk_bf16(v1[0], v1[1]); o.w = cvt_pk_bf16(v1[2], v1[3]);
                    *(GAS u32x4*)(base + ro + bj * HALF) = o; }
                asm volatile("" ::: "memory"); }
    }
};
struct BUnit { const char* A; const char* B; const char* gate; char* out; };
__device__ __forceinline__ void gload8_async(u32x2& dst, const void* p) { asm volatile("global_load_dwordx2 %0, %1, off" : "=&v"(dst) : "v"(p) : "memory"); }
template <class Sched>
__device__ __forceinline__ void branch_phase(LAS unsigned char* lds, const int tid, const Sched& S) {
    const int wid = __builtin_amdgcn_readfirstlane(tid >> 6), lane = tid & 63, wr = wid >> 2, wc = wid & 3, fr = lane & 15, fq = lane >> 4;
    constexpr int K = 2048, nt = K / BK, lda = 2048, ldb = 2048;
    unsigned voffA[2], voffB[2];
#pragma unroll
    for (int i = 0; i < 2; ++i) { int R, C; stage_rc(tid * 16 + i * 8192, R, C); const int Rb = (R & ~31) + perm32(R & 31);
        voffA[i] = (unsigned)(R * lda + C) * 2u; voffB[i] = (unsigned)(Rb * ldb + C) * 2u; }
    const size_t kstep = (size_t)(BK * 2);
    const size_t hstepA = (size_t)HALF * lda * 2;
    const unsigned ldsw = (unsigned)wid * 1024u;
    const int aoff = lds_byte(wr * 64 + fr, fq * 8), boff = lds_byte(wc * 32 + fr, fq * 8);
#define BR_SA(b, h) (((b) * 2 + (h)) * HTB)
#define BR_SB(b) ((4 + (b) * 2) * HTB)
#define BR_STAGE(bufoff, gbase, voff) do { _Pragma("unroll") for (int _i = 0; _i < 2; ++_i) \
        __builtin_amdgcn_global_load_lds((const unsigned*)((const char*)(gbase) + (voff)[_i]), (LAS unsigned*)(lds + (bufoff) + ldsw + _i * 8192), 16, 0, 0); } while (0)
#define BR_LDA(dst, b, h) do { _Pragma("unroll") for (int m = 0; m < 4; ++m) _Pragma("unroll") for (int k = 0; k < 2; ++k) dst[m][k] = *(const LAS bf16x8*)(lds + BR_SA(b, h) + aoff + m * 2048 + k * 1024); } while (0)
#define BR_LDB(dst, b) do { _Pragma("unroll") for (int n = 0; n < 2; ++n) _Pragma("unroll") for (int k = 0; k < 2; ++k) dst[n][k] = *(const LAS bf16x8*)(lds + BR_SB(b) + boff + n * 2048 + k * 1024); } while (0)
#define BR_MMA(ai) do { __builtin_amdgcn_s_setprio(1); _Pragma("unroll") for (int m = 0; m < 4; ++m) _Pragma("unroll") for (int n = 0; n < 2; ++n) _Pragma("unroll") for (int k = 0; k < 2; ++k) \
        acc[ai][m][n] = __builtin_amdgcn_mfma_f32_16x16x32_bf16(B0[n][k], At[m][k], acc[ai][m][n], 0, 0, 0); __builtin_amdgcn_s_setprio(0); } while (0)
#define BR_WAIT_V(n) asm volatile("s_waitcnt vmcnt(" #n ")" ::: "memory")
#define BR_WAIT_L0 asm volatile("s_waitcnt lgkmcnt(0)" ::: "memory")
#define BR_BAR __builtin_amdgcn_s_barrier()
#define BR_SCHED __builtin_amdgcn_sched_barrier(0)
    BUnit cur, nxt; int ui = 0;
    if (!S.next(0, cur)) return;
    f32x4 acc[2][4][2], macc[2][4][2];
#pragma unroll
    for (int a = 0; a < 2; ++a)
#pragma unroll
        for (int m = 0; m < 4; ++m)
#pragma unroll
            for (int n = 0; n < 2; ++n) { acc[a][m][n] = (f32x4){0.f, 0.f, 0.f, 0.f}; macc[a][m][n] = (f32x4){0.f, 0.f, 0.f, 0.f}; }
    bf16x8 At[4][2], B0[2][2];
    const char* cA = cur.A; const char* cB = cur.B;
    BR_STAGE(BR_SB(0), cB, voffB); BR_STAGE(BR_SA(0, 0), cA, voffA); BR_STAGE(BR_SA(0, 1), cA + hstepA, voffA);
    if (wr == 1) BR_BAR;
    BR_WAIT_V(2); BR_BAR;
    BR_STAGE(BR_SB(1), cB + kstep, voffB); BR_STAGE(BR_SA(1, 0), cA + kstep, voffA);
    BR_WAIT_V(4); BR_BAR;
    const size_t rowoff = (size_t)(wr * 64 + fr), coloff = (size_t)(wc * 32 + 8 * fq);
    for (;;) {
        const bool has_next = S.next(ui + 1, nxt);
        const char* nA = has_next ? nxt.A : cA; const char* nB = has_next ? nxt.B : cB;
        const char* gbase = cur.gate + (rowoff * GW + coloff);
        u32x2 g[8];
        for (int t = 0; t < nt; t += 2) {
            const bool last = (t == nt - 2);
            const bool hook = (t & 6) == 6;
            const char* a1 = cA + (size_t)(t + 1) * kstep;
            const char* a2 = last ? nA : cA + (size_t)(t + 2) * kstep; const char* b2 = last ? nB : cB + (size_t)(t + 2) * kstep;
            const char* a3 = a2 + kstep; const char* b3 = b2 + kstep;
            if (hook) {
                const char* gp = gbase + (size_t)(t >> 3) * 1024;
#pragma unroll
                for (int q = 0; q < 8; ++q) gload8_async(g[q], gp + (size_t)((q >> 2) * HALF + (q & 3) * 16) * GW);
            }
            BR_LDB(B0, 0); BR_SCHED; BR_LDA(At, 0, 0); BR_STAGE(BR_SA(1, 1), a1 + hstepA, voffA);
            if (hook) BR_WAIT_V(14); else BR_WAIT_V(6);
            BR_WAIT_L0; BR_BAR; BR_MMA(0); BR_BAR; BR_SCHED;
            BR_LDA(At, 0, 1); BR_STAGE(BR_SB(0), b2, voffB); BR_STAGE(BR_SA(0, 0), a2, voffA);
            if (hook) BR_WAIT_V(14); else BR_WAIT_V(6);
            BR_WAIT_L0; BR_BAR; BR_MMA(1); BR_BAR; BR_SCHED;
            BR_LDB(B0, 1); BR_SCHED; BR_LDA(At, 1, 0); BR_STAGE(BR_SA(0, 1), a2 + hstepA, voffA);
            BR_WAIT_V(6); BR_WAIT_L0; BR_BAR; BR_MMA(0); BR_BAR; BR_SCHED;
            BR_LDA(At, 1, 1); BR_STAGE(BR_SB(1), b3, voffB); BR_STAGE(BR_SA(1, 0), a3, voffA);
            BR_WAIT_V(6); BR_WAIT_L0; BR_BAR; BR_MMA(1); BR_BAR; BR_SCHED;
            if (hook) {
                asm volatile("s_waitcnt vmcnt(10)" : "+v"(g[0]), "+v"(g[1]), "+v"(g[2]), "+v"(g[3]), "+v"(g[4]), "+v"(g[5]), "+v"(g[6]), "+v"(g[7]) :: "memory");
#pragma unroll
                for (int ai = 0; ai < 2; ++ai)
#pragma unroll
                    for (int m = 0; m < 4; ++m) { const u32x2 gw = g[ai * 4 + m];
                        const f32x4 g0 = (f32x4){(float)(gw.x & 255u), (float)((gw.x >> 8) & 255u), (float)((gw.x >> 16) & 255u), (float)(gw.x >> 24)};
                        const f32x4 g1 = (f32x4){(float)(gw.y & 255u), (float)((gw.y >> 8) & 255u), (float)((gw.y >> 16) & 255u), (float)(gw.y >> 24)};
                        macc[ai][m][0] += acc[ai][m][0] * g0; macc[ai][m][1] += acc[ai][m][1] * g1;
                        acc[ai][m][0] = (f32x4){0.f, 0.f, 0.f, 0.f}; acc[ai][m][1] = (f32x4){0.f, 0.f, 0.f, 0.f}; }
            }
        }
        {
            GAS bf16_t* op = (GAS bf16_t*)cur.out + rowoff * 1024 + coloff;
#pragma unroll
            for (int ai = 0; ai < 2; ++ai)
#pragma unroll
                for (int m = 0; m < 4; ++m) { const f32x4 v0 = macc[ai][m][0] * (1.0f / 255.0f), v1 = macc[ai][m][1] * (1.0f / 255.0f);
                    u32x4 w; w.x = cvt_pk_bf16(v0[0], v0[1]); w.y = cvt_pk_bf16(v0[2], v0[3]); w.z = cvt_pk_bf16(v1[0], v1[1]); w.w = cvt_pk_bf16(v1[2], v1[3]);
                    *(GAS u32x4*)(op + (size_t)(ai * HALF + m * 16) * 1024) = w;
                    macc[ai][m][0] = (f32x4){0.f, 0.f, 0.f, 0.f}; macc[ai][m][1] = (f32x4){0.f, 0.f, 0.f, 0.f}; }
        }
        if (!has_next) break;
        cur = nxt; cA = nA; cB = nB; ++ui;
    }
    BR_WAIT_V(0);
    if (wr == 0) BR_BAR;
    BR_BAR;
#undef BR_SA
#undef BR_SB
#undef BR_STAGE
#undef BR_LDA
#undef BR_LDB
#undef BR_MMA
#undef BR_WAIT_V
#undef BR_WAIT_L0
#undef BR_BAR
#undef BR_SCHED
}
}

#define XB_TMO      128
#define XB_XCNT(j)  (256  + 64 * (j))
#define XB_XSUB(j)  (1280 + 64 * (j))
#define XB_XGEN(j)  (2304 + 64 * (j))
#define XB_TOP      3328
#define XB_TOPGEN   3392
#define XCD_BAR_WORDS 3456
#define XB_SPIN_CAP (1u << 20)

__device__ __forceinline__ unsigned xb_ld(unsigned* p)              { return __hip_atomic_load(p, __ATOMIC_RELAXED, __HIP_MEMORY_SCOPE_AGENT); }
__device__ __forceinline__ unsigned xb_add(unsigned* p, unsigned v) { return __hip_atomic_fetch_add(p, v, __ATOMIC_RELAXED, __HIP_MEMORY_SCOPE_AGENT); }
__device__ __forceinline__ unsigned xb_xcc_id() { return (unsigned)__builtin_amdgcn_s_getreg((3 << 11) | 20) & 0xFu; }
#define XB_SPIN(cond, bar) do { unsigned _sp = 0; while (cond) { __builtin_amdgcn_s_sleep(1); \
    if ((++_sp & 255u) == 0u) { if (xb_ld(&(bar)[XB_TMO])) break; if (_sp > XB_SPIN_CAP) { atomicAdd(&(bar)[XB_TMO], 1u); break; } } } } while (0)

struct XcdBarrier { unsigned* bar; unsigned x; volatile LAS unsigned* st; };

__device__ __forceinline__ XcdBarrier xcd_barrier_post(unsigned* bar, volatile LAS unsigned* st) {
    XcdBarrier b; b.bar = bar; b.x = xb_xcc_id(); b.st = st;
    if (threadIdx.x == 0) (void)xb_add(&bar[XB_XCNT(b.x)], 1u);
    return b;
}
__device__ __forceinline__ void xcd_barrier_complete(unsigned* bar, unsigned x, unsigned& nloc, unsigned& nx) {
    const unsigned G = gridDim.x * gridDim.y * gridDim.z;
    unsigned sum, cnt, mine, sp = 0u;
    for (;;) {
        sum = 0u; cnt = 0u; mine = 0u;
#pragma unroll
        for (unsigned j = 0; j < 16; ++j) { const unsigned c = xb_ld(&bar[XB_XCNT(j)]); sum += c; cnt += (c > 0u) ? 1u : 0u; mine = (j == x) ? c : mine; }
        if (sum == G) break;
        __builtin_amdgcn_s_sleep(1);
        if ((++sp & 255u) == 0u) { if (xb_ld(&bar[XB_TMO])) break; if (sp > XB_SPIN_CAP) { atomicAdd(&bar[XB_TMO], 1u); break; } }
    }
    nloc = mine > 0u ? mine : 1u; nx = cnt > 0u ? cnt : 1u;
}
__device__ __forceinline__ void xcd_barrier(const XcdBarrier& b, const bool leader) {
    asm volatile("s_waitcnt vmcnt(0)" ::: "memory");
    __syncthreads();
    unsigned* bar = b.bar; asm volatile("" : "+v"(bar));
    if (leader) {
        __builtin_amdgcn_s_waitcnt(0);
        unsigned nloc = b.st[0], nx = b.st[1];
        if (nloc == 0u) { xcd_barrier_complete(bar, b.x, nloc, nx); b.st[0] = nloc; b.st[1] = nx; }
        const unsigned old = xb_add(&bar[XB_XSUB(b.x)], 1u);
        const unsigned gen = old / nloc;
        if (old + 1u == (gen + 1u) * nloc) {
            __builtin_amdgcn_fence(__ATOMIC_RELEASE, "agent");
            asm volatile("s_waitcnt vmcnt(0)" ::: "memory");
            const unsigned og = xb_add(&bar[XB_TOP], 1u);
            const unsigned tg = og / nx;
            if (og + 1u == (tg + 1u) * nx) xb_add(&bar[XB_TOPGEN], 1u);
            else XB_SPIN(xb_ld(&bar[XB_TOPGEN]) == tg, bar);
            __builtin_amdgcn_fence(__ATOMIC_ACQUIRE, "agent");
            xb_add(&bar[XB_XGEN(b.x)], 1u);
            asm volatile("s_waitcnt vmcnt(0)" ::: "memory");
        } else {
            XB_SPIN(xb_ld(&bar[XB_XGEN(b.x)]) == gen, bar);
            __builtin_amdgcn_fence(__ATOMIC_ACQUIRE, "agent");
            asm volatile("s_waitcnt vmcnt(0)" ::: "memory");
        }
    }
    __syncthreads();
}

struct Args { const float* in[23]; float* out; unsigned char* ws; };
enum { I_X = 0, I_C, I_CTX, I_CCTX, I_WMOD, I_BMOD, I_N1G, I_N2G, I_WIN, I_DLAM, I_SUBLN, I_QKG, I_SINK, I_WBR, I_WOUT, I_FG, I_FU, I_FD, I_RW, I_MG, I_MU, I_MD, I_FINALG };

__device__ __forceinline__ bf16_t* w_layer(unsigned char* ws, int l, size_t off) { return (bf16_t*)(ws + WS_W + (size_t)l * W_LAYER + off); }
__device__ __forceinline__ bf16_t* w_dense(unsigned char* ws, int i, size_t off) { return (bf16_t*)(ws + WS_W + W_DENSE0 + (size_t)i * W_DENSE + off); }
__device__ __forceinline__ bf16_t* w_moe(unsigned char* ws, int i, int e, size_t off) { return (bf16_t*)(ws + WS_W + W_MOE0 + (size_t)i * W_MOE + (size_t)e * W_EXPERT + off); }

constexpr int CV_LAYER = 1536 + 2048 + 1024 + 512;
constexpr int CV_DENSE = 3 * 1408;
constexpr int CV_EXP = 3 * 1792;
constexpr int CV_TOTAL = 4 * CV_LAYER + 2 * CV_DENSE + 16 * CV_EXP;
struct ConvDesc { const float* src; bf16_t* dst; int ldsrc, lddst, perm; float f8s; int qm; };
__device__ __forceinline__ ConvDesc conv_decode(const Args& a, int it) {
    unsigned char* ws = a.ws;
    const float* src; int ldsrc, K, c0, ncols, mode = 0, drow0 = 0, blk, ldd = 0; bf16_t* dst; bool win = false; float f8s = 0.f; int qm = 1;
    if (it < 4 * CV_LAYER) { const int l = it / CV_LAYER, r = it % CV_LAYER;
        if (r < 1536) { blk = r; src = a.in[I_WIN] + (size_t)l * DM * DIN; ldsrc = DIN; K = DM; c0 = 0; ncols = 3072; dst = w_layer(ws, l, W_IN); drow0 = 0; win = true; }
        else if (r < 3584) { blk = r - 1536; src = a.in[I_WIN] + (size_t)l * DM * DIN; ldsrc = DIN; K = DM; c0 = 3584; ncols = 4096; dst = w_layer(ws, l, W_ING8); f8s = -128.0f * LOG2E; }
        else if (r < 4608) { const int q = r - 3584, rr = q / 256; blk = q % 256; src = a.in[I_WBR] + (size_t)(l * 4 + rr) * 512 * DM; ldsrc = DM; K = 512; c0 = 0; ncols = DM; dst = w_layer(ws, l, W_BR) + (size_t)rr * 512; ldd = 2048; }
        else { blk = r - 4608; src = a.in[I_WOUT] + (size_t)l * DM * DM; ldsrc = DM; K = DM; c0 = 0; ncols = DM; dst = w_layer(ws, l, W_OUT); }
    } else if (it < 4 * CV_LAYER + 2 * CV_DENSE) { const int q = it - 4 * CV_LAYER, i = q / CV_DENSE, r = q % CV_DENSE, which = r / 1408; blk = r % 1408;
        if (which < 2) { src = a.in[which == 0 ? I_FG : I_FU] + (size_t)i * DM * DFF; ldsrc = DFF; K = DM; c0 = 0; ncols = DFF; dst = w_dense(ws, i, W_DGU); mode = 1 + which; f8s = W8_GU; qm = 2; }
        else { src = a.in[I_FD] + (size_t)i * DFF * DM; ldsrc = DM; K = DFF; c0 = 0; ncols = DM; dst = w_dense(ws, i, W_DD); f8s = ((DENSE_F8_MASK >> i) & 1) ? 256.0f : 0.f; }
    } else { const int q = it - 4 * CV_LAYER - 2 * CV_DENSE, ie = q / CV_EXP, r = q % CV_EXP, which = r / 1792, i = ie >> 3, e = ie & 7; blk = r % 1792;
        if (which < 2) { src = a.in[which == 0 ? I_MG : I_MU] + (size_t)ie * DM * DFE; ldsrc = DFE; K = DM; c0 = 0; ncols = DFE; dst = w_moe(ws, i, e, W_MGU); mode = 1 + which; f8s = W8_GU; qm = 2; }
        else { src = a.in[I_MD] + (size_t)ie * DFE * DM; ldsrc = DM; K = DFE; c0 = 0; ncols = DM; dst = w_moe(ws, i, e, W_MD); f8s = 256.0f; }
    }
    const int nbn = ncols / 32, kb = blk / nbn, nb = blk % nbn, n = 32 * nb;
    const int drow = mode == 0 ? drow0 + n : 256 * (n >> 7) + (n & 127) + (mode == 2 ? 128 : 0);
    const bool perm = win && (n < 1024 || (n >= 1536 && n < 2176) || (n >= 2304 && n < 2944));
    ConvDesc d; d.src = src + (size_t)(64 * kb) * ldsrc + c0 + n; if (ldd == 0) ldd = K;
    d.dst = f8s != 0.f ? (bf16_t*)((unsigned char*)dst + (size_t)drow * ldd + 64 * kb) : dst + (size_t)drow * ldd + 64 * kb; d.ldsrc = ldsrc; d.lddst = ldd; d.perm = perm ? 1 : 0; d.f8s = f8s; d.qm = qm;
    return d;
}
__device__ __forceinline__ void conv_load(const ConvDesc& d, float (&r)[32], int lane) {
    const GAS float* s = (const GAS float*)d.src + (size_t)(lane >> 5) * d.ldsrc + (lane & 31);
#pragma unroll
    for (int i = 0; i < 32; ++i) r[i] = __builtin_nontemporal_load(s + (size_t)(2 * i) * d.ldsrc);
}
__device__ __forceinline__ void conv_store(const ConvDesc& d, const float (&r)[32], LAS float* scr, int lane) {
#pragma unroll
    for (int i = 0; i < 32; ++i) scr[(2 * i + (lane >> 5)) * 33 + (lane & 31)] = r[i];
    LDS_WAIT(); asm volatile("" ::: "memory");
    const int c = lane & 7;
    if (d.f8s != 0.f) { const float fs = d.f8s;
#pragma unroll
        for (int j = 0; j < 4; ++j) { const int n = (lane >> 3) + 8 * j; const LAS float* s = scr + (8 * c) * 33 + n;
            u32x2 o;
            if (d.qm == 2) { o.x = pack4_i8(s[0 * 33] * fs, s[1 * 33] * fs, s[2 * 33] * fs, s[3 * 33] * fs); o.y = pack4_i8(s[4 * 33] * fs, s[5 * 33] * fs, s[6 * 33] * fs, s[7 * 33] * fs); }
            else { o.x = cvt4_fp8(s[0 * 33] * fs, s[1 * 33] * fs, s[2 * 33] * fs, s[3 * 33] * fs); o.y = cvt4_fp8(s[4 * 33] * fs, s[5 * 33] * fs, s[6 * 33] * fs, s[7 * 33] * fs); }
            __builtin_nontemporal_store(o, (GAS u32x2*)((GAS unsigned char*)d.dst + (size_t)n * d.lddst + 8 * c)); }
    } else {
#pragma unroll
    for (int j = 0; j < 4; ++j) { const int n = (lane >> 3) + 8 * j; const LAS float* s = scr + (8 * c) * 33 + n;
        u32x4 o; o.x = cvt_pk_bf16(s[0 * 33], s[1 * 33]); o.y = cvt_pk_bf16(s[2 * 33], s[3 * 33]); o.z = cvt_pk_bf16(s[4 * 33], s[5 * 33]); o.w = cvt_pk_bf16(s[6 * 33], s[7 * 33]);
        const int dn = d.perm ? 2 * (n & 15) + (n >> 4) : n;
        __builtin_nontemporal_store(o, (GAS u32x4*)(d.dst + (size_t)dn * d.lddst + 8 * c)); }
    }
    LDS_WAIT(); asm volatile("" ::: "memory");
}
__device__ __forceinline__ void fzfold_item(const Args& a, int it, int lane) {
    const int mq = it & 3, kb = (it >> 2) & 15, g = (it >> 6) & 7, l = it >> 9, k0 = 64 * kb;
    const GAS f32x4* src = (const GAS f32x4*)(a.in[I_WIN] + (size_t)l * DM * DIN + (size_t)(k0 + lane) * DIN + 3072 + g * 64);
    float w[64];
#pragma unroll
    for (int i = 0; i < 16; ++i) { const f32x4 v = src[i]; w[4 * i] = v[0]; w[4 * i + 1] = v[1]; w[4 * i + 2] = v[2]; w[4 * i + 3] = v[3]; }
    const float cv = cospif((float)lane * (1.0f / 32.0f)), sv = sinpif((float)lane * (1.0f / 32.0f));
    GAS bf16_t* dst = (GAS bf16_t*)w_layer(a.ws, l, W_FZ);
    for (int m = 16 * mq; m < 16 * mq + 16; ++m) {
        float sc = 0.f, ss = 0.f;
#pragma unroll
        for (int c = 0; c < 64; ++c) { const int j = (c * m) & 63;
            const float cj = __builtin_bit_cast(float, __builtin_amdgcn_readlane(__builtin_bit_cast(int, cv), j)), sj = __builtin_bit_cast(float, __builtin_amdgcn_readlane(__builtin_bit_cast(int, sv), j));
            sc += w[c] * cj; ss += w[c] * sj; }
        dst[(size_t)(g * 64 + m) * DM + k0 + lane] = f2bf(sc);
        dst[(size_t)(512 + g * 64 + m) * DM + k0 + lane] = f2bf(ss);
    }
}
__device__ __forceinline__ void mod_item(const Args& a, int item, LAS unsigned char* lds, int tid) {
    const int l = item / 24, chunk = item % 24, wid = tid >> 6, lane = tid & 63;
    LAS float* sc = (LAS float*)lds;
    LAS float* red = (LAS float*)(lds + 36864);
    for (int i = tid; i < 9 * 1024; i += 512) { const float v = i < 8192 ? a.in[I_C][i] : a.in[I_CCTX][i - 8192]; sc[i] = siluf_(v); }
    __syncthreads();
    const float* w = a.in[I_WMOD] + (size_t)l * DM * 6144 + chunk * 256 + lane * 4;
    f32x4 acc[9];
#pragma unroll
    for (int r = 0; r < 9; ++r) acc[r] = (f32x4){0.f, 0.f, 0.f, 0.f};
    const int kb = wid * 128;
#pragma unroll 8
    for (int k = 0; k < 128; ++k) { const f32x4 wv = *(const GAS f32x4*)(w + (size_t)(kb + k) * 6144);
#pragma unroll
        for (int r = 0; r < 9; ++r) acc[r] += wv * sc[r * 1024 + kb + k]; }
#pragma unroll
    for (int r = 0; r < 9; ++r) *(LAS f32x4*)(red + (wid * 9 + r) * 256 + lane * 4) = acc[r];
    __syncthreads();
    float* modv = (float*)(a.ws + WS_MODV) + (size_t)l * 9 * 6144;
    for (int i = tid; i < 9 * 256; i += 512) { const int r = i >> 8, c = i & 255; float s = 0.f;
#pragma unroll
        for (int w8 = 0; w8 < 8; ++w8) s += red[(w8 * 9 + r) * 256 + c];
        modv[r * 6144 + chunk * 256 + c] = s + a.in[I_BMOD][l * 6144 + chunk * 256 + c]; }
    __syncthreads();
}

struct RowV { f32x4 v[4]; };
__device__ __forceinline__ RowV load_row_f32(const float* p, int lane) { RowV r; const f32x4* q = (const f32x4*)p + lane;
#pragma unroll
    for (int j = 0; j < 4; ++j) r.v[j] = q[64 * j];
    return r; }
__device__ __forceinline__ void store_row_f32(float* p, const RowV& r, int lane) { f32x4* q = (f32x4*)p + lane;
#pragma unroll
    for (int j = 0; j < 4; ++j) q[64 * j] = r.v[j]; }
__device__ __forceinline__ RowV load_row_bf16(const bf16_t* p, int lane) { RowV r; const u32x2* q = (const u32x2*)p + lane;
#pragma unroll
    for (int j = 0; j < 4; ++j) { const u32x2 w = q[64 * j]; r.v[j] = (f32x4){bf_lo(w.x), bf_hi(w.x), bf_lo(w.y), bf_hi(w.y)}; }
    return r; }
__device__ __forceinline__ void store_row_bf16(bf16_t* p, const RowV& r, int lane) { u32x2* q = (u32x2*)p + lane;
#pragma unroll
    for (int j = 0; j < 4; ++j) { u32x2 w; w.x = cvt_pk_bf16(r.v[j][0], r.v[j][1]); w.y = cvt_pk_bf16(r.v[j][2], r.v[j][3]); q[64 * j] = w; } }
struct RowQ { unsigned w[4]; float sc; };
__device__ __forceinline__ RowQ quant_row_i8(const RowV& r) {
    float am = 0.f;
#pragma unroll
    for (int j = 0; j < 4; ++j) am = fmaxf(fmaxf(am, fmaxf(fabsf(r.v[j][0]), fabsf(r.v[j][1]))), fmaxf(fabsf(r.v[j][2]), fabsf(r.v[j][3])));
#pragma unroll
    for (int o = 1; o < 64; o <<= 1) am = fmaxf(am, __shfl_xor(am, o));
    const float inv = am > 0.f ? 127.0f / am : 0.f;
    RowQ q; q.sc = am * (1.0f / 127.0f);
#pragma unroll
    for (int j = 0; j < 4; ++j) q.w[j] = pack4_i8(r.v[j][0] * inv, r.v[j][1] * inv, r.v[j][2] * inv, r.v[j][3] * inv);
    return q;
}
__device__ __forceinline__ void store_rowq(unsigned char* p, const RowQ& q, int lane) { unsigned* d = (unsigned*)p + lane;
#pragma unroll
    for (int j = 0; j < 4; ++j) d[64 * j] = q.w[j]; }
__device__ __forceinline__ void store_row_fp8(unsigned char* p, const RowV& r, int lane) { unsigned* q = (unsigned*)p + lane;
#pragma unroll
    for (int j = 0; j < 4; ++j) q[64 * j] = cvt4_fp8(r.v[j][0], r.v[j][1], r.v[j][2], r.v[j][3]); }
__device__ __forceinline__ RowV adaln_row(const RowV& x, const float* g, const float* shift, const float* scale, int lane) {
    float ss = 0.f;
#pragma unroll
    for (int j = 0; j < 4; ++j) ss += (x.v[j][0] * x.v[j][0] + x.v[j][1] * x.v[j][1]) + (x.v[j][2] * x.v[j][2] + x.v[j][3] * x.v[j][3]);
    const float rstd = 1.0f / sqrtf(wave_sum(ss) * (1.0f / DM) + 1e-6f);
    const RowV gv = load_row_f32(g, lane), sh = load_row_f32(shift, lane), sc = load_row_f32(scale, lane);
    RowV y;
#pragma unroll
    for (int j = 0; j < 4; ++j) y.v[j] = x.v[j] * rstd * gv.v[j] * (1.0f + sc.v[j]) + sh.v[j];
    return y;
}
__device__ __forceinline__ int mod_row_of(int row) { return row < NLAT ? (row >> 11) : 8; }
struct AdaCoef { RowV A, B; int mr; };
__device__ __forceinline__ void ada_coef_update(AdaCoef& c, int row, const float* g, const float* modbase, int shift_off, int scale_off, int lane) {
    const int mr = mod_row_of(row);
    if (mr != c.mr) { c.mr = mr; const float* mv = modbase + (size_t)mr * 6144;
        const RowV gv = load_row_f32(g, lane), sh = load_row_f32(mv + shift_off, lane), sc = load_row_f32(mv + scale_off, lane);
#pragma unroll
        for (int j = 0; j < 4; ++j) { c.A.v[j] = gv.v[j] * (1.0f + sc.v[j]); c.B.v[j] = sh.v[j]; } }
}
__device__ __forceinline__ RowV adaln_apply(const RowV& x, const AdaCoef& c) {
    float ss = 0.f;
#pragma unroll
    for (int j = 0; j < 4; ++j) ss += (x.v[j][0] * x.v[j][0] + x.v[j][1] * x.v[j][1]) + (x.v[j][2] * x.v[j][2] + x.v[j][3] * x.v[j][3]);
    const float rstd = 1.0f / sqrtf(wave_sum(ss) * (1.0f / DM) + 1e-6f);
    RowV y;
#pragma unroll
    for (int j = 0; j < 4; ++j) y.v[j] = x.v[j] * rstd * c.A.v[j] + c.B.v[j];
    return y;
}

struct MoeTiles { int tb[9]; };
__device__ __forceinline__ MoeTiles moe_tiles(unsigned* ctl, int i) { MoeTiles t; int s = 0;
#pragma unroll
    for (int e = 0; e < 8; ++e) { t.tb[e] = s; const unsigned c = (unsigned)__builtin_amdgcn_readfirstlane((int)__hip_atomic_load(ctl + CW_CNT + 64 * (8 * i + e), __ATOMIC_RELAXED, __HIP_MEMORY_SCOPE_AGENT)); s += (int)((c + 255u) >> 8); }
    t.tb[8] = s; return t; }

__device__ __forceinline__ float max3f(float a, float b, float c) { return __builtin_fmaxf(__builtin_fmaxf(a, b), c); }
__device__ __forceinline__ int crow(int r, int hi) { return (r & 3) + 8 * (r >> 2) + 4 * hi; }
typedef short v4i16_t __attribute__((ext_vector_type(4)));
__device__ __forceinline__ s16x4 vtr(const LAS unsigned char* p) { return __builtin_bit_cast(s16x4, __builtin_amdgcn_ds_read_tr16_b64_v4i16((LAS v4i16_t*)p)); }

struct AttnCtx { const bf16_t* P; bf16_t* O; const float* subln_g; float lam, one_m_li; const float* sink; };

constexpr float ATT_THR = 8.0f;
__device__ __forceinline__ void glds16(const void* gsrc, unsigned lds_dst) { unsigned keep;
    asm volatile("s_mov_b32 %0, m0\n\ts_mov_b32 m0, %2\n\ts_nop 0\n\tglobal_load_lds_dwordx4 %1, off\n\ts_mov_b32 m0, %0" : "=&s"(keep) : "v"(gsrc), "s"(lds_dst) : "memory"); }
#define ATT_BAR() do { __builtin_amdgcn_sched_barrier(0); asm volatile("s_waitcnt lgkmcnt(0)" ::: "memory"); __builtin_amdgcn_s_barrier(); asm volatile("" ::: "memory"); __builtin_amdgcn_sched_barrier(0); } while (0)
template <int VAR>
__device__ __forceinline__ void attn_unit(LAS unsigned char* lds, const int tid, const AttnCtx& ac, int b, int hh, int qb, bool ctxq) {
    constexpr int NDB = (VAR == 0) ? 4 : 2;
    constexpr int NLD = (VAR == 0) ? 2 : 1;
    constexpr int KB = (VAR == 0) ? 16384 : 8192;
    constexpr int VB = (VAR == 0) ? 16384 : 8192;
    constexpr int VBASE = 3 * KB;
    constexpr int WSF_OFF = 135168;
    const int lane = tid & 63, r32 = lane & 31, hi = lane >> 5; const int wid = __builtin_amdgcn_readfirstlane(tid >> 6);
    const int half = wid >> 2;
    int map = 0, g = 0, qsub, qcol, kcol, vcol, ocol, qpb;
    if (VAR == 0) { map = wid >> 2; qsub = wid & 3; qpb = 128; qcol = C_AQ + hh * 128 + map * 64; kcol = C_AK + hh * 128; vcol = C_AV + hh * 128; ocol = hh * 128; }
    else { g = wid >> 1; qsub = wid & 1; qpb = 64; qcol = (VAR == 1 ? C_BQ : C_CQ) + (hh * 4 + g) * 64; kcol = (VAR == 1 ? C_BK : C_CK) + hh * 64; vcol = (VAR == 1 ? C_BV : C_CV) + hh * 64; ocol = (VAR == 1 ? 512 : 1024) + (hh * 4 + g) * 64; }
    const int q0w = qb * qpb + qsub * 32;
    const int latbase = b * SEQ, ctxbase = NLAT + b * CTXL;
    const int qrow0 = (ctxq ? ctxbase : latbase) + q0w;
    int NT, lt0 = 0;
    if (ctxq) NT = 4;
    else if (VAR == 2) { lt0 = qb - 2 < 0 ? 0 : qb - 2; const int lt1 = qb + 2 > 31 ? 31 : qb + 2; NT = 4 + (lt1 - lt0 + 1); }
    else NT = 36;
    auto tile_row0 = [&](int t) -> int {
        if (ctxq) return ctxbase + 64 * t;
        if (VAR == 2) return t < 4 ? ctxbase + 64 * t : latbase + 64 * (lt0 + t - 4);
        return t < 32 ? latbase + 64 * t : ctxbase + 64 * (t - 32);
    };
    const GAS bf16_t* Pg = (const GAS bf16_t*)ac.P;
    bf16x8 qr[4];
    { const GAS bf16_t* qp = Pg + (size_t)(qrow0 + r32) * PW + qcol + hi * 8;
#pragma unroll
      for (int d0 = 0; d0 < 4; ++d0) qr[d0] = *(const GAS bf16x8*)(qp + d0 * 16); }
    const GAS bf16_t* kdma = Pg + (size_t)lane * PW + kcol + 8 * wid;
    const GAS bf16_t* vdma = Pg + (size_t)(16 * (wid & 3) + (lane >> 2)) * PW + vcol + (wid >> 2) * 32 + (lane & 3) * 8;
    const unsigned lds0 = (unsigned)(uintptr_t)lds + (unsigned)wid * 1024u;
    auto gloadK = [&](int t, int slot) { const GAS bf16_t* rp = kdma + (size_t)tile_row0(t) * PW;
#pragma unroll
        for (int j = 0; j < NLD; ++j) glds16((const void*)(rp + 64 * j), (unsigned)__builtin_amdgcn_readfirstlane(lds0 + (unsigned)(slot * KB + j * 8192))); };
    auto gloadV = [&](int t, int slot) { const GAS bf16_t* rp = vdma + (size_t)tile_row0(t) * PW;
#pragma unroll
        for (int j = 0; j < NLD; ++j) glds16((const void*)(rp + 64 * j), (unsigned)__builtin_amdgcn_readfirstlane(lds0 + (unsigned)(VBASE + slot * VB + j * 8192))); };
    volatile LAS float* wsf = (volatile LAS float*)(lds + WSF_OFF + wid * 256);
    const int koff = (VAR == 0 ? map * 8192 : 0) + hi * 1024 + r32 * 16;
    const int vlane = (4 * hi + ((lane & 15) >> 2)) * 64 + ((lane >> 4) & 1) * 32 + (lane & 3) * 8;
    f32x16 o[NDB];
#pragma unroll
    for (int d = 0; d < NDB; ++d) o[d] = (f32x16){0.f, 0.f, 0.f, 0.f, 0.f, 0.f, 0.f, 0.f, 0.f, 0.f, 0.f, 0.f, 0.f, 0.f, 0.f, 0.f};
    float m_run = 0.f, l_run = 0.f;
    f32x16 negm = (f32x16){0.f, 0.f, 0.f, 0.f, 0.f, 0.f, 0.f, 0.f, 0.f, 0.f, 0.f, 0.f, 0.f, 0.f, 0.f, 0.f};
    const int tq = q0w + r32;
    f32x16 s0, s1;
    auto qk = [&](int slot) { const LAS unsigned char* bp = lds + slot * KB + koff;
        s0 = negm; s1 = negm;
        constexpr int KH = (VAR == 0) ? 2 : 4;
#pragma unroll
        for (int h = 0; h < 4; h += KH) {
            bf16x8 kf[2 * KH];
#pragma unroll
            for (int d0 = 0; d0 < KH; ++d0) { kf[2 * d0] = *(const LAS bf16x8*)(bp + (h + d0) * 2048); kf[2 * d0 + 1] = *(const LAS bf16x8*)(bp + (h + d0) * 2048 + 512); }
            __builtin_amdgcn_sched_barrier(0);
#pragma unroll
            for (int d0 = 0; d0 < KH; ++d0) {
                s0 = __builtin_amdgcn_mfma_f32_32x32x16_bf16(kf[2 * d0], qr[h + d0], s0, 0, 0, 0);
                s1 = __builtin_amdgcn_mfma_f32_32x32x16_bf16(kf[2 * d0 + 1], qr[h + d0], s1, 0, 0, 0); }
            if (h + KH < 4) __builtin_amdgcn_sched_barrier(0);
        } };
    gloadK(0, 0); gloadV(0, 0);
    if (NT > 1) gloadK(1, 1);
    asm volatile("s_waitcnt vmcnt(0)" ::: "memory"); ATT_BAR();
    if (NT > 2) gloadK(2, 2);
    if (NT > 1) gloadV(1, 1);
    qk(0);
    ATT_BAR();
    if (half == 1) ATT_BAR();
    int k0 = 0;
    for (int t = 0; t < NT; ++t) {
        const bool more1 = t + 1 < NT, more2 = t + 2 < NT, more3 = t + 3 < NT;
        const int k1 = k0 == 2 ? 0 : k0 + 1, k2 = k1 == 2 ? 0 : k1 + 1;
        if (VAR == 2 && !ctxq && t >= 4) {
            const int lt = lt0 + t - 4, kb = 64 * lt + 4 * hi - tq;
            if (lt == qb - 2) {
#pragma unroll
                for (int r = 0; r < 16; ++r) { const int d = kb + (r & 3) + 8 * (r >> 2); if (d < -128) s0[r] = -1e30f; if (d + 32 < -128) s1[r] = -1e30f; }
            } else if (lt == qb + 2) {
#pragma unroll
                for (int r = 0; r < 16; ++r) { const int d = kb + (r & 3) + 8 * (r >> 2); if (d > 128) s0[r] = -1e30f; if (d + 32 > 128) s1[r] = -1e30f; }
            }
        }
        float ma = max3f(s0[0], s0[1], s1[0]), mb = max3f(s0[2], s0[3], s1[1]); ma = max3f(ma, s1[2], s1[3]);
#pragma unroll
        for (int r = 4; r < 16; r += 4) { ma = max3f(ma, s0[r], s0[r + 1]); mb = max3f(mb, s0[r + 2], s0[r + 3]); ma = max3f(ma, s1[r], s1[r + 1]); mb = max3f(mb, s1[r + 2], s1[r + 3]); }
        float mx = fmaxf(ma, mb);
        { const auto rr = __builtin_amdgcn_permlane32_swap(__float_as_uint(mx), __float_as_uint(mx), false, false); mx = fmaxf(__uint_as_float(rr[0]), __uint_as_float(rr[1])); }
        if (t == 0 || __any(mx > ATT_THR)) {
            const float dl = (t == 0) ? mx : fmaxf(mx, 0.f);
            m_run += dl;
#pragma unroll
            for (int r = 0; r < 16; ++r) { s0[r] -= dl; s1[r] -= dl; negm[r] = -m_run; }
            const float f = fast_exp2(-dl);
            l_run *= f;
            if (hi == 0) wsf[r32] = f;
            LDS_WAIT();
#pragma unroll
            for (int r = 0; r < 16; ++r) { const float al = wsf[crow(r, hi)];
#pragma unroll
                for (int d = 0; d < NDB; ++d) o[d][r] *= al; }
        }
        float la = 0.f, lb = 0.f;
#pragma unroll
        for (int r = 0; r < 16; ++r) { s0[r] = fast_exp2(s0[r]); s1[r] = fast_exp2(s1[r]); la += s0[r]; lb += s1[r]; }
        l_run += la + lb;
        bf16x8 pa[4];
        { u32x4 w;
          w.x = cvt_pk_bf16(s0[0], s0[1]); w.y = cvt_pk_bf16(s0[2], s0[3]); w.z = cvt_pk_bf16(s0[4], s0[5]); w.w = cvt_pk_bf16(s0[6], s0[7]); pa[0] = __builtin_bit_cast(bf16x8, w);
          w.x = cvt_pk_bf16(s0[8], s0[9]); w.y = cvt_pk_bf16(s0[10], s0[11]); w.z = cvt_pk_bf16(s0[12], s0[13]); w.w = cvt_pk_bf16(s0[14], s0[15]); pa[1] = __builtin_bit_cast(bf16x8, w);
          w.x = cvt_pk_bf16(s1[0], s1[1]); w.y = cvt_pk_bf16(s1[2], s1[3]); w.z = cvt_pk_bf16(s1[4], s1[5]); w.w = cvt_pk_bf16(s1[6], s1[7]); pa[2] = __builtin_bit_cast(bf16x8, w);
          w.x = cvt_pk_bf16(s1[8], s1[9]); w.y = cvt_pk_bf16(s1[10], s1[11]); w.z = cvt_pk_bf16(s1[12], s1[13]); w.w = cvt_pk_bf16(s1[14], s1[15]); pa[3] = __builtin_bit_cast(bf16x8, w); }
        ATT_BAR();
        if (more3) gloadK(t + 3, k0);
        if (more2) gloadV(t + 2, k2);
        const LAS unsigned char* vp = lds + VBASE + k0 * VB + vlane;
        s16x4 va_lo[NDB], va_hi[NDB], vb_lo[NDB], vb_hi[NDB];
#define ATT_VLOAD(LO, HI, KS) do { _Pragma("unroll") for (int d = 0; d < NDB; ++d) { LO[d] = vtr(vp + d * 4096 + (KS) * 1024); HI[d] = vtr(vp + d * 4096 + (KS) * 1024 + 512); } } while (0)
#define ATT_VMMA(LO, HI, KS) do { _Pragma("unroll") for (int d = 0; d < NDB; ++d) { const bf16x8 vf = (bf16x8){LO[d][0], LO[d][1], LO[d][2], LO[d][3], HI[d][0], HI[d][1], HI[d][2], HI[d][3]}; \
            o[d] = __builtin_amdgcn_mfma_f32_32x32x16_bf16(pa[KS], vf, o[d], 0, 0, 0); } } while (0)
        ATT_VLOAD(va_lo, va_hi, 0); ATT_VLOAD(vb_lo, vb_hi, 1);
        __builtin_amdgcn_sched_barrier(0);
        ATT_VMMA(va_lo, va_hi, 0);
        __builtin_amdgcn_sched_barrier(0);
        ATT_VLOAD(va_lo, va_hi, 2);
        __builtin_amdgcn_sched_barrier(0);
        ATT_VMMA(vb_lo, vb_hi, 1);
        __builtin_amdgcn_sched_barrier(0);
        ATT_VLOAD(vb_lo, vb_hi, 3);
        __builtin_amdgcn_sched_barrier(0);
        ATT_VMMA(va_lo, va_hi, 2);
        ATT_VMMA(vb_lo, vb_hi, 3);
#undef ATT_VLOAD
#undef ATT_VMMA
        if (more1) qk(k1);
        if (more3) { if (NLD == 2) asm volatile("s_waitcnt vmcnt(4)" ::: "memory"); else asm volatile("s_waitcnt vmcnt(2)" ::: "memory"); }
        else if (more2) { if (NLD == 2) asm volatile("s_waitcnt vmcnt(2)" ::: "memory"); else asm volatile("s_waitcnt vmcnt(1)" ::: "memory"); }
        else asm volatile("s_waitcnt vmcnt(0)" ::: "memory");
        ATT_BAR();
        k0 = k1;
    }
    if (half == 0) ATT_BAR();
    { float l_tot; { const auto rr = __builtin_amdgcn_permlane32_swap(__float_as_uint(l_run), __float_as_uint(l_run), false, false); l_tot = __uint_as_float(rr[0]) + __uint_as_float(rr[1]); }
      if (VAR == 2) l_tot += fast_exp2(ac.sink[hh * 4 + g] * LOG2E - m_run);
      if (hi == 0) wsf[r32] = 1.0f / l_tot;
      LDS_WAIT();
#pragma unroll
      for (int r = 0; r < 16; ++r) { const float il = wsf[crow(r, hi)];
#pragma unroll
          for (int d = 0; d < NDB; ++d) o[d][r] *= il; } }
    GAS bf16_t* Og = (GAS bf16_t*)ac.O;
    if (VAR != 0) {
#pragma unroll
        for (int r = 0; r < 16; ++r) { GAS bf16_t* op = Og + (size_t)(qrow0 + crow(r, hi)) * OW + ocol + r32;
#pragma unroll
            for (int d = 0; d < NDB; ++d) op[d * 32] = f2bf(o[d][r]); }
    } else {
        LAS float* tile = (LAS float*)lds + ((wid & 3) * 2 + map) * (32 * 132);
#pragma unroll
        for (int r = 0; r < 16; ++r)
#pragma unroll
            for (int d = 0; d < NDB; ++d) tile[crow(r, hi) * 132 + d * 32 + r32] = o[d][r];
        __syncthreads();
        const int ql = (wid >> 2) * 16 + (lane >> 2), part = lane & 3;
        const LAS float* t0 = (const LAS float*)lds + ((wid & 3) * 2) * (32 * 132) + ql * 132 + part * 32;
        const LAS float* t1 = t0 + 32 * 132;
        f32x4 dv[8]; float ss = 0.f;
#pragma unroll
        for (int j = 0; j < 8; ++j) { const f32x4 a = *(const LAS f32x4*)(t0 + 4 * j), bq = *(const LAS f32x4*)(t1 + 4 * j); dv[j] = a - ac.lam * bq;
            ss += (dv[j][0] * dv[j][0] + dv[j][1] * dv[j][1]) + (dv[j][2] * dv[j][2] + dv[j][3] * dv[j][3]); }
        ss += __shfl_xor(ss, 1); ss += __shfl_xor(ss, 2);
        const float rs = ac.one_m_li / sqrtf(ss * (1.0f / 128.0f) + 1e-5f);
        const GAS float* gp = (const GAS float*)ac.subln_g + part * 32;
        GAS bf16_t* op = Og + (size_t)((ctxq ? ctxbase : latbase) + qb * qpb + (wid & 3) * 32 + ql) * OW + ocol + part * 32;
#pragma unroll
        for (int k = 0; k < 4; ++k) { const f32x4 g0 = *(const GAS f32x4*)(gp + 8 * k), g1 = *(const GAS f32x4*)(gp + 8 * k + 4);
            const f32x4 v0 = dv[2 * k] * g0 * rs, v1 = dv[2 * k + 1] * g1 * rs;
            u32x4 w; w.x = cvt_pk_bf16(v0[0], v0[1]); w.y = cvt_pk_bf16(v0[2], v0[3]); w.z = cvt_pk_bf16(v1[0], v1[1]); w.w = cvt_pk_bf16(v1[2], v1[3]);
            *(GAS u32x4*)(op + 8 * k) = w; }
    }
}

using pg8::Unit;
struct SchedInproj {
    int c, G, nM, ntot, nfz; const char* xn; const char* win; const char* wfz; char* p; char* zz; char* zzc; const char* rope;
    __device__ __forceinline__ bool next(int i, Unit& u) const {
        const int L = i * G + c; if (L >= ntot + nfz) return false;
        u.aux = nullptr; u.aux2 = nullptr;
        if (L < ntot) { int pm, pn; pg8::tile_of(L, nM, 12, pm, pn);
            u.A = xn + (size_t)pm * 256 * DM * 2; u.B = win + (size_t)pn * 256 * DM * 2; u.out = p + ((size_t)pm * 256 * PW + pn * 256) * 2; u.ldc = PW;
            int fl = pm < 64 ? 16 : 0;
            if (pn < 2) fl |= 2 | 8; else if (pn < 4) fl |= 2; else if (pn == 9 || pn == 10) fl |= 2 | 8; else if (pn == 11) fl |= 4;
            u.flag = fl; u.aux = rope + (size_t)((pm * 256) & 2047) * 64 * 4; }
        else { const int q = L - ntot;
            if (q < 256) { const int b = q >> 5, pm = (q >> 3) & 3, pn = q & 7;
                u.A = wfz + (size_t)pm * 256 * DM * 2; u.B = xn + (size_t)(b * SEQ + pn * 256) * DM * 2;
                u.out = zz + ((size_t)b * 512 * 4096 + (size_t)((pm & 1) * 256) * 4096 + (pm >> 1) * 2048 + pn * 256) * 2; u.ldc = 4096; u.flag = 0; }
            else { const int q2 = q - 256, b = q2 >> 2, pm = q2 & 3;
                u.A = wfz + (size_t)pm * 256 * DM * 2; u.B = xn + (size_t)(NLAT + b * CTXL) * DM * 2;
                u.out = zzc + ((size_t)b * 512 * 512 + (size_t)((pm & 1) * 256) * 512 + (pm >> 1) * 256) * 2; u.ldc = 512; u.flag = 0; } }
        return true;
    }
};
struct SchedGate {
    int c, G, nM; const char* xn8; const char* wg; char* gates;
    __device__ __forceinline__ bool next(int i, Unit& u) const {
        const int L = i * G + c; if (L >= nM * 16) return false;
        int pm, pn; pg8::tile_of(L, nM, 16, pm, pn);
        u.A = xn8 + (size_t)pm * 256 * DM; u.B = wg + (size_t)pn * 256 * DM; u.out = gates + ((size_t)pm * 256 * GW + pn * 256); u.ldc = GW; u.flag = 0; u.aux = nullptr; u.aux2 = nullptr; return true;
    }
};
struct SchedDft {
    int c; const char* T; const char* zz; char* o;
    __device__ __forceinline__ bool next(int i, Unit& u) const {
        if (i > 0 || c >= 128) return false;
        const int b = c >> 4, pm = (c >> 1) & 7, pn = c & 1;
        u.A = T + (size_t)pm * 256 * 4096 * 2; u.B = zz + ((size_t)b * 512 + pn * 256) * 4096 * 2;
        u.out = o + ((size_t)(b * SEQ + pm * 256) * OW + 1536 + pn * 256) * 2; u.ldc = OW; u.flag = 0; u.aux = nullptr; u.aux2 = nullptr; return true;
    }
};
struct SchedDftCtx {
    int c; const char* T; const char* zzc; char* o;
    __device__ __forceinline__ bool next(int i, Unit& u) const {
        if (i > 0 || c < 128 || c >= 144) return false;
        const int q = c - 128, b = q >> 1, pn = q & 1;
        u.A = T; u.B = zzc + ((size_t)b * 512 + pn * 256) * 512 * 2;
        u.out = o + ((size_t)(NLAT + b * CTXL) * OW + 1536 + pn * 256) * 2; u.ldc = OW; u.flag = 0; u.aux = nullptr; u.aux2 = nullptr; return true;
    }
};
struct SchedBranch {
    int c, G, ntile; const char* o; const char* wbr; const char* p; char* merged;
    __device__ __forceinline__ bool next(int i, pg8::BUnit& u) const {
        const int xcd = c & 7, j = i * (G >> 3) + (c >> 3), pm = xcd + 8 * (j >> 3), pn2 = j & 7;
        if (pm * 8 >= ntile) return false;
        u.A = o + (size_t)pm * 256 * OW * 2; u.B = wbr + (size_t)pn2 * 128 * 2048 * 2;
        u.gate = p + ((size_t)pm * 256 * GW + pn2 * 128);
        u.out = merged + ((size_t)pm * 256 * 1024 + pn2 * 128) * 2; return true;
    }
};
struct SchedResid {
    int c, G, nM, K; const char* A; const char* B; char* xs; const char* modv; int goff; const char* xin; const char* cin;
    __device__ __forceinline__ bool next(int i, Unit& u) const {
        const int L = i * G + c; if (L >= nM * 4) return false;
        int pm, pn; pg8::tile_of(L, nM, 4, pm, pn);
        u.A = A + (size_t)pm * 256 * K * 2; u.B = B + (size_t)pn * 256 * K * 2; u.out = xs + ((size_t)pm * 256 * DM + pn * 256) * 2; u.ldc = DM;
        u.aux = modv + ((size_t)(pm < 64 ? (pm >> 3) : 8) * 6144 + goff + pn * 256) * 4; u.flag = xin ? 1 : 0;
        u.aux2 = xin ? (pm < 64 ? xin + ((size_t)pm * 256 * DM + pn * 256) * 4 : cin + ((size_t)(pm - 64) * 256 * DM + pn * 256) * 4) : (const char*)u.out; return true;
    }
};
struct SchedUp {
    int c, G, nM; const char* xn; const char* w; char* h; int eb; const float* rsc;
    __device__ __forceinline__ bool next(int i, Unit& u) const {
        const int L = i * G + c; if (L >= nM * 22) return false;
        int pm, pn; pg8::tile_of(L, nM, 22, pm, pn);
        u.A = xn + (size_t)pm * 256 * DM; u.B = w + (size_t)pn * 256 * DM; u.out = h + ((size_t)pm * 256 * DFF + pn * 128) * eb; u.ldc = DFF; u.flag = 0; u.aux = (const char*)(rsc + (size_t)pm * 256); u.aux2 = nullptr; return true;
    }
};
struct SchedMoe {
    int c, G, NT, K, RT; MoeTiles mt; const char* A; const char* W; size_t wsub; char* out; int ldc, colw, esz; const float* rsc;
    __device__ __forceinline__ bool next(int i, Unit& u) const {
        const int L0 = i * G + c, ntot = RT * NT; if (L0 >= ntot) return false;
        int L = L0; if (NT > 4) { const int q = ntot / 8, r = ntot % 8, xcd = L0 % 8, off = L0 / 8; L = (xcd < r ? xcd * (q + 1) : r * (q + 1) + (xcd - r) * q) + off; }
        const int gs = 8 * NT, g8 = L / gs, rem = L % gs, left = RT - 8 * g8, gsz = left < 8 ? left : 8;
        const int rt = 8 * g8 + rem % gsz, pn = rem / gsz;
        int e = 0;
#pragma unroll
        for (int k = 1; k < 8; ++k) e += (rt >= mt.tb[k]) ? 1 : 0;
        u.A = A + (size_t)rt * 256 * K * 2; u.B = W + (size_t)e * W_EXPERT + wsub + (size_t)pn * 256 * K * 2;
        u.out = out + ((size_t)rt * 256 * ldc + (size_t)pn * colw) * esz; u.ldc = ldc; u.flag = 0; u.aux = rsc ? (const char*)(rsc + (size_t)rt * 256) : nullptr; u.aux2 = nullptr; return true;
    }
};

struct SchedMoeSplit {
    int c, G, RF, RT; MoeTiles mt; const char* A; const char* W; char* y0; char* y1;
    __device__ __forceinline__ bool next(int i, Unit& u) const {
        const int L = i * G + c; if (L >= (RT - RF) * 8) return false;
        const int ts = L >> 1, kh = L & 1, rt = RF + (ts >> 2), pn = ts & 3;
        int e = 0;
#pragma unroll
        for (int k = 1; k < 8; ++k) e += (rt >= mt.tb[k]) ? 1 : 0;
        u.A = A + ((size_t)rt * 256 * DFE + kh * (DFE / 2)); u.B = W + (size_t)e * W_EXPERT + W_MD + ((size_t)pn * 256 * DFE + kh * (DFE / 2));
        u.out = kh ? y1 + ((size_t)(rt - RF) * 256 * DM + pn * 256) * 2 : y0 + ((size_t)rt * 256 * DM + pn * 256) * 2;
        u.ldc = DM; u.flag = 0; u.aux = nullptr; u.aux2 = nullptr; return true;
    }
};

#define LAUNDER_S(x) asm volatile("" : "+s"(x))
#define LAUNDER_V(x) asm volatile("" : "+v"(x))
constexpr int LDS_ARGOFF = LDS_CTLOFF + 512;
__device__ __forceinline__ const float* ARGP(LAS unsigned char* lds, int i) {
    unsigned off = LDS_ARGOFF + 8 * i; asm volatile("" : "+s"(off));
    volatile LAS unsigned* p = (volatile LAS unsigned*)(lds + off);
    const unsigned lo = __builtin_amdgcn_readfirstlane(p[0]), hi = __builtin_amdgcn_readfirstlane(p[1]);
    return (const float*)(((unsigned long long)hi << 32) | lo);
}
__device__ __forceinline__ void grid_barrier(LAS unsigned char* lds, int wv) {
    XcdBarrier b; b.bar = (unsigned*)((unsigned char*)ARGP(lds, 24) + WS_CTL) + CW_BAR; b.x = xb_xcc_id(); b.st = (volatile LAS unsigned*)(lds + LDS_CTLOFF);
    xcd_barrier(b, wv == 0 && lane_id() == 0);
}
struct Fr { LAS unsigned char* lds; unsigned char* ws; int tid, lane, wave, bid, G, gw, NGW; unsigned* ctl; };
__device__ __forceinline__ Fr make_frame(LAS unsigned char* lds, int wv) {
    Fr F; F.lds = lds;
    F.ws = (unsigned char*)ARGP(lds, 24); int t = wv * 64 + lane_id(); LAUNDER_V(t); F.tid = t; F.lane = t & 63; F.wave = wv;
    int b = blockIdx.x; LAUNDER_S(b); F.bid = b; int g = gridDim.x; LAUNDER_S(g); F.G = g; F.gw = b * 8 + F.wave; F.NGW = g * 8; F.ctl = (unsigned*)(F.ws + WS_CTL);
    return F;
}

constexpr int CV_PRO = 4 * CV_LAYER + 2 * CV_DENSE;
constexpr int CV_M1 = CV_PRO, CV_M3 = CV_PRO + 8 * CV_EXP;
#ifndef BG_BRW
#define BG_BRW 4
#endif
#ifndef BG_DDW
#define BG_DDW 7
#endif
constexpr int BG_BR = 192 * 8 * BG_BRW, BG_OUT = 224 * 8 * 4, BG_DD = 224 * 8 * BG_DDW;
constexpr int CVQ_BLK = 32;
constexpr int MQ1_S = CV_M1 + BG_BR + BG_OUT + BG_DD + BG_BR, MQ1_E = CV_M3, MQ2_S = CV_M3 + BG_OUT + BG_BR + BG_OUT + BG_DD, MQ2_E = CV_TOTAL;
static_assert(MQ1_S <= MQ1_E && MQ2_S <= MQ2_E && (MQ1_E - MQ1_S) % (8 * CVQ_BLK) == 0 && (MQ2_E - MQ2_S) % (8 * CVQ_BLK) == 0, "queue conversion ranges are whole units per XCD queue");
__device__ __forceinline__ void convert_range(LAS unsigned char* lds, const Fr& F, int start, int end, int gwi, int nw) {
    Args a;
#pragma unroll
    for (int i = 0; i < 23; ++i) a.in[i] = ARGP(lds, i);
    a.out = nullptr; a.ws = F.ws;
    LAS float* scr = (LAS float*)(lds + F.wave * 8704);
    float ra[32], rb[32]; ConvDesc d, dn; int it = start + gwi; bool have = it < end;
    if (have) { d = conv_decode(a, it); conv_load(d, ra, F.lane); }
    while (have) {
        const int itn = it + nw; const bool hn = itn < end;
        if (hn) { dn = conv_decode(a, itn); conv_load(dn, rb, F.lane); }
        conv_store(d, ra, scr, F.lane);
        if (hn) {
#pragma unroll
            for (int i = 0; i < 32; ++i) ra[i] = rb[i];
            d = dn; }
        it = itn; have = hn;
    }
}
__device__ __forceinline__ void bg_window(int kind, int l, int& s, int& e) {
    s = 0; e = 0;
    const int m1a = CV_M1, m1b = m1a + BG_BR, m1c = m1b + BG_OUT, m1d = m1c + BG_DD, m1e = MQ1_S;
    const int m3a = CV_M3, m3b = m3a + BG_OUT, m3c = m3b + BG_BR, m3d = m3c + BG_OUT, m3e = MQ2_S;
    if (kind == 0) { if (l == 0) { s = m1a; e = m1b; } else if (l == 1) { s = m1d; e = m1e; } else if (l == 2) { s = m3b; e = m3c; } }
    else if (kind == 1) { if (l == 0) { s = m1b; e = m1c; } else if (l == 1) { s = m3a; e = m3b; } else if (l == 2) { s = m3c; e = m3d; } }
    else { if (l == 0) { s = m1c; e = m1d; } else if (l == 2) { s = m3d; e = m3e; } }
}
__device__ __forceinline__ void phase_prologue(LAS unsigned char* lds, int wv) {
    const Fr F = make_frame(lds, wv);
    Args a;
#pragma unroll
    for (int i = 0; i < 23; ++i) a.in[i] = ARGP(lds, i);
    a.out = nullptr; a.ws = F.ws;
    if (F.bid < 96) mod_item(a, F.bid, lds, F.tid);
    for (int it = F.gw; it < 2048; it += F.NGW) fzfold_item(a, it, F.lane);
    convert_range(lds, F, 0, CV_LAYER, F.gw, F.NGW);
    float* rope = (float*)(F.ws + WS_ROPE);
    for (int i = F.gw * 64 + F.lane; i < SEQ * 64; i += F.NGW * 64) { const int t = i >> 6, j = i & 63, ax = j >> 5, isin = (j >> 4) & 1, f = j & 15;
        const float pos = (float)(ax == 0 ? (t >> 6) : (t & 63));
        const float inv = powf(10000.0f, -(float)f / 16.0f); const float ang = pos * inv;
        rope[i] = isin ? sinf(ang) : cosf(ang); }
    bf16_t* T = (bf16_t*)(F.ws + WS_T);
    for (int i = F.gw * 64 + F.lane; i < 2048 * 2048; i += F.NGW * 64) { const int k = i >> 11, n = i & 2047; const float x = (float)((k * n) & 2047) * (1.0f / 1024.0f);
        T[(size_t)k * 4096 + n] = f2bf(cospif(x)); T[(size_t)k * 4096 + 2048 + n] = f2bf(-sinpif(x)); }
    bf16_t* T2 = (bf16_t*)(F.ws + WS_T256);
    for (int i = F.gw * 64 + F.lane; i < 256 * 256; i += F.NGW * 64) { const int k = i >> 8, n = i & 255; const float x = (float)((k * n) & 255) * (1.0f / 128.0f);
        T2[k * 512 + n] = f2bf(cospif(x)); T2[k * 512 + 256 + n] = f2bf(-sinpif(x)); }
}
__device__ __forceinline__ void phase_first_norm(LAS unsigned char* lds, int wv) {
    const Fr F = make_frame(lds, wv);
    const float* X = ARGP(lds, I_X); const float* CX = ARGP(lds, I_CTX); const float* n1g = ARGP(lds, I_N1G);
    float* xs = (float*)(F.ws + WS_XS); bf16_t* xn = (bf16_t*)(F.ws + WS_XN); const float* modv_all = (const float*)(F.ws + WS_MODV);
    for (int row = F.gw; row < NTOK; row += F.NGW) {
        const float* src = row < NLAT ? X + (size_t)row * DM : CX + (size_t)(row - NLAT) * DM;
        const RowV x = load_row_f32(src, F.lane);
        const float* mv = modv_all + (size_t)mod_row_of(row) * 6144;
        const RowV y = adaln_row(x, n1g, mv, mv + 1024, F.lane);
        store_row_bf16(xn + (size_t)row * DM, y, F.lane);
        store_row_fp8(F.ws + WS_XN8 + (size_t)row * DM, y, F.lane);
    }
}
__device__ __forceinline__ void phase_inproj(LAS unsigned char* lds, int wv, int l) {
    const Fr F = make_frame(lds, wv); unsigned char* ws = F.ws; const bool lastl = l == DEPTH - 1;
    { SchedInproj S{F.bid, F.G, NTOK / 256, (NTOK / 256) * 12, lastl ? 256 : 288, (const char*)(ws + WS_XN), (const char*)w_layer(ws, l, W_IN), (const char*)w_layer(ws, l, W_FZ), (char*)(ws + WS_P), (char*)(ws + WS_ZZ), (char*)(ws + WS_ZZC), (const char*)(ws + WS_ROPE)};
      pg8::EpiInproj E{};
      pg8::gemm_phase<pg8::EpiInproj, SchedInproj, true, true>(lds, F.tid, DM, DM, DM, S, E); }
    { SchedGate S{(F.bid + (F.G >> 1)) % F.G, F.G, NTOK / 256, (const char*)(ws + WS_XN8), (const char*)w_layer(ws, l, W_ING8), (char*)(ws + WS_G)};
      pg8::EpiGate E{};
      int tl = F.tid; LAUNDER_V(tl);
      pg8::gemm_phase<pg8::EpiGate, SchedGate, true, true, true>(lds, tl, DM / 2, DM / 2, DM / 2, S, E, 120); }
}
__device__ __forceinline__ void phase_post(LAS unsigned char* lds, int wv, int l) {
    const Fr F = make_frame(lds, wv);
    GAS bf16_t* P = (GAS bf16_t*)(F.ws + WS_P); const GAS float* rope = (const GAS float*)(F.ws + WS_ROPE);
    const GAS float* gq = (const GAS float*)ARGP(lds, I_QKG) + l * 128; const GAS float* gk = gq + 64;
    const int lane = F.lane, a = (lane & 7) >> 2, i0 = 4 * (lane & 3);
    float gqv[8], gkv[8];
#pragma unroll
    for (int e = 0; e < 8; ++e) { const int d = 32 * a + 16 * (e & 1) + i0 + (e >> 1); gqv[e] = gq[d]; gkv[e] = gk[d]; }
    for (int row = F.gw; row < NTOK; row += F.NGW) {
        GAS bf16_t* pr = P + (size_t)row * PW;
        const bool lat = row < NLAT;
        f32x4 cs = (f32x4){1.f, 1.f, 1.f, 1.f}, sn = (f32x4){0.f, 0.f, 0.f, 0.f};
        if (lat) { const GAS float* rt = rope + (size_t)(row & 2047) * 64 + a * 32 + i0; cs = *(const GAS f32x4*)rt; sn = *(const GAS f32x4*)(rt + 16); }
        const u32x4 qw = *(const GAS u32x4*)(pr + C_BQ + 8 * lane);
        u32x4 kw = (u32x4){0u, 0u, 0u, 0u};
        if (lane < 16) kw = *(const GAS u32x4*)(pr + C_BK + 8 * lane);
        float x[8], y[8];
        x[0] = bf_lo(qw.x); x[1] = bf_hi(qw.x); x[2] = bf_lo(qw.y); x[3] = bf_hi(qw.y); x[4] = bf_lo(qw.z); x[5] = bf_hi(qw.z); x[6] = bf_lo(qw.w); x[7] = bf_hi(qw.w);
        y[0] = bf_lo(kw.x); y[1] = bf_hi(kw.x); y[2] = bf_lo(kw.y); y[3] = bf_hi(kw.y); y[4] = bf_lo(kw.z); y[5] = bf_hi(kw.z); y[6] = bf_lo(kw.w); y[7] = bf_hi(kw.w);
        float sq = 0.f, sk = 0.f;
#pragma unroll
        for (int e = 0; e < 8; ++e) { sq += x[e] * x[e]; sk += y[e] * y[e]; }
        sq += __shfl_xor(sq, 1); sq += __shfl_xor(sq, 2); sq += __shfl_xor(sq, 4);
        sk += __shfl_xor(sk, 1); sk += __shfl_xor(sk, 2); sk += __shfl_xor(sk, 4);
        const float rq = 1.0f / sqrtf(sq * (1.0f / 64.0f) + 1e-6f), rk = 1.0f / sqrtf(sk * (1.0f / 64.0f) + 1e-6f);
#pragma unroll
        for (int e = 0; e < 8; ++e) { x[e] *= rq * gqv[e]; y[e] *= rk * gkv[e]; }
        float xo[8], yo[8];
#pragma unroll
        for (int p2 = 0; p2 < 4; ++p2) { const float c = cs[p2], s = sn[p2];
            xo[2 * p2] = (x[2 * p2] * c - x[2 * p2 + 1] * s) * C2; xo[2 * p2 + 1] = (x[2 * p2 + 1] * c + x[2 * p2] * s) * C2;
            yo[2 * p2] = y[2 * p2] * c - y[2 * p2 + 1] * s; yo[2 * p2 + 1] = y[2 * p2 + 1] * c + y[2 * p2] * s; }
        u32x4 ow; ow.x = cvt_pk_bf16(xo[0], xo[1]); ow.y = cvt_pk_bf16(xo[2], xo[3]); ow.z = cvt_pk_bf16(xo[4], xo[5]); ow.w = cvt_pk_bf16(xo[6], xo[7]);
        *(GAS u32x4*)(pr + C_BQ + 8 * lane) = ow;
        if (lane < 16) { u32x4 kk; kk.x = cvt_pk_bf16(yo[0], yo[1]); kk.y = cvt_pk_bf16(yo[2], yo[3]); kk.z = cvt_pk_bf16(yo[4], yo[5]); kk.w = cvt_pk_bf16(yo[6], yo[7]);
            *(GAS u32x4*)(pr + C_BK + 8 * lane) = kk; }
    }
}
constexpr int CVQ_UNITS = (CV_PRO - CV_LAYER) / (8 * CVQ_BLK);
static_assert(CVQ_UNITS * 8 * CVQ_BLK == CV_PRO - CV_LAYER, "conversion units tile the deferred block range");
__device__ __forceinline__ void phase_mix(LAS unsigned char* lds, int wv, int l, int rep) {
    const Fr F = make_frame(lds, wv); unsigned char* ws = F.ws; const bool lastl = l == DEPTH - 1;
    volatile LAS unsigned* LCTL = (volatile LAS unsigned*)(lds + LDS_CTLOFF);
    { SchedDft S{F.bid, (const char*)(ws + WS_T), (const char*)(ws + WS_ZZ), (char*)(ws + WS_O)}; pg8::EpiStore E{1.0f / 362.03867196751236f};
      pg8::gemm_phase<pg8::EpiStore, SchedDft, false, true>(lds, F.tid, 4096, 4096, 4096, S, E); }
    if (!lastl) { SchedDftCtx S{F.bid, (const char*)(ws + WS_T256), (const char*)(ws + WS_ZZC), (char*)(ws + WS_O)}; pg8::EpiStore E{1.0f / 128.0f};
      pg8::gemm_phase<pg8::EpiStore, SchedDftCtx, false, true>(lds, F.tid, 512, 512, 512, S, E); }
    float c08 = 0.8f; asm volatile("" : "+v"(c08));
    const float li = c08 - 0.6f * expf(-0.3f * (float)l);
    const float* lp = ARGP(lds, I_DLAM) + l * 256;
    float d01 = 0.f, d23 = 0.f;
    for (int k = 0; k < 64; ++k) { d01 += lp[k] * lp[64 + k]; d23 += lp[128 + k] * lp[192 + k]; }
    const float lam_u = __builtin_bit_cast(float, __builtin_amdgcn_readfirstlane(__builtin_bit_cast(int, expf(d01) - expf(d23) + li)));
    const float oml_u = __builtin_bit_cast(float, __builtin_amdgcn_readfirstlane(__builtin_bit_cast(int, 1.0f - li)));
    AttnCtx ac{(const bf16_t*)(ws + WS_P), (bf16_t*)(ws + WS_O), ARGP(lds, I_SUBLN) + l * 128, lam_u, oml_u, ARGP(lds, I_SINK) + l * 8};
    const int NUB = lastl ? 192 : 216;
    int NCV = 0, cvbase = 0;
    if (rep == 0) { if (l == 0) { NCV = CVQ_UNITS; cvbase = CV_LAYER; } else if (l == 1) { NCV = (MQ1_E - MQ1_S) / (8 * CVQ_BLK); cvbase = MQ1_S; } else if (l == 2) { NCV = (MQ2_E - MQ2_S) / (8 * CVQ_BLK); cvbase = MQ2_S; } }
    const int bq = F.bid & 7;
    unsigned* qc = F.ctl + CW_Q + 64 * (8 * (l + 4 * rep) + bq);
    for (;;) {
        __syncthreads();
        if (F.tid == 0) LCTL[2] = xb_add(qc, 1u);
        __syncthreads();
        const int u = __builtin_amdgcn_readfirstlane((int)LCTL[2]);
        if (u >= NUB + NCV) break;
        if (u >= NUB) { const int s = cvbase + ((u - NUB) * 8 + bq) * CVQ_BLK; convert_range(lds, F, s, s + CVQ_BLK, F.wave, 8); continue; }
        int tl = F.tid; LAUNDER_V(tl);
        if (u < 64) attn_unit<0>(lds, tl, ac, bq, u >> 4, u & 15, false);
        else if (u < 128) { const int v = u - 64; attn_unit<1>(lds, tl, ac, bq, v >> 5, v & 31, false); }
        else if (u < 192) { const int v = u - 128; attn_unit<2>(lds, tl, ac, bq, v >> 5, v & 31, false); }
        else if (u < 200) { const int v = u - 192; attn_unit<0>(lds, tl, ac, bq, v >> 1, v & 1, true); }
        else if (u < 208) { const int v = u - 200; attn_unit<1>(lds, tl, ac, bq, v >> 2, v & 3, true); }
        else { const int v = u - 208; attn_unit<2>(lds, tl, ac, bq, v >> 2, v & 3, true); }
    }
}
__device__ __forceinline__ void phase_branch(LAS unsigned char* lds, int wv, int l) {
    const Fr F = make_frame(lds, wv); unsigned char* ws = F.ws; const int nMact = (l == DEPTH - 1) ? NLAT / 256 : NTOK / 256;
    SchedBranch S{F.bid, F.G, nMact * 8, (const char*)(ws + WS_O), (const char*)w_layer(ws, l, W_BR), (const char*)(ws + WS_G), (char*)(ws + WS_XN)};
    pg8::branch_phase<SchedBranch>(lds, F.tid, S);
    if (nMact == NTOK / 256 && (F.bid >> 3) >= 8) {
        int s, e; bg_window(0, l, s, e);
        if (e > s) convert_range(lds, F, s, e, ((F.bid & 7) * 24 + (F.bid >> 3) - 8) * 8 + F.wave, 192 * 8);
    }
}
__device__ __forceinline__ void phase_out(LAS unsigned char* lds, int wv, int l) {
    const Fr F = make_frame(lds, wv); unsigned char* ws = F.ws; const int nMact = (l == DEPTH - 1) ? NLAT / 256 : NTOK / 256;
    SchedResid S{F.bid, F.G, nMact, DM, (const char*)(ws + WS_XN), (const char*)w_layer(ws, l, W_OUT), (char*)(ws + WS_XS), (const char*)(ws + WS_MODV + (size_t)l * 9 * 6144 * 4), 2048, l == 0 ? (const char*)ARGP(lds, I_X) : nullptr, l == 0 ? (const char*)ARGP(lds, I_CTX) : nullptr};
    pg8::EpiResid E{};
    pg8::gemm_phase<pg8::EpiResid, SchedResid, true, true>(lds, F.tid, DM, DM, DM, S, E);
    if (nMact == NTOK / 256 && F.bid >= 32) {
        int s, e; bg_window(1, l, s, e);
        if (e > s) convert_range(lds, F, s, e, (F.bid - 32) * 8 + F.wave, 224 * 8);
    }
}
__device__ __forceinline__ void phase_norm2_dense(LAS unsigned char* lds, int wv, int l) {
    const Fr F = make_frame(lds, wv); const int nrows = (l == DEPTH - 1) ? NLAT : NTOK;
    const bf16_t* xs = (const bf16_t*)(F.ws + WS_XS); bf16_t* xn = (bf16_t*)(F.ws + WS_XN); const float* modv = (const float*)(F.ws + WS_MODV) + (size_t)l * 9 * 6144;
    const float* n2g = ARGP(lds, I_N2G) + l * DM;
    const int rpw = nrows / F.NGW, r0 = F.gw * rpw, r1 = r0 + rpw;
    AdaCoef co; co.mr = -1;
    for (int r = r0; r < r1; r += 3) {
        RowV x[3];
#pragma unroll
        for (int q = 0; q < 3; ++q) x[q] = load_row_bf16(xs + (size_t)(r + q < r1 ? r + q : r) * DM, F.lane);
#pragma unroll
        for (int q = 0; q < 3; ++q) if (r + q < r1) { ada_coef_update(co, r + q, n2g, modv, 3072, 4096, F.lane);
            const RowQ yq = quant_row_i8(adaln_apply(x[q], co));
            store_rowq((unsigned char*)xn + (size_t)(r + q) * DM, yq, F.lane); if (F.lane == 0) ((float*)(F.ws + WS_RSC))[r + q] = yq.sc; }
    }
}
__device__ __forceinline__ void phase_up_dense(LAS unsigned char* lds, int wv, int l) {
    const Fr F = make_frame(lds, wv); unsigned char* ws = F.ws; const int nMact = (l == DEPTH - 1) ? NLAT / 256 : NTOK / 256;
    if ((DENSE_F8_MASK >> (l >> 1)) & 1) {
        SchedUp S{F.bid, F.G, nMact, (const char*)(ws + WS_XN), (const char*)w_dense(ws, l >> 1, W_DGU), (char*)(ws + WS_P), 1, (const float*)(ws + WS_RSC)};
        pg8::EpiSwigluI8<true> E{1.0f / W8_GU};
        pg8::gemm_phase<pg8::EpiSwigluI8<true>, SchedUp, true, true, 2>(lds, F.tid, DM / 2, DM / 2, DM / 2, S, E);
    } else {
        SchedUp S{F.bid, F.G, nMact, (const char*)(ws + WS_XN), (const char*)w_dense(ws, l >> 1, W_DGU), (char*)(ws + WS_P), 2, (const float*)(ws + WS_RSC)};
        pg8::EpiSwigluI8<false> E{1.0f / W8_GU};
        pg8::gemm_phase<pg8::EpiSwigluI8<false>, SchedUp, true, true, 2>(lds, F.tid, DM / 2, DM / 2, DM / 2, S, E);
    }
}
__device__ __forceinline__ void phase_down_dense(LAS unsigned char* lds, int wv, int l) {
    const Fr F = make_frame(lds, wv); unsigned char* ws = F.ws; const int nMact = (l == DEPTH - 1) ? NLAT / 256 : NTOK / 256;
    pg8::EpiResid E{};
    if ((DENSE_F8_MASK >> (l >> 1)) & 1) {
        SchedResid S{F.bid, F.G, nMact, DFF / 2, (const char*)(ws + WS_P), (const char*)w_dense(ws, l >> 1, W_DD), (char*)(ws + WS_XS), (const char*)(ws + WS_MODV + (size_t)l * 9 * 6144 * 4), 5120, nullptr, nullptr};
        pg8::gemm_phase<pg8::EpiResid, SchedResid, true, true, true>(lds, F.tid, DFF / 2, DFF / 2, DFF / 2, S, E, 119);
    } else {
        SchedResid S{F.bid, F.G, nMact, DFF, (const char*)(ws + WS_P), (const char*)w_dense(ws, l >> 1, W_DD), (char*)(ws + WS_XS), (const char*)(ws + WS_MODV + (size_t)l * 9 * 6144 * 4), 5120, nullptr, nullptr};
        pg8::gemm_phase<pg8::EpiResid, SchedResid, true, true>(lds, F.tid, DFF, DFF, DFF, S, E);
    }
    if (nMact == NTOK / 256 && F.bid >= 32) {
        int s, e; bg_window(2, l, s, e);
        if (e > s) convert_range(lds, F, s, e, (F.bid - 32) * 8 + F.wave, 224 * 8);
    }
}
__device__ __forceinline__ void phase_norm2_moe(LAS unsigned char* lds, int wv, int l) {
    const Fr F = make_frame(lds, wv); const int nrows = (l == DEPTH - 1) ? NLAT : NTOK; const int mi = l >> 1;
    volatile LAS unsigned* LCTL = (volatile LAS unsigned*)(lds + LDS_CTLOFF);
    const bf16_t* xs = (const bf16_t*)(F.ws + WS_XS); bf16_t* xn = (bf16_t*)(F.ws + WS_XN); const float* modv = (const float*)(F.ws + WS_MODV) + (size_t)l * 9 * 6144;
    const float* n2g = ARGP(lds, I_N2G) + l * DM;
    int* toklist = (int*)(F.ws + WS_MOE); int* rec = toklist + 8 * NTOK;
    const int rpb = nrows / F.G;
    const int tid = F.tid, lane = F.lane;
    LAS int* lrec = (LAS int*)(lds + 1024);
    const float* rw = ARGP(lds, I_RW) + (size_t)mi * DM * 8;
    for (int rr = F.wave; rr < rpb; rr += 8) {
        const int row = F.bid * rpb + rr;
        const RowV x = load_row_bf16(xs + (size_t)row * DM, lane);
        const float* mv = modv + (size_t)mod_row_of(row) * 6144;
        const RowV y = adaln_row(x, n2g, mv + 3072, mv + 4096, lane);
        float lg[8];
#pragma unroll
        for (int e = 0; e < 8; ++e) lg[e] = 0.f;
#pragma unroll
        for (int j = 0; j < 4; ++j)
#pragma unroll
            for (int cc = 0; cc < 4; ++cc) { const float* wp = rw + (size_t)(256 * j + 4 * lane + cc) * 8; const f32x4 w0 = *(const f32x4*)wp, w1 = *(const f32x4*)(wp + 4); const float hv = y.v[j][cc];
                lg[0] += hv * w0[0]; lg[1] += hv * w0[1]; lg[2] += hv * w0[2]; lg[3] += hv * w0[3]; lg[4] += hv * w1[0]; lg[5] += hv * w1[1]; lg[6] += hv * w1[2]; lg[7] += hv * w1[3]; }
#pragma unroll
        for (int e = 0; e < 8; ++e) lg[e] = wave_sum(lg[e]);
        int i0 = 0; float v0 = lg[0];
#pragma unroll
        for (int e = 1; e < 8; ++e) if (lg[e] > v0) { v0 = lg[e]; i0 = e; }
        int i1 = -1; float v1 = -3.0e38f;
#pragma unroll
        for (int e = 0; e < 8; ++e) if (e != i0 && lg[e] > v1) { v1 = lg[e]; i1 = e; }
        if (lane == 0) {
            const float w0 = 1.0f / (1.0f + expf(v1 - v0)), w1 = 1.0f - w0;
            lrec[rr * 6 + 0] = i0; lrec[rr * 6 + 2] = __float_as_int(w0); lrec[rr * 6 + 3] = i1; lrec[rr * 6 + 5] = __float_as_int(w1);
        }
    }
    __syncthreads();
    { const int e = F.wave; int cnt = 0;
      for (int a0 = 0; a0 < 2 * rpb; a0 += 64) { const int a = a0 + lane; const bool valid = a < 2 * rpb; const int rr = a >> 1, k3 = 3 * (a & 1);
          const bool match = valid && lrec[rr * 6 + k3] == e;
          const unsigned long long bal = __ballot(match);
          if (match) lrec[rr * 6 + k3 + 1] = cnt + (int)__popcll(bal & ((1ull << lane) - 1ull));
          cnt += (int)__popcll(bal); }
      if (lane == 0) { toklist[F.bid * 8 + e] = cnt;
          (void)xb_add(F.ctl + CW_CNT + 64 * (8 * mi + e), (unsigned)cnt); } }
    __syncthreads();
    for (int rr = tid; rr < rpb; rr += 512) {
        const int row = F.bid * rpb + rr;
        int* rc = rec + (size_t)row * 8;
        rc[0] = lrec[rr * 6 + 0]; rc[1] = lrec[rr * 6 + 1]; rc[2] = lrec[rr * 6 + 2]; rc[3] = lrec[rr * 6 + 3]; rc[4] = lrec[rr * 6 + 4]; rc[5] = lrec[rr * 6 + 5];
    }
}
__device__ __forceinline__ void phase_moe_gather(LAS unsigned char* lds, int wv, int l) {
    const Fr F = make_frame(lds, wv); const int mi = l >> 1; const int nrows = (l == DEPTH - 1) ? NLAT : NTOK; const int rpb = nrows / F.G;
    volatile LAS unsigned* LCTL = (volatile LAS unsigned*)(lds + LDS_CTLOFF);
    const MoeTiles mt = moe_tiles(F.ctl, mi);
    const GAS bf16_t* xn = (const GAS bf16_t*)(F.ws + WS_XN); GAS bf16_t* hs = (GAS bf16_t*)(F.ws + WS_HY);
    const GAS int* blkcnt = (const GAS int*)(F.ws + WS_MOE); GAS int* rec = (GAS int*)(F.ws + WS_MOE) + 8 * NTOK;
    LAS int* red = (LAS int*)(lds + 1024);
    { const int e = F.tid & 7, ch = F.tid >> 3; int s = 0;
#pragma unroll
      for (int j = 0; j < 4; ++j) { const int bb = ch * 4 + j; if (bb < F.bid) s += blkcnt[bb * 8 + e]; }
      red[e * 64 + ch] = s; }
    __syncthreads();
    if (F.tid < 8) { int s = 0; for (int ch = 0; ch < 64; ++ch) s += red[F.tid * 64 + ch]; LCTL[16 + F.tid] = (unsigned)s; }
    __syncthreads();
    LAS int* sl = (LAS int*)(lds + 4096);
    for (int rr = F.tid; rr < rpb; rr += 512) {
        GAS int* rc = rec + (size_t)(F.bid * rpb + rr) * 8;
        const int e0 = rc[0], e1 = rc[3];
        const int p0 = rc[1] + (int)LCTL[16 + e0], p1 = rc[4] + (int)LCTL[16 + e1];
        int t0 = 0, t1 = 0;
#pragma unroll
        for (int k = 0; k < 8; ++k) { t0 = (e0 == k) ? mt.tb[k] : t0; t1 = (e1 == k) ? mt.tb[k] : t1; }
        sl[rr * 2] = t0 * 256 + p0; sl[rr * 2 + 1] = t1 * 256 + p1;
        rc[1] = p0; rc[4] = p1;
    }
    __syncthreads();
    const bf16_t* xs = (const bf16_t*)(F.ws + WS_XS); const float* modv = (const float*)(F.ws + WS_MODV) + (size_t)l * 9 * 6144; const float* n2g = ARGP(lds, I_N2G) + l * DM;
    AdaCoef co; co.mr = -1;
    for (int r0 = F.wave * (rpb >> 3); r0 < (F.wave + 1) * (rpb >> 3); r0 += 3) {
        RowV x[3]; int s[3][2];
#pragma unroll
        for (int q = 0; q < 3; ++q) { const int rr = r0 + q; const bool ok = rr < (F.wave + 1) * (rpb >> 3);
            x[q] = load_row_bf16(xs + (size_t)(F.bid * rpb + (ok ? rr : r0)) * DM, F.lane);
            s[q][0] = ok ? sl[rr * 2] : -1; s[q][1] = ok ? sl[rr * 2 + 1] : -1; }
#pragma unroll
        for (int q = 0; q < 3; ++q) if (s[q][0] >= 0) { const int row = F.bid * rpb + r0 + q;
            ada_coef_update(co, row, n2g, modv, 3072, 4096, F.lane);
            const RowV y = adaln_apply(x[q], co);
            const RowQ yq = quant_row_i8(y);
            store_rowq((unsigned char*)hs + (size_t)s[q][0] * DM, yq, F.lane); store_rowq((unsigned char*)hs + (size_t)s[q][1] * DM, yq, F.lane);
            if (F.lane == 0) { float* ssc = (float*)(F.ws + WS_SSC); ssc[s[q][0]] = yq.sc; ssc[s[q][1]] = yq.sc; } }
    }
    for (int idx = F.gw; idx < 8 * 256; idx += F.NGW) { const int e = idx >> 8, j = idx & 255;
        const int cnt = __builtin_amdgcn_readfirstlane((int)__hip_atomic_load(F.ctl + CW_CNT + 64 * (8 * mi + e), __ATOMIC_RELAXED, __HIP_MEMORY_SCOPE_AGENT));
        const int pad = ((cnt + 255) & ~255) - cnt; int tbe = 0;
#pragma unroll
        for (int k = 0; k < 8; ++k) tbe = (e == k) ? mt.tb[k] : tbe;
        if (j < pad) { unsigned z = 0u; asm volatile("" : "+v"(z));
            GAS u32x4* dp = (GAS u32x4*)((GAS unsigned char*)hs + (size_t)(tbe * 256 + cnt + j) * DM) + F.lane; dp[0] = (u32x4){z, z, z, z}; if (F.lane == 0) ((GAS float*)(F.ws + WS_SSC))[tbe * 256 + cnt + j] = __uint_as_float(z); } }
}
__device__ __forceinline__ void phase_up_moe(LAS unsigned char* lds, int wv, int l) {
    const Fr F = make_frame(lds, wv); unsigned char* ws = F.ws; const int mi = l >> 1;
    const MoeTiles mt = moe_tiles(F.ctl, mi);
    SchedMoe S{F.bid, F.G, 28, DM / 2, mt.tb[8], mt, (const char*)(ws + WS_HY), (const char*)w_moe(ws, mi, 0, 0), W_MGU, (char*)(ws + WS_P), DFE, 128, 1, (const float*)(ws + WS_SSC)};
    pg8::EpiSwigluI8<true> E{1.0f / W8_GU};
    pg8::gemm_phase<pg8::EpiSwigluI8<true>, SchedMoe, true, true, 2>(lds, F.tid, DM / 2, DM / 2, DM / 2, S, E);
}
__device__ __forceinline__ void phase_down_moe(LAS unsigned char* lds, int wv, int l) {
    const Fr F = make_frame(lds, wv); unsigned char* ws = F.ws; const int mi = l >> 1;
    const MoeTiles mt = moe_tiles(F.ctl, mi);
    const int RT = mt.tb[8], RF = RT < MOE_RF ? RT : MOE_RF;
    pg8::EpiStore E{1.0f};
    { SchedMoe S{F.bid, F.G, 4, DFE / 2, RF, mt, (const char*)(ws + WS_P), (const char*)w_moe(ws, mi, 0, 0), W_MD, (char*)(ws + WS_HY), DM, 256, 2};
      pg8::gemm_phase<pg8::EpiStore, SchedMoe, true, true, true>(lds, F.tid, DFE / 2, DFE / 2, DFE / 2, S, E, 119); }
    if (RT > RF) {
        SchedMoeSplit S2{F.bid, F.G, RF, RT, mt, (const char*)(ws + WS_P), (const char*)w_moe(ws, mi, 0, 0), (char*)(ws + WS_HY), (char*)(ws + WS_Y1)};
        pg8::gemm_phase<pg8::EpiStore, SchedMoeSplit, true, true, true>(lds, F.tid, DFE / 4, DFE / 2, DFE / 2, S2, E, 119);
    }
}
__device__ __forceinline__ void phase_next_norm(LAS unsigned char* lds, int wv, int l) {
    const Fr F = make_frame(lds, wv); const bool lastl = l == DEPTH - 1; const int nrows = lastl ? NLAT : NTOK; const int mi = l >> 1;
    const bool moe = (l & 1) != 0;
    MoeTiles mt; if (moe) mt = moe_tiles(F.ctl, mi); else {
#pragma unroll
        for (int k = 0; k < 9; ++k) mt.tb[k] = 0; }
    bf16_t* xs = (bf16_t*)(F.ws + WS_XS); bf16_t* xn = (bf16_t*)(F.ws + WS_XN);
    const bf16_t* yb = (const bf16_t*)(F.ws + WS_HY); const bf16_t* yb1 = (const bf16_t*)(F.ws + WS_Y1); const int* rec = (const int*)(F.ws + WS_MOE) + 8 * NTOK;
    const float* modv = (const float*)(F.ws + WS_MODV) + (size_t)l * 9 * 6144;
    const float* modn = modv + 9 * 6144;
    const float* n1g = ARGP(lds, I_N1G) + (lastl ? 0 : (l + 1) * DM); const float* fg = ARGP(lds, I_FINALG); float* outp = (float*)ARGP(lds, 23);
    const int lane = F.lane;
    for (int row = F.gw; row < nrows; row += F.NGW) {
        RowV x = load_row_bf16(xs + (size_t)row * DM, lane);
        if (moe) {
            const int* rc = rec + (size_t)row * 8;
            const int e0 = rc[0], p0 = rc[1], e1 = rc[3], p1 = rc[4]; const float w0 = __int_as_float(rc[2]), w1 = __int_as_float(rc[5]);
            int t0 = 0, t1 = 0;
#pragma unroll
            for (int k = 0; k < 8; ++k) { t0 = (e0 == k) ? mt.tb[k] : t0; t1 = (e1 == k) ? mt.tb[k] : t1; }
            RowV y0 = load_row_bf16(yb + (size_t)(t0 * 256 + p0) * DM, lane), y1 = load_row_bf16(yb + (size_t)(t1 * 256 + p1) * DM, lane);
            { const int rt0 = t0 + (p0 >> 8), rt1 = t1 + (p1 >> 8);
              if (rt0 >= MOE_RF) { const RowV z = load_row_bf16(yb1 + (size_t)((rt0 - MOE_RF) * 256 + (p0 & 255)) * DM, lane);
#pragma unroll
                  for (int j = 0; j < 4; ++j) y0.v[j] += z.v[j]; }
              if (rt1 >= MOE_RF) { const RowV z = load_row_bf16(yb1 + (size_t)((rt1 - MOE_RF) * 256 + (p1 & 255)) * DM, lane);
#pragma unroll
                  for (int j = 0; j < 4; ++j) y1.v[j] += z.v[j]; } }
            const RowV g2 = load_row_f32(modv + (size_t)mod_row_of(row) * 6144 + 5120, lane);
#pragma unroll
            for (int j = 0; j < 4; ++j) x.v[j] += g2.v[j] * (w0 * y0.v[j] + w1 * y1.v[j]);
            if (!lastl) store_row_bf16(xs + (size_t)row * DM, x, lane);
        }
        if (!lastl) {
            const float* mv = modn + (size_t)mod_row_of(row) * 6144;
            const RowV y = adaln_row(x, n1g, mv, mv + 1024, lane);
            store_row_bf16(xn + (size_t)row * DM, y, lane);
            store_row_fp8(F.ws + WS_XN8 + (size_t)row * DM, y, lane);
        } else {
            float ss = 0.f;
#pragma unroll
            for (int j = 0; j < 4; ++j) ss += (x.v[j][0] * x.v[j][0] + x.v[j][1] * x.v[j][1]) + (x.v[j][2] * x.v[j][2] + x.v[j][3] * x.v[j][3]);
            const float rstd = 1.0f / sqrtf(wave_sum(ss) * (1.0f / DM) + 1e-6f);
            const RowV gv = load_row_f32(fg, lane);
            RowV y;
#pragma unroll
            for (int j = 0; j < 4; ++j) y.v[j] = x.v[j] * rstd * gv.v[j];
            store_row_f32(outp + (size_t)row * DM, y, lane);
        }
    }
}

__global__ void __launch_bounds__(512, 2) mega_fwd(Args a) {
    extern __shared__ __attribute__((aligned(16))) unsigned char lds_raw[];
    LAS unsigned char* lds = (LAS unsigned char*)lds_raw;
    volatile LAS unsigned* LCTL = (volatile LAS unsigned*)(lds + LDS_CTLOFF);
    const int wv = __builtin_amdgcn_readfirstlane((int)(threadIdx.x >> 6));
    {
        const int tid = threadIdx.x;
        for (int u = tid; u < 64; u += 512) LCTL[u] = 0u;
        if (tid == 0) { LAS unsigned long long* ap = (LAS unsigned long long*)(lds + LDS_ARGOFF);
#pragma unroll
            for (int i = 0; i < 23; ++i) ap[i] = (unsigned long long)a.in[i];
            ap[23] = (unsigned long long)a.out; ap[24] = (unsigned long long)a.ws; }
        __syncthreads();
    }
    (void)xcd_barrier_post((unsigned*)(a.ws + WS_CTL) + CW_BAR, LCTL);
    phase_prologue(lds, wv);
    grid_barrier(lds, wv);
#if DUP_PRO
    phase_prologue(lds, wv);
    grid_barrier(lds, wv);
#endif
    phase_first_norm(lds, wv);
    grid_barrier(lds, wv);
    for (int l = 0; l < DEPTH; ++l) {
        phase_inproj(lds, wv, l);  grid_barrier(lds, wv);
#if DUP_INPROJ
        phase_inproj(lds, wv, l);  grid_barrier(lds, wv);
#endif
        phase_post(lds, wv, l);    grid_barrier(lds, wv);
        phase_mix(lds, wv, l, 0);  grid_barrier(lds, wv);
#if DUP_MIX
        phase_mix(lds, wv, l, 1);  grid_barrier(lds, wv);
#endif
        phase_branch(lds, wv, l);  grid_barrier(lds, wv);
#if DUP_BRANCH
        phase_branch(lds, wv, l);  grid_barrier(lds, wv);
#endif
        phase_out(lds, wv, l);     grid_barrier(lds, wv);
        if ((l & 1) == 0) {
            phase_norm2_dense(lds, wv, l); grid_barrier(lds, wv);
#if DUP_N2D
            phase_norm2_dense(lds, wv, l); grid_barrier(lds, wv);
#endif
            phase_up_dense(lds, wv, l);    grid_barrier(lds, wv);
#if DUP_UPD
            phase_up_dense(lds, wv, l);    grid_barrier(lds, wv);
#endif
            phase_down_dense(lds, wv, l);  grid_barrier(lds, wv);
        } else {
            phase_norm2_moe(lds, wv, l);   grid_barrier(lds, wv);
            phase_moe_gather(lds, wv, l);  grid_barrier(lds, wv);
#if DUP_GATH
            phase_moe_gather(lds, wv, l);  grid_barrier(lds, wv);
#endif
            phase_up_moe(lds, wv, l);      grid_barrier(lds, wv);
#if DUP_MOEG == 1
            phase_up_moe(lds, wv, l);      grid_barrier(lds, wv);
#endif
            phase_down_moe(lds, wv, l);    grid_barrier(lds, wv);
#if DUP_MOEG == 2
            phase_down_moe(lds, wv, l);    grid_barrier(lds, wv);
#endif
        }
        phase_next_norm(lds, wv, l);
        if (l != DEPTH - 1) grid_barrier(lds, wv);
    }
}

extern "C" void kernel_launch(void* const* d_in, const int* in_sizes, int n_in, void* d_out, int out_size, void* d_ws, size_t ws_size, hipStream_t stream) {
    static int grid = 0;
    if (grid == 0) {
        if (n_in != 23 || out_size != NLAT * DM || ws_size < WS_END) { fprintf(stderr, "kernel_launch: unexpected problem (n_in %d out %d ws %zu need %zu)\n", n_in, out_size, ws_size, (size_t)WS_END); grid = -1; return; }
        int dev = 0, cus = 0, per_cu = 0;
        if (hipGetDevice(&dev) != hipSuccess || hipDeviceGetAttribute(&cus, hipDeviceAttributeMultiprocessorCount, dev) != hipSuccess) { grid = -1; return; }
        if (hipFuncSetAttribute((const void*)mega_fwd, hipFuncAttributeMaxDynamicSharedMemorySize, LDS_BYTES) != hipSuccess) { fprintf(stderr, "kernel_launch: hipFuncSetAttribute failed\n"); grid = -1; return; }
        if (hipOccupancyMaxActiveBlocksPerMultiprocessor(&per_cu, (const void*)mega_fwd, 512, LDS_BYTES) != hipSuccess || per_cu < 1) { fprintf(stderr, "kernel_launch: occupancy query says %d\n", per_cu); }
        (void)hipGetLastError();
        grid = cus;
        if (grid != 256) fprintf(stderr, "kernel_launch: %d CUs (built for 256)\n", grid);
    }
    if (grid < 0) return;
    (void)hipMemsetAsync((char*)d_ws + WS_CTL, 0, CTL_ZERO_BYTES, stream);
    Args a{};
    for (int i = 0; i < 23; ++i) a.in[i] = (const float*)d_in[i];
    a.out = (float*)d_out; a.ws = (unsigned char*)d_ws;
    hipLaunchKernelGGL(mega_fwd, dim3(grid), dim3(512), LDS_BYTES, stream, a);
}
```

```cpp
#include <hip/hip_runtime.h>
#include <cstdio>
#include <cstdint>

#ifndef DUP_MIX
#define DUP_MIX 0
#endif
#ifndef DUP_PRO
#define DUP_PRO 0
#endif
#ifndef DUP_BRANCH
#define DUP_BRANCH 0
#endif
#ifndef DUP_MOEG
#define DUP_MOEG 0
#endif
#ifndef DUP_UPD
#define DUP_UPD 0
#endif
#ifndef DUP_N2D
#define DUP_N2D 0
#endif
#ifndef DUP_GATH
#define DUP_GATH 0
#endif
#ifndef DUP_INPROJ
#define DUP_INPROJ 0
#endif
#ifndef DENSE_F8_MASK
#define DENSE_F8_MASK 0
#endif
#define LAS __attribute__((address_space(3)))
#define GAS __attribute__((address_space(1)))
typedef unsigned short bf16_t;
typedef short bf16x8 __attribute__((ext_vector_type(8)));
typedef short s16x4 __attribute__((ext_vector_type(4)));
typedef float f32x4 __attribute__((ext_vector_type(4)));
typedef float f32x16 __attribute__((ext_vector_type(16)));
typedef unsigned u32x4 __attribute__((ext_vector_type(4)));
typedef unsigned u32x2 __attribute__((ext_vector_type(2)));
typedef int i32x4 __attribute__((ext_vector_type(4)));
typedef int i32x8 __attribute__((ext_vector_type(8)));

constexpr int NB = 8, SEQ = 2048, DM = 1024, DEPTH = 4, CTXL = 256;
constexpr int NLAT = NB * SEQ, NCTX = NB * CTXL, NTOK = NLAT + NCTX;
constexpr int DIN = 7680, PW = 3072, GW = 4096;
constexpr int C_AQ = 0, C_AK = 512, C_AV = 1024, C_BQ = 1536, C_BK = 2048, C_BV = 2176, C_CQ = 2304, C_CK = 2816, C_CV = 2944;
constexpr int DFF = 2816, DFE = 3584, NEXP = 8;
constexpr int OW = 2048;
constexpr int MAXSLOT = 2 * NTOK + 2048;
constexpr float C2 = 0.125f * 1.4426950408889634f;
constexpr float LOG2E = 1.4426950408889634f;

constexpr size_t MiB = 1u << 20;
constexpr size_t WS_CTL = 0, CTL_ZERO_BYTES = 1 * MiB;
constexpr size_t WS_MODV = 1 * MiB;
constexpr size_t WS_ROPE = 2 * MiB;
constexpr size_t WS_T256 = 3 * MiB;
constexpr size_t WS_MOE = 4 * MiB;
constexpr size_t WS_SSC = WS_MOE + 3 * MiB / 2;
constexpr size_t WS_RSC = WS_MOE + 7 * MiB / 4;
constexpr size_t WS_T = 6 * MiB;
constexpr size_t WS_W = 22 * MiB;
constexpr size_t W_IN = 0, W_ING8 = 6 * MiB  , W_FZ = 14 * MiB, W_BR = 16 * MiB, W_OUT = 20 * MiB, W_LAYER = 22 * MiB;
constexpr size_t W_DENSE0 = 4 * W_LAYER, W_DGU = 0, W_DD = 11 * MiB, W_DENSE = 33 * MiB / 2;
constexpr size_t W_MOE0 = W_DENSE0 + 2 * W_DENSE, W_MGU = 0, W_MD = 14 * MiB, W_EXPERT = 21 * MiB, W_MOE = 8 * W_EXPERT;
constexpr size_t WS_XS = WS_W + W_MOE0 + 2 * W_MOE;
constexpr size_t WS_XN8 = WS_XS + 36 * MiB;
constexpr size_t WS_XN = WS_XS + 72 * MiB;
constexpr size_t WS_P = WS_XN + 36 * MiB;
constexpr size_t WS_G = WS_P + 108 * MiB;
constexpr size_t WS_ZZ = WS_P + 252 * MiB;
constexpr size_t WS_ZZC = WS_ZZ + 32 * MiB;
constexpr size_t WS_O = WS_ZZC + 4 * MiB;
constexpr size_t WS_HY = WS_O + 72 * MiB;
constexpr size_t WS_Y1 = WS_HY + 76 * MiB;
constexpr size_t WS_END = WS_Y1 + 16 * MiB;
constexpr int MOE_RF = 128;
static_assert(WS_W + W_MOE0 + 2 * W_MOE == 479 * MiB, "weights");
static_assert((size_t)MAXSLOT * DFE * 2 <= 288 * MiB, "moe hidden fits p+zz");
static_assert((size_t)MAXSLOT * 1024 * 2 <= 76 * MiB, "hs fits");
static_assert(WS_END <= 1074 * MiB, "workspace");

constexpr int CW_BAR = 4096;
constexpr int CW_Q = 16384;
constexpr int CW_CNT = 24576;

constexpr int LDS_CTLOFF = 141312;
constexpr int LDS_BYTES = 147456;

typedef float f32x2_t __attribute__((ext_vector_type(2))); typedef __bf16 bf16x2_t __attribute__((ext_vector_type(2)));
__device__ __forceinline__ unsigned cvt_pk_bf16(float lo, float hi) { f32x2_t v = {lo, hi}; bf16x2_t b = __builtin_convertvector(v, bf16x2_t); return __builtin_bit_cast(unsigned, b); }
__device__ __forceinline__ float clamp_f8(float v) { return __builtin_amdgcn_fmed3f(v, -448.0f, 448.0f); }
__device__ __forceinline__ unsigned cvt4_fp8(float a, float b, float c, float d) { int w = 0; w = __builtin_amdgcn_cvt_pk_fp8_f32(clamp_f8(a), clamp_f8(b), w, false); w = __builtin_amdgcn_cvt_pk_fp8_f32(clamp_f8(c), clamp_f8(d), w, true); return (unsigned)w; }
__device__ __forceinline__ unsigned pack4_i8(float a, float b, float c, float d) {
    const int ia = (int)__builtin_rintf(__builtin_amdgcn_fmed3f(a, -127.0f, 127.0f)), ib = (int)__builtin_rintf(__builtin_amdgcn_fmed3f(b, -127.0f, 127.0f));
    const int ic = (int)__builtin_rintf(__builtin_amdgcn_fmed3f(c, -127.0f, 127.0f)), id = (int)__builtin_rintf(__builtin_amdgcn_fmed3f(d, -127.0f, 127.0f));
    return ((unsigned)ia & 255u) | (((unsigned)ib & 255u) << 8) | (((unsigned)ic & 255u) << 16) | ((unsigned)id << 24); }
constexpr float W8_GU = 127.0f * 32.0f / 6.0f;
__device__ __forceinline__ float bf_lo(unsigned w) { return __uint_as_float(w << 16); }
__device__ __forceinline__ float bf_hi(unsigned w) { return __uint_as_float(w & 0xffff0000u); }
__device__ __forceinline__ float bf2f(bf16_t h) { return __uint_as_float(((unsigned)h) << 16); }
__device__ __forceinline__ bf16_t f2bf(float f) { unsigned u = __float_as_uint(f); u += 0x7fffu + ((u >> 16) & 1u); return (bf16_t)(u >> 16); }
__device__ __forceinline__ float fast_exp2(float x) { return __builtin_amdgcn_exp2f(x); }
__device__ __forceinline__ float fast_rcp(float x) { return __builtin_amdgcn_rcpf(x); }
__device__ __forceinline__ float sigmoidf_(float x) { return fast_rcp(1.0f + fast_exp2(-x * LOG2E)); }
__device__ __forceinline__ float siluf_(float x) { return x * sigmoidf_(x); }
__device__ __forceinline__ float wave_sum(float v) {
#pragma unroll
    for (int o = 1; o < 64; o <<= 1) v += __shfl_xor(v, o);
    return v;
}
#define LDS_WAIT() asm volatile("s_waitcnt lgkmcnt(0)" ::: "memory")
__device__ __forceinline__ int lane_id() { int l; asm volatile("v_mbcnt_lo_u32_b32 %0, -1, 0\n\tv_mbcnt_hi_u32_b32 %0, -1, %0" : "=v"(l)); return l; }

namespace pg8 {
constexpr int BM = 256, BK = 64, HALF = 128, HTB = HALF * BK * 2, STAGE_BYTES = 8 * HTB, NXCD = 8, WGM = 8;
__host__ __device__ __forceinline__ int lds_byte(int r, int c) { const int st = (r >> 4) * 2 + (c >> 5), rr = r & 15, cc = c & 31, ob = rr * 64 + cc * 2; return st * 1024 + (ob ^ (((ob >> 9) & 1) << 5)); }
__host__ __device__ __forceinline__ void stage_rc(int b, int& R, int& C) { const int st = b / 1024, sb = b % 1024, swz = sb ^ (((sb >> 9) & 1) << 5); R = (st >> 1) * 16 + swz / 64; C = (st & 1) * 32 + (swz % 64) / 2; }
__host__ __device__ __forceinline__ int perm32(int rho) { const int n = rho >> 4, i = rho & 15; return 8 * (i >> 2) + 4 * n + (i & 3); }

struct Unit { const char* A; const char* B; char* out; const char* aux; const char* aux2; int ldc; int flag; };

__device__ __forceinline__ void tile_of(int L, int nM, int nN, int& pm, int& pn) {
    const int nwg = nM * nN; int wgid = L;
    { const int q = nwg / NXCD, r = nwg % NXCD, xcd = wgid % NXCD, off = wgid / NXCD; wgid = (xcd < r ? xcd * (q + 1) : r * (q + 1) + (xcd - r) * q) + off; }
    const int nig = WGM * nN, gid = wgid / nig, fm = gid * WGM, gsz = (nM - fm) < WGM ? (nM - fm) : WGM;
    pm = fm + ((wgid % nig) % gsz); pn = (wgid % nig) / gsz;
}

__device__ __forceinline__ i32x8 cat8(const bf16x8 a, const bf16x8 b) { return __builtin_shufflevector(__builtin_bit_cast(i32x4, a), __builtin_bit_cast(i32x4, b), 0, 1, 2, 3, 4, 5, 6, 7); }
template <class Epi, class Sched, bool ALIGN_EPI, bool SP2, int QM = 0>
__device__ __forceinline__ void gemm_phase(LAS unsigned char* lds, const int tid, const int K, const int lda, const int ldb, const Sched& S, const Epi& E, const int wsc = 127) {
    const int wid = __builtin_amdgcn_readfirstlane(tid >> 6), lane = tid & 63, wr = wid >> 2, wc = wid & 3, fr = lane & 15, fq = lane >> 4;
    const int nt = K / BK;
    unsigned voffA[2], voffB[2];
#pragma unroll
    for (int i = 0; i < 2; ++i) { int R, C; stage_rc(tid * 16 + i * 8192, R, C); const int Rb = Epi::PERM ? ((R & ~31) + perm32(R & 31)) : R;
        voffA[i] = (unsigned)(R * lda + C) * 2u; voffB[i] = (unsigned)(Rb * ldb + C) * 2u; }
    const size_t kstep = (size_t)(BK * 2);
    const size_t hstepA = (size_t)HALF * lda * 2, hstepB = (size_t)HALF * ldb * 2;
    const unsigned ldsw = (unsigned)wid * 1024u;
    const int aoff = lds_byte(wr * 64 + fr, fq * 8), boff = lds_byte(wc * 32 + fr, fq * 8);
#define PG8_SA(b, h) (((b) * 2 + (h)) * HTB)
#define PG8_SB(b, h) ((4 + (b) * 2 + (h)) * HTB)
#define PG8_STAGE(bufoff, gbase, voff) do { _Pragma("unroll") for (int _i = 0; _i < 2; ++_i) \
        __builtin_amdgcn_global_load_lds((const unsigned*)((const char*)(gbase) + (voff)[_i]), (LAS unsigned*)(lds + (bufoff) + ldsw + _i * 8192), 16, 0, 0); } while (0)
#define PG8_LDA(dst, b, h) do { _Pragma("unroll") for (int m = 0; m < 4; ++m) _Pragma("unroll") for (int k = 0; k < 2; ++k) dst[m][k] = *(const LAS bf16x8*)(lds + PG8_SA(b, h) + aoff + m * 2048 + k * 1024); } while (0)
#define PG8_LDB(dst, b, h) do { _Pragma("unroll") for (int n = 0; n < 2; ++n) _Pragma("unroll") for (int k = 0; k < 2; ++k) dst[n][k] = *(const LAS bf16x8*)(lds + PG8_SB(b, h) + boff + n * 2048 + k * 1024); } while (0)
#define PG8_MMA(ai, bj, At, Bt) do { __builtin_amdgcn_s_setprio(1); _Pragma("unroll") for (int m = 0; m < 4; ++m) _Pragma("unroll") for (int n = 0; n < 2; ++n) { \
        if constexpr (QM == 2) { _Pragma("unroll") for (int k = 0; k < 2; ++k) acc[ai][bj][m][n] = __builtin_bit_cast(f32x4, __builtin_amdgcn_mfma_i32_16x16x64_i8(__builtin_bit_cast(i32x4, Bt[n][k]), __builtin_bit_cast(i32x4, At[m][k]), __builtin_bit_cast(i32x4, acc[ai][bj][m][n]), 0, 0, 0)); \
            asm volatile("" : "+v"(acc[ai][bj][m][n])); } \
        else if constexpr (QM == 1) { acc[ai][bj][m][n] = __builtin_amdgcn_mfma_scale_f32_16x16x128_f8f6f4(cat8(Bt[n][0], Bt[n][1]), cat8(At[m][0], At[m][1]), acc[ai][bj][m][n], 0, 0, 0, wsc, 0, 127); \
            asm volatile("" : "+v"(acc[ai][bj][m][n]));   } \
        else { _Pragma("unroll") for (int k = 0; k < 2; ++k) acc[ai][bj][m][n] = __builtin_amdgcn_mfma_f32_16x16x32_bf16(Bt[n][k], At[m][k], acc[ai][bj][m][n], 0, 0, 0); } } __builtin_amdgcn_s_setprio(0); } while (0)
#define PG8_WAIT_V(n) asm volatile("s_waitcnt vmcnt(" #n ")" ::: "memory")
#define PG8_WAIT_L(n) asm volatile("s_waitcnt lgkmcnt(" #n ")" ::: "memory")
#define PG8_BAR __builtin_amdgcn_s_barrier()
#define PG8_SCHED __builtin_amdgcn_sched_barrier(0)
    Unit cur, nxt; int ui = 0;
    if (!S.next(0, cur)) return;
    f32x4 acc[2][2][4][2];
#pragma unroll
    for (int a = 0; a < 2; ++a)
#pragma unroll
        for (int b = 0; b < 2; ++b)
#pragma unroll
            for (int m = 0; m < 4; ++m)
#pragma unroll
                for (int n = 0; n < 2; ++n) acc[a][b][m][n] = (f32x4){0.f, 0.f, 0.f, 0.f};
    bf16x8 At[4][2], B0[2][2], B1[2][2];
    const char* cA = cur.A; const char* cB = cur.B;
    if constexpr (SP2) {
        PG8_STAGE(PG8_SB(0, 0), cB, voffB); PG8_STAGE(PG8_SB(0, 1), cB + hstepB, voffB); PG8_STAGE(PG8_SA(0, 0), cA, voffA); PG8_STAGE(PG8_SA(0, 1), cA + hstepA, voffA);
        if (wr == 1) PG8_BAR;
        PG8_WAIT_V(2); PG8_BAR;
        PG8_STAGE(PG8_SB(1, 0), cB + kstep, voffB); PG8_STAGE(PG8_SA(1, 0), cA + kstep, voffA); PG8_STAGE(PG8_SB(1, 1), cB + hstepB + kstep, voffB);
        PG8_WAIT_V(6); PG8_BAR;
    } else {
        PG8_STAGE(PG8_SB(0, 0), cB, voffB); PG8_STAGE(PG8_SA(0, 0), cA, voffA); PG8_STAGE(PG8_SB(0, 1), cB + hstepB, voffB); PG8_STAGE(PG8_SA(0, 1), cA + hstepA, voffA);
        if (wr == 1) PG8_BAR;
        PG8_WAIT_V(4); PG8_BAR;
        PG8_STAGE(PG8_SB(1, 0), cB + kstep, voffB); PG8_STAGE(PG8_SA(1, 0), cA + kstep, voffA); PG8_STAGE(PG8_SB(1, 1), cB + hstepB + kstep, voffB);
        PG8_WAIT_V(6); PG8_BAR;
    }
    for (;;) {
        const bool has_next = S.next(ui + 1, nxt);
        const char* nA = has_next ? nxt.A : cA; const char* nB = has_next ? nxt.B : cB;
        for (int t = 0; t < nt; t += 2) {
            const bool last = (t == nt - 2);
            const char* a1 = cA + (size_t)(t + 1) * kstep;
            const char* a2 = last ? nA : cA + (size_t)(t + 2) * kstep; const char* b2 = last ? nB : cB + (size_t)(t + 2) * kstep;
            const char* a3 = a2 + kstep; const char* b3 = b2 + kstep;
            if constexpr (SP2) {
            PG8_LDB(B0, 0, 0); PG8_LDB(B1, 0, 1); PG8_SCHED; PG8_LDA(At, 0, 0); PG8_STAGE(PG8_SA(1, 1), a1 + hstepA, voffA);
            PG8_WAIT_V(8); PG8_WAIT_L(0); PG8_BAR; PG8_MMA(0, 0, At, B0); PG8_MMA(0, 1, At, B1); PG8_BAR; PG8_SCHED;
            PG8_LDA(At, 0, 1); PG8_STAGE(PG8_SB(0, 0), b2, voffB); PG8_STAGE(PG8_SB(0, 1), b2 + hstepB, voffB); PG8_STAGE(PG8_SA(0, 0), a2, voffA);
            PG8_WAIT_V(8); PG8_WAIT_L(0); PG8_BAR; PG8_MMA(1, 0, At, B0); PG8_MMA(1, 1, At, B1); PG8_BAR; PG8_SCHED;
            PG8_LDB(B0, 1, 0); PG8_LDB(B1, 1, 1); PG8_SCHED; PG8_LDA(At, 1, 0); PG8_STAGE(PG8_SA(0, 1), a2 + hstepA, voffA);
            PG8_WAIT_V(8); PG8_WAIT_L(0); PG8_BAR; PG8_MMA(0, 0, At, B0); PG8_MMA(0, 1, At, B1); PG8_BAR; PG8_SCHED;
            PG8_LDA(At, 1, 1); PG8_STAGE(PG8_SB(1, 0), b3, voffB); PG8_STAGE(PG8_SB(1, 1), b3 + hstepB, voffB); PG8_STAGE(PG8_SA(1, 0), a3, voffA);
            PG8_WAIT_V(8); PG8_WAIT_L(0); PG8_BAR; PG8_MMA(1, 0, At, B0); PG8_MMA(1, 1, At, B1); PG8_BAR; PG8_SCHED;
            } else {
            PG8_LDB(B0, 0, 0); PG8_SCHED; PG8_LDA(At, 0, 0); PG8_STAGE(PG8_SA(1, 1), a1 + hstepA, voffA);
            PG8_WAIT_L(8); PG8_BAR; PG8_WAIT_L(0); PG8_MMA(0, 0, At, B0); PG8_BAR; PG8_SCHED;
            PG8_LDB(B1, 0, 1); PG8_STAGE(PG8_SB(0, 0), b2, voffB);
            PG8_BAR; PG8_WAIT_L(0); PG8_MMA(0, 1, At, B1); PG8_BAR;
            PG8_LDA(At, 0, 1); PG8_STAGE(PG8_SA(0, 0), a2, voffA);
            PG8_BAR; PG8_WAIT_L(0); PG8_MMA(1, 0, At, B0); PG8_BAR; PG8_SCHED;
            PG8_STAGE(PG8_SB(0, 1), b2 + hstepB, voffB);
            PG8_WAIT_V(6); PG8_BAR; PG8_MMA(1, 1, At, B1); PG8_BAR;
            PG8_LDB(B0, 1, 0); PG8_SCHED; PG8_LDA(At, 1, 0); PG8_STAGE(PG8_SA(0, 1), a2 + hstepA, voffA);
            PG8_WAIT_L(8); PG8_BAR; PG8_WAIT_L(0); PG8_MMA(0, 0, At, B0); PG8_BAR; PG8_SCHED;
            PG8_LDB(B1, 1, 1); PG8_STAGE(PG8_SB(1, 0), b3, voffB);
            PG8_BAR; PG8_WAIT_L(0); PG8_MMA(0, 1, At, B1); PG8_BAR;
            PG8_LDA(At, 1, 1); PG8_STAGE(PG8_SA(1, 0), a3, voffA);
            PG8_BAR; PG8_WAIT_L(0); PG8_MMA(1, 0, At, B0); PG8_BAR; PG8_SCHED;
            PG8_STAGE(PG8_SB(1, 1), b3 + hstepB, voffB);
            PG8_WAIT_V(6); PG8_BAR; PG8_MMA(1, 1, At, B1); PG8_BAR;
            }
        }
        if constexpr (ALIGN_EPI) { if (wr == 0) PG8_BAR; }
        E(acc, cur, wr, wc, fr, fq);
        if (!has_next) break;
#pragma unroll
        for (int a = 0; a < 2; ++a)
#pragma unroll
            for (int b = 0; b < 2; ++b)
#pragma unroll
                for (int m = 0; m < 4; ++m)
#pragma unroll
                    for (int n = 0; n < 2; ++n) acc[a][b][m][n] = (f32x4){0.f, 0.f, 0.f, 0.f};
        cur = nxt; cA = nA; cB = nB; ++ui;
        if constexpr (ALIGN_EPI) { if (wr == 1) PG8_BAR; }
    }
    PG8_WAIT_V(0);
    if constexpr (!ALIGN_EPI) { if (wr == 0) PG8_BAR; }
    PG8_BAR;
#undef PG8_SA
#undef PG8_SB
#undef PG8_STAGE
#undef PG8_LDA
#undef PG8_LDB
#undef PG8_MMA
#undef PG8_WAIT_V
#undef PG8_WAIT_L
#undef PG8_BAR
#undef PG8_SCHED
}

struct EpiStore {
    static constexpr bool PERM = true;
    float scale;
    __device__ __forceinline__ void operator()(const f32x4 (&acc)[2][2][4][2], const Unit& u, int wr, int wc, int fr, int fq) const {
        bf16_t* base = (bf16_t*)u.out + (size_t)(wr * 64 + fr) * u.ldc + wc * 32 + 8 * fq;
        const bool sg = u.flag == 1;
#pragma unroll
        for (int ai = 0; ai < 2; ++ai)
#pragma unroll
            for (int m = 0; m < 4; ++m) { bf16_t* rowp = base + (size_t)(ai * HALF + m * 16) * u.ldc;
#pragma unroll
                for (int bj = 0; bj < 2; ++bj) { f32x4 v0 = acc[ai][bj][m][0] * scale, v1 = acc[ai][bj][m][1] * scale;
                    if (sg) {
#pragma unroll
                        for (int j = 0; j < 4; ++j) { v0[j] = sigmoidf_(v0[j]); v1[j] = sigmoidf_(v1[j]); } }
                    u32x4 w; w.x = cvt_pk_bf16(v0[0], v0[1]); w.y = cvt_pk_bf16(v0[2], v0[3]); w.z = cvt_pk_bf16(v1[0], v1[1]); w.w = cvt_pk_bf16(v1[2], v1[3]);
                    *(u32x4*)(rowp + bj * HALF) = w; } }
    }
};
struct EpiInproj {
    static constexpr bool PERM = true;
    __device__ __forceinline__ void operator()(const f32x4 (&acc)[2][2][4][2], const Unit& u, int wr, int wc, int fr, int fq) const {
        GAS bf16_t* base = (GAS bf16_t*)u.out + (size_t)(wr * 64 + fr) * u.ldc + wc * 32 + 8 * fq;
        const bool lat = (u.flag & 16) != 0, r0 = lat && (u.flag & 6) != 0, r1 = lat && (u.flag & 2) != 0;
        const float qs = (u.flag & 8) ? C2 : 1.0f;
        const GAS float* rp = (const GAS float*)u.aux + (size_t)(wr * 64 + fr) * 64 + (wc & 1) * 32 + 4 * fq;
#pragma unroll
        for (int ai = 0; ai < 2; ++ai)
#pragma unroll
            for (int m = 0; m < 4; ++m) { GAS bf16_t* rowp = base + (size_t)(ai * HALF + m * 16) * u.ldc;
                f32x4 cs = (f32x4){1.f, 1.f, 1.f, 1.f}, sn = (f32x4){0.f, 0.f, 0.f, 0.f};
                if (r0) { const GAS float* rt = rp + (size_t)(ai * HALF + m * 16) * 64; cs = *(const GAS f32x4*)rt; sn = *(const GAS f32x4*)(rt + 16); }
#pragma unroll
                for (int bj = 0; bj < 2; ++bj) { f32x4 v0 = acc[ai][bj][m][0], v1 = acc[ai][bj][m][1];
                    if (bj == 0 ? r0 : r1) {
                        const float a0 = v0[0] * cs[0] - v0[1] * sn[0], a1 = v0[1] * cs[0] + v0[0] * sn[0], a2 = v0[2] * cs[1] - v0[3] * sn[1], a3 = v0[3] * cs[1] + v0[2] * sn[1];
                        const float b0 = v1[0] * cs[2] - v1[1] * sn[2], b1 = v1[1] * cs[2] + v1[0] * sn[2], b2 = v1[2] * cs[3] - v1[3] * sn[3], b3 = v1[3] * cs[3] + v1[2] * sn[3];
                        v0 = (f32x4){a0, a1, a2, a3}; v1 = (f32x4){b0, b1, b2, b3}; }
                    v0 *= qs; v1 *= qs;
                    u32x4 w; w.x = cvt_pk_bf16(v0[0], v0[1]); w.y = cvt_pk_bf16(v0[2], v0[3]); w.z = cvt_pk_bf16(v1[0], v1[1]); w.w = cvt_pk_bf16(v1[2], v1[3]);
                    *(GAS u32x4*)(rowp + bj * HALF) = w; } }
    }
};
struct EpiGate {
    static constexpr bool PERM = true;
    __device__ __forceinline__ void operator()(const f32x4 (&acc)[2][2][4][2], const Unit& u, int wr, int wc, int fr, int fq) const {
        GAS unsigned char* base = (GAS unsigned char*)u.out + (size_t)(wr * 64 + fr) * GW + wc * 32 + 8 * fq;
#pragma unroll
        for (int ai = 0; ai < 2; ++ai)
#pragma unroll
            for (int m = 0; m < 4; ++m) { GAS unsigned char* rowp = base + (size_t)(ai * HALF + m * 16) * GW;
#pragma unroll
                for (int bj = 0; bj < 2; ++bj) { const f32x4 v0 = acc[ai][bj][m][0], v1 = acc[ai][bj][m][1];
                    unsigned q[8];
#pragma unroll
                    for (int j = 0; j < 4; ++j) { q[j] = (unsigned)(fast_rcp(1.0f + fast_exp2(v0[j])) * 255.0f + 0.5f); q[4 + j] = (unsigned)(fast_rcp(1.0f + fast_exp2(v1[j])) * 255.0f + 0.5f); }
                    u32x2 w8; w8.x = q[0] | (q[1] << 8) | (q[2] << 16) | (q[3] << 24); w8.y = q[4] | (q[5] << 8) | (q[6] << 16) | (q[7] << 24);
                    *(GAS u32x2*)(rowp + bj * HALF) = w8; } }
    }
};
struct EpiSwiglu {
    static constexpr bool PERM = true;
    __device__ __forceinline__ void operator()(const f32x4 (&acc)[2][2][4][2], const Unit& u, int wr, int wc, int fr, int fq) const {
        bf16_t* base = (bf16_t*)u.out + (size_t)(wr * 64 + fr) * u.ldc + wc * 32 + 8 * fq;
#pragma unroll
        for (int ai = 0; ai < 2; ++ai)
#pragma unroll
            for (int m = 0; m < 4; ++m) { bf16_t* rowp = base + (size_t)(ai * HALF + m * 16) * u.ldc;
                f32x4 g0 = acc[ai][0][m][0], g1 = acc[ai][0][m][1]; const f32x4 u0 = acc[ai][1][m][0], u1 = acc[ai][1][m][1];
#pragma unroll
                for (int j = 0; j < 4; ++j) { g0[j] = siluf_(g0[j]) * u0[j]; g1[j] = siluf_(g1[j]) * u1[j]; }
                u32x4 w; w.x = cvt_pk_bf16(g0[0], g0[1]); w.y = cvt_pk_bf16(g0[2], g0[3]); w.z = cvt_pk_bf16(g1[0], g1[1]); w.w = cvt_pk_bf16(g1[2], g1[3]);
                *(u32x4*)rowp = w; }
    }
};
struct EpiSwigluF8 {
    static constexpr bool PERM = true;
    __device__ __forceinline__ void operator()(const f32x4 (&acc)[2][2][4][2], const Unit& u, int wr, int wc, int fr, int fq) const {
        GAS unsigned char* base = (GAS unsigned char*)u.out + (size_t)(wr * 64 + fr) * u.ldc + wc * 32 + 8 * fq;
#pragma unroll
        for (int ai = 0; ai < 2; ++ai)
#pragma unroll
            for (int m = 0; m < 4; ++m) { GAS unsigned char* rowp = base + (size_t)(ai * HALF + m * 16) * u.ldc;
                f32x4 g0 = acc[ai][0][m][0], g1 = acc[ai][0][m][1]; const f32x4 u0 = acc[ai][1][m][0], u1 = acc[ai][1][m][1];
#pragma unroll
                for (int j = 0; j < 4; ++j) { g0[j] = siluf_(g0[j]) * u0[j]; g1[j] = siluf_(g1[j]) * u1[j]; }
                u32x2 w; w.x = cvt4_fp8(g0[0], g0[1], g0[2], g0[3]); w.y = cvt4_fp8(g1[0], g1[1], g1[2], g1[3]);
                *(GAS u32x2*)rowp = w; }
    }
};
template <bool F8OUT> struct EpiSwigluI8 {
    static constexpr bool PERM = true;
    float wsc;
    __device__ __forceinline__ void operator()(const f32x4 (&acc)[2][2][4][2], const Unit& u, int wr, int wc, int fr, int fq) const {
        constexpr int EB = F8OUT ? 1 : 2;
        GAS unsigned char* base = (GAS unsigned char*)u.out + ((size_t)(wr * 64 + fr) * u.ldc + wc * 32 + 8 * fq) * EB;
        const GAS float* rs = (const GAS float*)u.aux + wr * 64 + fr;
        float sc[8];
#pragma unroll
        for (int q = 0; q < 8; ++q) sc[q] = rs[(q >> 2) * HALF + (q & 3) * 16] * wsc;
#pragma unroll
        for (int ai = 0; ai < 2; ++ai)
#pragma unroll
            for (int m = 0; m < 4; ++m) { GAS unsigned char* rowp = base + (size_t)(ai * HALF + m * 16) * u.ldc * EB; const float f = sc[ai * 4 + m];
                const i32x4 gi0 = __builtin_bit_cast(i32x4, acc[ai][0][m][0]), gi1 = __builtin_bit_cast(i32x4, acc[ai][0][m][1]), ui0 = __builtin_bit_cast(i32x4, acc[ai][1][m][0]), ui1 = __builtin_bit_cast(i32x4, acc[ai][1][m][1]);
                f32x4 g0, g1;
#pragma unroll
                for (int j = 0; j < 4; ++j) { const float a = (float)gi0[j] * f, b = (float)gi1[j] * f; g0[j] = siluf_(a) * ((float)ui0[j] * f); g1[j] = siluf_(b) * ((float)ui1[j] * f); }
                if constexpr (F8OUT) { u32x2 w; w.x = cvt4_fp8(g0[0], g0[1], g0[2], g0[3]); w.y = cvt4_fp8(g1[0], g1[1], g1[2], g1[3]); *(GAS u32x2*)rowp = w; }
                else { u32x4 w; w.x = cvt_pk_bf16(g0[0], g0[1]); w.y = cvt_pk_bf16(g0[2], g0[3]); w.z = cvt_pk_bf16(g1[0], g1[1]); w.w = cvt_pk_bf16(g1[2], g1[3]); *(GAS u32x4*)rowp = w; } }
    }
};
struct EpiResid {
    static constexpr bool PERM = true;
    __device__ __forceinline__ void operator()(const f32x4 (&acc)[2][2][4][2], const Unit& u, int wr, int wc, int fr, int fq) const {
        GAS bf16_t* base = (GAS bf16_t*)u.out + (size_t)(wr * 64 + fr) * u.ldc + wc * 32 + 8 * fq;
        const size_t roff = (size_t)(wr * 64 + fr) * u.ldc + wc * 32 + 8 * fq;
        const bool srcf = u.flag == 1;
        const GAS float* g = (const GAS float*)u.aux + wc * 32 + 8 * fq;
        f32x4 gv[2][2];
#pragma unroll
        for (int bj = 0; bj < 2; ++bj)
#pragma unroll
            for (int n = 0; n < 2; ++n) gv[bj][n] = *(const GAS f32x4*)(g + bj * HALF + n * 4);
#pragma unroll
        for (int ai = 0; ai < 2; ++ai)
#pragma unroll
            for (int m = 0; m < 4; ++m) { const size_t ro = (size_t)(ai * HALF + m * 16) * u.ldc;
#pragma unroll
                for (int bj = 0; bj < 2; ++bj) {
                    f32x4 r0, r1;
                    if (srcf) { const GAS float* sp = (const GAS float*)u.aux2 + roff + ro + bj * HALF; r0 = *(const GAS f32x4*)sp; r1 = *(const GAS f32x4*)(sp + 4); }
                    else { const u32x4 w = *(const GAS u32x4*)((const GAS bf16_t*)u.aux2 + roff + ro + bj * HALF);
                        r0 = (f32x4){bf_lo(w.x), bf_hi(w.x), bf_lo(w.y), bf_hi(w.y)}; r1 = (f32x4){bf_lo(w.z), bf_hi(w.z), bf_lo(w.w), bf_hi(w.w)}; }
                    const f32x4 v0 = r0 + gv[bj][0] * acc[ai][bj][m][0], v1 = r1 + gv[bj][1] * acc[ai][bj][m][1];
                    u32x4 o; o.x = cvt_pk_bf16(v0[0], v0[1]); o.y = cvt_pk_bf16(v0[2], v0[3]); o.z = cvt_pk_bf16(v1[0], v1[1]); o.w = cvt_pk_bf16(v1[2], v1[3]);
                    *(GAS u32x4*)(base + ro + bj * HALF) = o; }
                asm volatile("" ::: "memory"); }
    }
};
struct BUnit { const char* A; const char* B; const char* gate; char* out; };
__device__ __forceinline__ void gload8_async(u32x2& dst, const void* p) { asm volatile("global_load_dwordx2 %0, %1, off" : "=&v"(dst) : "v"(p) : "memory"); }
template <class Sched>
__device__ __forceinline__ void branch_phase(LAS unsigned char* lds, const int tid, const Sched& S) {
    const int wid = __builtin_amdgcn_readfirstlane(tid >> 6), lane = tid & 63, wr = wid >> 2, wc = wid & 3, fr = lane & 15, fq = lane >> 4;
    constexpr int K = 2048, nt = K / BK, lda = 2048, ldb = 2048;
    unsigned voffA[2], voffB[2];
#pragma unroll
    for (int i = 0; i < 2; ++i) { int R, C; stage_rc(tid * 16 + i * 8192, R, C); const int Rb = (R & ~31) + perm32(R & 31);
        voffA[i] = (unsigned)(R * lda + C) * 2u; voffB[i] = (unsigned)(Rb * ldb + C) * 2u; }
    const size_t kstep = (size_t)(BK * 2);
    const size_t hstepA = (size_t)HALF * lda * 2;
    const unsigned ldsw = (unsigned)wid * 1024u;
    const int aoff = lds_byte(wr * 64 + fr, fq * 8), boff = lds_byte(wc * 32 + fr, fq * 8);
#define BR_SA(b, h) (((b) * 2 + (h)) * HTB)
#define BR_SB(b) ((4 + (b) * 2) * HTB)
#define BR_STAGE(bufoff, gbase, voff) do { _Pragma("unroll") for (int _i = 0; _i < 2; ++_i) \
        __builtin_amdgcn_global_load_lds((const unsigned*)((const char*)(gbase) + (voff)[_i]), (LAS unsigned*)(lds + (bufoff) + ldsw + _i * 8192), 16, 0, 0); } while (0)
#define BR_LDA(dst, b, h) do { _Pragma("unroll") for (int m = 0; m < 4; ++m) _Pragma("unroll") for (int k = 0; k < 2; ++k) dst[m][k] = *(const LAS bf16x8*)(lds + BR_SA(b, h) + aoff + m * 2048 + k * 1024); } while (0)
#define BR_LDB(dst, b) do { _Pragma("unroll") for (int n = 0; n < 2; ++n) _Pragma("unroll") for (int k = 0; k < 2; ++k) dst[n][k] = *(const LAS bf16x8*)(lds + BR_SB(b) + boff + n * 2048 + k * 1024); } while (0)
#define BR_MMA(ai) do { __builtin_amdgcn_s_setprio(1); _Pragma("unroll") for (int m = 0; m < 4; ++m) _Pragma("unroll") for (int n = 0; n < 2; ++n) _Pragma("unroll") for (int k = 0; k < 2; ++k) \
        acc[ai][m][n] = __builtin_amdgcn_mfma_f32_16x16x32_bf16(B0[n][k], At[m][k], acc[ai][m][n], 0, 0, 0); __builtin_amdgcn_s_setprio(0); } while (0)
#define BR_WAIT_V(n) asm volatile("s_waitcnt vmcnt(" #n ")" ::: "memory")
#define BR_WAIT_L0 asm volatile("s_waitcnt lgkmcnt(0)" ::: "memory")
#define BR_BAR __builtin_amdgcn_s_barrier()
#define BR_SCHED __builtin_amdgcn_sched_barrier(0)
    BUnit cur, nxt; int ui = 0;
    if (!S.next(0, cur)) return;
    f32x4 acc[2][4][2], macc[2][4][2];
#pragma unroll
    for (int a = 0; a < 2; ++a)
#pragma unroll
        for (int m = 0; m < 4; ++m)
#pragma unroll
            for (int n = 0; n < 2; ++n) { acc[a][m][n] = (f32x4){0.f, 0.f, 0.f, 0.f}; macc[a][m][n] = (f32x4){0.f, 0.f, 0.f, 0.f}; }
    bf16x8 At[4][2], B0[2][2];
    const char* cA = cur.A; const char* cB = cur.B;
    BR_STAGE(BR_SB(0), cB, voffB); BR_STAGE(BR_SA(0, 0), cA, voffA); BR_STAGE(BR_SA(0, 1), cA + hstepA, voffA);
    if (wr == 1) BR_BAR;
    BR_WAIT_V(2); BR_BAR;
    BR_STAGE(BR_SB(1), cB + kstep, voffB); BR_STAGE(BR_SA(1, 0), cA + kstep, voffA);
    BR_WAIT_V(4); BR_BAR;
    const size_t rowoff = (size_t)(wr * 64 + fr), coloff = (size_t)(wc * 32 + 8 * fq);
    for (;;) {
        const bool has_next = S.next(ui + 1, nxt);
        const char* nA = has_next ? nxt.A : cA; const char* nB = has_next ? nxt.B : cB;
        const char* gbase = cur.gate + (rowoff * GW + coloff);
        u32x2 g[8];
        for (int t = 0; t < nt; t += 2) {
            const bool last = (t == nt - 2);
            const bool hook = (t & 6) == 6;
            const char* a1 = cA + (size_t)(t + 1) * kstep;
            const char* a2 = last ? nA : cA + (size_t)(t + 2) * kstep; const char* b2 = last ? nB : cB + (size_t)(t + 2) * kstep;
            const char* a3 = a2 + kstep; const char* b3 = b2 + kstep;
            if (hook) {
                const char* gp = gbase + (size_t)(t >> 3) * 1024;
#pragma unroll
                for (int q = 0; q < 8; ++q) gload8_async(g[q], gp + (size_t)((q >> 2) * HALF + (q & 3) * 16) * GW);
            }
            BR_LDB(B0, 0); BR_SCHED; BR_LDA(At, 0, 0); BR_STAGE(BR_SA(1, 1), a1 + hstepA, voffA);
            if (hook) BR_WAIT_V(14); else BR_WAIT_V(6);
            BR_WAIT_L0; BR_BAR; BR_MMA(0); BR_BAR; BR_SCHED;
            BR_LDA(At, 0, 1); BR_STAGE(BR_SB(0), b2, voffB); BR_STAGE(BR_SA(0, 0), a2, voffA);
            if (hook) BR_WAIT_V(14); else BR_WAIT_V(6);
            BR_WAIT_L0; BR_BAR; BR_MMA(1); BR_BAR; BR_SCHED;
            BR_LDB(B0, 1); BR_SCHED; BR_LDA(At, 1, 0); BR_STAGE(BR_SA(0, 1), a2 + hstepA, voffA);
            BR_WAIT_V(6); BR_WAIT_L0; BR_BAR; BR_MMA(0); BR_BAR; BR_SCHED;
            BR_LDA(At, 1, 1); BR_STAGE(BR_SB(1), b3, voffB); BR_STAGE(BR_SA(1, 0), a3, voffA);
            BR_WAIT_V(6); BR_WAIT_L0; BR_BAR; BR_MMA(1); BR_BAR; BR_SCHED;
            if (hook) {
                asm volatile("s_waitcnt vmcnt(10)" : "+v"(g[0]), "+v"(g[1]), "+v"(g[2]), "+v"(g[3]), "+v"(g[4]), "+v"(g[5]), "+v"(g[6]), "+v"(g[7]) :: "memory");
#pragma unroll
                for (int ai = 0; ai < 2; ++ai)
#pragma unroll
                    for (int m = 0; m < 4; ++m) { const u32x2 gw = g[ai * 4 + m];
                        const f32x4 g0 = (f32x4){(float)(gw.x & 255u), (float)((gw.x >> 8) & 255u), (float)((gw.x >> 16) & 255u), (float)(gw.x >> 24)};
                        const f32x4 g1 = (f32x4){(float)(gw.y & 255u), (float)((gw.y >> 8) & 255u), (float)((gw.y >> 16) & 255u), (float)(gw.y >> 24)};
                        macc[ai][m][0] += acc[ai][m][0] * g0; macc[ai][m][1] += acc[ai][m][1] * g1;
                        acc[ai][m][0] = (f32x4){0.f, 0.f, 0.f, 0.f}; acc[ai][m][1] = (f32x4){0.f, 0.f, 0.f, 0.f}; }
            }
        }
        {
            GAS bf16_t* op = (GAS bf16_t*)cur.out + rowoff * 1024 + coloff;
#pragma unroll
            for (int ai = 0; ai < 2; ++ai)
#pragma unroll
                for (int m = 0; m < 4; ++m) { const f32x4 v0 = macc[ai][m][0] * (1.0f / 255.0f), v1 = macc[ai][m][1] * (1.0f / 255.0f);
                    u32x4 w; w.x = cvt_pk_bf16(v0[0], v0[1]); w.y = cvt_pk_bf16(v0[2], v0[3]); w.z = cvt_pk_bf16(v1[0], v1[1]); w.w = cvt_pk_bf16(v1[2], v1[3]);
                    *(GAS u32x4*)(op + (size_t)(ai * HALF + m * 16) * 1024) = w;
                    macc[ai][m][0] = (f32x4){0.f, 0.f, 0.f, 0.f}; macc[ai][m][1] = (f32x4){0.f, 0.f, 0.f, 0.f}; }
        }
        if (!has_next) break;
        cur = nxt; cA = nA; cB = nB; ++ui;
    }
    BR_WAIT_V(0);
    if (wr == 0) BR_BAR;
    BR_BAR;
#undef BR_SA
#undef BR_SB
#undef BR_STAGE
#undef BR_LDA
#undef BR_LDB
#undef BR_MMA
#undef BR_WAIT_V
#undef BR_WAIT_L0
#undef BR_BAR
#undef BR_SCHED
}
}

#define XB_TMO      128
#define XB_XCNT(j)  (256  + 64 * (j))
#define XB_XSUB(j)  (1280 + 64 * (j))
#define XB_XGEN(j)  (2304 + 64 * (j))
#define XB_TOP      3328
#define XB_TOPGEN   3392
#define XCD_BAR_WORDS 3456
#define XB_SPIN_CAP (1u << 20)

__device__ __forceinline__ unsigned xb_ld(unsigned* p)              { return __hip_atomic_load(p, __ATOMIC_RELAXED, __HIP_MEMORY_SCOPE_AGENT); }
__device__ __forceinline__ unsigned xb_add(unsigned* p, unsigned v) { return __hip_atomic_fetch_add(p, v, __ATOMIC_RELAXED, __HIP_MEMORY_SCOPE_AGENT); }
__device__ __forceinline__ unsigned xb_xcc_id() { return (unsigned)__builtin_amdgcn_s_getreg((3 << 11) | 20) & 0xFu; }
#define XB_SPIN(cond, bar) do { unsigned _sp = 0; while (cond) { __builtin_amdgcn_s_sleep(1); \
    if ((++_sp & 255u) == 0u) { if (xb_ld(&(bar)[XB_TMO])) break; if (_sp > XB_SPIN_CAP) { atomicAdd(&(bar)[XB_TMO], 1u); break; } } } } while (0)

struct XcdBarrier { unsigned* bar; unsigned x; volatile LAS unsigned* st; };

__device__ __forceinline__ XcdBarrier xcd_barrier_post(unsigned* bar, volatile LAS unsigned* st) {
    XcdBarrier b; b.bar = bar; b.x = xb_xcc_id(); b.st = st;
    if (threadIdx.x == 0) (void)xb_add(&bar[XB_XCNT(b.x)], 1u);
    return b;
}
__device__ __forceinline__ void xcd_barrier_complete(unsigned* bar, unsigned x, unsigned& nloc, unsigned& nx) {
    const unsigned G = gridDim.x * gridDim.y * gridDim.z;
    unsigned sum, cnt, mine, sp = 0u;
    for (;;) {
        sum = 0u; cnt = 0u; mine = 0u;
#pragma unroll
        for (unsigned j = 0; j < 16; ++j) { const unsigned c = xb_ld(&bar[XB_XCNT(j)]); sum += c; cnt += (c > 0u) ? 1u : 0u; mine = (j == x) ? c : mine; }
        if (sum == G) break;
        __builtin_amdgcn_s_sleep(1);
        if ((++sp & 255u) == 0u) { if (xb_ld(&bar[XB_TMO])) break; if (sp > XB_SPIN_CAP) { atomicAdd(&bar[XB_TMO], 1u); break; } }
    }
    nloc = mine > 0u ? mine : 1u; nx = cnt > 0u ? cnt : 1u;
}
__device__ __forceinline__ void xcd_barrier(const XcdBarrier& b, const bool leader) {
    asm volatile("s_waitcnt vmcnt(0)" ::: "memory");
    __syncthreads();
    unsigned* bar = b.bar; asm volatile("" : "+v"(bar));
    if (leader) {
        __builtin_amdgcn_s_waitcnt(0);
        unsigned nloc = b.st[0], nx = b.st[1];
        if (nloc == 0u) { xcd_barrier_complete(bar, b.x, nloc, nx); b.st[0] = nloc; b.st[1] = nx; }
        const unsigned old = xb_add(&bar[XB_XSUB(b.x)], 1u);
        const unsigned gen = old / nloc;
        if (old + 1u == (gen + 1u) * nloc) {
            __builtin_amdgcn_fence(__ATOMIC_RELEASE, "agent");
            asm volatile("s_waitcnt vmcnt(0)" ::: "memory");
            const unsigned og = xb_add(&bar[XB_TOP], 1u);
            const unsigned tg = og / nx;
            if (og + 1u == (tg + 1u) * nx) xb_add(&bar[XB_TOPGEN], 1u);
            else XB_SPIN(xb_ld(&bar[XB_TOPGEN]) == tg, bar);
            __builtin_amdgcn_fence(__ATOMIC_ACQUIRE, "agent");
            xb_add(&bar[XB_XGEN(b.x)], 1u);
            asm volatile("s_waitcnt vmcnt(0)" ::: "memory");
        } else {
            XB_SPIN(xb_ld(&bar[XB_XGEN(b.x)]) == gen, bar);
            __builtin_amdgcn_fence(__ATOMIC_ACQUIRE, "agent");
            asm volatile("s_waitcnt vmcnt(0)" ::: "memory");
        }
    }
    __syncthreads();
}

struct Args { const float* in[23]; float* out; unsigned char* ws; };
enum { I_X = 0, I_C, I_CTX, I_CCTX, I_WMOD, I_BMOD, I_N1G, I_N2G, I_WIN, I_DLAM, I_SUBLN, I_QKG, I_SINK, I_WBR, I_WOUT, I_FG, I_FU, I_FD, I_RW, I_MG, I_MU, I_MD, I_FINALG };

__device__ __forceinline__ bf16_t* w_layer(unsigned char* ws, int l, size_t off) { return (bf16_t*)(ws + WS_W + (size_t)l * W_LAYER + off); }
__device__ __forceinline__ bf16_t* w_dense(unsigned char* ws, int i, size_t off) { return (bf16_t*)(ws + WS_W + W_DENSE0 + (size_t)i * W_DENSE + off); }
__device__ __forceinline__ bf16_t* w_moe(unsigned char* ws, int i, int e, size_t off) { return (bf16_t*)(ws + WS_W + W_MOE0 + (size_t)i * W_MOE + (size_t)e * W_EXPERT + off); }

constexpr int CV_LAYER = 1536 + 2048 + 1024 + 512;
constexpr int CV_DENSE = 3 * 1408;
constexpr int CV_EXP = 3 * 1792;
constexpr int CV_TOTAL = 4 * CV_LAYER + 2 * CV_DENSE + 16 * CV_EXP;
struct ConvDesc { const float* src; bf16_t* dst; int ldsrc, lddst, perm; float f8s; int qm; };
__device__ __forceinline__ ConvDesc conv_decode(const Args& a, int it) {
    unsigned char* ws = a.ws;
    const float* src; int ldsrc, K, c0, ncols, mode = 0, drow0 = 0, blk, ldd = 0; bf16_t* dst; bool win = false; float f8s = 0.f; int qm = 1;
    if (it < 4 * CV_LAYER) { const int l = it / CV_LAYER, r = it % CV_LAYER;
        if (r < 1536) { blk = r; src = a.in[I_WIN] + (size_t)l * DM * DIN; ldsrc = DIN; K = DM; c0 = 0; ncols = 3072; dst = w_layer(ws, l, W_IN); drow0 = 0; win = true; }
        else if (r < 3584) { blk = r - 1536; src = a.in[I_WIN] + (size_t)l * DM * DIN; ldsrc = DIN; K = DM; c0 = 3584; ncols = 4096; dst = w_layer(ws, l, W_ING8); f8s = -128.0f * LOG2E; }
        else if (r < 4608) { const int q = r - 3584, rr = q / 256; blk = q % 256; src = a.in[I_WBR] + (size_t)(l * 4 + rr) * 512 * DM; ldsrc = DM; K = 512; c0 = 0; ncols = DM; dst = w_layer(ws, l, W_BR) + (size_t)rr * 512; ldd = 2048; }
        else { blk = r - 4608; src = a.in[I_WOUT] + (size_t)l * DM * DM; ldsrc = DM; K = DM; c0 = 0; ncols = DM; dst = w_layer(ws, l, W_OUT); }
    } else if (it < 4 * CV_LAYER + 2 * CV_DENSE) { const int q = it - 4 * CV_LAYER, i = q / CV_DENSE, r = q % CV_DENSE, which = r / 1408; blk = r % 1408;
        if (which < 2) { src = a.in[which == 0 ? I_FG : I_FU] + (size_t)i * DM * DFF; ldsrc = DFF; K = DM; c0 = 0; ncols = DFF; dst = w_dense(ws, i, W_DGU); mode = 1 + which; f8s = W8_GU; qm = 2; }
        else { src = a.in[I_FD] + (size_t)i * DFF * DM; ldsrc = DM; K = DFF; c0 = 0; ncols = DM; dst = w_dense(ws, i, W_DD); f8s = ((DENSE_F8_MASK >> i) & 1) ? 256.0f : 0.f; }
    } else { const int q = it - 4 * CV_LAYER - 2 * CV_DENSE, ie = q / CV_EXP, r = q % CV_EXP, which = r / 1792, i = ie >> 3, e = ie & 7; blk = r % 1792;
        if (which < 2) { src = a.in[which == 0 ? I_MG : I_MU] + (size_t)ie * DM * DFE; ldsrc = DFE; K = DM; c0 = 0; ncols = DFE; dst = w_moe(ws, i, e, W_MGU); mode = 1 + which; f8s = W8_GU; qm = 2; }
        else { src = a.in[I_MD] + (size_t)ie * DFE * DM; ldsrc = DM; K = DFE; c0 = 0; ncols = DM; dst = w_moe(ws, i, e, W_MD); f8s = 256.0f; }
    }
    const int nbn = ncols / 32, kb = blk / nbn, nb = blk % nbn, n = 32 * nb;
    const int drow = mode == 0 ? drow0 + n : 256 * (n >> 7) + (n & 127) + (mode == 2 ? 128 : 0);
    const bool perm = win && (n < 1024 || (n >= 1536 && n < 2176) || (n >= 2304 && n < 2944));
    ConvDesc d; d.src = src + (size_t)(64 * kb) * ldsrc + c0 + n; if (ldd == 0) ldd = K;
    d.dst = f8s != 0.f ? (bf16_t*)((unsigned char*)dst + (size_t)drow * ldd + 64 * kb) : dst + (size_t)drow * ldd + 64 * kb; d.ldsrc = ldsrc; d.lddst = ldd; d.perm = perm ? 1 : 0; d.f8s = f8s; d.qm = qm;
    return d;
}
__device__ __forceinline__ void conv_load(const ConvDesc& d, float (&r)[32], int lane) {
    const GAS float* s = (const GAS float*)d.src + (size_t)(lane >> 5) * d.ldsrc + (lane & 31);
#pragma unroll
    for (int i = 0; i < 32; ++i) r[i] = __builtin_nontemporal_load(s + (size_t)(2 * i) * d.ldsrc);
}
__device__ __forceinline__ void conv_store(const ConvDesc& d, const float (&r)[32], LAS float* scr, int lane) {
#pragma unroll
    for (int i = 0; i < 32; ++i) scr[(2 * i + (lane >> 5)) * 33 + (lane & 31)] = r[i];
    LDS_WAIT(); asm volatile("" ::: "memory");
    const int c = lane & 7;
    if (d.f8s != 0.f) { const float fs = d.f8s;
#pragma unroll
        for (int j = 0; j < 4; ++j) { const int n = (lane >> 3) + 8 * j; const LAS float* s = scr + (8 * c) * 33 + n;
            u32x2 o;
            if (d.qm == 2) { o.x = pack4_i8(s[0 * 33] * fs, s[1 * 33] * fs, s[2 * 33] * fs, s[3 * 33] * fs); o.y = pack4_i8(s[4 * 33] * fs, s[5 * 33] * fs, s[6 * 33] * fs, s[7 * 33] * fs); }
            else { o.x = cvt4_fp8(s[0 * 33] * fs, s[1 * 33] * fs, s[2 * 33] * fs, s[3 * 33] * fs); o.y = cvt4_fp8(s[4 * 33] * fs, s[5 * 33] * fs, s[6 * 33] * fs, s[7 * 33] * fs); }
            __builtin_nontemporal_store(o, (GAS u32x2*)((GAS unsigned char*)d.dst + (size_t)n * d.lddst + 8 * c)); }
    } else {
#pragma unroll
    for (int j = 0; j < 4; ++j) { const int n = (lane >> 3) + 8 * j; const LAS float* s = scr + (8 * c) * 33 + n;
        u32x4 o; o.x = cvt_pk_bf16(s[0 * 33], s[1 * 33]); o.y = cvt_pk_bf16(s[2 * 33], s[3 * 33]); o.z = cvt_pk_bf16(s[4 * 33], s[5 * 33]); o.w = cvt_pk_bf16(s[6 * 33], s[7 * 33]);
        const int dn = d.perm ? 2 * (n & 15) + (n >> 4) : n;
        __builtin_nontemporal_store(o, (GAS u32x4*)(d.dst + (size_t)dn * d.lddst + 8 * c)); }
    }
    LDS_WAIT(); asm volatile("" ::: "memory");
}
__device__ __forceinline__ void fzfold_item(const Args& a, int it, int lane) {
    const int mq = it & 3, kb = (it >> 2) & 15, g = (it >> 6) & 7, l = it >> 9, k0 = 64 * kb;
    const GAS f32x4* src = (const GAS f32x4*)(a.in[I_WIN] + (size_t)l * DM * DIN + (size_t)(k0 + lane) * DIN + 3072 + g * 64);
    float w[64];
#pragma unroll
    for (int i = 0; i < 16; ++i) { const f32x4 v = src[i]; w[4 * i] = v[0]; w[4 * i + 1] = v[1]; w[4 * i + 2] = v[2]; w[4 * i + 3] = v[3]; }
    const float cv = cospif((float)lane * (1.0f / 32.0f)), sv = sinpif((float)lane * (1.0f / 32.0f));
    GAS bf16_t* dst = (GAS bf16_t*)w_layer(a.ws, l, W_FZ);
    for (int m = 16 * mq; m < 16 * mq + 16; ++m) {
        float sc = 0.f, ss = 0.f;
#pragma unroll
        for (int c = 0; c < 64; ++c) { const int j = (c * m) & 63;
            const float cj = __builtin_bit_cast(float, __builtin_amdgcn_readlane(__builtin_bit_cast(int, cv), j)), sj = __builtin_bit_cast(float, __builtin_amdgcn_readlane(__builtin_bit_cast(int, sv), j));
            sc += w[c] * cj; ss += w[c] * sj; }
        dst[(size_t)(g * 64 + m) * DM + k0 + lane] = f2bf(sc);
        dst[(size_t)(512 + g * 64 + m) * DM + k0 + lane] = f2bf(ss);
    }
}
__device__ __forceinline__ void mod_item(const Args& a, int item, LAS unsigned char* lds, int tid) {
    const int l = item / 24, chunk = item % 24, wid = tid >> 6, lane = tid & 63;
    LAS float* sc = (LAS float*)lds;
    LAS float* red = (LAS float*)(lds + 36864);
    for (int i = tid; i < 9 * 1024; i += 512) { const float v = i < 8192 ? a.in[I_C][i] : a.in[I_CCTX][i - 8192]; sc[i] = siluf_(v); }
    __syncthreads();
    const float* w = a.in[I_WMOD] + (size_t)l * DM * 6144 + chunk * 256 + lane * 4;
    f32x4 acc[9];
#pragma unroll
    for (int r = 0; r < 9; ++r) acc[r] = (f32x4){0.f, 0.f, 0.f, 0.f};
    const int kb = wid * 128;
#pragma unroll 8
    for (int k = 0; k < 128; ++k) { const f32x4 wv = *(const GAS f32x4*)(w + (size_t)(kb + k) * 6144);
#pragma unroll
        for (int r = 0; r < 9; ++r) acc[r] += wv * sc[r * 1024 + kb + k]; }
#pragma unroll
    for (int r = 0; r < 9; ++r) *(LAS f32x4*)(red + (wid * 9 + r) * 256 + lane * 4) = acc[r];
    __syncthreads();
    float* modv = (float*)(a.ws + WS_MODV) + (size_t)l * 9 * 6144;
    for (int i = tid; i < 9 * 256; i += 512) { const int r = i >> 8, c = i & 255; float s = 0.f;
#pragma unroll
        for (int w8 = 0; w8 < 8; ++w8) s += red[(w8 * 9 + r) * 256 + c];
        modv[r * 6144 + chunk * 256 + c] = s + a.in[I_BMOD][l * 6144 + chunk * 256 + c]; }
    __syncthreads();
}

struct RowV { f32x4 v[4]; };
__device__ __forceinline__ RowV load_row_f32(const float* p, int lane) { RowV r; const f32x4* q = (const f32x4*)p + lane;
#pragma unroll
    for (int j = 0; j < 4; ++j) r.v[j] = q[64 * j];
    return r; }
__device__ __forceinline__ void store_row_f32(float* p, const RowV& r, int lane) { f32x4* q = (f32x4*)p + lane;
#pragma unroll
    for (int j = 0; j < 4; ++j) q[64 * j] = r.v[j]; }
__device__ __forceinline__ RowV load_row_bf16(const bf16_t* p, int lane) { RowV r; const u32x2* q = (const u32x2*)p + lane;
#pragma unroll
    for (int j = 0; j < 4; ++j) { const u32x2 w = q[64 * j]; r.v[j] = (f32x4){bf_lo(w.x), bf_hi(w.x), bf_lo(w.y), bf_hi(w.y)}; }
    return r; }
__device__ __forceinline__ void store_row_bf16(bf16_t* p, const RowV& r, int lane) { u32x2* q = (u32x2*)p + lane;
#pragma unroll
    for (int j = 0; j < 4; ++j) { u32x2 w; w.x = cvt_pk_bf16(r.v[j][0], r.v[j][1]); w.y = cvt_pk_bf16(r.v[j][2], r.v[j][3]); q[64 * j] = w; } }
struct RowQ { unsigned w[4]; float sc; };
__device__ __forceinline__ RowQ quant_row_i8(const RowV& r) {
    float am = 0.f;
#pragma unroll
    for (int j = 0; j < 4; ++j) am = fmaxf(fmaxf(am, fmaxf(fabsf(r.v[j][0]), fabsf(r.v[j][1]))), fmaxf(fabsf(r.v[j][2]), fabsf(r.v[j][3])));
#pragma unroll
    for (int o = 1; o < 64; o <<= 1) am = fmaxf(am, __shfl_xor(am, o));
    const float inv = am > 0.f ? 127.0f / am : 0.f;
    RowQ q; q.sc = am * (1.0f / 127.0f);
#pragma unroll
    for (int j = 0; j < 4; ++j) q.w[j] = pack4_i8(r.v[j][0] * inv, r.v[j][1] * inv, r.v[j][2] * inv, r.v[j][3] * inv);
    return q;
}
__device__ __forceinline__ void store_rowq(unsigned char* p, const RowQ& q, int lane) { unsigned* d = (unsigned*)p + lane;
#pragma unroll
    for (int j = 0; j < 4; ++j) d[64 * j] = q.w[j]; }
__device__ __forceinline__ void store_row_fp8(unsigned char* p, const RowV& r, int lane) { unsigned* q = (unsigned*)p + lane;
#pragma unroll
    for (int j = 0; j < 4; ++j) q[64 * j] = cvt4_fp8(r.v[j][0], r.v[j][1], r.v[j][2], r.v[j][3]); }
__device__ __forceinline__ RowV adaln_row(const RowV& x, const float* g, const float* shift, const float* scale, int lane) {
    float ss = 0.f;
#pragma unroll
    for (int j = 0; j < 4; ++j) ss += (x.v[j][0] * x.v[j][0] + x.v[j][1] * x.v[j][1]) + (x.v[j][2] * x.v[j][2] + x.v[j][3] * x.v[j][3]);
    const float rstd = 1.0f / sqrtf(wave_sum(ss) * (1.0f / DM) + 1e-6f);
    const RowV gv = load_row_f32(g, lane), sh = load_row_f32(shift, lane), sc = load_row_f32(scale, lane);
    RowV y;
#pragma unroll
    for (int j = 0; j < 4; ++j) y.v[j] = x.v[j] * rstd * gv.v[j] * (1.0f + sc.v[j]) + sh.v[j];
    return y;
}
__device__ __forceinline__ int mod_row_of(int row) { return row < NLAT ? (row >> 11) : 8; }
struct AdaCoef { RowV A, B; int mr; };
__device__ __forceinline__ void ada_coef_update(AdaCoef& c, int row, const float* g, const float* modbase, int shift_off, int scale_off, int lane) {
    const int mr = mod_row_of(row);
    if (mr != c.mr) { c.mr = mr; const float* mv = modbase + (size_t)mr * 6144;
        const RowV gv = load_row_f32(g, lane), sh = load_row_f32(mv + shift_off, lane), sc = load_row_f32(mv + scale_off, lane);
#pragma unroll
        for (int j = 0; j < 4; ++j) { c.A.v[j] = gv.v[j] * (1.0f + sc.v[j]); c.B.v[j] = sh.v[j]; } }
}
__device__ __forceinline__ RowV adaln_apply(const RowV& x, const AdaCoef& c) {
    float ss = 0.f;
#pragma unroll
    for (int j = 0; j < 4; ++j) ss += (x.v[j][0] * x.v[j][0] + x.v[j][1] * x.v[j][1]) + (x.v[j][2] * x.v[j][2] + x.v[j][3] * x.v[j][3]);
    const float rstd = 1.0f / sqrtf(wave_sum(ss) * (1.0f / DM) + 1e-6f);
    RowV y;
#pragma unroll
    for (int j = 0; j < 4; ++j) y.v[j] = x.v[j] * rstd * c.A.v[j] + c.B.v[j];
    return y;
}

struct MoeTiles { int tb[9]; };
__device__ __forceinline__ MoeTiles moe_tiles(unsigned* ctl, int i) { MoeTiles t; int s = 0;
#pragma unroll
    for (int e = 0; e < 8; ++e) { t.tb[e] = s; const unsigned c = (unsigned)__builtin_amdgcn_readfirstlane((int)__hip_atomic_load(ctl + CW_CNT + 64 * (8 * i + e), __ATOMIC_RELAXED, __HIP_MEMORY_SCOPE_AGENT)); s += (int)((c + 255u) >> 8); }
    t.tb[8] = s; return t; }

__device__ __forceinline__ float max3f(float a, float b, float c) { return __builtin_fmaxf(__builtin_fmaxf(a, b), c); }
__device__ __forceinline__ int crow(int r, int hi) { return (r & 3) + 8 * (r >> 2) + 4 * hi; }
typedef short v4i16_t __attribute__((ext_vector_type(4)));
__device__ __forceinline__ s16x4 vtr(const LAS unsigned char* p) { return __builtin_bit_cast(s16x4, __builtin_amdgcn_ds_read_tr16_b64_v4i16((LAS v4i16_t*)p)); }

struct AttnCtx { const bf16_t* P; bf16_t* O; const float* subln_g; float lam, one_m_li; const float* sink; };

constexpr float ATT_THR = 8.0f;
__device__ __forceinline__ void glds16(const void* gsrc, unsigned lds_dst) { unsigned keep;
    asm volatile("s_mov_b32 %0, m0\n\ts_mov_b32 m0, %2\n\ts_nop 0\n\tglobal_load_lds_dwordx4 %1, off\n\ts_mov_b32 m0, %0" : "=&s"(keep) : "v"(gsrc), "s"(lds_dst) : "memory"); }
#define ATT_BAR() do { __builtin_amdgcn_sched_barrier(0); asm volatile("s_waitcnt lgkmcnt(0)" ::: "memory"); __builtin_amdgcn_s_barrier(); asm volatile("" ::: "memory"); __builtin_amdgcn_sched_barrier(0); } while (0)
template <int VAR>
__device__ __forceinline__ void attn_unit(LAS unsigned char* lds, const int tid, const AttnCtx& ac, int b, int hh, int qb, bool ctxq) {
    constexpr int NDB = (VAR == 0) ? 4 : 2;
    constexpr int NLD = (VAR == 0) ? 2 : 1;
    constexpr int KB = (VAR == 0) ? 16384 : 8192;
    constexpr int VB = (VAR == 0) ? 16384 : 8192;
    constexpr int VBASE = 3 * KB;
    constexpr int WSF_OFF = 135168;
    const int lane = tid & 63, r32 = lane & 31, hi = lane >> 5; const int wid = __builtin_amdgcn_readfirstlane(tid >> 6);
    const int half = wid >> 2;
    int map = 0, g = 0, qsub, qcol, kcol, vcol, ocol, qpb;
    if (VAR == 0) { map = wid >> 2; qsub = wid & 3; qpb = 128; qcol = C_AQ + hh * 128 + map * 64; kcol = C_AK + hh * 128; vcol = C_AV + hh * 128; ocol = hh * 128; }
    else { g = wid >> 1; qsub = wid & 1; qpb = 64; qcol = (VAR == 1 ? C_BQ : C_CQ) + (hh * 4 + g) * 64; kcol = (VAR == 1 ? C_BK : C_CK) + hh * 64; vcol = (VAR == 1 ? C_BV : C_CV) + hh * 64; ocol = (VAR == 1 ? 512 : 1024) + (hh * 4 + g) * 64; }
    const int q0w = qb * qpb + qsub * 32;
    const int latbase = b * SEQ, ctxbase = NLAT + b * CTXL;
    const int qrow0 = (ctxq ? ctxbase : latbase) + q0w;
    int NT, lt0 = 0;
    if (ctxq) NT = 4;
    else if (VAR == 2) { lt0 = qb - 2 < 0 ? 0 : qb - 2; const int lt1 = qb + 2 > 31 ? 31 : qb + 2; NT = 4 + (lt1 - lt0 + 1); }
    else NT = 36;
    auto tile_row0 = [&](int t) -> int {
        if (ctxq) return ctxbase + 64 * t;
        if (VAR == 2) return t < 4 ? ctxbase + 64 * t : latbase + 64 * (lt0 + t - 4);
        return t < 32 ? latbase + 64 * t : ctxbase + 64 * (t - 32);
    };
    const GAS bf16_t* Pg = (const GAS bf16_t*)ac.P;
    bf16x8 qr[4];
    { const GAS bf16_t* qp = Pg + (size_t)(qrow0 + r32) * PW + qcol + hi * 8;
#pragma unroll
      for (int d0 = 0; d0 < 4; ++d0) qr[d0] = *(const GAS bf16x8*)(qp + d0 * 16); }
    const GAS bf16_t* kdma = Pg + (size_t)lane * PW + kcol + 8 * wid;
    const GAS bf16_t* vdma = Pg + (size_t)(16 * (wid & 3) + (lane >> 2)) * PW + vcol + (wid >> 2) * 32 + (lane & 3) * 8;
    const unsigned lds0 = (unsigned)(uintptr_t)lds + (unsigned)wid * 1024u;
    auto gloadK = [&](int t, int slot) { const GAS bf16_t* rp = kdma + (size_t)tile_row0(t) * PW;
#pragma unroll
        for (int j = 0; j < NLD; ++j) glds16((const void*)(rp + 64 * j), (unsigned)__builtin_amdgcn_readfirstlane(lds0 + (unsigned)(slot * KB + j * 8192))); };
    auto gloadV = [&](int t, int slot) { const GAS bf16_t* rp = vdma + (size_t)tile_row0(t) * PW;
#pragma unroll
        for (int j = 0; j < NLD; ++j) glds16((const void*)(rp + 64 * j), (unsigned)__builtin_amdgcn_readfirstlane(lds0 + (unsigned)(VBASE + slot * VB + j * 8192))); };
    volatile LAS float* wsf = (volatile LAS float*)(lds + WSF_OFF + wid * 256);
    const int koff = (VAR == 0 ? map * 8192 : 0) + hi * 1024 + r32 * 16;
    const int vlane = (4 * hi + ((lane & 15) >> 2)) * 64 + ((lane >> 4) & 1) * 32 + (lane & 3) * 8;
    f32x16 o[NDB];
#pragma unroll
    for (int d = 0; d < NDB; ++d) o[d] = (f32x16){0.f, 0.f, 0.f, 0.f, 0.f, 0.f, 0.f, 0.f, 0.f, 0.f, 0.f, 0.f, 0.f, 0.f, 0.f, 0.f};
    float m_run = 0.f, l_run = 0.f;
    f32x16 negm = (f32x16){0.f, 0.f, 0.f, 0.f, 0.f, 0.f, 0.f, 0.f, 0.f, 0.f, 0.f, 0.f, 0.f, 0.f, 0.f, 0.f};
    const int tq = q0w + r32;
    f32x16 s0, s1;
    auto qk = [&](int slot) { const LAS unsigned char* bp = lds + slot * KB + koff;
        s0 = negm; s1 = negm;
        constexpr int KH = (VAR == 0) ? 2 : 4;
#pragma unroll
        for (int h = 0; h < 4; h += KH) {
            bf16x8 kf[2 * KH];
#pragma unroll
            for (int d0 = 0; d0 < KH; ++d0) { kf[2 * d0] = *(const LAS bf16x8*)(bp + (h + d0) * 2048); kf[2 * d0 + 1] = *(const LAS bf16x8*)(bp + (h + d0) * 2048 + 512); }
            __builtin_amdgcn_sched_barrier(0);
#pragma unroll
            for (int d0 = 0; d0 < KH; ++d0) {
                s0 = __builtin_amdgcn_mfma_f32_32x32x16_bf16(kf[2 * d0], qr[h + d0], s0, 0, 0, 0);
                s1 = __builtin_amdgcn_mfma_f32_32x32x16_bf16(kf[2 * d0 + 1], qr[h + d0], s1, 0, 0, 0); }
            if (h + KH < 4) __builtin_amdgcn_sched_barrier(0);
        } };
    gloadK(0, 0); gloadV(0, 0);
    if (NT > 1) gloadK(1, 1);
    asm volatile("s_waitcnt vmcnt(0)" ::: "memory"); ATT_BAR();
    if (NT > 2) gloadK(2, 2);
    if (NT > 1) gloadV(1, 1);
    qk(0);
    ATT_BAR();
    if (half == 1) ATT_BAR();
    int k0 = 0;
    for (int t = 0; t < NT; ++t) {
        const bool more1 = t + 1 < NT, more2 = t + 2 < NT, more3 = t + 3 < NT;
        const int k1 = k0 == 2 ? 0 : k0 + 1, k2 = k1 == 2 ? 0 : k1 + 1;
        if (VAR == 2 && !ctxq && t >= 4) {
            const int lt = lt0 + t - 4, kb = 64 * lt + 4 * hi - tq;
            if (lt == qb - 2) {
#pragma unroll
                for (int r = 0; r < 16; ++r) { const int d = kb + (r & 3) + 8 * (r >> 2); if (d < -128) s0[r] = -1e30f; if (d + 32 < -128) s1[r] = -1e30f; }
            } else if (lt == qb + 2) {
#pragma unroll
                for (int r = 0; r < 16; ++r) { const int d = kb + (r & 3) + 8 * (r >> 2); if (d > 128) s0[r] = -1e30f; if (d + 32 > 128) s1[r] = -1e30f; }
            }
        }
        float ma = max3f(s0[0], s0[1], s1[0]), mb = max3f(s0[2], s0[3], s1[1]); ma = max3f(ma, s1[2], s1[3]);
#pragma unroll
        for (int r = 4; r < 16; r += 4) { ma = max3f(ma, s0[r], s0[r + 1]); mb = max3f(mb, s0[r + 2], s0[r + 3]); ma = max3f(ma, s1[r], s1[r + 1]); mb = max3f(mb, s1[r + 2], s1[r + 3]); }
        float mx = fmaxf(ma, mb);
        { const auto rr = __builtin_amdgcn_permlane32_swap(__float_as_uint(mx), __float_as_uint(mx), false, false); mx = fmaxf(__uint_as_float(rr[0]), __uint_as_float(rr[1])); }
        if (t == 0 || __any(mx > ATT_THR)) {
            const float dl = (t == 0) ? mx : fmaxf(mx, 0.f);
            m_run += dl;
#pragma unroll
            for (int r = 0; r < 16; ++r) { s0[r] -= dl; s1[r] -= dl; negm[r] = -m_run; }
            const float f = fast_exp2(-dl);
            l_run *= f;
            if (hi == 0) wsf[r32] = f;
            LDS_WAIT();
#pragma unroll
            for (int r = 0; r < 16; ++r) { const float al = wsf[crow(r, hi)];
#pragma unroll
                for (int d = 0; d < NDB; ++d) o[d][r] *= al; }
        }
        float la = 0.f, lb = 0.f;
#pragma unroll
        for (int r = 0; r < 16; ++r) { s0[r] = fast_exp2(s0[r]); s1[r] = fast_exp2(s1[r]); la += s0[r]; lb += s1[r]; }
        l_run += la + lb;
        bf16x8 pa[4];
        { u32x4 w;
          w.x = cvt_pk_bf16(s0[0], s0[1]); w.y = cvt_pk_bf16(s0[2], s0[3]); w.z = cvt_pk_bf16(s0[4], s0[5]); w.w = cvt_pk_bf16(s0[6], s0[7]); pa[0] = __builtin_bit_cast(bf16x8, w);
          w.x = cvt_pk_bf16(s0[8], s0[9]); w.y = cvt_pk_bf16(s0[10], s0[11]); w.z = cvt_pk_bf16(s0[12], s0[13]); w.w = cvt_pk_bf16(s0[14], s0[15]); pa[1] = __builtin_bit_cast(bf16x8, w);
          w.x = cvt_pk_bf16(s1[0], s1[1]); w.y = cvt_pk_bf16(s1[2], s1[3]); w.z = cvt_pk_bf16(s1[4], s1[5]); w.w = cvt_pk_bf16(s1[6], s1[7]); pa[2] = __builtin_bit_cast(bf16x8, w);
          w.x = cvt_pk_bf16(s1[8], s1[9]); w.y = cvt_pk_bf16(s1[10], s1[11]); w.z = cvt_pk_bf16(s1[12], s1[13]); w.w = cvt_pk_bf16(s1[14], s1[15]); pa[3] = __builtin_bit_cast(bf16x8, w); }
        ATT_BAR();
        if (more3) gloadK(t + 3, k0);
        if (more2) gloadV(t + 2, k2);
        const LAS unsigned char* vp = lds + VBASE + k0 * VB + vlane;
        s16x4 va_lo[NDB], va_hi[NDB], vb_lo[NDB], vb_hi[NDB];
#define ATT_VLOAD(LO, HI, KS) do { _Pragma("unroll") for (int d = 0; d < NDB; ++d) { LO[d] = vtr(vp + d * 4096 + (KS) * 1024); HI[d] = vtr(vp + d * 4096 + (KS) * 1024 + 512); } } while (0)
#define ATT_VMMA(LO, HI, KS) do { _Pragma("unroll") for (int d = 0; d < NDB; ++d) { const bf16x8 vf = (bf16x8){LO[d][0], LO[d][1], LO[d][2], LO[d][3], HI[d][0], HI[d][1], HI[d][2], HI[d][3]}; \
            o[d] = __builtin_amdgcn_mfma_f32_32x32x16_bf16(pa[KS], vf, o[d], 0, 0, 0); } } while (0)
        ATT_VLOAD(va_lo, va_hi, 0); ATT_VLOAD(vb_lo, vb_hi, 1);
        __builtin_amdgcn_sched_barrier(0);
        ATT_VMMA(va_lo, va_hi, 0);
        __builtin_amdgcn_sched_barrier(0);
        ATT_VLOAD(va_lo, va_hi, 2);
        __builtin_amdgcn_sched_barrier(0);
        ATT_VMMA(vb_lo, vb_hi, 1);
        __builtin_amdgcn_sched_barrier(0);
        ATT_VLOAD(vb_lo, vb_hi, 3);
        __builtin_amdgcn_sched_barrier(0);
        ATT_VMMA(va_lo, va_hi, 2);
        ATT_VMMA(vb_lo, vb_hi, 3);
#undef ATT_VLOAD
#undef ATT_VMMA
        if (more1) qk(k1);
        if (more3) { if (NLD == 2) asm volatile("s_waitcnt vmcnt(4)" ::: "memory"); else asm volatile("s_waitcnt vmcnt(2)" ::: "memory"); }
        else if (more2) { if (NLD == 2) asm volatile("s_waitcnt vmcnt(2)" ::: "memory"); else asm volatile("s_waitcnt vmcnt(1)" ::: "memory"); }
        else asm volatile("s_waitcnt vmcnt(0)" ::: "memory");
        ATT_BAR();
        k0 = k1;
    }
    if (half == 0) ATT_BAR();
    { float l_tot; { const auto rr = __builtin_amdgcn_permlane32_swap(__float_as_uint(l_run), __float_as_uint(l_run), false, false); l_tot = __uint_as_float(rr[0]) + __uint_as_float(rr[1]); }
      if (VAR == 2) l_tot += fast_exp2(ac.sink[hh * 4 + g] * LOG2E - m_run);
      if (hi == 0) wsf[r32] = 1.0f / l_tot;
      LDS_WAIT();
#pragma unroll
      for (int r = 0; r < 16; ++r) { const float il = wsf[crow(r, hi)];
#pragma unroll
          for (int d = 0; d < NDB; ++d) o[d][r] *= il; } }
    GAS bf16_t* Og = (GAS bf16_t*)ac.O;
    if (VAR != 0) {
#pragma unroll
        for (int r = 0; r < 16; ++r) { GAS bf16_t* op = Og + (size_t)(qrow0 + crow(r, hi)) * OW + ocol + r32;
#pragma unroll
            for (int d = 0; d < NDB; ++d) op[d * 32] = f2bf(o[d][r]); }
    } else {
        LAS float* tile = (LAS float*)lds + ((wid & 3) * 2 + map) * (32 * 132);
#pragma unroll
        for (int r = 0; r < 16; ++r)
#pragma unroll
            for (int d = 0; d < NDB; ++d) tile[crow(r, hi) * 132 + d * 32 + r32] = o[d][r];
        __syncthreads();
        const int ql = (wid >> 2) * 16 + (lane >> 2), part = lane & 3;
        const LAS float* t0 = (const LAS float*)lds + ((wid & 3) * 2) * (32 * 132) + ql * 132 + part * 32;
        const LAS float* t1 = t0 + 32 * 132;
        f32x4 dv[8]; float ss = 0.f;
#pragma unroll
        for (int j = 0; j < 8; ++j) { const f32x4 a = *(const LAS f32x4*)(t0 + 4 * j), bq = *(const LAS f32x4*)(t1 + 4 * j); dv[j] = a - ac.lam * bq;
            ss += (dv[j][0] * dv[j][0] + dv[j][1] * dv[j][1]) + (dv[j][2] * dv[j][2] + dv[j][3] * dv[j][3]); }
        ss += __shfl_xor(ss, 1); ss += __shfl_xor(ss, 2);
        const float rs = ac.one_m_li / sqrtf(ss * (1.0f / 128.0f) + 1e-5f);
        const GAS float* gp = (const GAS float*)ac.subln_g + part * 32;
        GAS bf16_t* op = Og + (size_t)((ctxq ? ctxbase : latbase) + qb * qpb + (wid & 3) * 32 + ql) * OW + ocol + part * 32;
#pragma unroll
        for (int k = 0; k < 4; ++k) { const f32x4 g0 = *(const GAS f32x4*)(gp + 8 * k), g1 = *(const GAS f32x4*)(gp + 8 * k + 4);
            const f32x4 v0 = dv[2 * k] * g0 * rs, v1 = dv[2 * k + 1] * g1 * rs;
            u32x4 w; w.x = cvt_pk_bf16(v0[0], v0[1]); w.y = cvt_pk_bf16(v0[2], v0[3]); w.z = cvt_pk_bf16(v1[0], v1[1]); w.w = cvt_pk_bf16(v1[2], v1[3]);
            *(GAS u32x4*)(op + 8 * k) = w; }
    }
}

using pg8::Unit;
struct SchedInproj {
    int c, G, nM, ntot, nfz; const char* xn; const char* win; const char* wfz; char* p; char* zz; char* zzc; const char* rope;
    __device__ __forceinline__ bool next(int i, Unit& u) const {
        const int L = i * G + c; if (L >= ntot + nfz) return false;
        u.aux = nullptr; u.aux2 = nullptr;
        if (L < ntot) { int pm, pn; pg8::tile_of(L, nM, 12, pm, pn);
            u.A = xn + (size_t)pm * 256 * DM * 2; u.B = win + (size_t)pn * 256 * DM * 2; u.out = p + ((size_t)pm * 256 * PW + pn * 256) * 2; u.ldc = PW;
            int fl = pm < 64 ? 16 : 0;
            if (pn < 2) fl |= 2 | 8; else if (pn < 4) fl |= 2; else if (pn == 9 || pn == 10) fl |= 2 | 8; else if (pn == 11) fl |= 4;
            u.flag = fl; u.aux = rope + (size_t)((pm * 256) & 2047) * 64 * 4; }
        else { const int q = L - ntot;
            if (q < 256) { const int b = q >> 5, pm = (q >> 3) & 3, pn = q & 7;
                u.A = wfz + (size_t)pm * 256 * DM * 2; u.B = xn + (size_t)(b * SEQ + pn * 256) * DM * 2;
                u.out = zz + ((size_t)b * 512 * 4096 + (size_t)((pm & 1) * 256) * 4096 + (pm >> 1) * 2048 + pn * 256) * 2; u.ldc = 4096; u.flag = 0; }
            else { const int q2 = q - 256, b = q2 >> 2, pm = q2 & 3;
                u.A = wfz + (size_t)pm * 256 * DM * 2; u.B = xn + (size_t)(NLAT + b * CTXL) * DM * 2;
                u.out = zzc + ((size_t)b * 512 * 512 + (size_t)((pm & 1) * 256) * 512 + (pm >> 1) * 256) * 2; u.ldc = 512; u.flag = 0; } }
        return true;
    }
};
struct SchedGate {
    int c, G, nM; const char* xn8; const char* wg; char* gates;
    __device__ __forceinline__ bool next(int i, Unit& u) const {
        const int L = i * G + c; if (L >= nM * 16) return false;
        int pm, pn; pg8::tile_of(L, nM, 16, pm, pn);
        u.A = xn8 + (size_t)pm * 256 * DM; u.B = wg + (size_t)pn * 256 * DM; u.out = gates + ((size_t)pm * 256 * GW + pn * 256); u.ldc = GW; u.flag = 0; u.aux = nullptr; u.aux2 = nullptr; return true;
    }
};
struct SchedDft {
    int c; const char* T; const char* zz; char* o;
    __device__ __forceinline__ bool next(int i, Unit& u) const {
        if (i > 0 || c >= 128) return false;
        const int b = c >> 4, pm = (c >> 1) & 7, pn = c & 1;
        u.A = T + (size_t)pm * 256 * 4096 * 2; u.B = zz + ((size_t)b * 512 + pn * 256) * 4096 * 2;
        u.out = o + ((size_t)(b * SEQ + pm * 256) * OW + 1536 + pn * 256) * 2; u.ldc = OW; u.flag = 0; u.aux = nullptr; u.aux2 = nullptr; return true;
    }
};
struct SchedDftCtx {
    int c; const char* T; const char* zzc; char* o;
    __device__ __forceinline__ bool next(int i, Unit& u) const {
        if (i > 0 || c < 128 || c >= 144) return false;
        const int q = c - 128, b = q >> 1, pn = q & 1;
        u.A = T; u.B = zzc + ((size_t)b * 512 + pn * 256) * 512 * 2;
        u.out = o + ((size_t)(NLAT + b * CTXL) * OW + 1536 + pn * 256) * 2; u.ldc = OW; u.flag = 0; u.aux = nullptr; u.aux2 = nullptr; return true;
    }
};
struct SchedBranch {
    int c, G, ntile; const char* o; const char* wbr; const char* p; char* merged;
    __device__ __forceinline__ bool next(int i, pg8::BUnit& u) const {
        const int xcd = c & 7, j = i * (G >> 3) + (c >> 3), pm = xcd + 8 * (j >> 3), pn2 = j & 7;
        if (pm * 8 >= ntile) return false;
        u.A = o + (size_t)pm * 256 * OW * 2; u.B = wbr + (size_t)pn2 * 128 * 2048 * 2;
        u.gate = p + ((size_t)pm * 256 * GW + pn2 * 128);
        u.out = merged + ((size_t)pm * 256 * 1024 + pn2 * 128) * 2; return true;
    }
};
struct SchedResid {
    int c, G, nM, K; const char* A; const char* B; char* xs; const char* modv; int goff; const char* xin; const char* cin;
    __device__ __forceinline__ bool next(int i, Unit& u) const {
        const int L = i * G + c; if (L >= nM * 4) return false;
        int pm, pn; pg8::tile_of(L, nM, 4, pm, pn);
        u.A = A + (size_t)pm * 256 * K * 2; u.B = B + (size_t)pn * 256 * K * 2; u.out = xs + ((size_t)pm * 256 * DM + pn * 256) * 2; u.ldc = DM;
        u.aux = modv + ((size_t)(pm < 64 ? (pm >> 3) : 8) * 6144 + goff + pn * 256) * 4; u.flag = xin ? 1 : 0;
        u.aux2 = xin ? (pm < 64 ? xin + ((size_t)pm * 256 * DM + pn * 256) * 4 : cin + ((size_t)(pm - 64) * 256 * DM + pn * 256) * 4) : (const char*)u.out; return true;
    }
};
struct SchedUp {
    int c, G, nM; const char* xn; const char* w; char* h; int eb; const float* rsc;
    __device__ __forceinline__ bool next(int i, Unit& u) const {
        const int L = i * G + c; if (L >= nM * 22) return false;
        int pm, pn; pg8::tile_of(L, nM, 22, pm, pn);
        u.A = xn + (size_t)pm * 256 * DM; u.B = w + (size_t)pn * 256 * DM; u.out = h + ((size_t)pm * 256 * DFF + pn * 128) * eb; u.ldc = DFF; u.flag = 0; u.aux = (const char*)(rsc + (size_t)pm * 256); u.aux2 = nullptr; return true;
    }
};
struct SchedMoe {
    int c, G, NT, K, RT; MoeTiles mt; const char* A; const char* W; size_t wsub; char* out; int ldc, colw, esz; const float* rsc;
    __device__ __forceinline__ bool next(int i, Unit& u) const {
        const int L0 = i * G + c, ntot = RT * NT; if (L0 >= ntot) return false;
        int L = L0; if (NT > 4) { const int q = ntot / 8, r = ntot % 8, xcd = L0 % 8, off = L0 / 8; L = (xcd < r ? xcd * (q + 1) : r * (q + 1) + (xcd - r) * q) + off; }
        const int gs = 8 * NT, g8 = L / gs, rem = L % gs, left = RT - 8 * g8, gsz = left < 8 ? left : 8;
        const int rt = 8 * g8 + rem % gsz, pn = rem / gsz;
        int e = 0;
#pragma unroll
        for (int k = 1; k < 8; ++k) e += (rt >= mt.tb[k]) ? 1 : 0;
        u.A = A + (size_t)rt * 256 * K * 2; u.B = W + (size_t)e * W_EXPERT + wsub + (size_t)pn * 256 * K * 2;
        u.out = out + ((size_t)rt * 256 * ldc + (size_t)pn * colw) * esz; u.ldc = ldc; u.flag = 0; u.aux = rsc ? (const char*)(rsc + (size_t)rt * 256) : nullptr; u.aux2 = nullptr; return true;
    }
};

struct SchedMoeSplit {
    int c, G, RF, RT; MoeTiles mt; const char* A; const char* W; char* y0; char* y1;
    __device__ __forceinline__ bool next(int i, Unit& u) const {
        const int L = i * G + c; if (L >= (RT - RF) * 8) return false;
        const int ts = L >> 1, kh = L & 1, rt = RF + (ts >> 2), pn = ts & 3;
        int e = 0;
#pragma unroll
        for (int k = 1; k < 8; ++k) e += (rt >= mt.tb[k]) ? 1 : 0;
        u.A = A + ((size_t)rt * 256 * DFE + kh * (DFE / 2)); u.B = W + (size_t)e * W_EXPERT + W_MD + ((size_t)pn * 256 * DFE + kh * (DFE / 2));
        u.out = kh ? y1 + ((size_t)(rt - RF) * 256 * DM + pn * 256) * 2 : y0 + ((size_t)rt * 256 * DM + pn * 256) * 2;
        u.ldc = DM; u.flag = 0; u.aux = nullptr; u.aux2 = nullptr; return true;
    }
};

#define LAUNDER_S(x) asm volatile("" : "+s"(x))
#define LAUNDER_V(x) asm volatile("" : "+v"(x))
constexpr int LDS_ARGOFF = LDS_CTLOFF + 512;
__device__ __forceinline__ const float* ARGP(LAS unsigned char* lds, int i) {
    unsigned off = LDS_ARGOFF + 8 * i; asm volatile("" : "+s"(off));
    volatile LAS unsigned* p = (volatile LAS unsigned*)(lds + off);
    const unsigned lo = __builtin_amdgcn_readfirstlane(p[0]), hi = __builtin_amdgcn_readfirstlane(p[1]);
    return (const float*)(((unsigned long long)hi << 32) | lo);
}
__device__ __forceinline__ void grid_barrier(LAS unsigned char* lds, int wv) {
    XcdBarrier b; b.bar = (unsigned*)((unsigned char*)ARGP(lds, 24) + WS_CTL) + CW_BAR; b.x = xb_xcc_id(); b.st = (volatile LAS unsigned*)(lds + LDS_CTLOFF);
    xcd_barrier(b, wv == 0 && lane_id() == 0);
}
struct Fr { LAS unsigned char* lds; unsigned char* ws; int tid, lane, wave, bid, G, gw, NGW; unsigned* ctl; };
__device__ __forceinline__ Fr make_frame(LAS unsigned char* lds, int wv) {
    Fr F; F.lds = lds;
    F.ws = (unsigned char*)ARGP(lds, 24); int t = wv * 64 + lane_id(); LAUNDER_V(t); F.tid = t; F.lane = t & 63; F.wave = wv;
    int b = blockIdx.x; LAUNDER_S(b); F.bid = b; int g = gridDim.x; LAUNDER_S(g); F.G = g; F.gw = b * 8 + F.wave; F.NGW = g * 8; F.ctl = (unsigned*)(F.ws + WS_CTL);
    return F;
}

constexpr int CV_PRO = 4 * CV_LAYER + 2 * CV_DENSE;
constexpr int CV_M1 = CV_PRO, CV_M3 = CV_PRO + 8 * CV_EXP;
#ifndef BG_BRW
#define BG_BRW 6
#endif
#ifndef BG_DDW
#define BG_DDW 12
#endif
constexpr int BG_BR = 192 * 8 * BG_BRW, BG_OUT = 224 * 8 * 4, BG_DD = 224 * 8 * BG_DDW;
constexpr int CVQ_BLK = 32;
constexpr int cmin_(int a, int b) { return a < b ? a : b; }
constexpr int MQ1_E = CV_M3, MQ2_E = CV_TOTAL, MQ1_S = cmin_(CV_M1 + BG_BR + BG_OUT + BG_DD + BG_BR, MQ1_E), MQ2_S = cmin_(CV_M3 + BG_OUT + BG_BR + BG_OUT + BG_DD, MQ2_E);
static_assert(MQ1_S <= MQ1_E && MQ2_S <= MQ2_E && (MQ1_E - MQ1_S) % (8 * CVQ_BLK) == 0 && (MQ2_E - MQ2_S) % (8 * CVQ_BLK) == 0, "queue conversion ranges are whole units per XCD queue");
__device__ __forceinline__ void convert_range(LAS unsigned char* lds, const Fr& F, int start, int end, int gwi, int nw) {
    Args a;
#pragma unroll
    for (int i = 0; i < 23; ++i) a.in[i] = ARGP(lds, i);
    a.out = nullptr; a.ws = F.ws;
    LAS float* scr = (LAS float*)(lds + F.wave * 8704);
    float ra[32], rb[32]; ConvDesc d, dn; int it = start + gwi; bool have = it < end;
    if (have) { d = conv_decode(a, it); conv_load(d, ra, F.lane); }
    while (have) {
        const int itn = it + nw; const bool hn = itn < end;
        if (hn) { dn = conv_decode(a, itn); conv_load(dn, rb, F.lane); }
        conv_store(d, ra, scr, F.lane);
        if (hn) {
#pragma unroll
            for (int i = 0; i < 32; ++i) ra[i] = rb[i];
            d = dn; }
        it = itn; have = hn;
    }
}
__device__ __forceinline__ void bg_window(int kind, int l, int& s, int& e) {
    s = 0; e = 0;
    const int m1a = CV_M1, m1b = cmin_(m1a + BG_BR, MQ1_E), m1c = cmin_(m1b + BG_OUT, MQ1_E), m1d = cmin_(m1c + BG_DD, MQ1_E), m1e = MQ1_S;
    const int m3a = CV_M3, m3b = cmin_(m3a + BG_OUT, MQ2_E), m3c = cmin_(m3b + BG_BR, MQ2_E), m3d = cmin_(m3c + BG_OUT, MQ2_E), m3e = MQ2_S;
    if (kind == 0) { if (l == 0) { s = m1a; e = m1b; } else if (l == 1) { s = m1d; e = m1e; } else if (l == 2) { s = m3b; e = m3c; } }
    else if (kind == 1) { if (l == 0) { s = m1b; e = m1c; } else if (l == 1) { s = m3a; e = m3b; } else if (l == 2) { s = m3c; e = m3d; } }
    else { if (l == 0) { s = m1c; e = m1d; } else if (l == 2) { s = m3d; e = m3e; } }
}
__device__ __forceinline__ void phase_prologue(LAS unsigned char* lds, int wv) {
    const Fr F = make_frame(lds, wv);
    Args a;
#pragma unroll
    for (int i = 0; i < 23; ++i) a.in[i] = ARGP(lds, i);
    a.out = nullptr; a.ws = F.ws;
    if (F.bid < 96) mod_item(a, F.bid, lds, F.tid);
    for (int it = F.gw; it < 2048; it += F.NGW) fzfold_item(a, it, F.lane);
    convert_range(lds, F, 0, CV_LAYER, F.gw, F.NGW);
    float* rope = (float*)(F.ws + WS_ROPE);
    for (int i = F.gw * 64 + F.lane; i < SEQ * 64; i += F.NGW * 64) { const int t = i >> 6, j = i & 63, ax = j >> 5, isin = (j >> 4) & 1, f = j & 15;
        const float pos = (float)(ax == 0 ? (t >> 6) : (t & 63));
        const float inv = powf(10000.0f, -(float)f / 16.0f); const float ang = pos * inv;
        rope[i] = isin ? sinf(ang) : cosf(ang); }
    bf16_t* T = (bf16_t*)(F.ws + WS_T);
    for (int i = F.gw * 64 + F.lane; i < 2048 * 2048; i += F.NGW * 64) { const int k = i >> 11, n = i & 2047; const float x = (float)((k * n) & 2047) * (1.0f / 1024.0f);
        T[(size_t)k * 4096 + n] = f2bf(cospif(x)); T[(size_t)k * 4096 + 2048 + n] = f2bf(-sinpif(x)); }
    bf16_t* T2 = (bf16_t*)(F.ws + WS_T256);
    for (int i = F.gw * 64 + F.lane; i < 256 * 256; i += F.NGW * 64) { const int k = i >> 8, n = i & 255; const float x = (float)((k * n) & 255) * (1.0f / 128.0f);
        T2[k * 512 + n] = f2bf(cospif(x)); T2[k * 512 + 256 + n] = f2bf(-sinpif(x)); }
}
__device__ __forceinline__ void phase_first_norm(LAS unsigned char* lds, int wv) {
    const Fr F = make_frame(lds, wv);
    const float* X = ARGP(lds, I_X); const float* CX = ARGP(lds, I_CTX); const float* n1g = ARGP(lds, I_N1G);
    float* xs = (float*)(F.ws + WS_XS); bf16_t* xn = (bf16_t*)(F.ws + WS_XN); const float* modv_all = (const float*)(F.ws + WS_MODV);
    for (int row = F.gw; row < NTOK; row += F.NGW) {
        const float* src = row < NLAT ? X + (size_t)row * DM : CX + (size_t)(row - NLAT) * DM;
        const RowV x = load_row_f32(src, F.lane);
        const float* mv = modv_all + (size_t)mod_row_of(row) * 6144;
        const RowV y = adaln_row(x, n1g, mv, mv + 1024, F.lane);
        store_row_bf16(xn + (size_t)row * DM, y, F.lane);
        store_row_fp8(F.ws + WS_XN8 + (size_t)row * DM, y, F.lane);
    }
}
__device__ __forceinline__ void phase_inproj(LAS unsigned char* lds, int wv, int l) {
    const Fr F = make_frame(lds, wv); unsigned char* ws = F.ws; const bool lastl = l == DEPTH - 1;
    { SchedInproj S{F.bid, F.G, NTOK / 256, (NTOK / 256) * 12, lastl ? 256 : 288, (const char*)(ws + WS_XN), (const char*)w_layer(ws, l, W_IN), (const char*)w_layer(ws, l, W_FZ), (char*)(ws + WS_P), (char*)(ws + WS_ZZ), (char*)(ws + WS_ZZC), (const char*)(ws + WS_ROPE)};
      pg8::EpiInproj E{};
      pg8::gemm_phase<pg8::EpiInproj, SchedInproj, true, true>(lds, F.tid, DM, DM, DM, S, E); }
    { SchedGate S{(F.bid + (F.G >> 1)) % F.G, F.G, NTOK / 256, (const char*)(ws + WS_XN8), (const char*)w_layer(ws, l, W_ING8), (char*)(ws + WS_G)};
      pg8::EpiGate E{};
      int tl = F.tid; LAUNDER_V(tl);
      pg8::gemm_phase<pg8::EpiGate, SchedGate, true, true, true>(lds, tl, DM / 2, DM / 2, DM / 2, S, E, 120); }
}
__device__ __forceinline__ void phase_post(LAS unsigned char* lds, int wv, int l) {
    const Fr F = make_frame(lds, wv);
    GAS bf16_t* P = (GAS bf16_t*)(F.ws + WS_P); const GAS float* rope = (const GAS float*)(F.ws + WS_ROPE);
    const GAS float* gq = (const GAS float*)ARGP(lds, I_QKG) + l * 128; const GAS float* gk = gq + 64;
    const int lane = F.lane, a = (lane & 7) >> 2, i0 = 4 * (lane & 3);
    float gqv[8], gkv[8];
#pragma unroll
    for (int e = 0; e < 8; ++e) { const int d = 32 * a + 16 * (e & 1) + i0 + (e >> 1); gqv[e] = gq[d]; gkv[e] = gk[d]; }
    for (int row = F.gw; row < NTOK; row += F.NGW) {
        GAS bf16_t* pr = P + (size_t)row * PW;
        const bool lat = row < NLAT;
        f32x4 cs = (f32x4){1.f, 1.f, 1.f, 1.f}, sn = (f32x4){0.f, 0.f, 0.f, 0.f};
        if (lat) { const GAS float* rt = rope + (size_t)(row & 2047) * 64 + a * 32 + i0; cs = *(const GAS f32x4*)rt; sn = *(const GAS f32x4*)(rt + 16); }
        const u32x4 qw = *(const GAS u32x4*)(pr + C_BQ + 8 * lane);
        u32x4 kw = (u32x4){0u, 0u, 0u, 0u};
        if (lane < 16) kw = *(const GAS u32x4*)(pr + C_BK + 8 * lane);
        float x[8], y[8];
        x[0] = bf_lo(qw.x); x[1] = bf_hi(qw.x); x[2] = bf_lo(qw.y); x[3] = bf_hi(qw.y); x[4] = bf_lo(qw.z); x[5] = bf_hi(qw.z); x[6] = bf_lo(qw.w); x[7] = bf_hi(qw.w);
        y[0] = bf_lo(kw.x); y[1] = bf_hi(kw.x); y[2] = bf_lo(kw.y); y[3] = bf_hi(kw.y); y[4] = bf_lo(kw.z); y[5] = bf_hi(kw.z); y[6] = bf_lo(kw.w); y[7] = bf_hi(kw.w);
        float sq = 0.f, sk = 0.f;
#pragma unroll
        for (int e = 0; e < 8; ++e) { sq += x[e] * x[e]; sk += y[e] * y[e]; }
        sq += __shfl_xor(sq, 1); sq += __shfl_xor(sq, 2); sq += __shfl_xor(sq, 4);
        sk += __shfl_xor(sk, 1); sk += __shfl_xor(sk, 2); sk += __shfl_xor(sk, 4);
        const float rq = 1.0f / sqrtf(sq * (1.0f / 64.0f) + 1e-6f), rk = 1.0f / sqrtf(sk * (1.0f / 64.0f) + 1e-6f);
#pragma unroll
        for (int e = 0; e < 8; ++e) { x[e] *= rq * gqv[e]; y[e] *= rk * gkv[e]; }
        float xo[8], yo[8];
#pragma unroll
        for (int p2 = 0; p2 < 4; ++p2) { const float c = cs[p2], s = sn[p2];
            xo[2 * p2] = (x[2 * p2] * c - x[2 * p2 + 1] * s) * C2; xo[2 * p2 + 1] = (x[2 * p2 + 1] * c + x[2 * p2] * s) * C2;
            yo[2 * p2] = y[2 * p2] * c - y[2 * p2 + 1] * s; yo[2 * p2 + 1] = y[2 * p2 + 1] * c + y[2 * p2] * s; }
        u32x4 ow; ow.x = cvt_pk_bf16(xo[0], xo[1]); ow.y = cvt_pk_bf16(xo[2], xo[3]); ow.z = cvt_pk_bf16(xo[4], xo[5]); ow.w = cvt_pk_bf16(xo[6], xo[7]);
        *(GAS u32x4*)(pr + C_BQ + 8 * lane) = ow;
        if (lane < 16) { u32x4 kk; kk.x = cvt_pk_bf16(yo[0], yo[1]); kk.y = cvt_pk_bf16(yo[2], yo[3]); kk.z = cvt_pk_bf16(yo[4], yo[5]); kk.w = cvt_pk_bf16(yo[6], yo[7]);
            *(GAS u32x4*)(pr + C_BK + 8 * lane) = kk; }
    }
}
constexpr int CVQ_UNITS = (CV_PRO - CV_LAYER) / (8 * CVQ_BLK);
static_assert(CVQ_UNITS * 8 * CVQ_BLK == CV_PRO - CV_LAYER, "conversion units tile the deferred block range");
__device__ __forceinline__ void phase_mix(LAS unsigned char* lds, int wv, int l, int rep) {
    const Fr F = make_frame(lds, wv); unsigned char* ws = F.ws; const bool lastl = l == DEPTH - 1;
    volatile LAS unsigned* LCTL = (volatile LAS unsigned*)(lds + LDS_CTLOFF);
    { SchedDft S{F.bid, (const char*)(ws + WS_T), (const char*)(ws + WS_ZZ), (char*)(ws + WS_O)}; pg8::EpiStore E{1.0f / 362.03867196751236f};
      pg8::gemm_phase<pg8::EpiStore, SchedDft, false, true>(lds, F.tid, 4096, 4096, 4096, S, E); }
    if (!lastl) { SchedDftCtx S{F.bid, (const char*)(ws + WS_T256), (const char*)(ws + WS_ZZC), (char*)(ws + WS_O)}; pg8::EpiStore E{1.0f / 128.0f};
      pg8::gemm_phase<pg8::EpiStore, SchedDftCtx, false, true>(lds, F.tid, 512, 512, 512, S, E); }
    float c08 = 0.8f; asm volatile("" : "+v"(c08));
    const float li = c08 - 0.6f * expf(-0.3f * (float)l);
    const float* lp = ARGP(lds, I_DLAM) + l * 256;
    float d01 = 0.f, d23 = 0.f;
    for (int k = 0; k < 64; ++k) { d01 += lp[k] * lp[64 + k]; d23 += lp[128 + k] * lp[192 + k]; }
    const float lam_u = __builtin_bit_cast(float, __builtin_amdgcn_readfirstlane(__builtin_bit_cast(int, expf(d01) - expf(d23) + li)));
    const float oml_u = __builtin_bit_cast(float, __builtin_amdgcn_readfirstlane(__builtin_bit_cast(int, 1.0f - li)));
    AttnCtx ac{(const bf16_t*)(ws + WS_P), (bf16_t*)(ws + WS_O), ARGP(lds, I_SUBLN) + l * 128, lam_u, oml_u, ARGP(lds, I_SINK) + l * 8};
    const int NUB = lastl ? 192 : 216;
    int NCV = 0, cvbase = 0;
    if (rep == 0) { if (l == 0) { NCV = CVQ_UNITS; cvbase = CV_LAYER; } else if (l == 1) { NCV = (MQ1_E - MQ1_S) / (8 * CVQ_BLK); cvbase = MQ1_S; } else if (l == 2) { NCV = (MQ2_E - MQ2_S) / (8 * CVQ_BLK); cvbase = MQ2_S; } }
    const int bq = F.bid & 7;
    unsigned* qc = F.ctl + CW_Q + 64 * (8 * (l + 4 * rep) + bq);
    for (;;) {
        __syncthreads();
        if (F.tid == 0) LCTL[2] = xb_add(qc, 1u);
        __syncthreads();
        const int u = __builtin_amdgcn_readfirstlane((int)LCTL[2]);
        if (u >= NUB + NCV) break;
        if (u >= NUB) { const int s = cvbase + ((u - NUB) * 8 + bq) * CVQ_BLK; convert_range(lds, F, s, s + CVQ_BLK, F.wave, 8); continue; }
        int tl = F.tid; LAUNDER_V(tl);
        if (u < 64) attn_unit<0>(lds, tl, ac, bq, u >> 4, u & 15, false);
        else if (u < 128) { const int v = u - 64; attn_unit<1>(lds, tl, ac, bq, v >> 5, v & 31, false); }
        else if (u < 192) { const int v = u - 128; attn_unit<2>(lds, tl, ac, bq, v >> 5, v & 31, false); }
        else if (u < 200) { const int v = u - 192; attn_unit<0>(lds, tl, ac, bq, v >> 1, v & 1, true); }
        else if (u < 208) { const int v = u - 200; attn_unit<1>(lds, tl, ac, bq, v >> 2, v & 3, true); }
        else { const int v = u - 208; attn_unit<2>(lds, tl, ac, bq, v >> 2, v & 3, true); }
    }
}
__device__ __forceinline__ void phase_branch(LAS unsigned char* lds, int wv, int l) {
    const Fr F = make_frame(lds, wv); unsigned char* ws = F.ws; const int nMact = (l == DEPTH - 1) ? NLAT / 256 : NTOK / 256;
    SchedBranch S{F.bid, F.G, nMact * 8, (const char*)(ws + WS_O), (const char*)w_layer(ws, l, W_BR), (const char*)(ws + WS_G), (char*)(ws + WS_XN)};
    pg8::branch_phase<SchedBranch>(lds, F.tid, S);
    if (nMact == NTOK / 256 && (F.bid >> 3) >= 8) {
        int s, e; bg_window(0, l, s, e);
        if (e > s) convert_range(lds, F, s, e, ((F.bid & 7) * 24 + (F.bid >> 3) - 8) * 8 + F.wave, 192 * 8);
    }
}
__device__ __forceinline__ void phase_out(LAS unsigned char* lds, int wv, int l) {
    const Fr F = make_frame(lds, wv); unsigned char* ws = F.ws; const int nMact = (l == DEPTH - 1) ? NLAT / 256 : NTOK / 256;
    SchedResid S{F.bid, F.G, nMact, DM, (const char*)(ws + WS_XN), (const char*)w_layer(ws, l, W_OUT), (char*)(ws + WS_XS), (const char*)(ws + WS_MODV + (size_t)l * 9 * 6144 * 4), 2048, l == 0 ? (const char*)ARGP(lds, I_X) : nullptr, l == 0 ? (const char*)ARGP(lds, I_CTX) : nullptr};
    pg8::EpiResid E{};
    pg8::gemm_phase<pg8::EpiResid, SchedResid, true, true>(lds, F.tid, DM, DM, DM, S, E);
    if (nMact == NTOK / 256 && F.bid >= 32) {
        int s, e; bg_window(1, l, s, e);
        if (e > s) convert_range(lds, F, s, e, (F.bid - 32) * 8 + F.wave, 224 * 8);
    }
}
__device__ __forceinline__ void phase_norm2_dense(LAS unsigned char* lds, int wv, int l) {
    const Fr F = make_frame(lds, wv); const int nrows = (l == DEPTH - 1) ? NLAT : NTOK;
    const bf16_t* xs = (const bf16_t*)(F.ws + WS_XS); bf16_t* xn = (bf16_t*)(F.ws + WS_XN); const float* modv = (const float*)(F.ws + WS_MODV) + (size_t)l * 9 * 6144;
    const float* n2g = ARGP(lds, I_N2G) + l * DM;
    const int rpw = nrows / F.NGW, r0 = F.gw * rpw, r1 = r0 + rpw;
    AdaCoef co; co.mr = -1;
    for (int r = r0; r < r1; r += 3) {
        RowV x[3];
#pragma unroll
        for (int q = 0; q < 3; ++q) x[q] = load_row_bf16(xs + (size_t)(r + q < r1 ? r + q : r) * DM, F.lane);
#pragma unroll
        for (int q = 0; q < 3; ++q) if (r + q < r1) { ada_coef_update(co, r + q, n2g, modv, 3072, 4096, F.lane);
            const RowQ yq = quant_row_i8(adaln_apply(x[q], co));
            store_rowq((unsigned char*)xn + (size_t)(r + q) * DM, yq, F.lane); if (F.lane == 0) ((float*)(F.ws + WS_RSC))[r + q] = yq.sc; }
    }
}
__device__ __forceinline__ void phase_up_dense(LAS unsigned char* lds, int wv, int l) {
    const Fr F = make_frame(lds, wv); unsigned char* ws = F.ws; const int nMact = (l == DEPTH - 1) ? NLAT / 256 : NTOK / 256;
    if ((DENSE_F8_MASK >> (l >> 1)) & 1) {
        SchedUp S{F.bid, F.G, nMact, (const char*)(ws + WS_XN), (const char*)w_dense(ws, l >> 1, W_DGU), (char*)(ws + WS_P), 1, (const float*)(ws + WS_RSC)};
        pg8::EpiSwigluI8<true> E{1.0f / W8_GU};
        pg8::gemm_phase<pg8::EpiSwigluI8<true>, SchedUp, true, true, 2>(lds, F.tid, DM / 2, DM / 2, DM / 2, S, E);
    } else {
        SchedUp S{F.bid, F.G, nMact, (const char*)(ws + WS_XN), (const char*)w_dense(ws, l >> 1, W_DGU), (char*)(ws + WS_P), 2, (const float*)(ws + WS_RSC)};
        pg8::EpiSwigluI8<false> E{1.0f / W8_GU};
        pg8::gemm_phase<pg8::EpiSwigluI8<false>, SchedUp, true, true, 2>(lds, F.tid, DM / 2, DM / 2, DM / 2, S, E);
    }
}
__device__ __forceinline__ void phase_down_dense(LAS unsigned char* lds, int wv, int l) {
    const Fr F = make_frame(lds, wv); unsigned char* ws = F.ws; const int nMact = (l == DEPTH - 1) ? NLAT / 256 : NTOK / 256;
    pg8::EpiResid E{};
    if ((DENSE_F8_MASK >> (l >> 1)) & 1) {
        SchedResid S{F.bid, F.G, nMact, DFF / 2, (const char*)(ws + WS_P), (const char*)w_dense(ws, l >> 1, W_DD), (char*)(ws + WS_XS), (const char*)(ws + WS_MODV + (size_t)l * 9 * 6144 * 4), 5120, nullptr, nullptr};
        pg8::gemm_phase<pg8::EpiResid, SchedResid, true, true, true>(lds, F.tid, DFF / 2, DFF / 2, DFF / 2, S, E, 119);
    } else {
        SchedResid S{F.bid, F.G, nMact, DFF, (const char*)(ws + WS_P), (const char*)w_dense(ws, l >> 1, W_DD), (char*)(ws + WS_XS), (const char*)(ws + WS_MODV + (size_t)l * 9 * 6144 * 4), 5120, nullptr, nullptr};
        pg8::gemm_phase<pg8::EpiResid, SchedResid, true, true>(lds, F.tid, DFF, DFF, DFF, S, E);
    }
    if (nMact == NTOK / 256 && F.bid >= 32) {
        int s, e; bg_window(2, l, s, e);
        if (e > s) convert_range(lds, F, s, e, (F.bid - 32) * 8 + F.wave, 224 * 8);
    }
}
__device__ __forceinline__ void phase_norm2_moe(LAS unsigned char* lds, int wv, int l) {
    const Fr F = make_frame(lds, wv); const int nrows = (l == DEPTH - 1) ? NLAT : NTOK; const int mi = l >> 1;
    volatile LAS unsigned* LCTL = (volatile LAS unsigned*)(lds + LDS_CTLOFF);
    const bf16_t* xs = (const bf16_t*)(F.ws + WS_XS); bf16_t* xn = (bf16_t*)(F.ws + WS_XN); const float* modv = (const float*)(F.ws + WS_MODV) + (size_t)l * 9 * 6144;
    const float* n2g = ARGP(lds, I_N2G) + l * DM;
    int* toklist = (int*)(F.ws + WS_MOE); int* rec = toklist + 8 * NTOK;
    const int rpb = nrows / F.G;
    const int tid = F.tid, lane = F.lane;
    LAS int* lrec = (LAS int*)(lds + 1024);
    const float* rw = ARGP(lds, I_RW) + (size_t)mi * DM * 8;
    for (int rr = F.wave; rr < rpb; rr += 8) {
        const int row = F.bid * rpb + rr;
        const RowV x = load_row_bf16(xs + (size_t)row * DM, lane);
        const float* mv = modv + (size_t)mod_row_of(row) * 6144;
        const RowV y = adaln_row(x, n2g, mv + 3072, mv + 4096, lane);
        float lg[8];
#pragma unroll
        for (int e = 0; e < 8; ++e) lg[e] = 0.f;
#pragma unroll
        for (int j = 0; j < 4; ++j)
#pragma unroll
            for (int cc = 0; cc < 4; ++cc) { const float* wp = rw + (size_t)(256 * j + 4 * lane + cc) * 8; const f32x4 w0 = *(const f32x4*)wp, w1 = *(const f32x4*)(wp + 4); const float hv = y.v[j][cc];
                lg[0] += hv * w0[0]; lg[1] += hv * w0[1]; lg[2] += hv * w0[2]; lg[3] += hv * w0[3]; lg[4] += hv * w1[0]; lg[5] += hv * w1[1]; lg[6] += hv * w1[2]; lg[7] += hv * w1[3]; }
#pragma unroll
        for (int e = 0; e < 8; ++e) lg[e] = wave_sum(lg[e]);
        int i0 = 0; float v0 = lg[0];
#pragma unroll
        for (int e = 1; e < 8; ++e) if (lg[e] > v0) { v0 = lg[e]; i0 = e; }
        int i1 = -1; float v1 = -3.0e38f;
#pragma unroll
        for (int e = 0; e < 8; ++e) if (e != i0 && lg[e] > v1) { v1 = lg[e]; i1 = e; }
        if (lane == 0) {
            const float w0 = 1.0f / (1.0f + expf(v1 - v0)), w1 = 1.0f - w0;
            lrec[rr * 6 + 0] = i0; lrec[rr * 6 + 2] = __float_as_int(w0); lrec[rr * 6 + 3] = i1; lrec[rr * 6 + 5] = __float_as_int(w1);
        }
    }
    __syncthreads();
    { const int e = F.wave; int cnt = 0;
      for (int a0 = 0; a0 < 2 * rpb; a0 += 64) { const int a = a0 + lane; const bool valid = a < 2 * rpb; const int rr = a >> 1, k3 = 3 * (a & 1);
          const bool match = valid && lrec[rr * 6 + k3] == e;
          const unsigned long long bal = __ballot(match);
          if (match) lrec[rr * 6 + k3 + 1] = cnt + (int)__popcll(bal & ((1ull << lane) - 1ull));
          cnt += (int)__popcll(bal); }
      if (lane == 0) { toklist[F.bid * 8 + e] = cnt;
          (void)xb_add(F.ctl + CW_CNT + 64 * (8 * mi + e), (unsigned)cnt); } }
    __syncthreads();
    for (int rr = tid; rr < rpb; rr += 512) {
        const int row = F.bid * rpb + rr;
        int* rc = rec + (size_t)row * 8;
        rc[0] = lrec[rr * 6 + 0]; rc[1] = lrec[rr * 6 + 1]; rc[2] = lrec[rr * 6 + 2]; rc[3] = lrec[rr * 6 + 3]; rc[4] = lrec[rr * 6 + 4]; rc[5] = lrec[rr * 6 + 5];
    }
}
__device__ __forceinline__ void phase_moe_gather(LAS unsigned char* lds, int wv, int l) {
    const Fr F = make_frame(lds, wv); const int mi = l >> 1; const int nrows = (l == DEPTH - 1) ? NLAT : NTOK; const int rpb = nrows / F.G;
    volatile LAS unsigned* LCTL = (volatile LAS unsigned*)(lds + LDS_CTLOFF);
    const MoeTiles mt = moe_tiles(F.ctl, mi);
    const GAS bf16_t* xn = (const GAS bf16_t*)(F.ws + WS_XN); GAS bf16_t* hs = (GAS bf16_t*)(F.ws + WS_HY);
    const GAS int* blkcnt = (const GAS int*)(F.ws + WS_MOE); GAS int* rec = (GAS int*)(F.ws + WS_MOE) + 8 * NTOK;
    LAS int* red = (LAS int*)(lds + 1024);
    { const int e = F.tid & 7, ch = F.tid >> 3; int s = 0;
#pragma unroll
      for (int j = 0; j < 4; ++j) { const int bb = ch * 4 + j; if (bb < F.bid) s += blkcnt[bb * 8 + e]; }
      red[e * 64 + ch] = s; }
    __syncthreads();
    if (F.tid < 8) { int s = 0; for (int ch = 0; ch < 64; ++ch) s += red[F.tid * 64 + ch]; LCTL[16 + F.tid] = (unsigned)s; }
    __syncthreads();
    LAS int* sl = (LAS int*)(lds + 4096);
    for (int rr = F.tid; rr < rpb; rr += 512) {
        GAS int* rc = rec + (size_t)(F.bid * rpb + rr) * 8;
        const int e0 = rc[0], e1 = rc[3];
        const int p0 = rc[1] + (int)LCTL[16 + e0], p1 = rc[4] + (int)LCTL[16 + e1];
        int t0 = 0, t1 = 0;
#pragma unroll
        for (int k = 0; k < 8; ++k) { t0 = (e0 == k) ? mt.tb[k] : t0; t1 = (e1 == k) ? mt.tb[k] : t1; }
        sl[rr * 2] = t0 * 256 + p0; sl[rr * 2 + 1] = t1 * 256 + p1;
        rc[1] = p0; rc[4] = p1;
    }
    __syncthreads();
    const bf16_t* xs = (const bf16_t*)(F.ws + WS_XS); const float* modv = (const float*)(F.ws + WS_MODV) + (size_t)l * 9 * 6144; const float* n2g = ARGP(lds, I_N2G) + l * DM;
    AdaCoef co; co.mr = -1;
    for (int r0 = F.wave * (rpb >> 3); r0 < (F.wave + 1) * (rpb >> 3); r0 += 3) {
        RowV x[3]; int s[3][2];
#pragma unroll
        for (int q = 0; q < 3; ++q) { const int rr = r0 + q; const bool ok = rr < (F.wave + 1) * (rpb >> 3);
            x[q] = load_row_bf16(xs + (size_t)(F.bid * rpb + (ok ? rr : r0)) * DM, F.lane);
            s[q][0] = ok ? sl[rr * 2] : -1; s[q][1] = ok ? sl[rr * 2 + 1] : -1; }
#pragma unroll
        for (int q = 0; q < 3; ++q) if (s[q][0] >= 0) { const int row = F.bid * rpb + r0 + q;
            ada_coef_update(co, row, n2g, modv, 3072, 4096, F.lane);
            const RowV y = adaln_apply(x[q], co);
            const RowQ yq = quant_row_i8(y);
            store_rowq((unsigned char*)hs + (size_t)s[q][0] * DM, yq, F.lane); store_rowq((unsigned char*)hs + (size_t)s[q][1] * DM, yq, F.lane);
            if (F.lane == 0) { float* ssc = (float*)(F.ws + WS_SSC); ssc[s[q][0]] = yq.sc; ssc[s[q][1]] = yq.sc; } }
    }
    for (int idx = F.gw; idx < 8 * 256; idx += F.NGW) { const int e = idx >> 8, j = idx & 255;
        const int cnt = __builtin_amdgcn_readfirstlane((int)__hip_atomic_load(F.ctl + CW_CNT + 64 * (8 * mi + e), __ATOMIC_RELAXED, __HIP_MEMORY_SCOPE_AGENT));
        const int pad = ((cnt + 255) & ~255) - cnt; int tbe = 0;
#pragma unroll
        for (int k = 0; k < 8; ++k) tbe = (e == k) ? mt.tb[k] : tbe;
        if (j < pad) { unsigned z = 0u; asm volatile("" : "+v"(z));
            GAS u32x4* dp = (GAS u32x4*)((GAS unsigned char*)hs + (size_t)(tbe * 256 + cnt + j) * DM) + F.lane; dp[0] = (u32x4){z, z, z, z}; if (F.lane == 0) ((GAS float*)(F.ws + WS_SSC))[tbe * 256 + cnt + j] = __uint_as_float(z); } }
}
__device__ __forceinline__ void phase_up_moe(LAS unsigned char* lds, int wv, int l) {
    const Fr F = make_frame(lds, wv); unsigned char* ws = F.ws; const int mi = l >> 1;
    const MoeTiles mt = moe_tiles(F.ctl, mi);
    SchedMoe S{F.bid, F.G, 28, DM / 2, mt.tb[8], mt, (const char*)(ws + WS_HY), (const char*)w_moe(ws, mi, 0, 0), W_MGU, (char*)(ws + WS_P), DFE, 128, 1, (const float*)(ws + WS_SSC)};
    pg8::EpiSwigluI8<true> E{1.0f / W8_GU};
    pg8::gemm_phase<pg8::EpiSwigluI8<true>, SchedMoe, true, true, 2>(lds, F.tid, DM / 2, DM / 2, DM / 2, S, E);
}
__device__ __forceinline__ void phase_down_moe(LAS unsigned char* lds, int wv, int l) {
    const Fr F = make_frame(lds, wv); unsigned char* ws = F.ws; const int mi = l >> 1;
    const MoeTiles mt = moe_tiles(F.ctl, mi);
    const int RT = mt.tb[8], RF = RT < MOE_RF ? RT : MOE_RF;
    pg8::EpiStore E{1.0f};
    { SchedMoe S{F.bid, F.G, 4, DFE / 2, RF, mt, (const char*)(ws + WS_P), (const char*)w_moe(ws, mi, 0, 0), W_MD, (char*)(ws + WS_HY), DM, 256, 2};
      pg8::gemm_phase<pg8::EpiStore, SchedMoe, true, true, true>(lds, F.tid, DFE / 2, DFE / 2, DFE / 2, S, E, 119); }
    if (RT > RF) {
        SchedMoeSplit S2{F.bid, F.G, RF, RT, mt, (const char*)(ws + WS_P), (const char*)w_moe(ws, mi, 0, 0), (char*)(ws + WS_HY), (char*)(ws + WS_Y1)};
        pg8::gemm_phase<pg8::EpiStore, SchedMoeSplit, true, true, true>(lds, F.tid, DFE / 4, DFE / 2, DFE / 2, S2, E, 119);
    }
}
__device__ __forceinline__ void phase_next_norm(LAS unsigned char* lds, int wv, int l) {
    const Fr F = make_frame(lds, wv); const bool lastl = l == DEPTH - 1; const int nrows = lastl ? NLAT : NTOK; const int mi = l >> 1;
    const bool moe = (l & 1) != 0;
    MoeTiles mt; if (moe) mt = moe_tiles(F.ctl, mi); else {
#pragma unroll
        for (int k = 0; k < 9; ++k) mt.tb[k] = 0; }
    bf16_t* xs = (bf16_t*)(F.ws + WS_XS); bf16_t* xn = (bf16_t*)(F.ws + WS_XN);
    const bf16_t* yb = (const bf16_t*)(F.ws + WS_HY); const bf16_t* yb1 = (const bf16_t*)(F.ws + WS_Y1); const int* rec = (const int*)(F.ws + WS_MOE) + 8 * NTOK;
    const float* modv = (const float*)(F.ws + WS_MODV) + (size_t)l * 9 * 6144;
    const float* modn = modv + 9 * 6144;
    const float* n1g = ARGP(lds, I_N1G) + (lastl ? 0 : (l + 1) * DM); const float* fg = ARGP(lds, I_FINALG); float* outp = (float*)ARGP(lds, 23);
    const int lane = F.lane;
    for (int row = F.gw; row < nrows; row += F.NGW) {
        RowV x = load_row_bf16(xs + (size_t)row * DM, lane);
        if (moe) {
            const int* rc = rec + (size_t)row * 8;
            const int e0 = rc[0], p0 = rc[1], e1 = rc[3], p1 = rc[4]; const float w0 = __int_as_float(rc[2]), w1 = __int_as_float(rc[5]);
            int t0 = 0, t1 = 0;
#pragma unroll
            for (int k = 0; k < 8; ++k) { t0 = (e0 == k) ? mt.tb[k] : t0; t1 = (e1 == k) ? mt.tb[k] : t1; }
            RowV y0 = load_row_bf16(yb + (size_t)(t0 * 256 + p0) * DM, lane), y1 = load_row_bf16(yb + (size_t)(t1 * 256 + p1) * DM, lane);
            { const int rt0 = t0 + (p0 >> 8), rt1 = t1 + (p1 >> 8);
              if (rt0 >= MOE_RF) { const RowV z = load_row_bf16(yb1 + (size_t)((rt0 - MOE_RF) * 256 + (p0 & 255)) * DM, lane);
#pragma unroll
                  for (int j = 0; j < 4; ++j) y0.v[j] += z.v[j]; }
              if (rt1 >= MOE_RF) { const RowV z = load_row_bf16(yb1 + (size_t)((rt1 - MOE_RF) * 256 + (p1 & 255)) * DM, lane);
#pragma unroll
                  for (int j = 0; j < 4; ++j) y1.v[j] += z.v[j]; } }
            const RowV g2 = load_row_f32(modv + (size_t)mod_row_of(row) * 6144 + 5120, lane);
#pragma unroll
            for (int j = 0; j < 4; ++j) x.v[j] += g2.v[j] * (w0 * y0.v[j] + w1 * y1.v[j]);
            if (!lastl) store_row_bf16(xs + (size_t)row * DM, x, lane);
        }
        if (!lastl) {
            const float* mv = modn + (size_t)mod_row_of(row) * 6144;
            const RowV y = adaln_row(x, n1g, mv, mv + 1024, lane);
            store_row_bf16(xn + (size_t)row * DM, y, lane);
            store_row_fp8(F.ws + WS_XN8 + (size_t)row * DM, y, lane);
        } else {
            float ss = 0.f;
#pragma unroll
            for (int j = 0; j < 4; ++j) ss += (x.v[j][0] * x.v[j][0] + x.v[j][1] * x.v[j][1]) + (x.v[j][2] * x.v[j][2] + x.v[j][3] * x.v[j][3]);
            const float rstd = 1.0f / sqrtf(wave_sum(ss) * (1.0f / DM) + 1e-6f);
            const RowV gv = load_row_f32(fg, lane);
            RowV y;
#pragma unroll
            for (int j = 0; j < 4; ++j) y.v[j] = x.v[j] * rstd * gv.v[j];
            store_row_f32(outp + (size_t)row * DM, y, lane);
        }
    }
}

__global__ void __launch_bounds__(512, 2) mega_fwd(Args a) {
    extern __shared__ __attribute__((aligned(16))) unsigned char lds_raw[];
    LAS unsigned char* lds = (LAS unsigned char*)lds_raw;
    volatile LAS unsigned* LCTL = (volatile LAS unsigned*)(lds + LDS_CTLOFF);
    const int wv = __builtin_amdgcn_readfirstlane((int)(threadIdx.x >> 6));
    {
        const int tid = threadIdx.x;
        for (int u = tid; u < 64; u += 512) LCTL[u] = 0u;
        if (tid == 0) { LAS unsigned long long* ap = (LAS unsigned long long*)(lds + LDS_ARGOFF);
#pragma unroll
            for (int i = 0; i < 23; ++i) ap[i] = (unsigned long long)a.in[i];
            ap[23] = (unsigned long long)a.out; ap[24] = (unsigned long long)a.ws; }
        __syncthreads();
    }
    (void)xcd_barrier_post((unsigned*)(a.ws + WS_CTL) + CW_BAR, LCTL);
    phase_prologue(lds, wv);
    grid_barrier(lds, wv);
#if DUP_PRO
    phase_prologue(lds, wv);
    grid_barrier(lds, wv);
#endif
    phase_first_norm(lds, wv);
    grid_barrier(lds, wv);
    for (int l = 0; l < DEPTH; ++l) {
        phase_inproj(lds, wv, l);  grid_barrier(lds, wv);
#if DUP_INPROJ
        phase_inproj(lds, wv, l);  grid_barrier(lds, wv);
#endif
        phase_post(lds, wv, l);    grid_barrier(lds, wv);
        phase_mix(lds, wv, l, 0);  grid_barrier(lds, wv);
#if DUP_MIX
        phase_mix(lds, wv, l, 1);  grid_barrier(lds, wv);
#endif
        phase_branch(lds, wv, l);  grid_barrier(lds, wv);
#if DUP_BRANCH
        phase_branch(lds, wv, l);  grid_barrier(lds, wv);
#endif
        phase_out(lds, wv, l);     grid_barrier(lds, wv);
        if ((l & 1) == 0) {
            phase_norm2_dense(lds, wv, l); grid_barrier(lds, wv);
#if DUP_N2D
            phase_norm2_dense(lds, wv, l); grid_barrier(lds, wv);
#endif
            phase_up_dense(lds, wv, l);    grid_barrier(lds, wv);
#if DUP_UPD
            phase_up_dense(lds, wv, l);    grid_barrier(lds, wv);
#endif
            phase_down_dense(lds, wv, l);  grid_barrier(lds, wv);
        } else {
            phase_norm2_moe(lds, wv, l);   grid_barrier(lds, wv);
            phase_moe_gather(lds, wv, l);  grid_barrier(lds, wv);
#if DUP_GATH
            phase_moe_gather(lds, wv, l);  grid_barrier(lds, wv);
#endif
            phase_up_moe(lds, wv, l);      grid_barrier(lds, wv);
#if DUP_MOEG == 1
            phase_up_moe(lds, wv, l);      grid_barrier(lds, wv);
#endif
            phase_down_moe(lds, wv, l);    grid_barrier(lds, wv);
#if DUP_MOEG == 2
            phase_down_moe(lds, wv, l);    grid_barrier(lds, wv);
#endif
        }
        phase_next_norm(lds, wv, l);
        if (l != DEPTH - 1) grid_barrier(lds, wv);
    }
}

extern "C" void kernel_launch(void* const* d_in, const int* in_sizes, int n_in, void* d_out, int out_size, void* d_ws, size_t ws_size, hipStream_t stream) {
    static int grid = 0;
    if (grid == 0) {
        if (n_in != 23 || out_size != NLAT * DM || ws_size < WS_END) { fprintf(stderr, "kernel_launch: unexpected problem (n_in %d out %d ws %zu need %zu)\n", n_in, out_size, ws_size, (size_t)WS_END); grid = -1; return; }
        int dev = 0, cus = 0, per_cu = 0;
        if (hipGetDevice(&dev) != hipSuccess || hipDeviceGetAttribute(&cus, hipDeviceAttributeMultiprocessorCount, dev) != hipSuccess) { grid = -1; return; }
        if (hipFuncSetAttribute((const void*)mega_fwd, hipFuncAttributeMaxDynamicSharedMemorySize, LDS_BYTES) != hipSuccess) { fprintf(stderr, "kernel_launch: hipFuncSetAttribute failed\n"); grid = -1; return; }
        if (hipOccupancyMaxActiveBlocksPerMultiprocessor(&per_cu, (const void*)mega_fwd, 512, LDS_BYTES) != hipSuccess || per_cu < 1) { fprintf(stderr, "kernel_launch: occupancy query says %d\n", per_cu); }
        (void)hipGetLastError();
        grid = cus;
        if (grid != 256) fprintf(stderr, "kernel_launch: %d CUs (built for 256)\n", grid);
    }
    if (grid < 0) return;
    (void)hipMemsetAsync((char*)d_ws + WS_CTL, 0, CTL_ZERO_BYTES, stream);
    Args a{};
    for (int i = 0; i < 23; ++i) a.in[i] = (const float*)d_in[i];
    a.out = (float*)d_out; a.ws = (unsigned char*)d_ws;
    hipLaunchKernelGGL(mega_fwd, dim3(grid), dim3(512), LDS_BYTES, stream, a);
}
```

```cpp
#include <hip/hip_runtime.h>
#include <cstdio>
#include <cstdint>

#ifndef DUP_MIX
#define DUP_MIX 0
#endif
#ifndef DUP_PRO
#define DUP_PRO 0
#endif
#ifndef DUP_BRANCH
#define DUP_BRANCH 0
#endif
#ifndef DUP_MOEG
#define DUP_MOEG 0
#endif
#ifndef DUP_UPD
#define DUP_UPD 0
#endif
#ifndef DUP_N2D
#define DUP_N2D 0
#endif
#ifndef DUP_GATH
#define DUP_GATH 0
#endif
#ifndef DUP_INPROJ
#define DUP_INPROJ 0
#endif
#ifndef DENSE_F8_MASK
#define DENSE_F8_MASK 0
#endif
#define LAS __attribute__((address_space(3)))
#define GAS __attribute__((address_space(1)))
typedef unsigned short bf16_t;
typedef short bf16x8 __attribute__((ext_vector_type(8)));
typedef short s16x4 __attribute__((ext_vector_type(4)));
typedef float f32x4 __attribute__((ext_vector_type(4)));
typedef float f32x16 __attribute__((ext_vector_type(16)));
typedef unsigned u32x4 __attribute__((ext_vector_type(4)));
typedef unsigned u32x2 __attribute__((ext_vector_type(2)));
typedef int i32x4 __attribute__((ext_vector_type(4)));
typedef int i32x8 __attribute__((ext_vector_type(8)));

constexpr int NB = 8, SEQ = 2048, DM = 1024, DEPTH = 4, CTXL = 256;
constexpr int NLAT = NB * SEQ, NCTX = NB * CTXL, NTOK = NLAT + NCTX;
constexpr int DIN = 7680, PW = 3072, GW = 4096;
constexpr int C_AQ = 0, C_AK = 512, C_AV = 1024, C_BQ = 1536, C_BK = 2048, C_BV = 2176, C_CQ = 2304, C_CK = 2816, C_CV = 2944;
constexpr int DFF = 2816, DFE = 3584, NEXP = 8;
constexpr int OW = 2048;
constexpr int MAXSLOT = 2 * NTOK + 2048;
constexpr float C2 = 0.125f * 1.4426950408889634f;
constexpr float LOG2E = 1.4426950408889634f;

constexpr size_t MiB = 1u << 20;
constexpr size_t WS_CTL = 0, CTL_ZERO_BYTES = 1 * MiB;
constexpr size_t WS_MODV = 1 * MiB;
constexpr size_t WS_ROPE = 2 * MiB;
constexpr size_t WS_T256 = 3 * MiB;
constexpr size_t WS_MOE = 4 * MiB;
constexpr size_t WS_SSC = WS_MOE + 3 * MiB / 2;
constexpr size_t WS_RSC = WS_MOE + 7 * MiB / 4;
constexpr size_t WS_RSC1 = WS_MOE + 15 * MiB / 8;
constexpr size_t WS_T = 6 * MiB;
constexpr size_t WS_W = 22 * MiB;
constexpr size_t W_IN = 0, W_ING8 = 6 * MiB  , W_FZ = 14 * MiB, W_BR = 16 * MiB, W_OUT = 20 * MiB, W_LAYER = 22 * MiB;
constexpr size_t W_DENSE0 = 4 * W_LAYER, W_DGU = 0, W_DD = 11 * MiB, W_DENSE = 33 * MiB / 2;
constexpr size_t W_MOE0 = W_DENSE0 + 2 * W_DENSE, W_MGU = 0, W_MD = 14 * MiB, W_EXPERT = 21 * MiB, W_MOE = 8 * W_EXPERT;
constexpr size_t WS_XS = WS_W + W_MOE0 + 2 * W_MOE;
constexpr size_t WS_XN8 = WS_XS + 36 * MiB;
constexpr size_t WS_XN = WS_XS + 72 * MiB;
constexpr size_t WS_P = WS_XN + 36 * MiB;
constexpr size_t WS_G = WS_P + 108 * MiB;
constexpr size_t WS_ZZ = WS_P + 252 * MiB;
constexpr size_t WS_ZZC = WS_ZZ + 32 * MiB;
constexpr size_t WS_O = WS_ZZC + 4 * MiB;
constexpr size_t WS_HY = WS_O + 72 * MiB;
constexpr size_t WS_Y1 = WS_HY + 76 * MiB;
constexpr size_t WS_END = WS_Y1 + 16 * MiB;
constexpr int MOE_RF = 128;
static_assert(WS_W + W_MOE0 + 2 * W_MOE == 479 * MiB, "weights");
static_assert((size_t)MAXSLOT * DFE * 2 <= 288 * MiB, "moe hidden fits p+zz");
static_assert((size_t)MAXSLOT * 1024 * 2 <= 76 * MiB, "hs fits");
static_assert(WS_END <= 1074 * MiB, "workspace");

constexpr int CW_BAR = 4096;
constexpr int CW_Q = 16384;
constexpr int CW_CNT = 24576;

constexpr int LDS_CTLOFF = 141312;
constexpr int LDS_BYTES = 147456;

typedef float f32x2_t __attribute__((ext_vector_type(2))); typedef __bf16 bf16x2_t __attribute__((ext_vector_type(2)));
__device__ __forceinline__ unsigned cvt_pk_bf16(float lo, float hi) { f32x2_t v = {lo, hi}; bf16x2_t b = __builtin_convertvector(v, bf16x2_t); return __builtin_bit_cast(unsigned, b); }
__device__ __forceinline__ float clamp_f8(float v) { return __builtin_amdgcn_fmed3f(v, -448.0f, 448.0f); }
__device__ __forceinline__ unsigned cvt4_fp8(float a, float b, float c, float d) { int w = 0; w = __builtin_amdgcn_cvt_pk_fp8_f32(clamp_f8(a), clamp_f8(b), w, false); w = __builtin_amdgcn_cvt_pk_fp8_f32(clamp_f8(c), clamp_f8(d), w, true); return (unsigned)w; }
__device__ __forceinline__ unsigned pack4_i8(float a, float b, float c, float d) {
    const int ia = (int)__builtin_rintf(__builtin_amdgcn_fmed3f(a, -127.0f, 127.0f)), ib = (int)__builtin_rintf(__builtin_amdgcn_fmed3f(b, -127.0f, 127.0f));
    const int ic = (int)__builtin_rintf(__builtin_amdgcn_fmed3f(c, -127.0f, 127.0f)), id = (int)__builtin_rintf(__builtin_amdgcn_fmed3f(d, -127.0f, 127.0f));
    return ((unsigned)ia & 255u) | (((unsigned)ib & 255u) << 8) | (((unsigned)ic & 255u) << 16) | ((unsigned)id << 24); }
constexpr float W8_GU = 127.0f * 32.0f / 4.5f;
constexpr float W8_FZ = 127.0f / 1.125f;
__device__ __forceinline__ float bf_lo(unsigned w) { return __uint_as_float(w << 16); }
__device__ __forceinline__ float bf_hi(unsigned w) { return __uint_as_float(w & 0xffff0000u); }
__device__ __forceinline__ float bf2f(bf16_t h) { return __uint_as_float(((unsigned)h) << 16); }
__device__ __forceinline__ bf16_t f2bf(float f) { unsigned u = __float_as_uint(f); u += 0x7fffu + ((u >> 16) & 1u); return (bf16_t)(u >> 16); }
__device__ __forceinline__ float fast_exp2(float x) { return __builtin_amdgcn_exp2f(x); }
__device__ __forceinline__ float fast_rcp(float x) { return __builtin_amdgcn_rcpf(x); }
__device__ __forceinline__ float sigmoidf_(float x) { return fast_rcp(1.0f + fast_exp2(-x * LOG2E)); }
__device__ __forceinline__ float siluf_(float x) { return x * sigmoidf_(x); }
__device__ __forceinline__ float wave_sum(float v) {
#pragma unroll
    for (int o = 1; o < 64; o <<= 1) v += __shfl_xor(v, o);
    return v;
}
#define LDS_WAIT() asm volatile("s_waitcnt lgkmcnt(0)" ::: "memory")
__device__ __forceinline__ int lane_id() { int l; asm volatile("v_mbcnt_lo_u32_b32 %0, -1, 0\n\tv_mbcnt_hi_u32_b32 %0, -1, %0" : "=v"(l)); return l; }

namespace pg8 {
constexpr int BM = 256, BK = 64, HALF = 128, HTB = HALF * BK * 2, STAGE_BYTES = 8 * HTB, NXCD = 8, WGM = 8;
__host__ __device__ __forceinline__ int lds_byte(int r, int c) { const int st = (r >> 4) * 2 + (c >> 5), rr = r & 15, cc = c & 31, ob = rr * 64 + cc * 2; return st * 1024 + (ob ^ (((ob >> 9) & 1) << 5)); }
__host__ __device__ __forceinline__ void stage_rc(int b, int& R, int& C) { const int st = b / 1024, sb = b % 1024, swz = sb ^ (((sb >> 9) & 1) << 5); R = (st >> 1) * 16 + swz / 64; C = (st & 1) * 32 + (swz % 64) / 2; }
__host__ __device__ __forceinline__ int perm32(int rho) { const int n = rho >> 4, i = rho & 15; return 8 * (i >> 2) + 4 * n + (i & 3); }

struct Unit { const char* A; const char* B; char* out; const char* aux; const char* aux2; int ldc; int flag; };

__device__ __forceinline__ void tile_of(int L, int nM, int nN, int& pm, int& pn) {
    const int nwg = nM * nN; int wgid = L;
    { const int q = nwg / NXCD, r = nwg % NXCD, xcd = wgid % NXCD, off = wgid / NXCD; wgid = (xcd < r ? xcd * (q + 1) : r * (q + 1) + (xcd - r) * q) + off; }
    const int nig = WGM * nN, gid = wgid / nig, fm = gid * WGM, gsz = (nM - fm) < WGM ? (nM - fm) : WGM;
    pm = fm + ((wgid % nig) % gsz); pn = (wgid % nig) / gsz;
}

__device__ __forceinline__ i32x8 cat8(const bf16x8 a, const bf16x8 b) { return __builtin_shufflevector(__builtin_bit_cast(i32x4, a), __builtin_bit_cast(i32x4, b), 0, 1, 2, 3, 4, 5, 6, 7); }
template <class Epi, class Sched, bool ALIGN_EPI, bool SP2, int QM = 0>
__device__ __forceinline__ void gemm_phase(LAS unsigned char* lds, const int tid, const int K, const int lda, const int ldb, const Sched& S, const Epi& E, const int wsc = 127) {
    const int wid = __builtin_amdgcn_readfirstlane(tid >> 6), lane = tid & 63, wr = wid >> 2, wc = wid & 3, fr = lane & 15, fq = lane >> 4;
    const int nt = K / BK;
    unsigned voffA[2], voffB[2];
#pragma unroll
    for (int i = 0; i < 2; ++i) { int R, C; stage_rc(tid * 16 + i * 8192, R, C); const int Rb = Epi::PERM ? ((R & ~31) + perm32(R & 31)) : R;
        voffA[i] = (unsigned)(R * lda + C) * 2u; voffB[i] = (unsigned)(Rb * ldb + C) * 2u; }
    const size_t kstep = (size_t)(BK * 2);
    const size_t hstepA = (size_t)HALF * lda * 2, hstepB = (size_t)HALF * ldb * 2;
    const unsigned ldsw = (unsigned)wid * 1024u;
    const int aoff = lds_byte(wr * 64 + fr, fq * 8), boff = lds_byte(wc * 32 + fr, fq * 8);
#define PG8_SA(b, h) (((b) * 2 + (h)) * HTB)
#define PG8_SB(b, h) ((4 + (b) * 2 + (h)) * HTB)
#define PG8_STAGE(bufoff, gbase, voff) do { _Pragma("unroll") for (int _i = 0; _i < 2; ++_i) \
        __builtin_amdgcn_global_load_lds((const unsigned*)((const char*)(gbase) + (voff)[_i]), (LAS unsigned*)(lds + (bufoff) + ldsw + _i * 8192), 16, 0, 0); } while (0)
#define PG8_LDA(dst, b, h) do { _Pragma("unroll") for (int m = 0; m < 4; ++m) _Pragma("unroll") for (int k = 0; k < 2; ++k) dst[m][k] = *(const LAS bf16x8*)(lds + PG8_SA(b, h) + aoff + m * 2048 + k * 1024); } while (0)
#define PG8_LDB(dst, b, h) do { _Pragma("unroll") for (int n = 0; n < 2; ++n) _Pragma("unroll") for (int k = 0; k < 2; ++k) dst[n][k] = *(const LAS bf16x8*)(lds + PG8_SB(b, h) + boff + n * 2048 + k * 1024); } while (0)
#define PG8_MMA(ai, bj, At, Bt) do { __builtin_amdgcn_s_setprio(1); _Pragma("unroll") for (int m = 0; m < 4; ++m) _Pragma("unroll") for (int n = 0; n < 2; ++n) { \
        if constexpr (QM == 2) { _Pragma("unroll") for (int k = 0; k < 2; ++k) acc[ai][bj][m][n] = __builtin_bit_cast(f32x4, __builtin_amdgcn_mfma_i32_16x16x64_i8(__builtin_bit_cast(i32x4, Bt[n][k]), __builtin_bit_cast(i32x4, At[m][k]), __builtin_bit_cast(i32x4, acc[ai][bj][m][n]), 0, 0, 0)); \
            asm volatile("" : "+v"(acc[ai][bj][m][n])); } \
        else if constexpr (QM == 1) { acc[ai][bj][m][n] = __builtin_amdgcn_mfma_scale_f32_16x16x128_f8f6f4(cat8(Bt[n][0], Bt[n][1]), cat8(At[m][0], At[m][1]), acc[ai][bj][m][n], 0, 0, 0, wsc, 0, 127); \
            asm volatile("" : "+v"(acc[ai][bj][m][n]));   } \
        else { _Pragma("unroll") for (int k = 0; k < 2; ++k) acc[ai][bj][m][n] = __builtin_amdgcn_mfma_f32_16x16x32_bf16(Bt[n][k], At[m][k], acc[ai][bj][m][n], 0, 0, 0); } } __builtin_amdgcn_s_setprio(0); } while (0)
#define PG8_WAIT_V(n) asm volatile("s_waitcnt vmcnt(" #n ")" ::: "memory")
#define PG8_WAIT_L(n) asm volatile("s_waitcnt lgkmcnt(" #n ")" ::: "memory")
#define PG8_BAR __builtin_amdgcn_s_barrier()
#define PG8_SCHED __builtin_amdgcn_sched_barrier(0)
    Unit cur, nxt; int ui = 0;
    if (!S.next(0, cur)) return;
    f32x4 acc[2][2][4][2];
#pragma unroll
    for (int a = 0; a < 2; ++a)
#pragma unroll
        for (int b = 0; b < 2; ++b)
#pragma unroll
            for (int m = 0; m < 4; ++m)
#pragma unroll
                for (int n = 0; n < 2; ++n) acc[a][b][m][n] = (f32x4){0.f, 0.f, 0.f, 0.f};
    bf16x8 At[4][2], B0[2][2], B1[2][2];
    const char* cA = cur.A; const char* cB = cur.B;
    if constexpr (SP2) {
        PG8_STAGE(PG8_SB(0, 0), cB, voffB); PG8_STAGE(PG8_SB(0, 1), cB + hstepB, voffB); PG8_STAGE(PG8_SA(0, 0), cA, voffA); PG8_STAGE(PG8_SA(0, 1), cA + hstepA, voffA);
        if (wr == 1) PG8_BAR;
        PG8_WAIT_V(2); PG8_BAR;
        PG8_STAGE(PG8_SB(1, 0), cB + kstep, voffB); PG8_STAGE(PG8_SA(1, 0), cA + kstep, voffA); PG8_STAGE(PG8_SB(1, 1), cB + hstepB + kstep, voffB);
        PG8_WAIT_V(6); PG8_BAR;
    } else {
        PG8_STAGE(PG8_SB(0, 0), cB, voffB); PG8_STAGE(PG8_SA(0, 0), cA, voffA); PG8_STAGE(PG8_SB(0, 1), cB + hstepB, voffB); PG8_STAGE(PG8_SA(0, 1), cA + hstepA, voffA);
        if (wr == 1) PG8_BAR;
        PG8_WAIT_V(4); PG8_BAR;
        PG8_STAGE(PG8_SB(1, 0), cB + kstep, voffB); PG8_STAGE(PG8_SA(1, 0), cA + kstep, voffA); PG8_STAGE(PG8_SB(1, 1), cB + hstepB + kstep, voffB);
        PG8_WAIT_V(6); PG8_BAR;
    }
    for (;;) {
        const bool has_next = S.next(ui + 1, nxt);
        const char* nA = has_next ? nxt.A : cA; const char* nB = has_next ? nxt.B : cB;
        for (int t = 0; t < nt; t += 2) {
            const bool last = (t == nt - 2);
            const char* a1 = cA + (size_t)(t + 1) * kstep;
            const char* a2 = last ? nA : cA + (size_t)(t + 2) * kstep; const char* b2 = last ? nB : cB + (size_t)(t + 2) * kstep;
            const char* a3 = a2 + kstep; const char* b3 = b2 + kstep;
            if constexpr (SP2) {
            PG8_LDB(B0, 0, 0); PG8_LDB(B1, 0, 1); PG8_SCHED; PG8_LDA(At, 0, 0); PG8_STAGE(PG8_SA(1, 1), a1 + hstepA, voffA);
            PG8_WAIT_V(8); PG8_WAIT_L(0); PG8_BAR; PG8_MMA(0, 0, At, B0); PG8_MMA(0, 1, At, B1); PG8_BAR; PG8_SCHED;
            PG8_LDA(At, 0, 1); PG8_STAGE(PG8_SB(0, 0), b2, voffB); PG8_STAGE(PG8_SB(0, 1), b2 + hstepB, voffB); PG8_STAGE(PG8_SA(0, 0), a2, voffA);
            PG8_WAIT_V(8); PG8_WAIT_L(0); PG8_BAR; PG8_MMA(1, 0, At, B0); PG8_MMA(1, 1, At, B1); PG8_BAR; PG8_SCHED;
            PG8_LDB(B0, 1, 0); PG8_LDB(B1, 1, 1); PG8_SCHED; PG8_LDA(At, 1, 0); PG8_STAGE(PG8_SA(0, 1), a2 + hstepA, voffA);
            PG8_WAIT_V(8); PG8_WAIT_L(0); PG8_BAR; PG8_MMA(0, 0, At, B0); PG8_MMA(0, 1, At, B1); PG8_BAR; PG8_SCHED;
            PG8_LDA(At, 1, 1); PG8_STAGE(PG8_SB(1, 0), b3, voffB); PG8_STAGE(PG8_SB(1, 1), b3 + hstepB, voffB); PG8_STAGE(PG8_SA(1, 0), a3, voffA);
            PG8_WAIT_V(8); PG8_WAIT_L(0); PG8_BAR; PG8_MMA(1, 0, At, B0); PG8_MMA(1, 1, At, B1); PG8_BAR; PG8_SCHED;
            } else {
            PG8_LDB(B0, 0, 0); PG8_SCHED; PG8_LDA(At, 0, 0); PG8_STAGE(PG8_SA(1, 1), a1 + hstepA, voffA);
            PG8_WAIT_L(8); PG8_BAR; PG8_WAIT_L(0); PG8_MMA(0, 0, At, B0); PG8_BAR; PG8_SCHED;
            PG8_LDB(B1, 0, 1); PG8_STAGE(PG8_SB(0, 0), b2, voffB);
            PG8_BAR; PG8_WAIT_L(0); PG8_MMA(0, 1, At, B1); PG8_BAR;
            PG8_LDA(At, 0, 1); PG8_STAGE(PG8_SA(0, 0), a2, voffA);
            PG8_BAR; PG8_WAIT_L(0); PG8_MMA(1, 0, At, B0); PG8_BAR; PG8_SCHED;
            PG8_STAGE(PG8_SB(0, 1), b2 + hstepB, voffB);
            PG8_WAIT_V(6); PG8_BAR; PG8_MMA(1, 1, At, B1); PG8_BAR;
            PG8_LDB(B0, 1, 0); PG8_SCHED; PG8_LDA(At, 1, 0); PG8_STAGE(PG8_SA(0, 1), a2 + hstepA, voffA);
            PG8_WAIT_L(8); PG8_BAR; PG8_WAIT_L(0); PG8_MMA(0, 0, At, B0); PG8_BAR; PG8_SCHED;
            PG8_LDB(B1, 1, 1); PG8_STAGE(PG8_SB(1, 0), b3, voffB);
            PG8_BAR; PG8_WAIT_L(0); PG8_MMA(0, 1, At, B1); PG8_BAR;
            PG8_LDA(At, 1, 1); PG8_STAGE(PG8_SA(1, 0), a3, voffA);
            PG8_BAR; PG8_WAIT_L(0); PG8_MMA(1, 0, At, B0); PG8_BAR; PG8_SCHED;
            PG8_STAGE(PG8_SB(1, 1), b3 + hstepB, voffB);
            PG8_WAIT_V(6); PG8_BAR; PG8_MMA(1, 1, At, B1); PG8_BAR;
            }
        }
        if constexpr (ALIGN_EPI) { if (wr == 0) PG8_BAR; }
        E(acc, cur, wr, wc, fr, fq);
        if (!has_next) break;
#pragma unroll
        for (int a = 0; a < 2; ++a)
#pragma unroll
            for (int b = 0; b < 2; ++b)
#pragma unroll
                for (int m = 0; m < 4; ++m)
#pragma unroll
                    for (int n = 0; n < 2; ++n) acc[a][b][m][n] = (f32x4){0.f, 0.f, 0.f, 0.f};
        cur = nxt; cA = nA; cB = nB; ++ui;
        if constexpr (ALIGN_EPI) { if (wr == 1) PG8_BAR; }
    }
    PG8_WAIT_V(0);
    if constexpr (!ALIGN_EPI) { if (wr == 0) PG8_BAR; }
    PG8_BAR;
#undef PG8_SA
#undef PG8_SB
#undef PG8_STAGE
#undef PG8_LDA
#undef PG8_LDB
#undef PG8_MMA
#undef PG8_WAIT_V
#undef PG8_WAIT_L
#undef PG8_BAR
#undef PG8_SCHED
}

struct EpiStore {
    static constexpr bool PERM = true;
    float scale;
    __device__ __forceinline__ void operator()(const f32x4 (&acc)[2][2][4][2], const Unit& u, int wr, int wc, int fr, int fq) const {
        bf16_t* base = (bf16_t*)u.out + (size_t)(wr * 64 + fr) * u.ldc + wc * 32 + 8 * fq;
        const bool sg = u.flag == 1;
#pragma unroll
        for (int ai = 0; ai < 2; ++ai)
#pragma unroll
            for (int m = 0; m < 4; ++m) { bf16_t* rowp = base + (size_t)(ai * HALF + m * 16) * u.ldc;
#pragma unroll
                for (int bj = 0; bj < 2; ++bj) { f32x4 v0 = acc[ai][bj][m][0] * scale, v1 = acc[ai][bj][m][1] * scale;
                    if (sg) {
#pragma unroll
                        for (int j = 0; j < 4; ++j) { v0[j] = sigmoidf_(v0[j]); v1[j] = sigmoidf_(v1[j]); } }
                    u32x4 w; w.x = cvt_pk_bf16(v0[0], v0[1]); w.y = cvt_pk_bf16(v0[2], v0[3]); w.z = cvt_pk_bf16(v1[0], v1[1]); w.w = cvt_pk_bf16(v1[2], v1[3]);
                    *(u32x4*)(rowp + bj * HALF) = w; } }
    }
};
struct EpiInproj {
    static constexpr bool PERM = true;
    __device__ __forceinline__ void operator()(const f32x4 (&acc)[2][2][4][2], const Unit& u, int wr, int wc, int fr, int fq) const {
        GAS bf16_t* base = (GAS bf16_t*)u.out + (size_t)(wr * 64 + fr) * u.ldc + wc * 32 + 8 * fq;
        const bool sg = (u.flag & 1) != 0, lat = (u.flag & 16) != 0, r0 = lat && (u.flag & 6) != 0, r1 = lat && (u.flag & 2) != 0, fzt = (u.flag & 32) != 0;
        const float qs = (u.flag & 8) ? C2 : 1.0f;
        const GAS float* rp = (const GAS float*)u.aux + (size_t)(wr * 64 + fr) * 64 + (wc & 1) * 32 + 4 * fq;
        const GAS float* sp = (const GAS float*)u.aux2;
        float rsv[8]; f32x4 csv[2][2];
        if (fzt) {
#pragma unroll
            for (int bj = 0; bj < 2; ++bj) { csv[bj][0] = *(const GAS f32x4*)(sp + bj * HALF + wc * 32 + 8 * fq) * (1.0f / W8_FZ); csv[bj][1] = *(const GAS f32x4*)(sp + bj * HALF + wc * 32 + 8 * fq + 4) * (1.0f / W8_FZ); }
#pragma unroll
            for (int q = 0; q < 8; ++q) rsv[q] = 1.0f;
        } else {
#pragma unroll
            for (int q = 0; q < 8; ++q) rsv[q] = sp[wr * 64 + fr + (q >> 2) * HALF + (q & 3) * 16] * (1.0f / W8_GU);
#pragma unroll
            for (int bj = 0; bj < 2; ++bj) { csv[bj][0] = (f32x4){1.f, 1.f, 1.f, 1.f}; csv[bj][1] = (f32x4){1.f, 1.f, 1.f, 1.f}; }
        }
#pragma unroll
        for (int ai = 0; ai < 2; ++ai)
#pragma unroll
            for (int m = 0; m < 4; ++m) { GAS bf16_t* rowp = base + (size_t)(ai * HALF + m * 16) * u.ldc; const float rf = rsv[ai * 4 + m];
                f32x4 cs = (f32x4){1.f, 1.f, 1.f, 1.f}, sn = (f32x4){0.f, 0.f, 0.f, 0.f};
                if (r0) { const GAS float* rt = rp + (size_t)(ai * HALF + m * 16) * 64; cs = *(const GAS f32x4*)rt; sn = *(const GAS f32x4*)(rt + 16); }
#pragma unroll
                for (int bj = 0; bj < 2; ++bj) { const i32x4 i0 = __builtin_bit_cast(i32x4, acc[ai][bj][m][0]), i1 = __builtin_bit_cast(i32x4, acc[ai][bj][m][1]);
                    f32x4 v0, v1;
#pragma unroll
                    for (int j = 0; j < 4; ++j) { v0[j] = (float)i0[j] * rf; v1[j] = (float)i1[j] * rf; }
                    v0 *= csv[bj][0]; v1 *= csv[bj][1];
                    if (sg) {
                        unsigned q[8];
#pragma unroll
                        for (int j = 0; j < 4; ++j) { q[j] = (unsigned)(fast_rcp(1.0f + fast_exp2(v0[j])) * 255.0f + 0.5f); q[4 + j] = (unsigned)(fast_rcp(1.0f + fast_exp2(v1[j])) * 255.0f + 0.5f); }
                        u32x2 w8; w8.x = q[0] | (q[1] << 8) | (q[2] << 16) | (q[3] << 24); w8.y = q[4] | (q[5] << 8) | (q[6] << 16) | (q[7] << 24);
                        *(GAS u32x2*)((GAS unsigned char*)u.out + (size_t)(wr * 64 + fr + ai * HALF + m * 16) * GW + wc * 32 + 8 * fq + bj * HALF) = w8;
                    } else {
                    if (bj == 0 ? r0 : r1) {
                        const float a0 = v0[0] * cs[0] - v0[1] * sn[0], a1 = v0[1] * cs[0] + v0[0] * sn[0], a2 = v0[2] * cs[1] - v0[3] * sn[1], a3 = v0[3] * cs[1] + v0[2] * sn[1];
                        const float b0 = v1[0] * cs[2] - v1[1] * sn[2], b1 = v1[1] * cs[2] + v1[0] * sn[2], b2 = v1[2] * cs[3] - v1[3] * sn[3], b3 = v1[3] * cs[3] + v1[2] * sn[3];
                        v0 = (f32x4){a0, a1, a2, a3}; v1 = (f32x4){b0, b1, b2, b3}; }
                    v0 *= qs; v1 *= qs;
                    u32x4 w; w.x = cvt_pk_bf16(v0[0], v0[1]); w.y = cvt_pk_bf16(v0[2], v0[3]); w.z = cvt_pk_bf16(v1[0], v1[1]); w.w = cvt_pk_bf16(v1[2], v1[3]);
                    *(GAS u32x4*)(rowp + bj * HALF) = w; } } }
    }
};
struct EpiSwiglu {
    static constexpr bool PERM = true;
    __device__ __forceinline__ void operator()(const f32x4 (&acc)[2][2][4][2], const Unit& u, int wr, int wc, int fr, int fq) const {
        bf16_t* base = (bf16_t*)u.out + (size_t)(wr * 64 + fr) * u.ldc + wc * 32 + 8 * fq;
#pragma unroll
        for (int ai = 0; ai < 2; ++ai)
#pragma unroll
            for (int m = 0; m < 4; ++m) { bf16_t* rowp = base + (size_t)(ai * HALF + m * 16) * u.ldc;
                f32x4 g0 = acc[ai][0][m][0], g1 = acc[ai][0][m][1]; const f32x4 u0 = acc[ai][1][m][0], u1 = acc[ai][1][m][1];
#pragma unroll
                for (int j = 0; j < 4; ++j) { g0[j] = siluf_(g0[j]) * u0[j]; g1[j] = siluf_(g1[j]) * u1[j]; }
                u32x4 w; w.x = cvt_pk_bf16(g0[0], g0[1]); w.y = cvt_pk_bf16(g0[2], g0[3]); w.z = cvt_pk_bf16(g1[0], g1[1]); w.w = cvt_pk_bf16(g1[2], g1[3]);
                *(u32x4*)rowp = w; }
    }
};
struct EpiSwigluF8 {
    static constexpr bool PERM = true;
    __device__ __forceinline__ void operator()(const f32x4 (&acc)[2][2][4][2], const Unit& u, int wr, int wc, int fr, int fq) const {
        GAS unsigned char* base = (GAS unsigned char*)u.out + (size_t)(wr * 64 + fr) * u.ldc + wc * 32 + 8 * fq;
#pragma unroll
        for (int ai = 0; ai < 2; ++ai)
#pragma unroll
            for (int m = 0; m < 4; ++m) { GAS unsigned char* rowp = base + (size_t)(ai * HALF + m * 16) * u.ldc;
                f32x4 g0 = acc[ai][0][m][0], g1 = acc[ai][0][m][1]; const f32x4 u0 = acc[ai][1][m][0], u1 = acc[ai][1][m][1];
#pragma unroll
                for (int j = 0; j < 4; ++j) { g0[j] = siluf_(g0[j]) * u0[j]; g1[j] = siluf_(g1[j]) * u1[j]; }
                u32x2 w; w.x = cvt4_fp8(g0[0], g0[1], g0[2], g0[3]); w.y = cvt4_fp8(g1[0], g1[1], g1[2], g1[3]);
                *(GAS u32x2*)rowp = w; }
    }
};
template <bool F8OUT> struct EpiSwigluI8 {
    static constexpr bool PERM = true;
    float wsc;
    __device__ __forceinline__ void operator()(const f32x4 (&acc)[2][2][4][2], const Unit& u, int wr, int wc, int fr, int fq) const {
        constexpr int EB = F8OUT ? 1 : 2;
        GAS unsigned char* base = (GAS unsigned char*)u.out + ((size_t)(wr * 64 + fr) * u.ldc + wc * 32 + 8 * fq) * EB;
        const GAS float* rs = (const GAS float*)u.aux + wr * 64 + fr;
        float sc[8];
#pragma unroll
        for (int q = 0; q < 8; ++q) sc[q] = rs[(q >> 2) * HALF + (q & 3) * 16] * wsc;
#pragma unroll
        for (int ai = 0; ai < 2; ++ai)
#pragma unroll
            for (int m = 0; m < 4; ++m) { GAS unsigned char* rowp = base + (size_t)(ai * HALF + m * 16) * u.ldc * EB; const float f = sc[ai * 4 + m];
                const i32x4 gi0 = __builtin_bit_cast(i32x4, acc[ai][0][m][0]), gi1 = __builtin_bit_cast(i32x4, acc[ai][0][m][1]), ui0 = __builtin_bit_cast(i32x4, acc[ai][1][m][0]), ui1 = __builtin_bit_cast(i32x4, acc[ai][1][m][1]);
                f32x4 g0, g1;
#pragma unroll
                for (int j = 0; j < 4; ++j) { const float a = (float)gi0[j] * f, b = (float)gi1[j] * f; g0[j] = siluf_(a) * ((float)ui0[j] * f); g1[j] = siluf_(b) * ((float)ui1[j] * f); }
                if constexpr (F8OUT) { u32x2 w; w.x = cvt4_fp8(g0[0], g0[1], g0[2], g0[3]); w.y = cvt4_fp8(g1[0], g1[1], g1[2], g1[3]); *(GAS u32x2*)rowp = w; }
                else { u32x4 w; w.x = cvt_pk_bf16(g0[0], g0[1]); w.y = cvt_pk_bf16(g0[2], g0[3]); w.z = cvt_pk_bf16(g1[0], g1[1]); w.w = cvt_pk_bf16(g1[2], g1[3]); *(GAS u32x4*)rowp = w; } }
    }
};
struct EpiResid {
    static constexpr bool PERM = true;
    __device__ __forceinline__ void operator()(const f32x4 (&acc)[2][2][4][2], const Unit& u, int wr, int wc, int fr, int fq) const {
        GAS bf16_t* base = (GAS bf16_t*)u.out + (size_t)(wr * 64 + fr) * u.ldc + wc * 32 + 8 * fq;
        const size_t roff = (size_t)(wr * 64 + fr) * u.ldc + wc * 32 + 8 * fq;
        const bool srcf = u.flag == 1;
        const GAS float* g = (const GAS float*)u.aux + wc * 32 + 8 * fq;
        f32x4 gv[2][2];
#pragma unroll
        for (int bj = 0; bj < 2; ++bj)
#pragma unroll
            for (int n = 0; n < 2; ++n) gv[bj][n] = *(const GAS f32x4*)(g + bj * HALF + n * 4);
#pragma unroll
        for (int ai = 0; ai < 2; ++ai)
#pragma unroll
            for (int m = 0; m < 4; ++m) { const size_t ro = (size_t)(ai * HALF + m * 16) * u.ldc;
#pragma unroll
                for (int bj = 0; bj < 2; ++bj) {
                    f32x4 r0, r1;
                    if (srcf) { const GAS float* sp = (const GAS float*)u.aux2 + roff + ro + bj * HALF; r0 = *(const GAS f32x4*)sp; r1 = *(const GAS f32x4*)(sp + 4); }
                    else { const u32x4 w = *(const GAS u32x4*)((const GAS bf16_t*)u.aux2 + roff + ro + bj * HALF);
                        r0 = (f32x4){bf_lo(w.x), bf_hi(w.x), bf_lo(w.y), bf_hi(w.y)}; r1 = (f32x4){bf_lo(w.z), bf_hi(w.z), bf_lo(w.w), bf_hi(w.w)}; }
                    const f32x4 v0 = r0 + gv[bj][0] * acc[ai][bj][m][0], v1 = r1 + gv[bj][1] * acc[ai][bj][m][1];
                    u32x4 o; o.x = cvt_pk_bf16(v0[0], v0[1]); o.y = cvt_pk_bf16(v0[2], v0[3]); o.z = cvt_pk_bf16(v1[0], v1[1]); o.w = cvt_pk_bf16(v1[2], v1[3]);
                    *(GAS u32x4*)(base + ro + bj * HALF) = o; }
                asm volatile("" ::: "memory"); }
    }
};
struct BUnit { const char* A; const char* B; const char* gate; char* out; };
__device__ __forceinline__ void gload8_async(u32x2& dst, const void* p) { asm volatile("global_load_dwordx2 %0, %1, off" : "=&v"(dst) : "v"(p) : "memory"); }
template <class Sched>
__device__ __forceinline__ void branch_phase(LAS unsigned char* lds, const int tid, const Sched& S) {
    const int wid = __builtin_amdgcn_readfirstlane(tid >> 6), lane = tid & 63, wr = wid >> 2, wc = wid & 3, fr = lane & 15, fq = lane >> 4;
    constexpr int K = 2048, nt = K / BK, lda = 2048, ldb = 2048;
    unsigned voffA[2], voffB[2];
#pragma unroll
    for (int i = 0; i < 2; ++i) { int R, C; stage_rc(tid * 16 + i * 8192, R, C); const int Rb = (R & ~31) + perm32(R & 31);
        voffA[i] = (unsigned)(R * lda + C) * 2u; voffB[i] = (unsigned)(Rb * ldb + C) * 2u; }
    const size_t kstep = (size_t)(BK * 2);
    const size_t hstepA = (size_t)HALF * lda * 2;
    const unsigned ldsw = (unsigned)wid * 1024u;
    const int aoff = lds_byte(wr * 64 + fr, fq * 8), boff = lds_byte(wc * 32 + fr, fq * 8);
#define BR_SA(b, h) (((b) * 2 + (h)) * HTB)
#define BR_SB(b) ((4 + (b) * 2) * HTB)
#define BR_STAGE(bufoff, gbase, voff) do { _Pragma("unroll") for (int _i = 0; _i < 2; ++_i) \
        __builtin_amdgcn_global_load_lds((const unsigned*)((const char*)(gbase) + (voff)[_i]), (LAS unsigned*)(lds + (bufoff) + ldsw + _i * 8192), 16, 0, 0); } while (0)
#define BR_LDA(dst, b, h) do { _Pragma("unroll") for (int m = 0; m < 4; ++m) _Pragma("unroll") for (int k = 0; k < 2; ++k) dst[m][k] = *(const LAS bf16x8*)(lds + BR_SA(b, h) + aoff + m * 2048 + k * 1024); } while (0)
#define BR_LDB(dst, b) do { _Pragma("unroll") for (int n = 0; n < 2; ++n) _Pragma("unroll") for (int k = 0; k < 2; ++k) dst[n][k] = *(const LAS bf16x8*)(lds + BR_SB(b) + boff + n * 2048 + k * 1024); } while (0)
#define BR_MMA(ai) do { __builtin_amdgcn_s_setprio(1); _Pragma("unroll") for (int m = 0; m < 4; ++m) _Pragma("unroll") for (int n = 0; n < 2; ++n) _Pragma("unroll") for (int k = 0; k < 2; ++k) \
        acc[ai][m][n] = __builtin_amdgcn_mfma_f32_16x16x32_bf16(B0[n][k], At[m][k], acc[ai][m][n], 0, 0, 0); __builtin_amdgcn_s_setprio(0); } while (0)
#define BR_WAIT_V(n) asm volatile("s_waitcnt vmcnt(" #n ")" ::: "memory")
#define BR_WAIT_L0 asm volatile("s_waitcnt lgkmcnt(0)" ::: "memory")
#define BR_BAR __builtin_amdgcn_s_barrier()
#define BR_SCHED __builtin_amdgcn_sched_barrier(0)
    BUnit cur, nxt; int ui = 0;
    if (!S.next(0, cur)) return;
    f32x4 acc[2][4][2], macc[2][4][2];
#pragma unroll
    for (int a = 0; a < 2; ++a)
#pragma unroll
        for (int m = 0; m < 4; ++m)
#pragma unroll
            for (int n = 0; n < 2; ++n) { acc[a][m][n] = (f32x4){0.f, 0.f, 0.f, 0.f}; macc[a][m][n] = (f32x4){0.f, 0.f, 0.f, 0.f}; }
    bf16x8 At[4][2], B0[2][2];
    const char* cA = cur.A; const char* cB = cur.B;
    BR_STAGE(BR_SB(0), cB, voffB); BR_STAGE(BR_SA(0, 0), cA, voffA); BR_STAGE(BR_SA(0, 1), cA + hstepA, voffA);
    if (wr == 1) BR_BAR;
    BR_WAIT_V(2); BR_BAR;
    BR_STAGE(BR_SB(1), cB + kstep, voffB); BR_STAGE(BR_SA(1, 0), cA + kstep, voffA);
    BR_WAIT_V(4); BR_BAR;
    const size_t rowoff = (size_t)(wr * 64 + fr), coloff = (size_t)(wc * 32 + 8 * fq);
    for (;;) {
        const bool has_next = S.next(ui + 1, nxt);
        const char* nA = has_next ? nxt.A : cA; const char* nB = has_next ? nxt.B : cB;
        const char* gbase = cur.gate + (rowoff * GW + coloff);
        u32x2 g[8];
        for (int t = 0; t < nt; t += 2) {
            const bool last = (t == nt - 2);
            const bool hook = (t & 6) == 6;
            const char* a1 = cA + (size_t)(t + 1) * kstep;
            const char* a2 = last ? nA : cA + (size_t)(t + 2) * kstep; const char* b2 = last ? nB : cB + (size_t)(t + 2) * kstep;
            const char* a3 = a2 + kstep; const char* b3 = b2 + kstep;
            if (hook) {
                const char* gp = gbase + (size_t)(t >> 3) * 1024;
#pragma unroll
                for (int q = 0; q < 8; ++q) gload8_async(g[q], gp + (size_t)((q >> 2) * HALF + (q & 3) * 16) * GW);
            }
            BR_LDB(B0, 0); BR_SCHED; BR_LDA(At, 0, 0); BR_STAGE(BR_SA(1, 1), a1 + hstepA, voffA);
            if (hook) BR_WAIT_V(14); else BR_WAIT_V(6);
            BR_WAIT_L0; BR_BAR; BR_MMA(0); BR_BAR; BR_SCHED;
            BR_LDA(At, 0, 1); BR_STAGE(BR_SB(0), b2, voffB); BR_STAGE(BR_SA(0, 0), a2, voffA);
            if (hook) BR_WAIT_V(14); else BR_WAIT_V(6);
            BR_WAIT_L0; BR_BAR; BR_MMA(1); BR_BAR; BR_SCHED;
            BR_LDB(B0, 1); BR_SCHED; BR_LDA(At, 1, 0); BR_STAGE(BR_SA(0, 1), a2 + hstepA, voffA);
            BR_WAIT_V(6); BR_WAIT_L0; BR_BAR; BR_MMA(0); BR_BAR; BR_SCHED;
            BR_LDA(At, 1, 1); BR_STAGE(BR_SB(1), b3, voffB); BR_STAGE(BR_SA(1, 0), a3, voffA);
            BR_WAIT_V(6); BR_WAIT_L0; BR_BAR; BR_MMA(1); BR_BAR; BR_SCHED;
            if (hook) {
                asm volatile("s_waitcnt vmcnt(10)" : "+v"(g[0]), "+v"(g[1]), "+v"(g[2]), "+v"(g[3]), "+v"(g[4]), "+v"(g[5]), "+v"(g[6]), "+v"(g[7]) :: "memory");
#pragma unroll
                for (int ai = 0; ai < 2; ++ai)
#pragma unroll
                    for (int m = 0; m < 4; ++m) { const u32x2 gw = g[ai * 4 + m];
                        const f32x4 g0 = (f32x4){(float)(gw.x & 255u), (float)((gw.x >> 8) & 255u), (float)((gw.x >> 16) & 255u), (float)(gw.x >> 24)};
                        const f32x4 g1 = (f32x4){(float)(gw.y & 255u), (float)((gw.y >> 8) & 255u), (float)((gw.y >> 16) & 255u), (float)(gw.y >> 24)};
                        macc[ai][m][0] += acc[ai][m][0] * g0; macc[ai][m][1] += acc[ai][m][1] * g1;
                        acc[ai][m][0] = (f32x4){0.f, 0.f, 0.f, 0.f}; acc[ai][m][1] = (f32x4){0.f, 0.f, 0.f, 0.f}; }
            }
        }
        {
            GAS bf16_t* op = (GAS bf16_t*)cur.out + rowoff * 1024 + coloff;
#pragma unroll
            for (int ai = 0; ai < 2; ++ai)
#pragma unroll
                for (int m = 0; m < 4; ++m) { const f32x4 v0 = macc[ai][m][0] * (1.0f / 255.0f), v1 = macc[ai][m][1] * (1.0f / 255.0f);
                    u32x4 w; w.x = cvt_pk_bf16(v0[0], v0[1]); w.y = cvt_pk_bf16(v0[2], v0[3]); w.z = cvt_pk_bf16(v1[0], v1[1]); w.w = cvt_pk_bf16(v1[2], v1[3]);
                    *(GAS u32x4*)(op + (size_t)(ai * HALF + m * 16) * 1024) = w;
                    macc[ai][m][0] = (f32x4){0.f, 0.f, 0.f, 0.f}; macc[ai][m][1] = (f32x4){0.f, 0.f, 0.f, 0.f}; }
        }
        if (!has_next) break;
        cur = nxt; cA = nA; cB = nB; ++ui;
    }
    BR_WAIT_V(0);
    if (wr == 0) BR_BAR;
    BR_BAR;
#undef BR_SA
#undef BR_SB
#undef BR_STAGE
#undef BR_LDA
#undef BR_LDB
#undef BR_MMA
#undef BR_WAIT_V
#undef BR_WAIT_L0
#undef BR_BAR
#undef BR_SCHED
}
}

#define XB_TMO      128
#define XB_XCNT(j)  (256  + 64 * (j))
#define XB_XSUB(j)  (1280 + 64 * (j))
#define XB_XGEN(j)  (2304 + 64 * (j))
#define XB_TOP      3328
#define XB_TOPGEN   3392
#define XCD_BAR_WORDS 3456
#define XB_SPIN_CAP (1u << 20)

__device__ __forceinline__ unsigned xb_ld(unsigned* p)              { return __hip_atomic_load(p, __ATOMIC_RELAXED, __HIP_MEMORY_SCOPE_AGENT); }
__device__ __forceinline__ unsigned xb_add(unsigned* p, unsigned v) { return __hip_atomic_fetch_add(p, v, __ATOMIC_RELAXED, __HIP_MEMORY_SCOPE_AGENT); }
__device__ __forceinline__ unsigned xb_xcc_id() { return (unsigned)__builtin_amdgcn_s_getreg((3 << 11) | 20) & 0xFu; }
#define XB_SPIN(cond, bar) do { unsigned _sp = 0; while (cond) { __builtin_amdgcn_s_sleep(1); \
    if ((++_sp & 255u) == 0u) { if (xb_ld(&(bar)[XB_TMO])) break; if (_sp > XB_SPIN_CAP) { atomicAdd(&(bar)[XB_TMO], 1u); break; } } } } while (0)

struct XcdBarrier { unsigned* bar; unsigned x; volatile LAS unsigned* st; };

__device__ __forceinline__ XcdBarrier xcd_barrier_post(unsigned* bar, volatile LAS unsigned* st) {
    XcdBarrier b; b.bar = bar; b.x = xb_xcc_id(); b.st = st;
    if (threadIdx.x == 0) (void)xb_add(&bar[XB_XCNT(b.x)], 1u);
    return b;
}
__device__ __forceinline__ void xcd_barrier_complete(unsigned* bar, unsigned x, unsigned& nloc, unsigned& nx) {
    const unsigned G = gridDim.x * gridDim.y * gridDim.z;
    unsigned sum, cnt, mine, sp = 0u;
    for (;;) {
        sum = 0u; cnt = 0u; mine = 0u;
#pragma unroll
        for (unsigned j = 0; j < 16; ++j) { const unsigned c = xb_ld(&bar[XB_XCNT(j)]); sum += c; cnt += (c > 0u) ? 1u : 0u; mine = (j == x) ? c : mine; }
        if (sum == G) break;
        __builtin_amdgcn_s_sleep(1);
        if ((++sp & 255u) == 0u) { if (xb_ld(&bar[XB_TMO])) break; if (sp > XB_SPIN_CAP) { atomicAdd(&bar[XB_TMO], 1u); break; } }
    }
    nloc = mine > 0u ? mine : 1u; nx = cnt > 0u ? cnt : 1u;
}
__device__ __forceinline__ void xcd_barrier(const XcdBarrier& b, const bool leader) {
    asm volatile("s_waitcnt vmcnt(0)" ::: "memory");
    __syncthreads();
    unsigned* bar = b.bar; asm volatile("" : "+v"(bar));
    if (leader) {
        __builtin_amdgcn_s_waitcnt(0);
        unsigned nloc = b.st[0], nx = b.st[1];
        if (nloc == 0u) { xcd_barrier_complete(bar, b.x, nloc, nx); b.st[0] = nloc; b.st[1] = nx; }
        const unsigned old = xb_add(&bar[XB_XSUB(b.x)], 1u);
        const unsigned gen = old / nloc;
        if (old + 1u == (gen + 1u) * nloc) {
            __builtin_amdgcn_fence(__ATOMIC_RELEASE, "agent");
            asm volatile("s_waitcnt vmcnt(0)" ::: "memory");
            const unsigned og = xb_add(&bar[XB_TOP], 1u);
            const unsigned tg = og / nx;
            if (og + 1u == (tg + 1u) * nx) xb_add(&bar[XB_TOPGEN], 1u);
            else XB_SPIN(xb_ld(&bar[XB_TOPGEN]) == tg, bar);
            __builtin_amdgcn_fence(__ATOMIC_ACQUIRE, "agent");
            xb_add(&bar[XB_XGEN(b.x)], 1u);
            asm volatile("s_waitcnt vmcnt(0)" ::: "memory");
        } else {
            XB_SPIN(xb_ld(&bar[XB_XGEN(b.x)]) == gen, bar);
            __builtin_amdgcn_fence(__ATOMIC_ACQUIRE, "agent");
            asm volatile("s_waitcnt vmcnt(0)" ::: "memory");
        }
    }
    __syncthreads();
}

struct Args { const float* in[23]; float* out; unsigned char* ws; };
enum { I_X = 0, I_C, I_CTX, I_CCTX, I_WMOD, I_BMOD, I_N1G, I_N2G, I_WIN, I_DLAM, I_SUBLN, I_QKG, I_SINK, I_WBR, I_WOUT, I_FG, I_FU, I_FD, I_RW, I_MG, I_MU, I_MD, I_FINALG };

__device__ __forceinline__ bf16_t* w_layer(unsigned char* ws, int l, size_t off) { return (bf16_t*)(ws + WS_W + (size_t)l * W_LAYER + off); }
__device__ __forceinline__ bf16_t* w_dense(unsigned char* ws, int i, size_t off) { return (bf16_t*)(ws + WS_W + W_DENSE0 + (size_t)i * W_DENSE + off); }
__device__ __forceinline__ bf16_t* w_moe(unsigned char* ws, int i, int e, size_t off) { return (bf16_t*)(ws + WS_W + W_MOE0 + (size_t)i * W_MOE + (size_t)e * W_EXPERT + off); }

constexpr int CV_LAYER = 1536 + 2048 + 1024 + 512;
constexpr int CV_DENSE = 3 * 1408;
constexpr int CV_EXP = 3 * 1792;
constexpr int CV_TOTAL = 4 * CV_LAYER + 2 * CV_DENSE + 16 * CV_EXP;
struct ConvDesc { const float* src; bf16_t* dst; int ldsrc, lddst, perm; float f8s; int qm; };
__device__ __forceinline__ ConvDesc conv_decode(const Args& a, int it) {
    unsigned char* ws = a.ws;
    const float* src; int ldsrc, K, c0, ncols, mode = 0, drow0 = 0, blk, ldd = 0; bf16_t* dst; bool win = false; float f8s = 0.f; int qm = 1;
    if (it < 4 * CV_LAYER) { const int l = it / CV_LAYER, r = it % CV_LAYER;
        if (r < 1536) { blk = r; src = a.in[I_WIN] + (size_t)l * DM * DIN; ldsrc = DIN; K = DM; c0 = 0; ncols = 3072; dst = w_layer(ws, l, W_IN); drow0 = 0; win = true; f8s = W8_GU; qm = 2; }
        else if (r < 3584) { blk = r - 1536; src = a.in[I_WIN] + (size_t)l * DM * DIN; ldsrc = DIN; K = DM; c0 = 3584; ncols = 4096; dst = w_layer(ws, l, W_IN); drow0 = 3072; f8s = -W8_GU * LOG2E; qm = 2; }
        else if (r < 4608) { const int q = r - 3584, rr = q / 256; blk = q % 256; src = a.in[I_WBR] + (size_t)(l * 4 + rr) * 512 * DM; ldsrc = DM; K = 512; c0 = 0; ncols = DM; dst = w_layer(ws, l, W_BR) + (size_t)rr * 512; ldd = 2048; }
        else { blk = r - 4608; src = a.in[I_WOUT] + (size_t)l * DM * DM; ldsrc = DM; K = DM; c0 = 0; ncols = DM; dst = w_layer(ws, l, W_OUT); }
    } else if (it < 4 * CV_LAYER + 2 * CV_DENSE) { const int q = it - 4 * CV_LAYER, i = q / CV_DENSE, r = q % CV_DENSE, which = r / 1408; blk = r % 1408;
        if (which < 2) { src = a.in[which == 0 ? I_FG : I_FU] + (size_t)i * DM * DFF; ldsrc = DFF; K = DM; c0 = 0; ncols = DFF; dst = w_dense(ws, i, W_DGU); mode = 1 + which; f8s = W8_GU; qm = 2; }
        else { src = a.in[I_FD] + (size_t)i * DFF * DM; ldsrc = DM; K = DFF; c0 = 0; ncols = DM; dst = w_dense(ws, i, W_DD); f8s = ((DENSE_F8_MASK >> i) & 1) ? 256.0f : 0.f; }
    } else { const int q = it - 4 * CV_LAYER - 2 * CV_DENSE, ie = q / CV_EXP, r = q % CV_EXP, which = r / 1792, i = ie >> 3, e = ie & 7; blk = r % 1792;
        if (which < 2) { src = a.in[which == 0 ? I_MG : I_MU] + (size_t)ie * DM * DFE; ldsrc = DFE; K = DM; c0 = 0; ncols = DFE; dst = w_moe(ws, i, e, W_MGU); mode = 1 + which; f8s = W8_GU; qm = 2; }
        else { src = a.in[I_MD] + (size_t)ie * DFE * DM; ldsrc = DM; K = DFE; c0 = 0; ncols = DM; dst = w_moe(ws, i, e, W_MD); f8s = 256.0f; }
    }
    const int nbn = ncols / 32, kb = blk / nbn, nb = blk % nbn, n = 32 * nb;
    const int drow = mode == 0 ? drow0 + n : 256 * (n >> 7) + (n & 127) + (mode == 2 ? 128 : 0);
    const bool perm = win && (n < 1024 || (n >= 1536 && n < 2176) || (n >= 2304 && n < 2944));
    ConvDesc d; d.src = src + (size_t)(64 * kb) * ldsrc + c0 + n; if (ldd == 0) ldd = K;
    d.dst = f8s != 0.f ? (bf16_t*)((unsigned char*)dst + (size_t)drow * ldd + 64 * kb) : dst + (size_t)drow * ldd + 64 * kb; d.ldsrc = ldsrc; d.lddst = ldd; d.perm = perm ? 1 : 0; d.f8s = f8s; d.qm = qm;
    return d;
}
__device__ __forceinline__ void conv_load(const ConvDesc& d, float (&r)[32], int lane) {
    const GAS float* s = (const GAS float*)d.src + (size_t)(lane >> 5) * d.ldsrc + (lane & 31);
#pragma unroll
    for (int i = 0; i < 32; ++i) r[i] = __builtin_nontemporal_load(s + (size_t)(2 * i) * d.ldsrc);
}
__device__ __forceinline__ void conv_store(const ConvDesc& d, const float (&r)[32], LAS float* scr, int lane) {
#pragma unroll
    for (int i = 0; i < 32; ++i) scr[(2 * i + (lane >> 5)) * 33 + (lane & 31)] = r[i];
    LDS_WAIT(); asm volatile("" ::: "memory");
    const int c = lane & 7;
    if (d.f8s != 0.f) { const float fs = d.f8s;
#pragma unroll
        for (int j = 0; j < 4; ++j) { const int n = (lane >> 3) + 8 * j; const LAS float* s = scr + (8 * c) * 33 + n;
            u32x2 o;
            if (d.qm == 2) { o.x = pack4_i8(s[0 * 33] * fs, s[1 * 33] * fs, s[2 * 33] * fs, s[3 * 33] * fs); o.y = pack4_i8(s[4 * 33] * fs, s[5 * 33] * fs, s[6 * 33] * fs, s[7 * 33] * fs); }
            else { o.x = cvt4_fp8(s[0 * 33] * fs, s[1 * 33] * fs, s[2 * 33] * fs, s[3 * 33] * fs); o.y = cvt4_fp8(s[4 * 33] * fs, s[5 * 33] * fs, s[6 * 33] * fs, s[7 * 33] * fs); }
            const int dn = d.perm ? 2 * (n & 15) + (n >> 4) : n;
            __builtin_nontemporal_store(o, (GAS u32x2*)((GAS unsigned char*)d.dst + (size_t)dn * d.lddst + 8 * c)); }
    } else {
#pragma unroll
    for (int j = 0; j < 4; ++j) { const int n = (lane >> 3) + 8 * j; const LAS float* s = scr + (8 * c) * 33 + n;
        u32x4 o; o.x = cvt_pk_bf16(s[0 * 33], s[1 * 33]); o.y = cvt_pk_bf16(s[2 * 33], s[3 * 33]); o.z = cvt_pk_bf16(s[4 * 33], s[5 * 33]); o.w = cvt_pk_bf16(s[6 * 33], s[7 * 33]);
        const int dn = d.perm ? 2 * (n & 15) + (n >> 4) : n;
        __builtin_nontemporal_store(o, (GAS u32x4*)(d.dst + (size_t)dn * d.lddst + 8 * c)); }
    }
    LDS_WAIT(); asm volatile("" ::: "memory");
}
__device__ __forceinline__ void fzfold_item(const Args& a, int it, int lane) {
    const int mq = it & 3, kb = (it >> 2) & 15, g = (it >> 6) & 7, l = it >> 9, k0 = 64 * kb;
    const GAS f32x4* src = (const GAS f32x4*)(a.in[I_WIN] + (size_t)l * DM * DIN + (size_t)(k0 + lane) * DIN + 3072 + g * 64);
    float w[64];
#pragma unroll
    for (int i = 0; i < 16; ++i) { const f32x4 v = src[i]; w[4 * i] = v[0]; w[4 * i + 1] = v[1]; w[4 * i + 2] = v[2]; w[4 * i + 3] = v[3]; }
    const float cv = cospif((float)lane * (1.0f / 32.0f)), sv = sinpif((float)lane * (1.0f / 32.0f));
    GAS signed char* dst = (GAS signed char*)w_layer(a.ws, l, W_FZ);
    for (int m = 16 * mq; m < 16 * mq + 16; ++m) {
        float sc = 0.f, ss = 0.f;
#pragma unroll
        for (int c = 0; c < 64; ++c) { const int j = (c * m) & 63;
            const float cj = __builtin_bit_cast(float, __builtin_amdgcn_readlane(__builtin_bit_cast(int, cv), j)), sj = __builtin_bit_cast(float, __builtin_amdgcn_readlane(__builtin_bit_cast(int, sv), j));
            sc += w[c] * cj; ss += w[c] * sj; }
        dst[(size_t)(g * 64 + m) * DM + k0 + lane] = (signed char)(int)__builtin_rintf(__builtin_amdgcn_fmed3f(sc * W8_FZ, -127.0f, 127.0f));
        dst[(size_t)(512 + g * 64 + m) * DM + k0 + lane] = (signed char)(int)__builtin_rintf(__builtin_amdgcn_fmed3f(ss * W8_FZ, -127.0f, 127.0f));
    }
}
__device__ __forceinline__ void mod_item(const Args& a, int item, LAS unsigned char* lds, int tid) {
    const int l = item / 24, chunk = item % 24, wid = tid >> 6, lane = tid & 63;
    LAS float* sc = (LAS float*)lds;
    LAS float* red = (LAS float*)(lds + 36864);
    for (int i = tid; i < 9 * 1024; i += 512) { const float v = i < 8192 ? a.in[I_C][i] : a.in[I_CCTX][i - 8192]; sc[i] = siluf_(v); }
    __syncthreads();
    const float* w = a.in[I_WMOD] + (size_t)l * DM * 6144 + chunk * 256 + lane * 4;
    f32x4 acc[9];
#pragma unroll
    for (int r = 0; r < 9; ++r) acc[r] = (f32x4){0.f, 0.f, 0.f, 0.f};
    const int kb = wid * 128;
#pragma unroll 8
    for (int k = 0; k < 128; ++k) { const f32x4 wv = *(const GAS f32x4*)(w + (size_t)(kb + k) * 6144);
#pragma unroll
        for (int r = 0; r < 9; ++r) acc[r] += wv * sc[r * 1024 + kb + k]; }
#pragma unroll
    for (int r = 0; r < 9; ++r) *(LAS f32x4*)(red + (wid * 9 + r) * 256 + lane * 4) = acc[r];
    __syncthreads();
    float* modv = (float*)(a.ws + WS_MODV) + (size_t)l * 9 * 6144;
    for (int i = tid; i < 9 * 256; i += 512) { const int r = i >> 8, c = i & 255; float s = 0.f;
#pragma unroll
        for (int w8 = 0; w8 < 8; ++w8) s += red[(w8 * 9 + r) * 256 + c];
        modv[r * 6144 + chunk * 256 + c] = s + a.in[I_BMOD][l * 6144 + chunk * 256 + c]; }
    __syncthreads();
}

struct RowV { f32x4 v[4]; };
__device__ __forceinline__ RowV load_row_f32(const float* p, int lane) { RowV r; const f32x4* q = (const f32x4*)p + lane;
#pragma unroll
    for (int j = 0; j < 4; ++j) r.v[j] = q[64 * j];
    return r; }
__device__ __forceinline__ void store_row_f32(float* p, const RowV& r, int lane) { f32x4* q = (f32x4*)p + lane;
#pragma unroll
    for (int j = 0; j < 4; ++j) q[64 * j] = r.v[j]; }
__device__ __forceinline__ RowV load_row_bf16(const bf16_t* p, int lane) { RowV r; const u32x2* q = (const u32x2*)p + lane;
#pragma unroll
    for (int j = 0; j < 4; ++j) { const u32x2 w = q[64 * j]; r.v[j] = (f32x4){bf_lo(w.x), bf_hi(w.x), bf_lo(w.y), bf_hi(w.y)}; }
    return r; }
__device__ __forceinline__ void store_row_bf16(bf16_t* p, const RowV& r, int lane) { u32x2* q = (u32x2*)p + lane;
#pragma unroll
    for (int j = 0; j < 4; ++j) { u32x2 w; w.x = cvt_pk_bf16(r.v[j][0], r.v[j][1]); w.y = cvt_pk_bf16(r.v[j][2], r.v[j][3]); q[64 * j] = w; } }
struct RowQ { unsigned w[4]; float sc; };
__device__ __forceinline__ RowQ quant_row_i8(const RowV& r) {
    float am = 0.f;
#pragma unroll
    for (int j = 0; j < 4; ++j) am = fmaxf(fmaxf(am, fmaxf(fabsf(r.v[j][0]), fabsf(r.v[j][1]))), fmaxf(fabsf(r.v[j][2]), fabsf(r.v[j][3])));
#pragma unroll
    for (int o = 1; o < 64; o <<= 1) am = fmaxf(am, __shfl_xor(am, o));
    const float inv = am > 0.f ? 127.0f / am : 0.f;
    RowQ q; q.sc = am * (1.0f / 127.0f);
#pragma unroll
    for (int j = 0; j < 4; ++j) q.w[j] = pack4_i8(r.v[j][0] * inv, r.v[j][1] * inv, r.v[j][2] * inv, r.v[j][3] * inv);
    return q;
}
__device__ __forceinline__ void store_rowq(unsigned char* p, const RowQ& q, int lane) { unsigned* d = (unsigned*)p + lane;
#pragma unroll
    for (int j = 0; j < 4; ++j) d[64 * j] = q.w[j]; }
__device__ __forceinline__ void store_row_fp8(unsigned char* p, const RowV& r, int lane) { unsigned* q = (unsigned*)p + lane;
#pragma unroll
    for (int j = 0; j < 4; ++j) q[64 * j] = cvt4_fp8(r.v[j][0], r.v[j][1], r.v[j][2], r.v[j][3]); }
__device__ __forceinline__ RowV adaln_row(const RowV& x, const float* g, const float* shift, const float* scale, int lane) {
    float ss = 0.f;
#pragma unroll
    for (int j = 0; j < 4; ++j) ss += (x.v[j][0] * x.v[j][0] + x.v[j][1] * x.v[j][1]) + (x.v[j][2] * x.v[j][2] + x.v[j][3] * x.v[j][3]);
    const float rstd = 1.0f / sqrtf(wave_sum(ss) * (1.0f / DM) + 1e-6f);
    const RowV gv = load_row_f32(g, lane), sh = load_row_f32(shift, lane), sc = load_row_f32(scale, lane);
    RowV y;
#pragma unroll
    for (int j = 0; j < 4; ++j) y.v[j] = x.v[j] * rstd * gv.v[j] * (1.0f + sc.v[j]) + sh.v[j];
    return y;
}
__device__ __forceinline__ int mod_row_of(int row) { return row < NLAT ? (row >> 11) : 8; }
struct AdaCoef { RowV A, B; int mr; };
__device__ __forceinline__ void ada_coef_update(AdaCoef& c, int row, const float* g, const float* modbase, int shift_off, int scale_off, int lane) {
    const int mr = mod_row_of(row);
    if (mr != c.mr) { c.mr = mr; const float* mv = modbase + (size_t)mr * 6144;
        const RowV gv = load_row_f32(g, lane), sh = load_row_f32(mv + shift_off, lane), sc = load_row_f32(mv + scale_off, lane);
#pragma unroll
        for (int j = 0; j < 4; ++j) { c.A.v[j] = gv.v[j] * (1.0f + sc.v[j]); c.B.v[j] = sh.v[j]; } }
}
__device__ __forceinline__ RowV adaln_apply(const RowV& x, const AdaCoef& c) {
    float ss = 0.f;
#pragma unroll
    for (int j = 0; j < 4; ++j) ss += (x.v[j][0] * x.v[j][0] + x.v[j][1] * x.v[j][1]) + (x.v[j][2] * x.v[j][2] + x.v[j][3] * x.v[j][3]);
    const float rstd = 1.0f / sqrtf(wave_sum(ss) * (1.0f / DM) + 1e-6f);
    RowV y;
#pragma unroll
    for (int j = 0; j < 4; ++j) y.v[j] = x.v[j] * rstd * c.A.v[j] + c.B.v[j];
    return y;
}

struct MoeTiles { int tb[9]; };
__device__ __forceinline__ MoeTiles moe_tiles(unsigned* ctl, int i) { MoeTiles t; int s = 0;
#pragma unroll
    for (int e = 0; e < 8; ++e) { t.tb[e] = s; const unsigned c = (unsigned)__builtin_amdgcn_readfirstlane((int)__hip_atomic_load(ctl + CW_CNT + 64 * (8 * i + e), __ATOMIC_RELAXED, __HIP_MEMORY_SCOPE_AGENT)); s += (int)((c + 255u) >> 8); }
    t.tb[8] = s; return t; }

__device__ __forceinline__ float max3f(float a, float b, float c) { return __builtin_fmaxf(__builtin_fmaxf(a, b), c); }
__device__ __forceinline__ int crow(int r, int hi) { return (r & 3) + 8 * (r >> 2) + 4 * hi; }
typedef short v4i16_t __attribute__((ext_vector_type(4)));
__device__ __forceinline__ s16x4 vtr(const LAS unsigned char* p) { return __builtin_bit_cast(s16x4, __builtin_amdgcn_ds_read_tr16_b64_v4i16((LAS v4i16_t*)p)); }

struct AttnCtx { const bf16_t* P; bf16_t* O; const float* subln_g; float lam, one_m_li; const float* sink; };

constexpr float ATT_THR = 8.0f;
__device__ __forceinline__ void glds16(const void* gsrc, unsigned lds_dst) { unsigned keep;
    asm volatile("s_mov_b32 %0, m0\n\ts_mov_b32 m0, %2\n\ts_nop 0\n\tglobal_load_lds_dwordx4 %1, off\n\ts_mov_b32 m0, %0" : "=&s"(keep) : "v"(gsrc), "s"(lds_dst) : "memory"); }
#define ATT_BAR() do { __builtin_amdgcn_sched_barrier(0); asm volatile("s_waitcnt lgkmcnt(0)" ::: "memory"); __builtin_amdgcn_s_barrier(); asm volatile("" ::: "memory"); __builtin_amdgcn_sched_barrier(0); } while (0)
template <int VAR>
__device__ __forceinline__ void attn_unit(LAS unsigned char* lds, const int tid, const AttnCtx& ac, int b, int hh, int qb, bool ctxq) {
    constexpr int NDB = (VAR == 0) ? 4 : 2;
    constexpr int NLD = (VAR == 0) ? 2 : 1;
    constexpr int KB = (VAR == 0) ? 16384 : 8192;
    constexpr int VB = (VAR == 0) ? 16384 : 8192;
    constexpr int VBASE = 3 * KB;
    constexpr int WSF_OFF = 135168;
    const int lane = tid & 63, r32 = lane & 31, hi = lane >> 5; const int wid = __builtin_amdgcn_readfirstlane(tid >> 6);
    const int half = wid >> 2;
    int map = 0, g = 0, qsub, qcol, kcol, vcol, ocol, qpb;
    if (VAR == 0) { map = wid >> 2; qsub = wid & 3; qpb = 128; qcol = C_AQ + hh * 128 + map * 64; kcol = C_AK + hh * 128; vcol = C_AV + hh * 128; ocol = hh * 128; }
    else { g = wid >> 1; qsub = wid & 1; qpb = 64; qcol = (VAR == 1 ? C_BQ : C_CQ) + (hh * 4 + g) * 64; kcol = (VAR == 1 ? C_BK : C_CK) + hh * 64; vcol = (VAR == 1 ? C_BV : C_CV) + hh * 64; ocol = (VAR == 1 ? 512 : 1024) + (hh * 4 + g) * 64; }
    const int q0w = qb * qpb + qsub * 32;
    const int latbase = b * SEQ, ctxbase = NLAT + b * CTXL;
    const int qrow0 = (ctxq ? ctxbase : latbase) + q0w;
    int NT, lt0 = 0;
    if (ctxq) NT = 4;
    else if (VAR == 2) { lt0 = qb - 2 < 0 ? 0 : qb - 2; const int lt1 = qb + 2 > 31 ? 31 : qb + 2; NT = 4 + (lt1 - lt0 + 1); }
    else NT = 36;
    auto tile_row0 = [&](int t) -> int {
        if (ctxq) return ctxbase + 64 * t;
        if (VAR == 2) return t < 4 ? ctxbase + 64 * t : latbase + 64 * (lt0 + t - 4);
        return t < 32 ? latbase + 64 * t : ctxbase + 64 * (t - 32);
    };
    const GAS bf16_t* Pg = (const GAS bf16_t*)ac.P;
    bf16x8 qr[4];
    { const GAS bf16_t* qp = Pg + (size_t)(qrow0 + r32) * PW + qcol + hi * 8;
#pragma unroll
      for (int d0 = 0; d0 < 4; ++d0) qr[d0] = *(const GAS bf16x8*)(qp + d0 * 16); }
    const GAS bf16_t* kdma = Pg + (size_t)lane * PW + kcol + 8 * wid;
    const GAS bf16_t* vdma = Pg + (size_t)(16 * (wid & 3) + (lane >> 2)) * PW + vcol + (wid >> 2) * 32 + (lane & 3) * 8;
    const unsigned lds0 = (unsigned)(uintptr_t)lds + (unsigned)wid * 1024u;
    auto gloadK = [&](int t, int slot) { const GAS bf16_t* rp = kdma + (size_t)tile_row0(t) * PW;
#pragma unroll
        for (int j = 0; j < NLD; ++j) glds16((const void*)(rp + 64 * j), (unsigned)__builtin_amdgcn_readfirstlane(lds0 + (unsigned)(slot * KB + j * 8192))); };
    auto gloadV = [&](int t, int slot) { const GAS bf16_t* rp = vdma + (size_t)tile_row0(t) * PW;
#pragma unroll
        for (int j = 0; j < NLD; ++j) glds16((const void*)(rp + 64 * j), (unsigned)__builtin_amdgcn_readfirstlane(lds0 + (unsigned)(VBASE + slot * VB + j * 8192))); };
    volatile LAS float* wsf = (volatile LAS float*)(lds + WSF_OFF + wid * 256);
    const int koff = (VAR == 0 ? map * 8192 : 0) + hi * 1024 + r32 * 16;
    const int vlane = (4 * hi + ((lane & 15) >> 2)) * 64 + ((lane >> 4) & 1) * 32 + (lane & 3) * 8;
    f32x16 o[NDB];
#pragma unroll
    for (int d = 0; d < NDB; ++d) o[d] = (f32x16){0.f, 0.f, 0.f, 0.f, 0.f, 0.f, 0.f, 0.f, 0.f, 0.f, 0.f, 0.f, 0.f, 0.f, 0.f, 0.f};
    float m_run = 0.f, l_run = 0.f;
    f32x16 negm = (f32x16){0.f, 0.f, 0.f, 0.f, 0.f, 0.f, 0.f, 0.f, 0.f, 0.f, 0.f, 0.f, 0.f, 0.f, 0.f, 0.f};
    const int tq = q0w + r32;
    f32x16 s0, s1;
    auto qk = [&](int slot) { const LAS unsigned char* bp = lds + slot * KB + koff;
        s0 = negm; s1 = negm;
        constexpr int KH = (VAR == 0) ? 2 : 4;
#pragma unroll
        for (int h = 0; h < 4; h += KH) {
            bf16x8 kf[2 * KH];
#pragma unroll
            for (int d0 = 0; d0 < KH; ++d0) { kf[2 * d0] = *(const LAS bf16x8*)(bp + (h + d0) * 2048); kf[2 * d0 + 1] = *(const LAS bf16x8*)(bp + (h + d0) * 2048 + 512); }
            __builtin_amdgcn_sched_barrier(0);
#pragma unroll
            for (int d0 = 0; d0 < KH; ++d0) {
                s0 = __builtin_amdgcn_mfma_f32_32x32x16_bf16(kf[2 * d0], qr[h + d0], s0, 0, 0, 0);
                s1 = __builtin_amdgcn_mfma_f32_32x32x16_bf16(kf[2 * d0 + 1], qr[h + d0], s1, 0, 0, 0); }
            if (h + KH < 4) __builtin_amdgcn_sched_barrier(0);
        } };
    gloadK(0, 0); gloadV(0, 0);
    if (NT > 1) gloadK(1, 1);
    asm volatile("s_waitcnt vmcnt(0)" ::: "memory"); ATT_BAR();
    if (NT > 2) gloadK(2, 2);
    if (NT > 1) gloadV(1, 1);
    qk(0);
    ATT_BAR();
    if (half == 1) ATT_BAR();
    int k0 = 0;
    for (int t = 0; t < NT; ++t) {
        const bool more1 = t + 1 < NT, more2 = t + 2 < NT, more3 = t + 3 < NT;
        const int k1 = k0 == 2 ? 0 : k0 + 1, k2 = k1 == 2 ? 0 : k1 + 1;
        if (VAR == 2 && !ctxq && t >= 4) {
            const int lt = lt0 + t - 4, kb = 64 * lt + 4 * hi - tq;
            if (lt == qb - 2) {
#pragma unroll
                for (int r = 0; r < 16; ++r) { const int d = kb + (r & 3) + 8 * (r >> 2); if (d < -128) s0[r] = -1e30f; if (d + 32 < -128) s1[r] = -1e30f; }
            } else if (lt == qb + 2) {
#pragma unroll
                for (int r = 0; r < 16; ++r) { const int d = kb + (r & 3) + 8 * (r >> 2); if (d > 128) s0[r] = -1e30f; if (d + 32 > 128) s1[r] = -1e30f; }
            }
        }
        float ma = max3f(s0[0], s0[1], s1[0]), mb = max3f(s0[2], s0[3], s1[1]); ma = max3f(ma, s1[2], s1[3]);
#pragma unroll
        for (int r = 4; r < 16; r += 4) { ma = max3f(ma, s0[r], s0[r + 1]); mb = max3f(mb, s0[r + 2], s0[r + 3]); ma = max3f(ma, s1[r], s1[r + 1]); mb = max3f(mb, s1[r + 2], s1[r + 3]); }
        float mx = fmaxf(ma, mb);
        { const auto rr = __builtin_amdgcn_permlane32_swap(__float_as_uint(mx), __float_as_uint(mx), false, false); mx = fmaxf(__uint_as_float(rr[0]), __uint_as_float(rr[1])); }
        if (t == 0 || __any(mx > ATT_THR)) {
            const float dl = (t == 0) ? mx : fmaxf(mx, 0.f);
            m_run += dl;
#pragma unroll
            for (int r = 0; r < 16; ++r) { s0[r] -= dl; s1[r] -= dl; negm[r] = -m_run; }
            const float f = fast_exp2(-dl);
            l_run *= f;
            if (hi == 0) wsf[r32] = f;
            LDS_WAIT();
#pragma unroll
            for (int r = 0; r < 16; ++r) { const float al = wsf[crow(r, hi)];
#pragma unroll
                for (int d = 0; d < NDB; ++d) o[d][r] *= al; }
        }
        float la = 0.f, lb = 0.f;
#pragma unroll
        for (int r = 0; r < 16; ++r) { s0[r] = fast_exp2(s0[r]); s1[r] = fast_exp2(s1[r]); la += s0[r]; lb += s1[r]; }
        l_run += la + lb;
        bf16x8 pa[4];
        { u32x4 w;
          w.x = cvt_pk_bf16(s0[0], s0[1]); w.y = cvt_pk_bf16(s0[2], s0[3]); w.z = cvt_pk_bf16(s0[4], s0[5]); w.w = cvt_pk_bf16(s0[6], s0[7]); pa[0] = __builtin_bit_cast(bf16x8, w);
          w.x = cvt_pk_bf16(s0[8], s0[9]); w.y = cvt_pk_bf16(s0[10], s0[11]); w.z = cvt_pk_bf16(s0[12], s0[13]); w.w = cvt_pk_bf16(s0[14], s0[15]); pa[1] = __builtin_bit_cast(bf16x8, w);
          w.x = cvt_pk_bf16(s1[0], s1[1]); w.y = cvt_pk_bf16(s1[2], s1[3]); w.z = cvt_pk_bf16(s1[4], s1[5]); w.w = cvt_pk_bf16(s1[6], s1[7]); pa[2] = __builtin_bit_cast(bf16x8, w);
          w.x = cvt_pk_bf16(s1[8], s1[9]); w.y = cvt_pk_bf16(s1[10], s1[11]); w.z = cvt_pk_bf16(s1[12], s1[13]); w.w = cvt_pk_bf16(s1[14], s1[15]); pa[3] = __builtin_bit_cast(bf16x8, w); }
        ATT_BAR();
        if (more3) gloadK(t + 3, k0);
        if (more2) gloadV(t + 2, k2);
        const LAS unsigned char* vp = lds + VBASE + k0 * VB + vlane;
        s16x4 va_lo[NDB], va_hi[NDB], vb_lo[NDB], vb_hi[NDB];
#define ATT_VLOAD(LO, HI, KS) do { _Pragma("unroll") for (int d = 0; d < NDB; ++d) { LO[d] = vtr(vp + d * 4096 + (KS) * 1024); HI[d] = vtr(vp + d * 4096 + (KS) * 1024 + 512); } } while (0)
#define ATT_VMMA(LO, HI, KS) do { _Pragma("unroll") for (int d = 0; d < NDB; ++d) { const bf16x8 vf = (bf16x8){LO[d][0], LO[d][1], LO[d][2], LO[d][3], HI[d][0], HI[d][1], HI[d][2], HI[d][3]}; \
            o[d] = __builtin_amdgcn_mfma_f32_32x32x16_bf16(pa[KS], vf, o[d], 0, 0, 0); } } while (0)
        ATT_VLOAD(va_lo, va_hi, 0); ATT_VLOAD(vb_lo, vb_hi, 1);
        __builtin_amdgcn_sched_barrier(0);
        ATT_VMMA(va_lo, va_hi, 0);
        __builtin_amdgcn_sched_barrier(0);
        ATT_VLOAD(va_lo, va_hi, 2);
        __builtin_amdgcn_sched_barrier(0);
        ATT_VMMA(vb_lo, vb_hi, 1);
        __builtin_amdgcn_sched_barrier(0);
        ATT_VLOAD(vb_lo, vb_hi, 3);
        __builtin_amdgcn_sched_barrier(0);
        ATT_VMMA(va_lo, va_hi, 2);
        ATT_VMMA(vb_lo, vb_hi, 3);
#undef ATT_VLOAD
#undef ATT_VMMA
        if (more1) qk(k1);
        if (more3) { if (NLD == 2) asm volatile("s_waitcnt vmcnt(4)" ::: "memory"); else asm volatile("s_waitcnt vmcnt(2)" ::: "memory"); }
        else if (more2) { if (NLD == 2) asm volatile("s_waitcnt vmcnt(2)" ::: "memory"); else asm volatile("s_waitcnt vmcnt(1)" ::: "memory"); }
        else asm volatile("s_waitcnt vmcnt(0)" ::: "memory");
        ATT_BAR();
        k0 = k1;
    }
    if (half == 0) ATT_BAR();
    { float l_tot; { const auto rr = __builtin_amdgcn_permlane32_swap(__float_as_uint(l_run), __float_as_uint(l_run), false, false); l_tot = __uint_as_float(rr[0]) + __uint_as_float(rr[1]); }
      if (VAR == 2) l_tot += fast_exp2(ac.sink[hh * 4 + g] * LOG2E - m_run);
      if (hi == 0) wsf[r32] = 1.0f / l_tot;
      LDS_WAIT();
#pragma unroll
      for (int r = 0; r < 16; ++r) { const float il = wsf[crow(r, hi)];
#pragma unroll
          for (int d = 0; d < NDB; ++d) o[d][r] *= il; } }
    GAS bf16_t* Og = (GAS bf16_t*)ac.O;
    if (VAR != 0) {
#pragma unroll
        for (int r = 0; r < 16; ++r) { GAS bf16_t* op = Og + (size_t)(qrow0 + crow(r, hi)) * OW + ocol + r32;
#pragma unroll
            for (int d = 0; d < NDB; ++d) op[d * 32] = f2bf(o[d][r]); }
    } else {
        LAS float* tile = (LAS float*)lds + ((wid & 3) * 2 + map) * (32 * 132);
#pragma unroll
        for (int r = 0; r < 16; ++r)
#pragma unroll
            for (int d = 0; d < NDB; ++d) tile[crow(r, hi) * 132 + d * 32 + r32] = o[d][r];
        __syncthreads();
        const int ql = (wid >> 2) * 16 + (lane >> 2), part = lane & 3;
        const LAS float* t0 = (const LAS float*)lds + ((wid & 3) * 2) * (32 * 132) + ql * 132 + part * 32;
        const LAS float* t1 = t0 + 32 * 132;
        f32x4 dv[8]; float ss = 0.f;
#pragma unroll
        for (int j = 0; j < 8; ++j) { const f32x4 a = *(const LAS f32x4*)(t0 + 4 * j), bq = *(const LAS f32x4*)(t1 + 4 * j); dv[j] = a - ac.lam * bq;
            ss += (dv[j][0] * dv[j][0] + dv[j][1] * dv[j][1]) + (dv[j][2] * dv[j][2] + dv[j][3] * dv[j][3]); }
        ss += __shfl_xor(ss, 1); ss += __shfl_xor(ss, 2);
        const float rs = ac.one_m_li / sqrtf(ss * (1.0f / 128.0f) + 1e-5f);
        const GAS float* gp = (const GAS float*)ac.subln_g + part * 32;
        GAS bf16_t* op = Og + (size_t)((ctxq ? ctxbase : latbase) + qb * qpb + (wid & 3) * 32 + ql) * OW + ocol + part * 32;
#pragma unroll
        for (int k = 0; k < 4; ++k) { const f32x4 g0 = *(const GAS f32x4*)(gp + 8 * k), g1 = *(const GAS f32x4*)(gp + 8 * k + 4);
            const f32x4 v0 = dv[2 * k] * g0 * rs, v1 = dv[2 * k + 1] * g1 * rs;
            u32x4 w; w.x = cvt_pk_bf16(v0[0], v0[1]); w.y = cvt_pk_bf16(v0[2], v0[3]); w.z = cvt_pk_bf16(v1[0], v1[1]); w.w = cvt_pk_bf16(v1[2], v1[3]);
            *(GAS u32x4*)(op + 8 * k) = w; }
    }
}

using pg8::Unit;
struct SchedInproj {
    int c, G, nM, ntot, nfz; const char* xn; const char* win; const char* wfz; char* p; char* zz; char* zzc; const char* rope; char* gates; const float* rsc;
    __device__ __forceinline__ bool next(int i, Unit& u) const {
        const int L = i * G + c; if (L >= ntot + nfz) return false;
        u.aux = nullptr;
        if (L < ntot) { int pm, pn; pg8::tile_of(L, nM, 28, pm, pn);
            u.A = xn + (size_t)pm * 256 * DM; u.B = win + (size_t)pn * 256 * DM; u.aux2 = (const char*)(rsc + (size_t)pm * 256);
            if (pn < 12) { u.out = p + ((size_t)pm * 256 * PW + pn * 256) * 2; u.ldc = PW; } else { u.out = gates + ((size_t)pm * 256 * GW + (pn - 12) * 256); u.ldc = GW; }
            int fl = pm < 64 ? 16 : 0;
            if (pn >= 12) fl |= 1; else if (pn < 2) fl |= 2 | 8; else if (pn < 4) fl |= 2; else if (pn == 9 || pn == 10) fl |= 2 | 8; else if (pn == 11) fl |= 4;
            u.flag = fl; u.aux = rope + (size_t)((pm * 256) & 2047) * 64 * 4; }
        else { const int q = L - ntot;
            if (q < 256) { const int b = q >> 5, pm = (q >> 3) & 3, pn = q & 7;
                u.A = wfz + (size_t)pm * 256 * DM; u.B = xn + (size_t)(b * SEQ + pn * 256) * DM; u.aux2 = (const char*)(rsc + (size_t)(b * SEQ + pn * 256));
                u.out = zz + ((size_t)b * 512 * 4096 + (size_t)((pm & 1) * 256) * 4096 + (pm >> 1) * 2048 + pn * 256) * 2; u.ldc = 4096; u.flag = 32; }
            else { const int q2 = q - 256, b = q2 >> 2, pm = q2 & 3;
                u.A = wfz + (size_t)pm * 256 * DM; u.B = xn + (size_t)(NLAT + b * CTXL) * DM; u.aux2 = (const char*)(rsc + (size_t)(NLAT + b * CTXL));
                u.out = zzc + ((size_t)b * 512 * 512 + (size_t)((pm & 1) * 256) * 512 + (pm >> 1) * 256) * 2; u.ldc = 512; u.flag = 32; } }
        return true;
    }
};
struct SchedDft {
    int c; const char* T; const char* zz; char* o;
    __device__ __forceinline__ bool next(int i, Unit& u) const {
        if (i > 0 || c >= 128) return false;
        const int b = c >> 4, pm = (c >> 1) & 7, pn = c & 1;
        u.A = T + (size_t)pm * 256 * 4096 * 2; u.B = zz + ((size_t)b * 512 + pn * 256) * 4096 * 2;
        u.out = o + ((size_t)(b * SEQ + pm * 256) * OW + 1536 + pn * 256) * 2; u.ldc = OW; u.flag = 0; u.aux = nullptr; u.aux2 = nullptr; return true;
    }
};
struct SchedDftCtx {
    int c; const char* T; const char* zzc; char* o;
    __device__ __forceinline__ bool next(int i, Unit& u) const {
        if (i > 0 || c < 128 || c >= 144) return false;
        const int q = c - 128, b = q >> 1, pn = q & 1;
        u.A = T; u.B = zzc + ((size_t)b * 512 + pn * 256) * 512 * 2;
        u.out = o + ((size_t)(NLAT + b * CTXL) * OW + 1536 + pn * 256) * 2; u.ldc = OW; u.flag = 0; u.aux = nullptr; u.aux2 = nullptr; return true;
    }
};
struct SchedBranch {
    int c, G, ntile; const char* o; const char* wbr; const char* p; char* merged;
    __device__ __forceinline__ bool next(int i, pg8::BUnit& u) const {
        const int xcd = c & 7, j = i * (G >> 3) + (c >> 3), pm = xcd + 8 * (j >> 3), pn2 = j & 7;
        if (pm * 8 >= ntile) return false;
        u.A = o + (size_t)pm * 256 * OW * 2; u.B = wbr + (size_t)pn2 * 128 * 2048 * 2;
        u.gate = p + ((size_t)pm * 256 * GW + pn2 * 128);
        u.out = merged + ((size_t)pm * 256 * 1024 + pn2 * 128) * 2; return true;
    }
};
struct SchedResid {
    int c, G, nM, K; const char* A; const char* B; char* xs; const char* modv; int goff; const char* xin; const char* cin;
    __device__ __forceinline__ bool next(int i, Unit& u) const {
        const int L = i * G + c; if (L >= nM * 4) return false;
        int pm, pn; pg8::tile_of(L, nM, 4, pm, pn);
        u.A = A + (size_t)pm * 256 * K * 2; u.B = B + (size_t)pn * 256 * K * 2; u.out = xs + ((size_t)pm * 256 * DM + pn * 256) * 2; u.ldc = DM;
        u.aux = modv + ((size_t)(pm < 64 ? (pm >> 3) : 8) * 6144 + goff + pn * 256) * 4; u.flag = xin ? 1 : 0;
        u.aux2 = xin ? (pm < 64 ? xin + ((size_t)pm * 256 * DM + pn * 256) * 4 : cin + ((size_t)(pm - 64) * 256 * DM + pn * 256) * 4) : (const char*)u.out; return true;
    }
};
struct SchedUp {
    int c, G, nM; const char* xn; const char* w; char* h; int eb; const float* rsc;
    __device__ __forceinline__ bool next(int i, Unit& u) const {
        const int L = i * G + c; if (L >= nM * 22) return false;
        int pm, pn; pg8::tile_of(L, nM, 22, pm, pn);
        u.A = xn + (size_t)pm * 256 * DM; u.B = w + (size_t)pn * 256 * DM; u.out = h + ((size_t)pm * 256 * DFF + pn * 128) * eb; u.ldc = DFF; u.flag = 0; u.aux = (const char*)(rsc + (size_t)pm * 256); u.aux2 = nullptr; return true;
    }
};
struct SchedMoe {
    int c, G, NT, K, RT; MoeTiles mt; const char* A; const char* W; size_t wsub; char* out; int ldc, colw, esz; const float* rsc;
    __device__ __forceinline__ bool next(int i, Unit& u) const {
        const int L0 = i * G + c, ntot = RT * NT; if (L0 >= ntot) return false;
        int L = L0; if (NT > 4) { const int q = ntot / 8, r = ntot % 8, xcd = L0 % 8, off = L0 / 8; L = (xcd < r ? xcd * (q + 1) : r * (q + 1) + (xcd - r) * q) + off; }
        const int gs = 8 * NT, g8 = L / gs, rem = L % gs, left = RT - 8 * g8, gsz = left < 8 ? left : 8;
        const int rt = 8 * g8 + rem % gsz, pn = rem / gsz;
        int e = 0;
#pragma unroll
        for (int k = 1; k < 8; ++k) e += (rt >= mt.tb[k]) ? 1 : 0;
        u.A = A + (size_t)rt * 256 * K * 2; u.B = W + (size_t)e * W_EXPERT + wsub + (size_t)pn * 256 * K * 2;
        u.out = out + ((size_t)rt * 256 * ldc + (size_t)pn * colw) * esz; u.ldc = ldc; u.flag = 0; u.aux = rsc ? (const char*)(rsc + (size_t)rt * 256) : nullptr; u.aux2 = nullptr; return true;
    }
};

struct SchedMoeSplit {
    int c, G, RF, RT; MoeTiles mt; const char* A; const char* W; char* y0; char* y1;
    __device__ __forceinline__ bool next(int i, Unit& u) const {
        const int L = i * G + c; if (L >= (RT - RF) * 8) return false;
        const int ts = L >> 1, kh = L & 1, rt = RF + (ts >> 2), pn = ts & 3;
        int e = 0;
#pragma unroll
        for (int k = 1; k < 8; ++k) e += (rt >= mt.tb[k]) ? 1 : 0;
        u.A = A + ((size_t)rt * 256 * DFE + kh * (DFE / 2)); u.B = W + (size_t)e * W_EXPERT + W_MD + ((size_t)pn * 256 * DFE + kh * (DFE / 2));
        u.out = kh ? y1 + ((size_t)(rt - RF) * 256 * DM + pn * 256) * 2 : y0 + ((size_t)rt * 256 * DM + pn * 256) * 2;
        u.ldc = DM; u.flag = 0; u.aux = nullptr; u.aux2 = nullptr; return true;
    }
};

#define LAUNDER_S(x) asm volatile("" : "+s"(x))
#define LAUNDER_V(x) asm volatile("" : "+v"(x))
constexpr int LDS_ARGOFF = LDS_CTLOFF + 512;
__device__ __forceinline__ const float* ARGP(LAS unsigned char* lds, int i) {
    unsigned off = LDS_ARGOFF + 8 * i; asm volatile("" : "+s"(off));
    volatile LAS unsigned* p = (volatile LAS unsigned*)(lds + off);
    const unsigned lo = __builtin_amdgcn_readfirstlane(p[0]), hi = __builtin_amdgcn_readfirstlane(p[1]);
    return (const float*)(((unsigned long long)hi << 32) | lo);
}
__device__ __forceinline__ void grid_barrier(LAS unsigned char* lds, int wv) {
    XcdBarrier b; b.bar = (unsigned*)((unsigned char*)ARGP(lds, 24) + WS_CTL) + CW_BAR; b.x = xb_xcc_id(); b.st = (volatile LAS unsigned*)(lds + LDS_CTLOFF);
    xcd_barrier(b, wv == 0 && lane_id() == 0);
}
struct Fr { LAS unsigned char* lds; unsigned char* ws; int tid, lane, wave, bid, G, gw, NGW; unsigned* ctl; };
__device__ __forceinline__ Fr make_frame(LAS unsigned char* lds, int wv) {
    Fr F; F.lds = lds;
    F.ws = (unsigned char*)ARGP(lds, 24); int t = wv * 64 + lane_id(); LAUNDER_V(t); F.tid = t; F.lane = t & 63; F.wave = wv;
    int b = blockIdx.x; LAUNDER_S(b); F.bid = b; int g = gridDim.x; LAUNDER_S(g); F.G = g; F.gw = b * 8 + F.wave; F.NGW = g * 8; F.ctl = (unsigned*)(F.ws + WS_CTL);
    return F;
}

constexpr int CV_PRO = 4 * CV_LAYER + 2 * CV_DENSE;
constexpr int CV_M1 = CV_PRO, CV_M3 = CV_PRO + 8 * CV_EXP;
#ifndef BG_BRW
#define BG_BRW 6
#endif
#ifndef BG_DDW
#define BG_DDW 12
#endif
constexpr int BG_BR = 192 * 8 * BG_BRW, BG_OUT = 224 * 8 * 4, BG_DD = 224 * 8 * BG_DDW;
constexpr int CVQ_BLK = 32;
constexpr int cmin_(int a, int b) { return a < b ? a : b; }
constexpr int MQ1_E = CV_M3, MQ2_E = CV_TOTAL, MQ1_S = cmin_(CV_M1 + BG_BR + BG_OUT + BG_DD + BG_BR, MQ1_E), MQ2_S = cmin_(CV_M3 + BG_OUT + BG_BR + BG_OUT + BG_DD, MQ2_E);
static_assert(MQ1_S <= MQ1_E && MQ2_S <= MQ2_E && (MQ1_E - MQ1_S) % (8 * CVQ_BLK) == 0 && (MQ2_E - MQ2_S) % (8 * CVQ_BLK) == 0, "queue conversion ranges are whole units per XCD queue");
__device__ __forceinline__ void convert_range(LAS unsigned char* lds, const Fr& F, int start, int end, int gwi, int nw) {
    Args a;
#pragma unroll
    for (int i = 0; i < 23; ++i) a.in[i] = ARGP(lds, i);
    a.out = nullptr; a.ws = F.ws;
    LAS float* scr = (LAS float*)(lds + F.wave * 8704);
    float ra[32], rb[32]; ConvDesc d, dn; int it = start + gwi; bool have = it < end;
    if (have) { d = conv_decode(a, it); conv_load(d, ra, F.lane); }
    while (have) {
        const int itn = it + nw; const bool hn = itn < end;
        if (hn) { dn = conv_decode(a, itn); conv_load(dn, rb, F.lane); }
        conv_store(d, ra, scr, F.lane);
        if (hn) {
#pragma unroll
            for (int i = 0; i < 32; ++i) ra[i] = rb[i];
            d = dn; }
        it = itn; have = hn;
    }
}
__device__ __forceinline__ void bg_window(int kind, int l, int& s, int& e) {
    s = 0; e = 0;
    const int m1a = CV_M1, m1b = cmin_(m1a + BG_BR, MQ1_E), m1c = cmin_(m1b + BG_OUT, MQ1_E), m1d = cmin_(m1c + BG_DD, MQ1_E), m1e = MQ1_S;
    const int m3a = CV_M3, m3b = cmin_(m3a + BG_OUT, MQ2_E), m3c = cmin_(m3b + BG_BR, MQ2_E), m3d = cmin_(m3c + BG_OUT, MQ2_E), m3e = MQ2_S;
    if (kind == 0) { if (l == 0) { s = m1a; e = m1b; } else if (l == 1) { s = m1d; e = m1e; } else if (l == 2) { s = m3b; e = m3c; } }
    else if (kind == 1) { if (l == 0) { s = m1b; e = m1c; } else if (l == 1) { s = m3a; e = m3b; } else if (l == 2) { s = m3c; e = m3d; } }
    else { if (l == 0) { s = m1c; e = m1d; } else if (l == 2) { s = m3d; e = m3e; } }
}
__device__ __forceinline__ void phase_prologue(LAS unsigned char* lds, int wv) {
    const Fr F = make_frame(lds, wv);
    Args a;
#pragma unroll
    for (int i = 0; i < 23; ++i) a.in[i] = ARGP(lds, i);
    a.out = nullptr; a.ws = F.ws;
    if (F.bid < 96) mod_item(a, F.bid, lds, F.tid);
    for (int it = F.gw; it < 2048; it += F.NGW) fzfold_item(a, it, F.lane);
    convert_range(lds, F, 0, CV_LAYER, F.gw, F.NGW);
    float* rope = (float*)(F.ws + WS_ROPE);
    for (int i = F.gw * 64 + F.lane; i < SEQ * 64; i += F.NGW * 64) { const int t = i >> 6, j = i & 63, ax = j >> 5, isin = (j >> 4) & 1, f = j & 15;
        const float pos = (float)(ax == 0 ? (t >> 6) : (t & 63));
        const float inv = powf(10000.0f, -(float)f / 16.0f); const float ang = pos * inv;
        rope[i] = isin ? sinf(ang) : cosf(ang); }
    bf16_t* T = (bf16_t*)(F.ws + WS_T);
    for (int i = F.gw * 64 + F.lane; i < 2048 * 2048; i += F.NGW * 64) { const int k = i >> 11, n = i & 2047; const float x = (float)((k * n) & 2047) * (1.0f / 1024.0f);
        T[(size_t)k * 4096 + n] = f2bf(cospif(x)); T[(size_t)k * 4096 + 2048 + n] = f2bf(-sinpif(x)); }
    bf16_t* T2 = (bf16_t*)(F.ws + WS_T256);
    for (int i = F.gw * 64 + F.lane; i < 256 * 256; i += F.NGW * 64) { const int k = i >> 8, n = i & 255; const float x = (float)((k * n) & 255) * (1.0f / 128.0f);
        T2[k * 512 + n] = f2bf(cospif(x)); T2[k * 512 + 256 + n] = f2bf(-sinpif(x)); }
}
__device__ __forceinline__ void phase_first_norm(LAS unsigned char* lds, int wv) {
    const Fr F = make_frame(lds, wv);
    const float* X = ARGP(lds, I_X); const float* CX = ARGP(lds, I_CTX); const float* n1g = ARGP(lds, I_N1G);
    float* xs = (float*)(F.ws + WS_XS); bf16_t* xn = (bf16_t*)(F.ws + WS_XN); const float* modv_all = (const float*)(F.ws + WS_MODV);
    for (int row = F.gw; row < NTOK; row += F.NGW) {
        const float* src = row < NLAT ? X + (size_t)row * DM : CX + (size_t)(row - NLAT) * DM;
        const RowV x = load_row_f32(src, F.lane);
        const float* mv = modv_all + (size_t)mod_row_of(row) * 6144;
        const RowV y = adaln_row(x, n1g, mv, mv + 1024, F.lane);
        const RowQ yq = quant_row_i8(y);
        store_rowq(F.ws + WS_XN8 + (size_t)row * DM, yq, F.lane); if (F.lane == 0) ((float*)(F.ws + WS_RSC1))[row] = yq.sc;
    }
}
__device__ __forceinline__ void phase_inproj(LAS unsigned char* lds, int wv, int l) {
    const Fr F = make_frame(lds, wv); unsigned char* ws = F.ws; const bool lastl = l == DEPTH - 1;
    SchedInproj S{F.bid, F.G, NTOK / 256, (NTOK / 256) * 28, lastl ? 256 : 288, (const char*)(ws + WS_XN8), (const char*)w_layer(ws, l, W_IN), (const char*)w_layer(ws, l, W_FZ), (char*)(ws + WS_P), (char*)(ws + WS_ZZ), (char*)(ws + WS_ZZC), (const char*)(ws + WS_ROPE), (char*)(ws + WS_G), (const float*)(ws + WS_RSC1)};
    pg8::EpiInproj E{};
    pg8::gemm_phase<pg8::EpiInproj, SchedInproj, true, true, 2>(lds, F.tid, DM / 2, DM / 2, DM / 2, S, E);
}
__device__ __forceinline__ void phase_post(LAS unsigned char* lds, int wv, int l) {
    const Fr F = make_frame(lds, wv);
    GAS bf16_t* P = (GAS bf16_t*)(F.ws + WS_P); const GAS float* rope = (const GAS float*)(F.ws + WS_ROPE);
    const GAS float* gq = (const GAS float*)ARGP(lds, I_QKG) + l * 128; const GAS float* gk = gq + 64;
    const int lane = F.lane, a = (lane & 7) >> 2, i0 = 4 * (lane & 3);
    float gqv[8], gkv[8];
#pragma unroll
    for (int e = 0; e < 8; ++e) { const int d = 32 * a + 16 * (e & 1) + i0 + (e >> 1); gqv[e] = gq[d]; gkv[e] = gk[d]; }
    for (int row = F.gw; row < NTOK; row += F.NGW) {
        GAS bf16_t* pr = P + (size_t)row * PW;
        const bool lat = row < NLAT;
        f32x4 cs = (f32x4){1.f, 1.f, 1.f, 1.f}, sn = (f32x4){0.f, 0.f, 0.f, 0.f};
        if (lat) { const GAS float* rt = rope + (size_t)(row & 2047) * 64 + a * 32 + i0; cs = *(const GAS f32x4*)rt; sn = *(const GAS f32x4*)(rt + 16); }
        const u32x4 qw = *(const GAS u32x4*)(pr + C_BQ + 8 * lane);
        u32x4 kw = (u32x4){0u, 0u, 0u, 0u};
        if (lane < 16) kw = *(const GAS u32x4*)(pr + C_BK + 8 * lane);
        float x[8], y[8];
        x[0] = bf_lo(qw.x); x[1] = bf_hi(qw.x); x[2] = bf_lo(qw.y); x[3] = bf_hi(qw.y); x[4] = bf_lo(qw.z); x[5] = bf_hi(qw.z); x[6] = bf_lo(qw.w); x[7] = bf_hi(qw.w);
        y[0] = bf_lo(kw.x); y[1] = bf_hi(kw.x); y[2] = bf_lo(kw.y); y[3] = bf_hi(kw.y); y[4] = bf_lo(kw.z); y[5] = bf_hi(kw.z); y[6] = bf_lo(kw.w); y[7] = bf_hi(kw.w);
        float sq = 0.f, sk = 0.f;
#pragma unroll
        for (int e = 0; e < 8; ++e) { sq += x[e] * x[e]; sk += y[e] * y[e]; }
        sq += __shfl_xor(sq, 1); sq += __shfl_xor(sq, 2); sq += __shfl_xor(sq, 4);
        sk += __shfl_xor(sk, 1); sk += __shfl_xor(sk, 2); sk += __shfl_xor(sk, 4);
        const float rq = 1.0f / sqrtf(sq * (1.0f / 64.0f) + 1e-6f), rk = 1.0f / sqrtf(sk * (1.0f / 64.0f) + 1e-6f);
#pragma unroll
        for (int e = 0; e < 8; ++e) { x[e] *= rq * gqv[e]; y[e] *= rk * gkv[e]; }
        float xo[8], yo[8];
#pragma unroll
        for (int p2 = 0; p2 < 4; ++p2) { const float c = cs[p2], s = sn[p2];
            xo[2 * p2] = (x[2 * p2] * c - x[2 * p2 + 1] * s) * C2; xo[2 * p2 + 1] = (x[2 * p2 + 1] * c + x[2 * p2] * s) * C2;
            yo[2 * p2] = y[2 * p2] * c - y[2 * p2 + 1] * s; yo[2 * p2 + 1] = y[2 * p2 + 1] * c + y[2 * p2] * s; }
        u32x4 ow; ow.x = cvt_pk_bf16(xo[0], xo[1]); ow.y = cvt_pk_bf16(xo[2], xo[3]); ow.z = cvt_pk_bf16(xo[4], xo[5]); ow.w = cvt_pk_bf16(xo[6], xo[7]);
        *(GAS u32x4*)(pr + C_BQ + 8 * lane) = ow;
        if (lane < 16) { u32x4 kk; kk.x = cvt_pk_bf16(yo[0], yo[1]); kk.y = cvt_pk_bf16(yo[2], yo[3]); kk.z = cvt_pk_bf16(yo[4], yo[5]); kk.w = cvt_pk_bf16(yo[6], yo[7]);
            *(GAS u32x4*)(pr + C_BK + 8 * lane) = kk; }
    }
}
constexpr int CVQ_UNITS = (CV_PRO - CV_LAYER) / (8 * CVQ_BLK);
static_assert(CVQ_UNITS * 8 * CVQ_BLK == CV_PRO - CV_LAYER, "conversion units tile the deferred block range");
__device__ __forceinline__ void phase_mix(LAS unsigned char* lds, int wv, int l, int rep) {
    const Fr F = make_frame(lds, wv); unsigned char* ws = F.ws; const bool lastl = l == DEPTH - 1;
    volatile LAS unsigned* LCTL = (volatile LAS unsigned*)(lds + LDS_CTLOFF);
    { SchedDft S{F.bid, (const char*)(ws + WS_T), (const char*)(ws + WS_ZZ), (char*)(ws + WS_O)}; pg8::EpiStore E{1.0f / 362.03867196751236f};
      pg8::gemm_phase<pg8::EpiStore, SchedDft, false, true>(lds, F.tid, 4096, 4096, 4096, S, E); }
    if (!lastl) { SchedDftCtx S{F.bid, (const char*)(ws + WS_T256), (const char*)(ws + WS_ZZC), (char*)(ws + WS_O)}; pg8::EpiStore E{1.0f / 128.0f};
      pg8::gemm_phase<pg8::EpiStore, SchedDftCtx, false, true>(lds, F.tid, 512, 512, 512, S, E); }
    float c08 = 0.8f; asm volatile("" : "+v"(c08));
    const float li = c08 - 0.6f * expf(-0.3f * (float)l);
    const float* lp = ARGP(lds, I_DLAM) + l * 256;
    float d01 = 0.f, d23 = 0.f;
    for (int k = 0; k < 64; ++k) { d01 += lp[k] * lp[64 + k]; d23 += lp[128 + k] * lp[192 + k]; }
    const float lam_u = __builtin_bit_cast(float, __builtin_amdgcn_readfirstlane(__builtin_bit_cast(int, expf(d01) - expf(d23) + li)));
    const float oml_u = __builtin_bit_cast(float, __builtin_amdgcn_readfirstlane(__builtin_bit_cast(int, 1.0f - li)));
    AttnCtx ac{(const bf16_t*)(ws + WS_P), (bf16_t*)(ws + WS_O), ARGP(lds, I_SUBLN) + l * 128, lam_u, oml_u, ARGP(lds, I_SINK) + l * 8};
    const int NUB = lastl ? 192 : 216;
    int NCV = 0, cvbase = 0;
    if (rep == 0) { if (l == 0) { NCV = CVQ_UNITS; cvbase = CV_LAYER; } else if (l == 1) { NCV = (MQ1_E - MQ1_S) / (8 * CVQ_BLK); cvbase = MQ1_S; } else if (l == 2) { NCV = (MQ2_E - MQ2_S) / (8 * CVQ_BLK); cvbase = MQ2_S; } }
    const int bq = F.bid & 7;
    unsigned* qc = F.ctl + CW_Q + 64 * (8 * (l + 4 * rep) + bq);
    for (;;) {
        __syncthreads();
        if (F.tid == 0) LCTL[2] = xb_add(qc, 1u);
        __syncthreads();
        const int u = __builtin_amdgcn_readfirstlane((int)LCTL[2]);
        if (u >= NUB + NCV) break;
        if (u >= NUB) { const int s = cvbase + ((u - NUB) * 8 + bq) * CVQ_BLK; convert_range(lds, F, s, s + CVQ_BLK, F.wave, 8); continue; }
        int tl = F.tid; LAUNDER_V(tl);
        if (u < 64) attn_unit<0>(lds, tl, ac, bq, u >> 4, u & 15, false);
        else if (u < 128) { const int v = u - 64; attn_unit<1>(lds, tl, ac, bq, v >> 5, v & 31, false); }
        else if (u < 192) { const int v = u - 128; attn_unit<2>(lds, tl, ac, bq, v >> 5, v & 31, false); }
        else if (u < 200) { const int v = u - 192; attn_unit<0>(lds, tl, ac, bq, v >> 1, v & 1, true); }
        else if (u < 208) { const int v = u - 200; attn_unit<1>(lds, tl, ac, bq, v >> 2, v & 3, true); }
        else { const int v = u - 208; attn_unit<2>(lds, tl, ac, bq, v >> 2, v & 3, true); }
    }
}
__device__ __forceinline__ void phase_branch(LAS unsigned char* lds, int wv, int l) {
    const Fr F = make_frame(lds, wv); unsigned char* ws = F.ws; const int nMact = (l == DEPTH - 1) ? NLAT / 256 : NTOK / 256;
    SchedBranch S{F.bid, F.G, nMact * 8, (const char*)(ws + WS_O), (const char*)w_layer(ws, l, W_BR), (const char*)(ws + WS_G), (char*)(ws + WS_XN)};
    pg8::branch_phase<SchedBranch>(lds, F.tid, S);
    if (nMact == NTOK / 256 && (F.bid >> 3) >= 8) {
        int s, e; bg_window(0, l, s, e);
        if (e > s) convert_range(lds, F, s, e, ((F.bid & 7) * 24 + (F.bid >> 3) - 8) * 8 + F.wave, 192 * 8);
    }
}
__device__ __forceinline__ void phase_out(LAS unsigned char* lds, int wv, int l) {
    const Fr F = make_frame(lds, wv); unsigned char* ws = F.ws; const int nMact = (l == DEPTH - 1) ? NLAT / 256 : NTOK / 256;
    SchedResid S{F.bid, F.G, nMact, DM, (const char*)(ws + WS_XN), (const char*)w_layer(ws, l, W_OUT), (char*)(ws + WS_XS), (const char*)(ws + WS_MODV + (size_t)l * 9 * 6144 * 4), 2048, l == 0 ? (const char*)ARGP(lds, I_X) : nullptr, l == 0 ? (const char*)ARGP(lds, I_CTX) : nullptr};
    pg8::EpiResid E{};
    pg8::gemm_phase<pg8::EpiResid, SchedResid, true, true>(lds, F.tid, DM, DM, DM, S, E);
    if (nMact == NTOK / 256 && F.bid >= 32) {
        int s, e; bg_window(1, l, s, e);
        if (e > s) convert_range(lds, F, s, e, (F.bid - 32) * 8 + F.wave, 224 * 8);
    }
}
__device__ __forceinline__ void phase_norm2_dense(LAS unsigned char* lds, int wv, int l) {
    const Fr F = make_frame(lds, wv); const int nrows = (l == DEPTH - 1) ? NLAT : NTOK;
    const bf16_t* xs = (const bf16_t*)(F.ws + WS_XS); bf16_t* xn = (bf16_t*)(F.ws + WS_XN); const float* modv = (const float*)(F.ws + WS_MODV) + (size_t)l * 9 * 6144;
    const float* n2g = ARGP(lds, I_N2G) + l * DM;
    const int rpw = nrows / F.NGW, r0 = F.gw * rpw, r1 = r0 + rpw;
    AdaCoef co; co.mr = -1;
    for (int r = r0; r < r1; r += 3) {
        RowV x[3];
#pragma unroll
        for (int q = 0; q < 3; ++q) x[q] = load_row_bf16(xs + (size_t)(r + q < r1 ? r + q : r) * DM, F.lane);
#pragma unroll
        for (int q = 0; q < 3; ++q) if (r + q < r1) { ada_coef_update(co, r + q, n2g, modv, 3072, 4096, F.lane);
            const RowQ yq = quant_row_i8(adaln_apply(x[q], co));
            store_rowq((unsigned char*)xn + (size_t)(r + q) * DM, yq, F.lane); if (F.lane == 0) ((float*)(F.ws + WS_RSC))[r + q] = yq.sc; }
    }
}
__device__ __forceinline__ void phase_up_dense(LAS unsigned char* lds, int wv, int l) {
    const Fr F = make_frame(lds, wv); unsigned char* ws = F.ws; const int nMact = (l == DEPTH - 1) ? NLAT / 256 : NTOK / 256;
    if ((DENSE_F8_MASK >> (l >> 1)) & 1) {
        SchedUp S{F.bid, F.G, nMact, (const char*)(ws + WS_XN), (const char*)w_dense(ws, l >> 1, W_DGU), (char*)(ws + WS_P), 1, (const float*)(ws + WS_RSC)};
        pg8::EpiSwigluI8<true> E{1.0f / W8_GU};
        pg8::gemm_phase<pg8::EpiSwigluI8<true>, SchedUp, true, true, 2>(lds, F.tid, DM / 2, DM / 2, DM / 2, S, E);
    } else {
        SchedUp S{F.bid, F.G, nMact, (const char*)(ws + WS_XN), (const char*)w_dense(ws, l >> 1, W_DGU), (char*)(ws + WS_P), 2, (const float*)(ws + WS_RSC)};
        pg8::EpiSwigluI8<false> E{1.0f / W8_GU};
        pg8::gemm_phase<pg8::EpiSwigluI8<false>, SchedUp, true, true, 2>(lds, F.tid, DM / 2, DM / 2, DM / 2, S, E);
    }
}
__device__ __forceinline__ void phase_down_dense(LAS unsigned char* lds, int wv, int l) {
    const Fr F = make_frame(lds, wv); unsigned char* ws = F.ws; const int nMact = (l == DEPTH - 1) ? NLAT / 256 : NTOK / 256;
    pg8::EpiResid E{};
    if ((DENSE_F8_MASK >> (l >> 1)) & 1) {
        SchedResid S{F.bid, F.G, nMact, DFF / 2, (const char*)(ws + WS_P), (const char*)w_dense(ws, l >> 1, W_DD), (char*)(ws + WS_XS), (const char*)(ws + WS_MODV + (size_t)l * 9 * 6144 * 4), 5120, nullptr, nullptr};
        pg8::gemm_phase<pg8::EpiResid, SchedResid, true, true, true>(lds, F.tid, DFF / 2, DFF / 2, DFF / 2, S, E, 119);
    } else {
        SchedResid S{F.bid, F.G, nMact, DFF, (const char*)(ws + WS_P), (const char*)w_dense(ws, l >> 1, W_DD), (char*)(ws + WS_XS), (const char*)(ws + WS_MODV + (size_t)l * 9 * 6144 * 4), 5120, nullptr, nullptr};
        pg8::gemm_phase<pg8::EpiResid, SchedResid, true, true>(lds, F.tid, DFF, DFF, DFF, S, E);
    }
    if (nMact == NTOK / 256 && F.bid >= 32) {
        int s, e; bg_window(2, l, s, e);
        if (e > s) convert_range(lds, F, s, e, (F.bid - 32) * 8 + F.wave, 224 * 8);
    }
}
__device__ __forceinline__ void phase_norm2_moe(LAS unsigned char* lds, int wv, int l) {
    const Fr F = make_frame(lds, wv); const int nrows = (l == DEPTH - 1) ? NLAT : NTOK; const int mi = l >> 1;
    volatile LAS unsigned* LCTL = (volatile LAS unsigned*)(lds + LDS_CTLOFF);
    const bf16_t* xs = (const bf16_t*)(F.ws + WS_XS); bf16_t* xn = (bf16_t*)(F.ws + WS_XN); const float* modv = (const float*)(F.ws + WS_MODV) + (size_t)l * 9 * 6144;
    const float* n2g = ARGP(lds, I_N2G) + l * DM;
    int* toklist = (int*)(F.ws + WS_MOE); int* rec = toklist + 8 * NTOK;
    const int rpb = nrows / F.G;
    const int tid = F.tid, lane = F.lane;
    LAS int* lrec = (LAS int*)(lds + 1024);
    const float* rw = ARGP(lds, I_RW) + (size_t)mi * DM * 8;
    for (int rr = F.wave; rr < rpb; rr += 8) {
        const int row = F.bid * rpb + rr;
        const RowV x = load_row_bf16(xs + (size_t)row * DM, lane);
        const float* mv = modv + (size_t)mod_row_of(row) * 6144;
        const RowV y = adaln_row(x, n2g, mv + 3072, mv + 4096, lane);
        float lg[8];
#pragma unroll
        for (int e = 0; e < 8; ++e) lg[e] = 0.f;
#pragma unroll
        for (int j = 0; j < 4; ++j)
#pragma unroll
            for (int cc = 0; cc < 4; ++cc) { const float* wp = rw + (size_t)(256 * j + 4 * lane + cc) * 8; const f32x4 w0 = *(const f32x4*)wp, w1 = *(const f32x4*)(wp + 4); const float hv = y.v[j][cc];
                lg[0] += hv * w0[0]; lg[1] += hv * w0[1]; lg[2] += hv * w0[2]; lg[3] += hv * w0[3]; lg[4] += hv * w1[0]; lg[5] += hv * w1[1]; lg[6] += hv * w1[2]; lg[7] += hv * w1[3]; }
#pragma unroll
        for (int e = 0; e < 8; ++e) lg[e] = wave_sum(lg[e]);
        int i0 = 0; float v0 = lg[0];
#pragma unroll
        for (int e = 1; e < 8; ++e) if (lg[e] > v0) { v0 = lg[e]; i0 = e; }
        int i1 = -1; float v1 = -3.0e38f;
#pragma unroll
        for (int e = 0; e < 8; ++e) if (e != i0 && lg[e] > v1) { v1 = lg[e]; i1 = e; }
        if (lane == 0) {
            const float w0 = 1.0f / (1.0f + expf(v1 - v0)), w1 = 1.0f - w0;
            lrec[rr * 6 + 0] = i0; lrec[rr * 6 + 2] = __float_as_int(w0); lrec[rr * 6 + 3] = i1; lrec[rr * 6 + 5] = __float_as_int(w1);
        }
    }
    __syncthreads();
    { const int e = F.wave; int cnt = 0;
      for (int a0 = 0; a0 < 2 * rpb; a0 += 64) { const int a = a0 + lane; const bool valid = a < 2 * rpb; const int rr = a >> 1, k3 = 3 * (a & 1);
          const bool match = valid && lrec[rr * 6 + k3] == e;
          const unsigned long long bal = __ballot(match);
          if (match) lrec[rr * 6 + k3 + 1] = cnt + (int)__popcll(bal & ((1ull << lane) - 1ull));
          cnt += (int)__popcll(bal); }
      if (lane == 0) { toklist[F.bid * 8 + e] = cnt;
          (void)xb_add(F.ctl + CW_CNT + 64 * (8 * mi + e), (unsigned)cnt); } }
    __syncthreads();
    for (int rr = tid; rr < rpb; rr += 512) {
        const int row = F.bid * rpb + rr;
        int* rc = rec + (size_t)row * 8;
        rc[0] = lrec[rr * 6 + 0]; rc[1] = lrec[rr * 6 + 1]; rc[2] = lrec[rr * 6 + 2]; rc[3] = lrec[rr * 6 + 3]; rc[4] = lrec[rr * 6 + 4]; rc[5] = lrec[rr * 6 + 5];
    }
}
__device__ __forceinline__ void phase_moe_gather(LAS unsigned char* lds, int wv, int l) {
    const Fr F = make_frame(lds, wv); const int mi = l >> 1; const int nrows = (l == DEPTH - 1) ? NLAT : NTOK; const int rpb = nrows / F.G;
    volatile LAS unsigned* LCTL = (volatile LAS unsigned*)(lds + LDS_CTLOFF);
    const MoeTiles mt = moe_tiles(F.ctl, mi);
    const GAS bf16_t* xn = (const GAS bf16_t*)(F.ws + WS_XN); GAS bf16_t* hs = (GAS bf16_t*)(F.ws + WS_HY);
    const GAS int* blkcnt = (const GAS int*)(F.ws + WS_MOE); GAS int* rec = (GAS int*)(F.ws + WS_MOE) + 8 * NTOK;
    LAS int* red = (LAS int*)(lds + 1024);
    { const int e = F.tid & 7, ch = F.tid >> 3; int s = 0;
#pragma unroll
      for (int j = 0; j < 4; ++j) { const int bb = ch * 4 + j; if (bb < F.bid) s += blkcnt[bb * 8 + e]; }
      red[e * 64 + ch] = s; }
    __syncthreads();
    if (F.tid < 8) { int s = 0; for (int ch = 0; ch < 64; ++ch) s += red[F.tid * 64 + ch]; LCTL[16 + F.tid] = (unsigned)s; }
    __syncthreads();
    LAS int* sl = (LAS int*)(lds + 4096);
    for (int rr = F.tid; rr < rpb; rr += 512) {
        GAS int* rc = rec + (size_t)(F.bid * rpb + rr) * 8;
        const int e0 = rc[0], e1 = rc[3];
        const int p0 = rc[1] + (int)LCTL[16 + e0], p1 = rc[4] + (int)LCTL[16 + e1];
        int t0 = 0, t1 = 0;
#pragma unroll
        for (int k = 0; k < 8; ++k) { t0 = (e0 == k) ? mt.tb[k] : t0; t1 = (e1 == k) ? mt.tb[k] : t1; }
        sl[rr * 2] = t0 * 256 + p0; sl[rr * 2 + 1] = t1 * 256 + p1;
        rc[1] = p0; rc[4] = p1;
    }
    __syncthreads();
    const bf16_t* xs = (const bf16_t*)(F.ws + WS_XS); const float* modv = (const float*)(F.ws + WS_MODV) + (size_t)l * 9 * 6144; const float* n2g = ARGP(lds, I_N2G) + l * DM;
    AdaCoef co; co.mr = -1;
    for (int r0 = F.wave * (rpb >> 3); r0 < (F.wave + 1) * (rpb >> 3); r0 += 3) {
        RowV x[3]; int s[3][2];
#pragma unroll
        for (int q = 0; q < 3; ++q) { const int rr = r0 + q; const bool ok = rr < (F.wave + 1) * (rpb >> 3);
            x[q] = load_row_bf16(xs + (size_t)(F.bid * rpb + (ok ? rr : r0)) * DM, F.lane);
            s[q][0] = ok ? sl[rr * 2] : -1; s[q][1] = ok ? sl[rr * 2 + 1] : -1; }
#pragma unroll
        for (int q = 0; q < 3; ++q) if (s[q][0] >= 0) { const int row = F.bid * rpb + r0 + q;
            ada_coef_update(co, row, n2g, modv, 3072, 4096, F.lane);
            const RowV y = adaln_apply(x[q], co);
            const RowQ yq = quant_row_i8(y);
            store_rowq((unsigned char*)hs + (size_t)s[q][0] * DM, yq, F.lane); store_rowq((unsigned char*)hs + (size_t)s[q][1] * DM, yq, F.lane);
            if (F.lane == 0) { float* ssc = (float*)(F.ws + WS_SSC); ssc[s[q][0]] = yq.sc; ssc[s[q][1]] = yq.sc; } }
    }
    for (int idx = F.gw; idx < 8 * 256; idx += F.NGW) { const int e = idx >> 8, j = idx & 255;
        const int cnt = __builtin_amdgcn_readfirstlane((int)__hip_atomic_load(F.ctl + CW_CNT + 64 * (8 * mi + e), __ATOMIC_RELAXED, __HIP_MEMORY_SCOPE_AGENT));
        const int pad = ((cnt + 255) & ~255) - cnt; int tbe = 0;
#pragma unroll
        for (int k = 0; k < 8; ++k) tbe = (e == k) ? mt.tb[k] : tbe;
        if (j < pad) { unsigned z = 0u; asm volatile("" : "+v"(z));
            GAS u32x4* dp = (GAS u32x4*)((GAS unsigned char*)hs + (size_t)(tbe * 256 + cnt + j) * DM) + F.lane; dp[0] = (u32x4){z, z, z, z}; if (F.lane == 0) ((GAS float*)(F.ws + WS_SSC))[tbe * 256 + cnt + j] = __uint_as_float(z); } }
}
__device__ __forceinline__ void phase_up_moe(LAS unsigned char* lds, int wv, int l) {
    const Fr F = make_frame(lds, wv); unsigned char* ws = F.ws; const int mi = l >> 1;
    const MoeTiles mt = moe_tiles(F.ctl, mi);
    SchedMoe S{F.bid, F.G, 28, DM / 2, mt.tb[8], mt, (const char*)(ws + WS_HY), (const char*)w_moe(ws, mi, 0, 0), W_MGU, (char*)(ws + WS_P), DFE, 128, 1, (const float*)(ws + WS_SSC)};
    pg8::EpiSwigluI8<true> E{1.0f / W8_GU};
    pg8::gemm_phase<pg8::EpiSwigluI8<true>, SchedMoe, true, true, 2>(lds, F.tid, DM / 2, DM / 2, DM / 2, S, E);
}
__device__ __forceinline__ void phase_down_moe(LAS unsigned char* lds, int wv, int l) {
    const Fr F = make_frame(lds, wv); unsigned char* ws = F.ws; const int mi = l >> 1;
    const MoeTiles mt = moe_tiles(F.ctl, mi);
    const int RT = mt.tb[8], RF = RT < MOE_RF ? RT : MOE_RF;
    pg8::EpiStore E{1.0f};
    { SchedMoe S{F.bid, F.G, 4, DFE / 2, RF, mt, (const char*)(ws + WS_P), (const char*)w_moe(ws, mi, 0, 0), W_MD, (char*)(ws + WS_HY), DM, 256, 2};
      pg8::gemm_phase<pg8::EpiStore, SchedMoe, true, true, true>(lds, F.tid, DFE / 2, DFE / 2, DFE / 2, S, E, 119); }
    if (RT > RF) {
        SchedMoeSplit S2{F.bid, F.G, RF, RT, mt, (const char*)(ws + WS_P), (const char*)w_moe(ws, mi, 0, 0), (char*)(ws + WS_HY), (char*)(ws + WS_Y1)};
        pg8::gemm_phase<pg8::EpiStore, SchedMoeSplit, true, true, true>(lds, F.tid, DFE / 4, DFE / 2, DFE / 2, S2, E, 119);
    }
}
__device__ __forceinline__ void phase_next_norm(LAS unsigned char* lds, int wv, int l) {
    const Fr F = make_frame(lds, wv); const bool lastl = l == DEPTH - 1; const int nrows = lastl ? NLAT : NTOK; const int mi = l >> 1;
    const bool moe = (l & 1) != 0;
    MoeTiles mt; if (moe) mt = moe_tiles(F.ctl, mi); else {
#pragma unroll
        for (int k = 0; k < 9; ++k) mt.tb[k] = 0; }
    bf16_t* xs = (bf16_t*)(F.ws + WS_XS); bf16_t* xn = (bf16_t*)(F.ws + WS_XN);
    const bf16_t* yb = (const bf16_t*)(F.ws + WS_HY); const bf16_t* yb1 = (const bf16_t*)(F.ws + WS_Y1); const int* rec = (const int*)(F.ws + WS_MOE) + 8 * NTOK;
    const float* modv = (const float*)(F.ws + WS_MODV) + (size_t)l * 9 * 6144;
    const float* modn = modv + 9 * 6144;
    const float* n1g = ARGP(lds, I_N1G) + (lastl ? 0 : (l + 1) * DM); const float* fg = ARGP(lds, I_FINALG); float* outp = (float*)ARGP(lds, 23);
    const int lane = F.lane;
    for (int row = F.gw; row < nrows; row += F.NGW) {
        RowV x = load_row_bf16(xs + (size_t)row * DM, lane);
        if (moe) {
            const int* rc = rec + (size_t)row * 8;
            const int e0 = rc[0], p0 = rc[1], e1 = rc[3], p1 = rc[4]; const float w0 = __int_as_float(rc[2]), w1 = __int_as_float(rc[5]);
            int t0 = 0, t1 = 0;
#pragma unroll
            for (int k = 0; k < 8; ++k) { t0 = (e0 == k) ? mt.tb[k] : t0; t1 = (e1 == k) ? mt.tb[k] : t1; }
            RowV y0 = load_row_bf16(yb + (size_t)(t0 * 256 + p0) * DM, lane), y1 = load_row_bf16(yb + (size_t)(t1 * 256 + p1) * DM, lane);
            { const int rt0 = t0 + (p0 >> 8), rt1 = t1 + (p1 >> 8);
              if (rt0 >= MOE_RF) { const RowV z = load_row_bf16(yb1 + (size_t)((rt0 - MOE_RF) * 256 + (p0 & 255)) * DM, lane);
#pragma unroll
                  for (int j = 0; j < 4; ++j) y0.v[j] += z.v[j]; }
              if (rt1 >= MOE_RF) { const RowV z = load_row_bf16(yb1 + (size_t)((rt1 - MOE_RF) * 256 + (p1 & 255)) * DM, lane);
#pragma unroll
                  for (int j = 0; j < 4; ++j) y1.v[j] += z.v[j]; } }
            const RowV g2 = load_row_f32(modv + (size_t)mod_row_of(row) * 6144 + 5120, lane);
#pragma unroll
            for (int j = 0; j < 4; ++j) x.v[j] += g2.v[j] * (w0 * y0.v[j] + w1 * y1.v[j]);
            if (!lastl) store_row_bf16(xs + (size_t)row * DM, x, lane);
        }
        if (!lastl) {
            const float* mv = modn + (size_t)mod_row_of(row) * 6144;
            const RowV y = adaln_row(x, n1g, mv, mv + 1024, lane);
            const RowQ yq = quant_row_i8(y);
            store_rowq(F.ws + WS_XN8 + (size_t)row * DM, yq, lane); if (lane == 0) ((float*)(F.ws + WS_RSC1))[row] = yq.sc;
        } else {
            float ss = 0.f;
#pragma unroll
            for (int j = 0; j < 4; ++j) ss += (x.v[j][0] * x.v[j][0] + x.v[j][1] * x.v[j][1]) + (x.v[j][2] * x.v[j][2] + x.v[j][3] * x.v[j][3]);
            const float rstd = 1.0f / sqrtf(wave_sum(ss) * (1.0f / DM) + 1e-6f);
            const RowV gv = load_row_f32(fg, lane);
            RowV y;
#pragma unroll
            for (int j = 0; j < 4; ++j) y.v[j] = x.v[j] * rstd * gv.v[j];
            store_row_f32(outp + (size_t)row * DM, y, lane);
        }
    }
}

__global__ void __launch_bounds__(512, 2) mega_fwd(Args a) {
    extern __shared__ __attribute__((aligned(16))) unsigned char lds_raw[];
    LAS unsigned char* lds = (LAS unsigned char*)lds_raw;
    volatile LAS unsigned* LCTL = (volatile LAS unsigned*)(lds + LDS_CTLOFF);
    const int wv = __builtin_amdgcn_readfirstlane((int)(threadIdx.x >> 6));
    {
        const int tid = threadIdx.x;
        for (int u = tid; u < 64; u += 512) LCTL[u] = 0u;
        if (tid == 0) { LAS unsigned long long* ap = (LAS unsigned long long*)(lds + LDS_ARGOFF);
#pragma unroll
            for (int i = 0; i < 23; ++i) ap[i] = (unsigned long long)a.in[i];
            ap[23] = (unsigned long long)a.out; ap[24] = (unsigned long long)a.ws; }
        __syncthreads();
    }
    (void)xcd_barrier_post((unsigned*)(a.ws + WS_CTL) + CW_BAR, LCTL);
    phase_prologue(lds, wv);
    grid_barrier(lds, wv);
#if DUP_PRO
    phase_prologue(lds, wv);
    grid_barrier(lds, wv);
#endif
    phase_first_norm(lds, wv);
    grid_barrier(lds, wv);
    for (int l = 0; l < DEPTH; ++l) {
        phase_inproj(lds, wv, l);  grid_barrier(lds, wv);
#if DUP_INPROJ
        phase_inproj(lds, wv, l);  grid_barrier(lds, wv);
#endif
        phase_post(lds, wv, l);    grid_barrier(lds, wv);
        phase_mix(lds, wv, l, 0);  grid_barrier(lds, wv);
#if DUP_MIX
        phase_mix(lds, wv, l, 1);  grid_barrier(lds, wv);
#endif
        phase_branch(lds, wv, l);  grid_barrier(lds, wv);
#if DUP_BRANCH
        phase_branch(lds, wv, l);  grid_barrier(lds, wv);
#endif
        phase_out(lds, wv, l);     grid_barrier(lds, wv);
        if ((l & 1) == 0) {
            phase_norm2_dense(lds, wv, l); grid_barrier(lds, wv);
#if DUP_N2D
            phase_norm2_dense(lds, wv, l); grid_barrier(lds, wv);
#endif
            phase_up_dense(lds, wv, l);    grid_barrier(lds, wv);
#if DUP_UPD
            phase_up_dense(lds, wv, l);    grid_barrier(lds, wv);
#endif
            phase_down_dense(lds, wv, l);  grid_barrier(lds, wv);
        } else {
            phase_norm2_moe(lds, wv, l);   grid_barrier(lds, wv);
            phase_moe_gather(lds, wv, l);  grid_barrier(lds, wv);
#if DUP_GATH
            phase_moe_gather(lds, wv, l);  grid_barrier(lds, wv);
#endif
            phase_up_moe(lds, wv, l);      grid_barrier(lds, wv);
#if DUP_MOEG == 1
            phase_up_moe(lds, wv, l);      grid_barrier(lds, wv);
#endif
            phase_down_moe(lds, wv, l);    grid_barrier(lds, wv);
#if DUP_MOEG == 2
            phase_down_moe(lds, wv, l);    grid_barrier(lds, wv);
#endif
        }
        phase_next_norm(lds, wv, l);
        if (l != DEPTH - 1) grid_barrier(lds, wv);
    }
}

extern "C" void kernel_launch(void* const* d_in, const int* in_sizes, int n_in, void* d_out, int out_size, void* d_ws, size_t ws_size, hipStream_t stream) {
    static int grid = 0;
    if (grid == 0) {
        if (n_in != 23 || out_size != NLAT * DM || ws_size < WS_END) { fprintf(stderr, "kernel_launch: unexpected problem (n_in %d out %d ws %zu need %zu)\n", n_in, out_size, ws_size, (size_t)WS_END); grid = -1; return; }
        int dev = 0, cus = 0, per_cu = 0;
        if (hipGetDevice(&dev) != hipSuccess || hipDeviceGetAttribute(&cus, hipDeviceAttributeMultiprocessorCount, dev) != hipSuccess) { grid = -1; return; }
        if (hipFuncSetAttribute((const void*)mega_fwd, hipFuncAttributeMaxDynamicSharedMemorySize, LDS_BYTES) != hipSuccess) { fprintf(stderr, "kernel_launch: hipFuncSetAttribute failed\n"); grid = -1; return; }
        if (hipOccupancyMaxActiveBlocksPerMultiprocessor(&per_cu, (const void*)mega_fwd, 512, LDS_BYTES) != hipSuccess || per_cu < 1) { fprintf(stderr, "kernel_launch: occupancy query says %d\n", per_cu); }
        (void)hipGetLastError();
        grid = cus;
        if (grid != 256) fprintf(stderr, "kernel_launch: %d CUs (built for 256)\n", grid);
    }
    if (grid < 0) return;
    (void)hipMemsetAsync((char*)d_ws + WS_CTL, 0, CTL_ZERO_BYTES, stream);
    Args a{};
    for (int i = 0; i < 23; ++i) a.in[i] = (const float*)d_in[i];
    a.out = (float*)d_out; a.ws = (unsigned char*)d_ws;
    hipLaunchKernelGGL(mega_fwd, dim3(grid), dim3(512), LDS_BYTES, stream, a);
}
```

```cpp
#include <hip/hip_runtime.h>
#include <cstdio>
#include <cstdint>

#ifndef DUP_MIX
#define DUP_MIX 0
#endif
#ifndef DUP_PRO
#define DUP_PRO 0
#endif
#ifndef DUP_BRANCH
#define DUP_BRANCH 0
#endif
#ifndef DUP_MOEG
#define DUP_MOEG 0
#endif
#ifndef DUP_UPD
#define DUP_UPD 0
#endif
#ifndef DUP_N2D
#define DUP_N2D 0
#endif
#ifndef DUP_GATH
#define DUP_GATH 0
#endif
#ifndef DUP_INPROJ
#define DUP_INPROJ 0
#endif
#ifndef DENSE_F8_MASK
#define DENSE_F8_MASK 0
#endif
#define LAS __attribute__((address_space(3)))
#define GAS __attribute__((address_space(1)))
typedef unsigned short bf16_t;
typedef short bf16x8 __attribute__((ext_vector_type(8)));
typedef short s16x4 __attribute__((ext_vector_type(4)));
typedef float f32x4 __attribute__((ext_vector_type(4)));
typedef float f32x16 __attribute__((ext_vector_type(16)));
typedef unsigned u32x4 __attribute__((ext_vector_type(4)));
typedef unsigned u32x2 __attribute__((ext_vector_type(2)));
typedef int i32x4 __attribute__((ext_vector_type(4)));
typedef int i32x8 __attribute__((ext_vector_type(8)));

constexpr int NB = 8, SEQ = 2048, DM = 1024, DEPTH = 4, CTXL = 256;
constexpr int NLAT = NB * SEQ, NCTX = NB * CTXL, NTOK = NLAT + NCTX;
constexpr int DIN = 7680, PW = 3072, GW = 4096;
constexpr int C_AQ = 0, C_AK = 512, C_AV = 1024, C_BQ = 1536, C_BK = 2048, C_BV = 2176, C_CQ = 2304, C_CK = 2816, C_CV = 2944;
constexpr int DFF = 2816, DFE = 3584, NEXP = 8;
constexpr int OW = 2048;
constexpr int MAXSLOT = 2 * NTOK + 2048;
constexpr float C2 = 0.125f * 1.4426950408889634f;
constexpr float LOG2E = 1.4426950408889634f;

constexpr size_t MiB = 1u << 20;
constexpr size_t WS_CTL = 0, CTL_ZERO_BYTES = 1 * MiB;
constexpr size_t WS_MODV = 1 * MiB;
constexpr size_t WS_ROPE = 2 * MiB;
constexpr size_t WS_T256 = 3 * MiB;
constexpr size_t WS_MOE = 4 * MiB;
constexpr size_t WS_SSC = WS_MOE + 3 * MiB / 2;
constexpr size_t WS_RSC = WS_MOE + 7 * MiB / 4;
constexpr size_t WS_RSC1 = WS_MOE + 15 * MiB / 8;
constexpr size_t WS_T = 6 * MiB;
constexpr size_t WS_W = 22 * MiB;
constexpr size_t W_IN = 0, W_ING8 = 6 * MiB  , W_FZ = 14 * MiB, W_BR = 16 * MiB, W_OUT = 20 * MiB, W_LAYER = 22 * MiB;
constexpr size_t W_DENSE0 = 4 * W_LAYER, W_DGU = 0, W_DD = 11 * MiB, W_DENSE = 33 * MiB / 2;
constexpr size_t W_MOE0 = W_DENSE0 + 2 * W_DENSE, W_MGU = 0, W_MD = 14 * MiB, W_EXPERT = 21 * MiB, W_MOE = 8 * W_EXPERT;
constexpr size_t WS_XS = WS_W + W_MOE0 + 2 * W_MOE;
constexpr size_t WS_XN8 = WS_XS + 36 * MiB;
constexpr size_t WS_XN = WS_XS + 72 * MiB;
constexpr size_t WS_P = WS_XN + 36 * MiB;
constexpr size_t WS_G = WS_P + 108 * MiB;
constexpr size_t WS_ZZ = WS_P + 252 * MiB;
constexpr size_t WS_ZZC = WS_ZZ + 32 * MiB;
constexpr size_t WS_O = WS_ZZC + 4 * MiB;
constexpr size_t WS_HY = WS_O + 72 * MiB;
constexpr size_t WS_Y1 = WS_HY + 76 * MiB;
constexpr size_t WS_END = WS_Y1 + 16 * MiB;
constexpr int MOE_RF = 128;
static_assert(WS_W + W_MOE0 + 2 * W_MOE == 479 * MiB, "weights");
static_assert((size_t)MAXSLOT * DFE * 2 <= 288 * MiB, "moe hidden fits p+zz");
static_assert((size_t)MAXSLOT * 1024 * 2 <= 76 * MiB, "hs fits");
static_assert(WS_END <= 1074 * MiB, "workspace");

constexpr int CW_BAR = 4096;
constexpr int CW_Q = 16384;
constexpr int CW_CNT = 24576;

constexpr int LDS_CTLOFF = 141312;
constexpr int LDS_BYTES = 147456;

typedef float f32x2_t __attribute__((ext_vector_type(2))); typedef __bf16 bf16x2_t __attribute__((ext_vector_type(2)));
__device__ __forceinline__ unsigned cvt_pk_bf16(float lo, float hi) { f32x2_t v = {lo, hi}; bf16x2_t b = __builtin_convertvector(v, bf16x2_t); return __builtin_bit_cast(unsigned, b); }
__device__ __forceinline__ float clamp_f8(float v) { return __builtin_amdgcn_fmed3f(v, -448.0f, 448.0f); }
__device__ __forceinline__ unsigned cvt4_fp8(float a, float b, float c, float d) { int w = 0; w = __builtin_amdgcn_cvt_pk_fp8_f32(clamp_f8(a), clamp_f8(b), w, false); w = __builtin_amdgcn_cvt_pk_fp8_f32(clamp_f8(c), clamp_f8(d), w, true); return (unsigned)w; }
__device__ __forceinline__ unsigned pack4_i8(float a, float b, float c, float d) {
    const int ia = (int)__builtin_rintf(__builtin_amdgcn_fmed3f(a, -127.0f, 127.0f)), ib = (int)__builtin_rintf(__builtin_amdgcn_fmed3f(b, -127.0f, 127.0f));
    const int ic = (int)__builtin_rintf(__builtin_amdgcn_fmed3f(c, -127.0f, 127.0f)), id = (int)__builtin_rintf(__builtin_amdgcn_fmed3f(d, -127.0f, 127.0f));
    return ((unsigned)ia & 255u) | (((unsigned)ib & 255u) << 8) | (((unsigned)ic & 255u) << 16) | ((unsigned)id << 24); }
constexpr float W8_GU = 127.0f * 32.0f / 4.5f;
constexpr float ZZ8 = 127.0f / 40.0f;
constexpr float W8_FZ = 127.0f / 1.125f;
__device__ __forceinline__ float bf_lo(unsigned w) { return __uint_as_float(w << 16); }
__device__ __forceinline__ float bf_hi(unsigned w) { return __uint_as_float(w & 0xffff0000u); }
__device__ __forceinline__ float bf2f(bf16_t h) { return __uint_as_float(((unsigned)h) << 16); }
__device__ __forceinline__ bf16_t f2bf(float f) { unsigned u = __float_as_uint(f); u += 0x7fffu + ((u >> 16) & 1u); return (bf16_t)(u >> 16); }
__device__ __forceinline__ float fast_exp2(float x) { return __builtin_amdgcn_exp2f(x); }
__device__ __forceinline__ float fast_rcp(float x) { return __builtin_amdgcn_rcpf(x); }
__device__ __forceinline__ float sigmoidf_(float x) { return fast_rcp(1.0f + fast_exp2(-x * LOG2E)); }
__device__ __forceinline__ float siluf_(float x) { return x * sigmoidf_(x); }
__device__ __forceinline__ float wave_sum(float v) {
#pragma unroll
    for (int o = 1; o < 64; o <<= 1) v += __shfl_xor(v, o);
    return v;
}
#define LDS_WAIT() asm volatile("s_waitcnt lgkmcnt(0)" ::: "memory")
__device__ __forceinline__ int lane_id() { int l; asm volatile("v_mbcnt_lo_u32_b32 %0, -1, 0\n\tv_mbcnt_hi_u32_b32 %0, -1, %0" : "=v"(l)); return l; }

namespace pg8 {
constexpr int BM = 256, BK = 64, HALF = 128, HTB = HALF * BK * 2, STAGE_BYTES = 8 * HTB, NXCD = 8, WGM = 8;
__host__ __device__ __forceinline__ int lds_byte(int r, int c) { const int st = (r >> 4) * 2 + (c >> 5), rr = r & 15, cc = c & 31, ob = rr * 64 + cc * 2; return st * 1024 + (ob ^ (((ob >> 9) & 1) << 5)); }
__host__ __device__ __forceinline__ void stage_rc(int b, int& R, int& C) { const int st = b / 1024, sb = b % 1024, swz = sb ^ (((sb >> 9) & 1) << 5); R = (st >> 1) * 16 + swz / 64; C = (st & 1) * 32 + (swz % 64) / 2; }
__host__ __device__ __forceinline__ int perm32(int rho) { const int n = rho >> 4, i = rho & 15; return 8 * (i >> 2) + 4 * n + (i & 3); }

struct Unit { const char* A; const char* B; char* out; const char* aux; const char* aux2; int ldc; int flag; };

__device__ __forceinline__ void tile_of(int L, int nM, int nN, int& pm, int& pn) {
    const int nwg = nM * nN; int wgid = L;
    { const int q = nwg / NXCD, r = nwg % NXCD, xcd = wgid % NXCD, off = wgid / NXCD; wgid = (xcd < r ? xcd * (q + 1) : r * (q + 1) + (xcd - r) * q) + off; }
    const int nig = WGM * nN, gid = wgid / nig, fm = gid * WGM, gsz = (nM - fm) < WGM ? (nM - fm) : WGM;
    pm = fm + ((wgid % nig) % gsz); pn = (wgid % nig) / gsz;
}

__device__ __forceinline__ i32x8 cat8(const bf16x8 a, const bf16x8 b) { return __builtin_shufflevector(__builtin_bit_cast(i32x4, a), __builtin_bit_cast(i32x4, b), 0, 1, 2, 3, 4, 5, 6, 7); }
template <class Epi, class Sched, bool ALIGN_EPI, bool SP2, int QM = 0>
__device__ __forceinline__ void gemm_phase(LAS unsigned char* lds, const int tid, const int K, const int lda, const int ldb, const Sched& S, const Epi& E, const int wsc = 127) {
    const int wid = __builtin_amdgcn_readfirstlane(tid >> 6), lane = tid & 63, wr = wid >> 2, wc = wid & 3, fr = lane & 15, fq = lane >> 4;
    const int nt = K / BK;
    unsigned voffA[2], voffB[2];
#pragma unroll
    for (int i = 0; i < 2; ++i) { int R, C; stage_rc(tid * 16 + i * 8192, R, C); const int Rb = Epi::PERM ? ((R & ~31) + perm32(R & 31)) : R;
        voffA[i] = (unsigned)(R * lda + C) * 2u; voffB[i] = (unsigned)(Rb * ldb + C) * 2u; }
    const size_t kstep = (size_t)(BK * 2);
    const size_t hstepA = (size_t)HALF * lda * 2, hstepB = (size_t)HALF * ldb * 2;
    const unsigned ldsw = (unsigned)wid * 1024u;
    const int aoff = lds_byte(wr * 64 + fr, fq * 8), boff = lds_byte(wc * 32 + fr, fq * 8);
#define PG8_SA(b, h) (((b) * 2 + (h)) * HTB)
#define PG8_SB(b, h) ((4 + (b) * 2 + (h)) * HTB)
#define PG8_STAGE(bufoff, gbase, voff) do { _Pragma("unroll") for (int _i = 0; _i < 2; ++_i) \
        __builtin_amdgcn_global_load_lds((const unsigned*)((const char*)(gbase) + (voff)[_i]), (LAS unsigned*)(lds + (bufoff) + ldsw + _i * 8192), 16, 0, 0); } while (0)
#define PG8_LDA(dst, b, h) do { _Pragma("unroll") for (int m = 0; m < 4; ++m) _Pragma("unroll") for (int k = 0; k < 2; ++k) dst[m][k] = *(const LAS bf16x8*)(lds + PG8_SA(b, h) + aoff + m * 2048 + k * 1024); } while (0)
#define PG8_LDB(dst, b, h) do { _Pragma("unroll") for (int n = 0; n < 2; ++n) _Pragma("unroll") for (int k = 0; k < 2; ++k) dst[n][k] = *(const LAS bf16x8*)(lds + PG8_SB(b, h) + boff + n * 2048 + k * 1024); } while (0)
#define PG8_MMA(ai, bj, At, Bt) do { __builtin_amdgcn_s_setprio(1); _Pragma("unroll") for (int m = 0; m < 4; ++m) _Pragma("unroll") for (int n = 0; n < 2; ++n) { \
        if constexpr (QM == 2) { _Pragma("unroll") for (int k = 0; k < 2; ++k) acc[ai][bj][m][n] = __builtin_bit_cast(f32x4, __builtin_amdgcn_mfma_i32_16x16x64_i8(__builtin_bit_cast(i32x4, Bt[n][k]), __builtin_bit_cast(i32x4, At[m][k]), __builtin_bit_cast(i32x4, acc[ai][bj][m][n]), 0, 0, 0)); \
            asm volatile("" : "+v"(acc[ai][bj][m][n])); } \
        else if constexpr (QM == 1) { acc[ai][bj][m][n] = __builtin_amdgcn_mfma_scale_f32_16x16x128_f8f6f4(cat8(Bt[n][0], Bt[n][1]), cat8(At[m][0], At[m][1]), acc[ai][bj][m][n], 0, 0, 0, wsc, 0, 127); \
            asm volatile("" : "+v"(acc[ai][bj][m][n]));   } \
        else { _Pragma("unroll") for (int k = 0; k < 2; ++k) acc[ai][bj][m][n] = __builtin_amdgcn_mfma_f32_16x16x32_bf16(Bt[n][k], At[m][k], acc[ai][bj][m][n], 0, 0, 0); } } __builtin_amdgcn_s_setprio(0); } while (0)
#define PG8_WAIT_V(n) asm volatile("s_waitcnt vmcnt(" #n ")" ::: "memory")
#define PG8_WAIT_L(n) asm volatile("s_waitcnt lgkmcnt(" #n ")" ::: "memory")
#define PG8_BAR __builtin_amdgcn_s_barrier()
#define PG8_SCHED __builtin_amdgcn_sched_barrier(0)
    Unit cur, nxt; int ui = 0;
    if (!S.next(0, cur)) return;
    f32x4 acc[2][2][4][2];
#pragma unroll
    for (int a = 0; a < 2; ++a)
#pragma unroll
        for (int b = 0; b < 2; ++b)
#pragma unroll
            for (int m = 0; m < 4; ++m)
#pragma unroll
                for (int n = 0; n < 2; ++n) acc[a][b][m][n] = (f32x4){0.f, 0.f, 0.f, 0.f};
    bf16x8 At[4][2], B0[2][2], B1[2][2];
    const char* cA = cur.A; const char* cB = cur.B;
    if constexpr (SP2) {
        PG8_STAGE(PG8_SB(0, 0), cB, voffB); PG8_STAGE(PG8_SB(0, 1), cB + hstepB, voffB); PG8_STAGE(PG8_SA(0, 0), cA, voffA); PG8_STAGE(PG8_SA(0, 1), cA + hstepA, voffA);
        if (wr == 1) PG8_BAR;
        PG8_WAIT_V(2); PG8_BAR;
        PG8_STAGE(PG8_SB(1, 0), cB + kstep, voffB); PG8_STAGE(PG8_SA(1, 0), cA + kstep, voffA); PG8_STAGE(PG8_SB(1, 1), cB + hstepB + kstep, voffB);
        PG8_WAIT_V(6); PG8_BAR;
    } else {
        PG8_STAGE(PG8_SB(0, 0), cB, voffB); PG8_STAGE(PG8_SA(0, 0), cA, voffA); PG8_STAGE(PG8_SB(0, 1), cB + hstepB, voffB); PG8_STAGE(PG8_SA(0, 1), cA + hstepA, voffA);
        if (wr == 1) PG8_BAR;
        PG8_WAIT_V(4); PG8_BAR;
        PG8_STAGE(PG8_SB(1, 0), cB + kstep, voffB); PG8_STAGE(PG8_SA(1, 0), cA + kstep, voffA); PG8_STAGE(PG8_SB(1, 1), cB + hstepB + kstep, voffB);
        PG8_WAIT_V(6); PG8_BAR;
    }
    for (;;) {
        const bool has_next = S.next(ui + 1, nxt);
        const char* nA = has_next ? nxt.A : cA; const char* nB = has_next ? nxt.B : cB;
        { unsigned long long pa = (unsigned long long)nA, pb = (unsigned long long)nB;
          pa = ((unsigned long long)(unsigned)__builtin_amdgcn_readfirstlane((int)(pa >> 32)) << 32) | (unsigned)__builtin_amdgcn_readfirstlane((int)pa);
          pb = ((unsigned long long)(unsigned)__builtin_amdgcn_readfirstlane((int)(pb >> 32)) << 32) | (unsigned)__builtin_amdgcn_readfirstlane((int)pb);
          asm volatile("" : "+s"(pa), "+s"(pb)); nA = (const char*)pa; nB = (const char*)pb; }
        for (int t = 0; t < nt; t += 2) {
            const bool last = (t == nt - 2);
            const char* a1 = cA + (size_t)(t + 1) * kstep;
            const char* a2 = last ? nA : cA + (size_t)(t + 2) * kstep; const char* b2 = last ? nB : cB + (size_t)(t + 2) * kstep;
            const char* a3 = a2 + kstep; const char* b3 = b2 + kstep;
            if constexpr (SP2) {
            PG8_LDB(B0, 0, 0); PG8_LDB(B1, 0, 1); PG8_SCHED; PG8_LDA(At, 0, 0); PG8_STAGE(PG8_SA(1, 1), a1 + hstepA, voffA);
            PG8_WAIT_V(8); PG8_WAIT_L(0); PG8_BAR; PG8_MMA(0, 0, At, B0); PG8_MMA(0, 1, At, B1); PG8_BAR; PG8_SCHED;
            PG8_LDA(At, 0, 1); PG8_STAGE(PG8_SB(0, 0), b2, voffB); PG8_STAGE(PG8_SB(0, 1), b2 + hstepB, voffB); PG8_STAGE(PG8_SA(0, 0), a2, voffA);
            PG8_WAIT_V(8); PG8_WAIT_L(0); PG8_BAR; PG8_MMA(1, 0, At, B0); PG8_MMA(1, 1, At, B1); PG8_BAR; PG8_SCHED;
            PG8_LDB(B0, 1, 0); PG8_LDB(B1, 1, 1); PG8_SCHED; PG8_LDA(At, 1, 0); PG8_STAGE(PG8_SA(0, 1), a2 + hstepA, voffA);
            PG8_WAIT_V(8); PG8_WAIT_L(0); PG8_BAR; PG8_MMA(0, 0, At, B0); PG8_MMA(0, 1, At, B1); PG8_BAR; PG8_SCHED;
            PG8_LDA(At, 1, 1); PG8_STAGE(PG8_SB(1, 0), b3, voffB); PG8_STAGE(PG8_SB(1, 1), b3 + hstepB, voffB); PG8_STAGE(PG8_SA(1, 0), a3, voffA);
            PG8_WAIT_V(8); PG8_WAIT_L(0); PG8_BAR; PG8_MMA(1, 0, At, B0); PG8_MMA(1, 1, At, B1); PG8_BAR; PG8_SCHED;
            } else {
            PG8_LDB(B0, 0, 0); PG8_SCHED; PG8_LDA(At, 0, 0); PG8_STAGE(PG8_SA(1, 1), a1 + hstepA, voffA);
            PG8_WAIT_L(8); PG8_BAR; PG8_WAIT_L(0); PG8_MMA(0, 0, At, B0); PG8_BAR; PG8_SCHED;
            PG8_LDB(B1, 0, 1); PG8_STAGE(PG8_SB(0, 0), b2, voffB);
            PG8_BAR; PG8_WAIT_L(0); PG8_MMA(0, 1, At, B1); PG8_BAR;
            PG8_LDA(At, 0, 1); PG8_STAGE(PG8_SA(0, 0), a2, voffA);
            PG8_BAR; PG8_WAIT_L(0); PG8_MMA(1, 0, At, B0); PG8_BAR; PG8_SCHED;
            PG8_STAGE(PG8_SB(0, 1), b2 + hstepB, voffB);
            PG8_WAIT_V(6); PG8_BAR; PG8_MMA(1, 1, At, B1); PG8_BAR;
            PG8_LDB(B0, 1, 0); PG8_SCHED; PG8_LDA(At, 1, 0); PG8_STAGE(PG8_SA(0, 1), a2 + hstepA, voffA);
            PG8_WAIT_L(8); PG8_BAR; PG8_WAIT_L(0); PG8_MMA(0, 0, At, B0); PG8_BAR; PG8_SCHED;
            PG8_LDB(B1, 1, 1); PG8_STAGE(PG8_SB(1, 0), b3, voffB);
            PG8_BAR; PG8_WAIT_L(0); PG8_MMA(0, 1, At, B1); PG8_BAR;
            PG8_LDA(At, 1, 1); PG8_STAGE(PG8_SA(1, 0), a3, voffA);
            PG8_BAR; PG8_WAIT_L(0); PG8_MMA(1, 0, At, B0); PG8_BAR; PG8_SCHED;
            PG8_STAGE(PG8_SB(1, 1), b3 + hstepB, voffB);
            PG8_WAIT_V(6); PG8_BAR; PG8_MMA(1, 1, At, B1); PG8_BAR;
            }
        }
        if constexpr (ALIGN_EPI) { if (wr == 0) PG8_BAR; }
        { int fr2 = fr, fq2 = fq; asm volatile("" : "+v"(fr2), "+v"(fq2));
          E(acc, cur, wr, wc, fr2, fq2); }
        if (!has_next) break;
#pragma unroll
        for (int a = 0; a < 2; ++a)
#pragma unroll
            for (int b = 0; b < 2; ++b)
#pragma unroll
                for (int m = 0; m < 4; ++m)
#pragma unroll
                    for (int n = 0; n < 2; ++n) acc[a][b][m][n] = (f32x4){0.f, 0.f, 0.f, 0.f};
        cur = nxt; cA = nA; cB = nB; ++ui;
        if constexpr (ALIGN_EPI) { if (wr == 1) PG8_BAR; }
    }
    PG8_WAIT_V(0);
    if constexpr (!ALIGN_EPI) { if (wr == 0) PG8_BAR; }
    PG8_BAR;
#undef PG8_SA
#undef PG8_SB
#undef PG8_STAGE
#undef PG8_LDA
#undef PG8_LDB
#undef PG8_MMA
#undef PG8_WAIT_V
#undef PG8_WAIT_L
#undef PG8_BAR
#undef PG8_SCHED
}

struct EpiStoreI8 {
    static constexpr bool PERM = true;
    float scale;
    __device__ __forceinline__ void operator()(const f32x4 (&acc)[2][2][4][2], const Unit& u, int wr, int wc, int fr, int fq) const {
        bf16_t* base = (bf16_t*)u.out + (size_t)(wr * 64 + fr) * u.ldc + wc * 32 + 8 * fq;
#pragma unroll
        for (int ai = 0; ai < 2; ++ai)
#pragma unroll
            for (int m = 0; m < 4; ++m) { bf16_t* rowp = base + (size_t)(ai * HALF + m * 16) * u.ldc;
#pragma unroll
                for (int bj = 0; bj < 2; ++bj) { const i32x4 i0 = __builtin_bit_cast(i32x4, acc[ai][bj][m][0]), i1 = __builtin_bit_cast(i32x4, acc[ai][bj][m][1]);
                    f32x4 v0, v1;
#pragma unroll
                    for (int j = 0; j < 4; ++j) { v0[j] = (float)i0[j] * scale; v1[j] = (float)i1[j] * scale; }
                    u32x4 w; w.x = cvt_pk_bf16(v0[0], v0[1]); w.y = cvt_pk_bf16(v0[2], v0[3]); w.z = cvt_pk_bf16(v1[0], v1[1]); w.w = cvt_pk_bf16(v1[2], v1[3]);
                    *(u32x4*)(rowp + bj * HALF) = w; } }
    }
};
struct EpiStore {
    static constexpr bool PERM = true;
    float scale;
    __device__ __forceinline__ void operator()(const f32x4 (&acc)[2][2][4][2], const Unit& u, int wr, int wc, int fr, int fq) const {
        bf16_t* base = (bf16_t*)u.out + (size_t)(wr * 64 + fr) * u.ldc + wc * 32 + 8 * fq;
        const bool sg = u.flag == 1;
#pragma unroll
        for (int ai = 0; ai < 2; ++ai)
#pragma unroll
            for (int m = 0; m < 4; ++m) { bf16_t* rowp = base + (size_t)(ai * HALF + m * 16) * u.ldc;
#pragma unroll
                for (int bj = 0; bj < 2; ++bj) { f32x4 v0 = acc[ai][bj][m][0] * scale, v1 = acc[ai][bj][m][1] * scale;
                    if (sg) {
#pragma unroll
                        for (int j = 0; j < 4; ++j) { v0[j] = sigmoidf_(v0[j]); v1[j] = sigmoidf_(v1[j]); } }
                    u32x4 w; w.x = cvt_pk_bf16(v0[0], v0[1]); w.y = cvt_pk_bf16(v0[2], v0[3]); w.z = cvt_pk_bf16(v1[0], v1[1]); w.w = cvt_pk_bf16(v1[2], v1[3]);
                    *(u32x4*)(rowp + bj * HALF) = w; } }
    }
};
struct EpiInproj {
    static constexpr bool PERM = true;
    __device__ __forceinline__ void operator()(const f32x4 (&acc)[2][2][4][2], const Unit& u, int wr, int wc, int fr, int fq) const {
        GAS bf16_t* base = (GAS bf16_t*)u.out + (size_t)(wr * 64 + fr) * u.ldc + wc * 32 + 8 * fq;
        const bool sg = (u.flag & 1) != 0, lat = (u.flag & 16) != 0, r0 = lat && (u.flag & 6) != 0, r1 = lat && (u.flag & 2) != 0, fzt = (u.flag & 32) != 0;
        const float qs = (u.flag & 8) ? C2 : 1.0f;
        const GAS float* rp = (const GAS float*)u.aux + (size_t)(wr * 64 + fr) * 64 + (wc & 1) * 32 + 4 * fq;
        const GAS float* sp = (const GAS float*)u.aux2;
        float rsv[8]; f32x4 csv[2][2];
        if (fzt) {
#pragma unroll
            for (int bj = 0; bj < 2; ++bj) { csv[bj][0] = *(const GAS f32x4*)(sp + bj * HALF + wc * 32 + 8 * fq) * (1.0f / W8_FZ); csv[bj][1] = *(const GAS f32x4*)(sp + bj * HALF + wc * 32 + 8 * fq + 4) * (1.0f / W8_FZ); }
#pragma unroll
            for (int q = 0; q < 8; ++q) rsv[q] = 1.0f;
        } else {
#pragma unroll
            for (int q = 0; q < 8; ++q) rsv[q] = sp[wr * 64 + fr + (q >> 2) * HALF + (q & 3) * 16] * (1.0f / W8_GU);
#pragma unroll
            for (int bj = 0; bj < 2; ++bj) { csv[bj][0] = (f32x4){1.f, 1.f, 1.f, 1.f}; csv[bj][1] = (f32x4){1.f, 1.f, 1.f, 1.f}; }
        }
#pragma unroll
        for (int ai = 0; ai < 2; ++ai)
#pragma unroll
            for (int m = 0; m < 4; ++m) { GAS bf16_t* rowp = base + (size_t)(ai * HALF + m * 16) * u.ldc; const float rf = rsv[ai * 4 + m];
                f32x4 cs = (f32x4){1.f, 1.f, 1.f, 1.f}, sn = (f32x4){0.f, 0.f, 0.f, 0.f};
                if (r0) { const GAS float* rt = rp + (size_t)(ai * HALF + m * 16) * 64; cs = *(const GAS f32x4*)rt; sn = *(const GAS f32x4*)(rt + 16); }
#pragma unroll
                for (int bj = 0; bj < 2; ++bj) { const i32x4 i0 = __builtin_bit_cast(i32x4, acc[ai][bj][m][0]), i1 = __builtin_bit_cast(i32x4, acc[ai][bj][m][1]);
                    f32x4 v0, v1;
#pragma unroll
                    for (int j = 0; j < 4; ++j) { v0[j] = (float)i0[j] * rf; v1[j] = (float)i1[j] * rf; }
                    v0 *= csv[bj][0]; v1 *= csv[bj][1];
                    if (fzt) {
                        u32x2 w8; w8.x = pack4_i8(v0[0] * ZZ8, v0[1] * ZZ8, v0[2] * ZZ8, v0[3] * ZZ8); w8.y = pack4_i8(v1[0] * ZZ8, v1[1] * ZZ8, v1[2] * ZZ8, v1[3] * ZZ8);
                        *(GAS u32x2*)((GAS unsigned char*)u.out + (size_t)(wr * 64 + fr + ai * HALF + m * 16) * u.ldc + wc * 32 + 8 * fq + bj * HALF) = w8;
                    } else if (sg) {
                        unsigned q[8];
#pragma unroll
                        for (int j = 0; j < 4; ++j) { q[j] = (unsigned)(fast_rcp(1.0f + fast_exp2(v0[j])) * 255.0f + 0.5f); q[4 + j] = (unsigned)(fast_rcp(1.0f + fast_exp2(v1[j])) * 255.0f + 0.5f); }
                        u32x2 w8; w8.x = q[0] | (q[1] << 8) | (q[2] << 16) | (q[3] << 24); w8.y = q[4] | (q[5] << 8) | (q[6] << 16) | (q[7] << 24);
                        *(GAS u32x2*)((GAS unsigned char*)u.out + (size_t)(wr * 64 + fr + ai * HALF + m * 16) * GW + wc * 32 + 8 * fq + bj * HALF) = w8;
                    } else {
                    if (bj == 0 ? r0 : r1) {
                        const float a0 = v0[0] * cs[0] - v0[1] * sn[0], a1 = v0[1] * cs[0] + v0[0] * sn[0], a2 = v0[2] * cs[1] - v0[3] * sn[1], a3 = v0[3] * cs[1] + v0[2] * sn[1];
                        const float b0 = v1[0] * cs[2] - v1[1] * sn[2], b1 = v1[1] * cs[2] + v1[0] * sn[2], b2 = v1[2] * cs[3] - v1[3] * sn[3], b3 = v1[3] * cs[3] + v1[2] * sn[3];
                        v0 = (f32x4){a0, a1, a2, a3}; v1 = (f32x4){b0, b1, b2, b3}; }
                    v0 *= qs; v1 *= qs;
                    u32x4 w; w.x = cvt_pk_bf16(v0[0], v0[1]); w.y = cvt_pk_bf16(v0[2], v0[3]); w.z = cvt_pk_bf16(v1[0], v1[1]); w.w = cvt_pk_bf16(v1[2], v1[3]);
                    *(GAS u32x4*)(rowp + bj * HALF) = w; } } }
    }
};
struct EpiSwiglu {
    static constexpr bool PERM = true;
    __device__ __forceinline__ void operator()(const f32x4 (&acc)[2][2][4][2], const Unit& u, int wr, int wc, int fr, int fq) const {
        bf16_t* base = (bf16_t*)u.out + (size_t)(wr * 64 + fr) * u.ldc + wc * 32 + 8 * fq;
#pragma unroll
        for (int ai = 0; ai < 2; ++ai)
#pragma unroll
            for (int m = 0; m < 4; ++m) { bf16_t* rowp = base + (size_t)(ai * HALF + m * 16) * u.ldc;
                f32x4 g0 = acc[ai][0][m][0], g1 = acc[ai][0][m][1]; const f32x4 u0 = acc[ai][1][m][0], u1 = acc[ai][1][m][1];
#pragma unroll
                for (int j = 0; j < 4; ++j) { g0[j] = siluf_(g0[j]) * u0[j]; g1[j] = siluf_(g1[j]) * u1[j]; }
                u32x4 w; w.x = cvt_pk_bf16(g0[0], g0[1]); w.y = cvt_pk_bf16(g0[2], g0[3]); w.z = cvt_pk_bf16(g1[0], g1[1]); w.w = cvt_pk_bf16(g1[2], g1[3]);
                *(u32x4*)rowp = w; }
    }
};
struct EpiSwigluF8 {
    static constexpr bool PERM = true;
    __device__ __forceinline__ void operator()(const f32x4 (&acc)[2][2][4][2], const Unit& u, int wr, int wc, int fr, int fq) const {
        GAS unsigned char* base = (GAS unsigned char*)u.out + (size_t)(wr * 64 + fr) * u.ldc + wc * 32 + 8 * fq;
#pragma unroll
        for (int ai = 0; ai < 2; ++ai)
#pragma unroll
            for (int m = 0; m < 4; ++m) { GAS unsigned char* rowp = base + (size_t)(ai * HALF + m * 16) * u.ldc;
                f32x4 g0 = acc[ai][0][m][0], g1 = acc[ai][0][m][1]; const f32x4 u0 = acc[ai][1][m][0], u1 = acc[ai][1][m][1];
#pragma unroll
                for (int j = 0; j < 4; ++j) { g0[j] = siluf_(g0[j]) * u0[j]; g1[j] = siluf_(g1[j]) * u1[j]; }
                u32x2 w; w.x = cvt4_fp8(g0[0], g0[1], g0[2], g0[3]); w.y = cvt4_fp8(g1[0], g1[1], g1[2], g1[3]);
                *(GAS u32x2*)rowp = w; }
    }
};
template <bool F8OUT> struct EpiSwigluI8 {
    static constexpr bool PERM = true;
    float wsc;
    __device__ __forceinline__ void operator()(const f32x4 (&acc)[2][2][4][2], const Unit& u, int wr, int wc, int fr, int fq) const {
        constexpr int EB = F8OUT ? 1 : 2;
        GAS unsigned char* base = (GAS unsigned char*)u.out + ((size_t)(wr * 64 + fr) * u.ldc + wc * 32 + 8 * fq) * EB;
        const GAS float* rs = (const GAS float*)u.aux + wr * 64 + fr;
        float sc[8];
#pragma unroll
        for (int q = 0; q < 8; ++q) sc[q] = rs[(q >> 2) * HALF + (q & 3) * 16] * wsc;
#pragma unroll
        for (int ai = 0; ai < 2; ++ai)
#pragma unroll
            for (int m = 0; m < 4; ++m) { GAS unsigned char* rowp = base + (size_t)(ai * HALF + m * 16) * u.ldc * EB; const float f = sc[ai * 4 + m];
                const i32x4 gi0 = __builtin_bit_cast(i32x4, acc[ai][0][m][0]), gi1 = __builtin_bit_cast(i32x4, acc[ai][0][m][1]), ui0 = __builtin_bit_cast(i32x4, acc[ai][1][m][0]), ui1 = __builtin_bit_cast(i32x4, acc[ai][1][m][1]);
                f32x4 g0, g1;
#pragma unroll
                for (int j = 0; j < 4; ++j) { const float a = (float)gi0[j] * f, b = (float)gi1[j] * f; g0[j] = siluf_(a) * ((float)ui0[j] * f); g1[j] = siluf_(b) * ((float)ui1[j] * f); }
                if constexpr (F8OUT) { u32x2 w; w.x = cvt4_fp8(g0[0], g0[1], g0[2], g0[3]); w.y = cvt4_fp8(g1[0], g1[1], g1[2], g1[3]); *(GAS u32x2*)rowp = w; }
                else { u32x4 w; w.x = cvt_pk_bf16(g0[0], g0[1]); w.y = cvt_pk_bf16(g0[2], g0[3]); w.z = cvt_pk_bf16(g1[0], g1[1]); w.w = cvt_pk_bf16(g1[2], g1[3]); *(GAS u32x4*)rowp = w; } }
    }
};
struct EpiResid {
    static constexpr bool PERM = true;
    __device__ __forceinline__ void operator()(const f32x4 (&acc)[2][2][4][2], const Unit& u, int wr, int wc, int fr, int fq) const {
        GAS bf16_t* base = (GAS bf16_t*)u.out + (size_t)(wr * 64 + fr) * u.ldc + wc * 32 + 8 * fq;
        const size_t roff = (size_t)(wr * 64 + fr) * u.ldc + wc * 32 + 8 * fq;
        const bool srcf = u.flag == 1;
        const GAS float* g = (const GAS float*)u.aux + wc * 32 + 8 * fq;
        f32x4 gv[2][2];
#pragma unroll
        for (int bj = 0; bj < 2; ++bj)
#pragma unroll
            for (int n = 0; n < 2; ++n) gv[bj][n] = *(const GAS f32x4*)(g + bj * HALF + n * 4);
#pragma unroll
        for (int ai = 0; ai < 2; ++ai)
#pragma unroll
            for (int m = 0; m < 4; ++m) { const size_t ro = (size_t)(ai * HALF + m * 16) * u.ldc;
#pragma unroll
                for (int bj = 0; bj < 2; ++bj) {
                    f32x4 r0, r1;
                    if (srcf) { const GAS float* sp = (const GAS float*)u.aux2 + roff + ro + bj * HALF; r0 = *(const GAS f32x4*)sp; r1 = *(const GAS f32x4*)(sp + 4); }
                    else { const u32x4 w = *(const GAS u32x4*)((const GAS bf16_t*)u.aux2 + roff + ro + bj * HALF);
                        r0 = (f32x4){bf_lo(w.x), bf_hi(w.x), bf_lo(w.y), bf_hi(w.y)}; r1 = (f32x4){bf_lo(w.z), bf_hi(w.z), bf_lo(w.w), bf_hi(w.w)}; }
                    const f32x4 v0 = r0 + gv[bj][0] * acc[ai][bj][m][0], v1 = r1 + gv[bj][1] * acc[ai][bj][m][1];
                    u32x4 o; o.x = cvt_pk_bf16(v0[0], v0[1]); o.y = cvt_pk_bf16(v0[2], v0[3]); o.z = cvt_pk_bf16(v1[0], v1[1]); o.w = cvt_pk_bf16(v1[2], v1[3]);
                    *(GAS u32x4*)(base + ro + bj * HALF) = o; }
                asm volatile("" ::: "memory"); }
    }
};
struct BUnit { const char* A; const char* B; const char* gate; char* out; };
__device__ __forceinline__ void gload8_async(u32x2& dst, const void* p) { asm volatile("global_load_dwordx2 %0, %1, off" : "=&v"(dst) : "v"(p) : "memory"); }
template <class Sched>
__device__ __forceinline__ void branch_phase(LAS unsigned char* lds, const int tid, const Sched& S) {
    const int wid = __builtin_amdgcn_readfirstlane(tid >> 6), lane = tid & 63, wr = wid >> 2, wc = wid & 3, fr = lane & 15, fq = lane >> 4;
    constexpr int K = 2048, nt = K / BK, lda = 2048, ldb = 2048;
    unsigned voffA[2], voffB[2];
#pragma unroll
    for (int i = 0; i < 2; ++i) { int R, C; stage_rc(tid * 16 + i * 8192, R, C); const int Rb = (R & ~31) + perm32(R & 31);
        voffA[i] = (unsigned)(R * lda + C) * 2u; voffB[i] = (unsigned)(Rb * ldb + C) * 2u; }
    const size_t kstep = (size_t)(BK * 2);
    const size_t hstepA = (size_t)HALF * lda * 2;
    const unsigned ldsw = (unsigned)wid * 1024u;
    const int aoff = lds_byte(wr * 64 + fr, fq * 8), boff = lds_byte(wc * 32 + fr, fq * 8);
#define BR_SA(b, h) (((b) * 2 + (h)) * HTB)
#define BR_SB(b) ((4 + (b) * 2) * HTB)
#define BR_STAGE(bufoff, gbase, voff) do { _Pragma("unroll") for (int _i = 0; _i < 2; ++_i) \
        __builtin_amdgcn_global_load_lds((const unsigned*)((const char*)(gbase) + (voff)[_i]), (LAS unsigned*)(lds + (bufoff) + ldsw + _i * 8192), 16, 0, 0); } while (0)
#define BR_LDA(dst, b, h) do { _Pragma("unroll") for (int m = 0; m < 4; ++m) _Pragma("unroll") for (int k = 0; k < 2; ++k) dst[m][k] = *(const LAS bf16x8*)(lds + BR_SA(b, h) + aoff + m * 2048 + k * 1024); } while (0)
#define BR_LDB(dst, b) do { _Pragma("unroll") for (int n = 0; n < 2; ++n) _Pragma("unroll") for (int k = 0; k < 2; ++k) dst[n][k] = *(const LAS bf16x8*)(lds + BR_SB(b) + boff + n * 2048 + k * 1024); } while (0)
#define BR_MMA(ai) do { __builtin_amdgcn_s_setprio(1); _Pragma("unroll") for (int m = 0; m < 4; ++m) _Pragma("unroll") for (int n = 0; n < 2; ++n) _Pragma("unroll") for (int k = 0; k < 2; ++k) \
        acc[ai][m][n] = __builtin_amdgcn_mfma_f32_16x16x32_bf16(B0[n][k], At[m][k], acc[ai][m][n], 0, 0, 0); __builtin_amdgcn_s_setprio(0); } while (0)
#define BR_WAIT_V(n) asm volatile("s_waitcnt vmcnt(" #n ")" ::: "memory")
#define BR_WAIT_L0 asm volatile("s_waitcnt lgkmcnt(0)" ::: "memory")
#define BR_BAR __builtin_amdgcn_s_barrier()
#define BR_SCHED __builtin_amdgcn_sched_barrier(0)
    BUnit cur, nxt; int ui = 0;
    if (!S.next(0, cur)) return;
    f32x4 acc[2][4][2], macc[2][4][2];
#pragma unroll
    for (int a = 0; a < 2; ++a)
#pragma unroll
        for (int m = 0; m < 4; ++m)
#pragma unroll
            for (int n = 0; n < 2; ++n) { acc[a][m][n] = (f32x4){0.f, 0.f, 0.f, 0.f}; macc[a][m][n] = (f32x4){0.f, 0.f, 0.f, 0.f}; }
    bf16x8 At[4][2], B0[2][2];
    const char* cA = cur.A; const char* cB = cur.B;
    BR_STAGE(BR_SB(0), cB, voffB); BR_STAGE(BR_SA(0, 0), cA, voffA); BR_STAGE(BR_SA(0, 1), cA + hstepA, voffA);
    if (wr == 1) BR_BAR;
    BR_WAIT_V(2); BR_BAR;
    BR_STAGE(BR_SB(1), cB + kstep, voffB); BR_STAGE(BR_SA(1, 0), cA + kstep, voffA);
    BR_WAIT_V(4); BR_BAR;
    const size_t rowoff = (size_t)(wr * 64 + fr), coloff = (size_t)(wc * 32 + 8 * fq);
    for (;;) {
        const bool has_next = S.next(ui + 1, nxt);
        const char* nA = has_next ? nxt.A : cA; const char* nB = has_next ? nxt.B : cB;
        const char* gbase = cur.gate + (rowoff * GW + coloff);
        u32x2 g[8];
        for (int t = 0; t < nt; t += 2) {
            const bool last = (t == nt - 2);
            const bool hook = (t & 6) == 6;
            const char* a1 = cA + (size_t)(t + 1) * kstep;
            const char* a2 = last ? nA : cA + (size_t)(t + 2) * kstep; const char* b2 = last ? nB : cB + (size_t)(t + 2) * kstep;
            const char* a3 = a2 + kstep; const char* b3 = b2 + kstep;
            if (hook) {
                const char* gp = gbase + (size_t)(t >> 3) * 1024;
#pragma unroll
                for (int q = 0; q < 8; ++q) gload8_async(g[q], gp + (size_t)((q >> 2) * HALF + (q & 3) * 16) * GW);
            }
            BR_LDB(B0, 0); BR_SCHED; BR_LDA(At, 0, 0); BR_STAGE(BR_SA(1, 1), a1 + hstepA, voffA);
            if (hook) BR_WAIT_V(14); else BR_WAIT_V(6);
            BR_WAIT_L0; BR_BAR; BR_MMA(0); BR_BAR; BR_SCHED;
            BR_LDA(At, 0, 1); BR_STAGE(BR_SB(0), b2, voffB); BR_STAGE(BR_SA(0, 0), a2, voffA);
            if (hook) BR_WAIT_V(14); else BR_WAIT_V(6);
            BR_WAIT_L0; BR_BAR; BR_MMA(1); BR_BAR; BR_SCHED;
            BR_LDB(B0, 1); BR_SCHED; BR_LDA(At, 1, 0); BR_STAGE(BR_SA(0, 1), a2 + hstepA, voffA);
            BR_WAIT_V(6); BR_WAIT_L0; BR_BAR; BR_MMA(0); BR_BAR; BR_SCHED;
            BR_LDA(At, 1, 1); BR_STAGE(BR_SB(1), b3, voffB); BR_STAGE(BR_SA(1, 0), a3, voffA);
            BR_WAIT_V(6); BR_WAIT_L0; BR_BAR; BR_MMA(1); BR_BAR; BR_SCHED;
            if (hook) {
                asm volatile("s_waitcnt vmcnt(10)" : "+v"(g[0]), "+v"(g[1]), "+v"(g[2]), "+v"(g[3]), "+v"(g[4]), "+v"(g[5]), "+v"(g[6]), "+v"(g[7]) :: "memory");
#pragma unroll
                for (int ai = 0; ai < 2; ++ai)
#pragma unroll
                    for (int m = 0; m < 4; ++m) { const u32x2 gw = g[ai * 4 + m];
                        const f32x4 g0 = (f32x4){(float)(gw.x & 255u), (float)((gw.x >> 8) & 255u), (float)((gw.x >> 16) & 255u), (float)(gw.x >> 24)};
                        const f32x4 g1 = (f32x4){(float)(gw.y & 255u), (float)((gw.y >> 8) & 255u), (float)((gw.y >> 16) & 255u), (float)(gw.y >> 24)};
                        macc[ai][m][0] += acc[ai][m][0] * g0; macc[ai][m][1] += acc[ai][m][1] * g1;
                        acc[ai][m][0] = (f32x4){0.f, 0.f, 0.f, 0.f}; acc[ai][m][1] = (f32x4){0.f, 0.f, 0.f, 0.f}; }
            }
        }
        {
            GAS bf16_t* op = (GAS bf16_t*)cur.out + rowoff * 1024 + coloff;
#pragma unroll
            for (int ai = 0; ai < 2; ++ai)
#pragma unroll
                for (int m = 0; m < 4; ++m) { const f32x4 v0 = macc[ai][m][0] * (1.0f / 255.0f), v1 = macc[ai][m][1] * (1.0f / 255.0f);
                    u32x4 w; w.x = cvt_pk_bf16(v0[0], v0[1]); w.y = cvt_pk_bf16(v0[2], v0[3]); w.z = cvt_pk_bf16(v1[0], v1[1]); w.w = cvt_pk_bf16(v1[2], v1[3]);
                    *(GAS u32x4*)(op + (size_t)(ai * HALF + m * 16) * 1024) = w;
                    macc[ai][m][0] = (f32x4){0.f, 0.f, 0.f, 0.f}; macc[ai][m][1] = (f32x4){0.f, 0.f, 0.f, 0.f}; }
        }
        if (!has_next) break;
        cur = nxt; cA = nA; cB = nB; ++ui;
    }
    BR_WAIT_V(0);
    if (wr == 0) BR_BAR;
    BR_BAR;
#undef BR_SA
#undef BR_SB
#undef BR_STAGE
#undef BR_LDA
#undef BR_LDB
#undef BR_MMA
#undef BR_WAIT_V
#undef BR_WAIT_L0
#undef BR_BAR
#undef BR_SCHED
}
}

#define XB_TMO      128
#define XB_XCNT(j)  (256  + 64 * (j))
#define XB_XSUB(j)  (1280 + 64 * (j))
#define XB_XGEN(j)  (2304 + 64 * (j))
#define XB_TOP      3328
#define XB_TOPGEN   3392
#define XCD_BAR_WORDS 3456
#define XB_SPIN_CAP (1u << 20)

__device__ __forceinline__ unsigned xb_ld(unsigned* p)              { return __hip_atomic_load(p, __ATOMIC_RELAXED, __HIP_MEMORY_SCOPE_AGENT); }
__device__ __forceinline__ unsigned xb_add(unsigned* p, unsigned v) { return __hip_atomic_fetch_add(p, v, __ATOMIC_RELAXED, __HIP_MEMORY_SCOPE_AGENT); }
__device__ __forceinline__ unsigned xb_xcc_id() { return (unsigned)__builtin_amdgcn_s_getreg((3 << 11) | 20) & 0xFu; }
#define XB_SPIN(cond, bar) do { unsigned _sp = 0; while (cond) { __builtin_amdgcn_s_sleep(1); \
    if ((++_sp & 255u) == 0u) { if (xb_ld(&(bar)[XB_TMO])) break; if (_sp > XB_SPIN_CAP) { atomicAdd(&(bar)[XB_TMO], 1u); break; } } } } while (0)

struct XcdBarrier { unsigned* bar; unsigned x; volatile LAS unsigned* st; };

__device__ __forceinline__ XcdBarrier xcd_barrier_post(unsigned* bar, volatile LAS unsigned* st) {
    XcdBarrier b; b.bar = bar; b.x = xb_xcc_id(); b.st = st;
    if (threadIdx.x == 0) (void)xb_add(&bar[XB_XCNT(b.x)], 1u);
    return b;
}
__device__ __forceinline__ void xcd_barrier_complete(unsigned* bar, unsigned x, unsigned& nloc, unsigned& nx) {
    const unsigned G = gridDim.x * gridDim.y * gridDim.z;
    unsigned sum, cnt, mine, sp = 0u;
    for (;;) {
        sum = 0u; cnt = 0u; mine = 0u;
#pragma unroll
        for (unsigned j = 0; j < 16; ++j) { const unsigned c = xb_ld(&bar[XB_XCNT(j)]); sum += c; cnt += (c > 0u) ? 1u : 0u; mine = (j == x) ? c : mine; }
        if (sum == G) break;
        __builtin_amdgcn_s_sleep(1);
        if ((++sp & 255u) == 0u) { if (xb_ld(&bar[XB_TMO])) break; if (sp > XB_SPIN_CAP) { atomicAdd(&bar[XB_TMO], 1u); break; } }
    }
    nloc = mine > 0u ? mine : 1u; nx = cnt > 0u ? cnt : 1u;
}
__device__ __forceinline__ void xcd_barrier(const XcdBarrier& b, const bool leader) {
    asm volatile("s_waitcnt vmcnt(0)" ::: "memory");
    __syncthreads();
    unsigned* bar = b.bar; asm volatile("" : "+v"(bar));
    if (leader) {
        __builtin_amdgcn_s_waitcnt(0);
        unsigned nloc = b.st[0], nx = b.st[1];
        if (nloc == 0u) { xcd_barrier_complete(bar, b.x, nloc, nx); b.st[0] = nloc; b.st[1] = nx; }
        const unsigned old = xb_add(&bar[XB_XSUB(b.x)], 1u);
        const unsigned gen = old / nloc;
        if (old + 1u == (gen + 1u) * nloc) {
            __builtin_amdgcn_fence(__ATOMIC_RELEASE, "agent");
            asm volatile("s_waitcnt vmcnt(0)" ::: "memory");
            const unsigned og = xb_add(&bar[XB_TOP], 1u);
            const unsigned tg = og / nx;
            if (og + 1u == (tg + 1u) * nx) xb_add(&bar[XB_TOPGEN], 1u);
            else XB_SPIN(xb_ld(&bar[XB_TOPGEN]) == tg, bar);
            __builtin_amdgcn_fence(__ATOMIC_ACQUIRE, "agent");
            xb_add(&bar[XB_XGEN(b.x)], 1u);
            asm volatile("s_waitcnt vmcnt(0)" ::: "memory");
        } else {
            XB_SPIN(xb_ld(&bar[XB_XGEN(b.x)]) == gen, bar);
            __builtin_amdgcn_fence(__ATOMIC_ACQUIRE, "agent");
            asm volatile("s_waitcnt vmcnt(0)" ::: "memory");
        }
    }
    __syncthreads();
}

struct Args { const float* in[23]; float* out; unsigned char* ws; };
enum { I_X = 0, I_C, I_CTX, I_CCTX, I_WMOD, I_BMOD, I_N1G, I_N2G, I_WIN, I_DLAM, I_SUBLN, I_QKG, I_SINK, I_WBR, I_WOUT, I_FG, I_FU, I_FD, I_RW, I_MG, I_MU, I_MD, I_FINALG };

__device__ __forceinline__ bf16_t* w_layer(unsigned char* ws, int l, size_t off) { return (bf16_t*)(ws + WS_W + (size_t)l * W_LAYER + off); }
__device__ __forceinline__ bf16_t* w_dense(unsigned char* ws, int i, size_t off) { return (bf16_t*)(ws + WS_W + W_DENSE0 + (size_t)i * W_DENSE + off); }
__device__ __forceinline__ bf16_t* w_moe(unsigned char* ws, int i, int e, size_t off) { return (bf16_t*)(ws + WS_W + W_MOE0 + (size_t)i * W_MOE + (size_t)e * W_EXPERT + off); }

constexpr int CV_LAYER = 1536 + 2048 + 1024 + 512;
constexpr int CV_DENSE = 3 * 1408;
constexpr int CV_EXP = 3 * 1792;
constexpr int CV_TOTAL = 4 * CV_LAYER + 2 * CV_DENSE + 16 * CV_EXP;
struct ConvDesc { const float* src; bf16_t* dst; int ldsrc, lddst, perm; float f8s; int qm; };
__device__ __forceinline__ ConvDesc conv_decode(const Args& a, int it) {
    unsigned char* ws = a.ws;
    const float* src; int ldsrc, K, c0, ncols, mode = 0, drow0 = 0, blk, ldd = 0; bf16_t* dst; bool win = false; float f8s = 0.f; int qm = 1;
    if (it < 4 * CV_LAYER) { const int l = it / CV_LAYER, r = it % CV_LAYER;
        if (r < 1536) { blk = r; src = a.in[I_WIN] + (size_t)l * DM * DIN; ldsrc = DIN; K = DM; c0 = 0; ncols = 3072; dst = w_layer(ws, l, W_IN); drow0 = 0; win = true; f8s = W8_GU; qm = 2; }
        else if (r < 3584) { blk = r - 1536; src = a.in[I_WIN] + (size_t)l * DM * DIN; ldsrc = DIN; K = DM; c0 = 3584; ncols = 4096; dst = w_layer(ws, l, W_IN); drow0 = 3072; f8s = -W8_GU * LOG2E; qm = 2; }
        else if (r < 4608) { const int q = r - 3584, rr = q / 256; blk = q % 256; src = a.in[I_WBR] + (size_t)(l * 4 + rr) * 512 * DM; ldsrc = DM; K = 512; c0 = 0; ncols = DM; dst = w_layer(ws, l, W_BR) + (size_t)rr * 512; ldd = 2048; }
        else { blk = r - 4608; src = a.in[I_WOUT] + (size_t)l * DM * DM; ldsrc = DM; K = DM; c0 = 0; ncols = DM; dst = w_layer(ws, l, W_OUT); }
    } else if (it < 4 * CV_LAYER + 2 * CV_DENSE) { const int q = it - 4 * CV_LAYER, i = q / CV_DENSE, r = q % CV_DENSE, which = r / 1408; blk = r % 1408;
        if (which < 2) { src = a.in[which == 0 ? I_FG : I_FU] + (size_t)i * DM * DFF; ldsrc = DFF; K = DM; c0 = 0; ncols = DFF; dst = w_dense(ws, i, W_DGU); mode = 1 + which; f8s = W8_GU; qm = 2; }
        else { src = a.in[I_FD] + (size_t)i * DFF * DM; ldsrc = DM; K = DFF; c0 = 0; ncols = DM; dst = w_dense(ws, i, W_DD); f8s = ((DENSE_F8_MASK >> i) & 1) ? 256.0f : 0.f; }
    } else { const int q = it - 4 * CV_LAYER - 2 * CV_DENSE, ie = q / CV_EXP, r = q % CV_EXP, which = r / 1792, i = ie >> 3, e = ie & 7; blk = r % 1792;
        if (which < 2) { src = a.in[which == 0 ? I_MG : I_MU] + (size_t)ie * DM * DFE; ldsrc = DFE; K = DM; c0 = 0; ncols = DFE; dst = w_moe(ws, i, e, W_MGU); mode = 1 + which; f8s = W8_GU; qm = 2; }
        else { src = a.in[I_MD] + (size_t)ie * DFE * DM; ldsrc = DM; K = DFE; c0 = 0; ncols = DM; dst = w_moe(ws, i, e, W_MD); f8s = 256.0f; }
    }
    const int nbn = ncols / 32, kb = blk / nbn, nb = blk % nbn, n = 32 * nb;
    const int drow = mode == 0 ? drow0 + n : 256 * (n >> 7) + (n & 127) + (mode == 2 ? 128 : 0);
    const bool perm = win && (n < 1024 || (n >= 1536 && n < 2176) || (n >= 2304 && n < 2944));
    ConvDesc d; d.src = src + (size_t)(64 * kb) * ldsrc + c0 + n; if (ldd == 0) ldd = K;
    d.dst = f8s != 0.f ? (bf16_t*)((unsigned char*)dst + (size_t)drow * ldd + 64 * kb) : dst + (size_t)drow * ldd + 64 * kb; d.ldsrc = ldsrc; d.lddst = ldd; d.perm = perm ? 1 : 0; d.f8s = f8s; d.qm = qm;
    return d;
}
__device__ __forceinline__ void conv_load(const ConvDesc& d, float (&r)[32], int lane) {
    const GAS float* s = (const GAS float*)d.src + (size_t)(lane >> 5) * d.ldsrc + (lane & 31);
#pragma unroll
    for (int i = 0; i < 32; ++i) r[i] = __builtin_nontemporal_load(s + (size_t)(2 * i) * d.ldsrc);
}
__device__ __forceinline__ void conv_store(const ConvDesc& d, const float (&r)[32], LAS float* scr, int lane) {
#pragma unroll
    for (int i = 0; i < 32; ++i) scr[(2 * i + (lane >> 5)) * 33 + (lane & 31)] = r[i];
    LDS_WAIT(); asm volatile("" ::: "memory");
    const int c = lane & 7;
    if (d.f8s != 0.f) { const float fs = d.f8s;
#pragma unroll
        for (int j = 0; j < 4; ++j) { const int n = (lane >> 3) + 8 * j; const LAS float* s = scr + (8 * c) * 33 + n;
            u32x2 o;
            if (d.qm == 2) { o.x = pack4_i8(s[0 * 33] * fs, s[1 * 33] * fs, s[2 * 33] * fs, s[3 * 33] * fs); o.y = pack4_i8(s[4 * 33] * fs, s[5 * 33] * fs, s[6 * 33] * fs, s[7 * 33] * fs); }
            else { o.x = cvt4_fp8(s[0 * 33] * fs, s[1 * 33] * fs, s[2 * 33] * fs, s[3 * 33] * fs); o.y = cvt4_fp8(s[4 * 33] * fs, s[5 * 33] * fs, s[6 * 33] * fs, s[7 * 33] * fs); }
            const int dn = d.perm ? 2 * (n & 15) + (n >> 4) : n;
            __builtin_nontemporal_store(o, (GAS u32x2*)((GAS unsigned char*)d.dst + (size_t)dn * d.lddst + 8 * c)); }
    } else {
#pragma unroll
    for (int j = 0; j < 4; ++j) { const int n = (lane >> 3) + 8 * j; const LAS float* s = scr + (8 * c) * 33 + n;
        u32x4 o; o.x = cvt_pk_bf16(s[0 * 33], s[1 * 33]); o.y = cvt_pk_bf16(s[2 * 33], s[3 * 33]); o.z = cvt_pk_bf16(s[4 * 33], s[5 * 33]); o.w = cvt_pk_bf16(s[6 * 33], s[7 * 33]);
        const int dn = d.perm ? 2 * (n & 15) + (n >> 4) : n;
        __builtin_nontemporal_store(o, (GAS u32x4*)(d.dst + (size_t)dn * d.lddst + 8 * c)); }
    }
    LDS_WAIT(); asm volatile("" ::: "memory");
}
__device__ __forceinline__ void fzfold_item(const Args& a, int it, int lane) {
    const int mq = it & 3, kb = (it >> 2) & 15, g = (it >> 6) & 7, l = it >> 9, k0 = 64 * kb;
    const GAS f32x4* src = (const GAS f32x4*)(a.in[I_WIN] + (size_t)l * DM * DIN + (size_t)(k0 + lane) * DIN + 3072 + g * 64);
    float w[64];
#pragma unroll
    for (int i = 0; i < 16; ++i) { const f32x4 v = src[i]; w[4 * i] = v[0]; w[4 * i + 1] = v[1]; w[4 * i + 2] = v[2]; w[4 * i + 3] = v[3]; }
    const float cv = cospif((float)lane * (1.0f / 32.0f)), sv = sinpif((float)lane * (1.0f / 32.0f));
    GAS signed char* dst = (GAS signed char*)w_layer(a.ws, l, W_FZ);
    for (int m = 16 * mq; m < 16 * mq + 16; ++m) {
        float sc = 0.f, ss = 0.f;
#pragma unroll
        for (int c = 0; c < 64; ++c) { const int j = (c * m) & 63;
            const float cj = __builtin_bit_cast(float, __builtin_amdgcn_readlane(__builtin_bit_cast(int, cv), j)), sj = __builtin_bit_cast(float, __builtin_amdgcn_readlane(__builtin_bit_cast(int, sv), j));
            sc += w[c] * cj; ss += w[c] * sj; }
        dst[(size_t)(g * 64 + m) * DM + k0 + lane] = (signed char)(int)__builtin_rintf(__builtin_amdgcn_fmed3f(sc * W8_FZ, -127.0f, 127.0f));
        dst[(size_t)(512 + g * 64 + m) * DM + k0 + lane] = (signed char)(int)__builtin_rintf(__builtin_amdgcn_fmed3f(ss * W8_FZ, -127.0f, 127.0f));
    }
}
__device__ __forceinline__ void mod_item(const Args& a, int item, LAS unsigned char* lds, int tid) {
    const int l = item / 24, chunk = item % 24, wid = tid >> 6, lane = tid & 63;
    LAS float* sc = (LAS float*)lds;
    LAS float* red = (LAS float*)(lds + 36864);
    for (int i = tid; i < 9 * 1024; i += 512) { const float v = i < 8192 ? a.in[I_C][i] : a.in[I_CCTX][i - 8192]; sc[i] = siluf_(v); }
    __syncthreads();
    const float* w = a.in[I_WMOD] + (size_t)l * DM * 6144 + chunk * 256 + lane * 4;
    f32x4 acc[9];
#pragma unroll
    for (int r = 0; r < 9; ++r) acc[r] = (f32x4){0.f, 0.f, 0.f, 0.f};
    const int kb = wid * 128;
#pragma unroll 8
    for (int k = 0; k < 128; ++k) { const f32x4 wv = *(const GAS f32x4*)(w + (size_t)(kb + k) * 6144);
#pragma unroll
        for (int r = 0; r < 9; ++r) acc[r] += wv * sc[r * 1024 + kb + k]; }
#pragma unroll
    for (int r = 0; r < 9; ++r) *(LAS f32x4*)(red + (wid * 9 + r) * 256 + lane * 4) = acc[r];
    __syncthreads();
    float* modv = (float*)(a.ws + WS_MODV) + (size_t)l * 9 * 6144;
    for (int i = tid; i < 9 * 256; i += 512) { const int r = i >> 8, c = i & 255; float s = 0.f;
#pragma unroll
        for (int w8 = 0; w8 < 8; ++w8) s += red[(w8 * 9 + r) * 256 + c];
        modv[r * 6144 + chunk * 256 + c] = s + a.in[I_BMOD][l * 6144 + chunk * 256 + c]; }
    __syncthreads();
}

struct RowV { f32x4 v[4]; };
__device__ __forceinline__ RowV load_row_f32(const float* p, int lane) { RowV r; const f32x4* q = (const f32x4*)p + lane;
#pragma unroll
    for (int j = 0; j < 4; ++j) r.v[j] = q[64 * j];
    return r; }
__device__ __forceinline__ void store_row_f32(float* p, const RowV& r, int lane) { f32x4* q = (f32x4*)p + lane;
#pragma unroll
    for (int j = 0; j < 4; ++j) q[64 * j] = r.v[j]; }
__device__ __forceinline__ RowV load_row_bf16(const bf16_t* p, int lane) { RowV r; const u32x2* q = (const u32x2*)p + lane;
#pragma unroll
    for (int j = 0; j < 4; ++j) { const u32x2 w = q[64 * j]; r.v[j] = (f32x4){bf_lo(w.x), bf_hi(w.x), bf_lo(w.y), bf_hi(w.y)}; }
    return r; }
__device__ __forceinline__ void store_row_bf16(bf16_t* p, const RowV& r, int lane) { u32x2* q = (u32x2*)p + lane;
#pragma unroll
    for (int j = 0; j < 4; ++j) { u32x2 w; w.x = cvt_pk_bf16(r.v[j][0], r.v[j][1]); w.y = cvt_pk_bf16(r.v[j][2], r.v[j][3]); q[64 * j] = w; } }
struct RowQ { unsigned w[4]; float sc; };
__device__ __forceinline__ RowQ quant_row_i8(const RowV& r) {
    float am = 0.f;
#pragma unroll
    for (int j = 0; j < 4; ++j) am = fmaxf(fmaxf(am, fmaxf(fabsf(r.v[j][0]), fabsf(r.v[j][1]))), fmaxf(fabsf(r.v[j][2]), fabsf(r.v[j][3])));
#pragma unroll
    for (int o = 1; o < 64; o <<= 1) am = fmaxf(am, __shfl_xor(am, o));
    const float inv = am > 0.f ? 127.0f / am : 0.f;
    RowQ q; q.sc = am * (1.0f / 127.0f);
#pragma unroll
    for (int j = 0; j < 4; ++j) q.w[j] = pack4_i8(r.v[j][0] * inv, r.v[j][1] * inv, r.v[j][2] * inv, r.v[j][3] * inv);
    return q;
}
__device__ __forceinline__ void store_rowq(unsigned char* p, const RowQ& q, int lane) { unsigned* d = (unsigned*)p + lane;
#pragma unroll
    for (int j = 0; j < 4; ++j) d[64 * j] = q.w[j]; }
__device__ __forceinline__ void store_row_fp8(unsigned char* p, const RowV& r, int lane) { unsigned* q = (unsigned*)p + lane;
#pragma unroll
    for (int j = 0; j < 4; ++j) q[64 * j] = cvt4_fp8(r.v[j][0], r.v[j][1], r.v[j][2], r.v[j][3]); }
__device__ __forceinline__ RowV adaln_row(const RowV& x, const float* g, const float* shift, const float* scale, int lane) {
    float ss = 0.f;
#pragma unroll
    for (int j = 0; j < 4; ++j) ss += (x.v[j][0] * x.v[j][0] + x.v[j][1] * x.v[j][1]) + (x.v[j][2] * x.v[j][2] + x.v[j][3] * x.v[j][3]);
    const float rstd = 1.0f / sqrtf(wave_sum(ss) * (1.0f / DM) + 1e-6f);
    const RowV gv = load_row_f32(g, lane), sh = load_row_f32(shift, lane), sc = load_row_f32(scale, lane);
    RowV y;
#pragma unroll
    for (int j = 0; j < 4; ++j) y.v[j] = x.v[j] * rstd * gv.v[j] * (1.0f + sc.v[j]) + sh.v[j];
    return y;
}
__device__ __forceinline__ int mod_row_of(int row) { return row < NLAT ? (row >> 11) : 8; }
struct AdaCoef { RowV A, B; int mr; };
__device__ __forceinline__ void ada_coef_update(AdaCoef& c, int row, const float* g, const float* modbase, int shift_off, int scale_off, int lane) {
    const int mr = mod_row_of(row);
    if (mr != c.mr) { c.mr = mr; const float* mv = modbase + (size_t)mr * 6144;
        const RowV gv = load_row_f32(g, lane), sh = load_row_f32(mv + shift_off, lane), sc = load_row_f32(mv + scale_off, lane);
#pragma unroll
        for (int j = 0; j < 4; ++j) { c.A.v[j] = gv.v[j] * (1.0f + sc.v[j]); c.B.v[j] = sh.v[j]; } }
}
__device__ __forceinline__ RowV adaln_apply(const RowV& x, const AdaCoef& c) {
    float ss = 0.f;
#pragma unroll
    for (int j = 0; j < 4; ++j) ss += (x.v[j][0] * x.v[j][0] + x.v[j][1] * x.v[j][1]) + (x.v[j][2] * x.v[j][2] + x.v[j][3] * x.v[j][3]);
    const float rstd = 1.0f / sqrtf(wave_sum(ss) * (1.0f / DM) + 1e-6f);
    RowV y;
#pragma unroll
    for (int j = 0; j < 4; ++j) y.v[j] = x.v[j] * rstd * c.A.v[j] + c.B.v[j];
    return y;
}

struct MoeTiles { int tb[9]; };
__device__ __forceinline__ MoeTiles moe_tiles(unsigned* ctl, int i) { MoeTiles t; int s = 0;
#pragma unroll
    for (int e = 0; e < 8; ++e) { t.tb[e] = s; const unsigned c = (unsigned)__builtin_amdgcn_readfirstlane((int)__hip_atomic_load(ctl + CW_CNT + 64 * (8 * i + e), __ATOMIC_RELAXED, __HIP_MEMORY_SCOPE_AGENT)); s += (int)((c + 255u) >> 8); }
    t.tb[8] = s; return t; }

__device__ __forceinline__ float max3f(float a, float b, float c) { return __builtin_fmaxf(__builtin_fmaxf(a, b), c); }
__device__ __forceinline__ int crow(int r, int hi) { return (r & 3) + 8 * (r >> 2) + 4 * hi; }
typedef short v4i16_t __attribute__((ext_vector_type(4)));
__device__ __forceinline__ s16x4 vtr(const LAS unsigned char* p) { return __builtin_bit_cast(s16x4, __builtin_amdgcn_ds_read_tr16_b64_v4i16((LAS v4i16_t*)p)); }

struct AttnCtx { const bf16_t* P; bf16_t* O; const float* subln_g; float lam, one_m_li; const float* sink; };

constexpr float ATT_THR = 8.0f;
__device__ __forceinline__ void glds16(const void* gsrc, unsigned lds_dst) { unsigned keep;
    asm volatile("s_mov_b32 %0, m0\n\ts_mov_b32 m0, %2\n\ts_nop 0\n\tglobal_load_lds_dwordx4 %1, off\n\ts_mov_b32 m0, %0" : "=&s"(keep) : "v"(gsrc), "s"(lds_dst) : "memory"); }
#define ATT_BAR() do { __builtin_amdgcn_sched_barrier(0); asm volatile("s_waitcnt lgkmcnt(0)" ::: "memory"); __builtin_amdgcn_s_barrier(); asm volatile("" ::: "memory"); __builtin_amdgcn_sched_barrier(0); } while (0)
template <int VAR>
__device__ __forceinline__ void attn_unit(LAS unsigned char* lds, const int tid, const AttnCtx& ac, int b, int hh, int qb, bool ctxq) {
    constexpr int NDB = (VAR == 0) ? 4 : 2;
    constexpr int NLD = (VAR == 0) ? 2 : 1;
    constexpr int KB = (VAR == 0) ? 16384 : 8192;
    constexpr int VB = (VAR == 0) ? 16384 : 8192;
    constexpr int VBASE = 3 * KB;
    constexpr int WSF_OFF = 135168;
    const int lane = tid & 63, r32 = lane & 31, hi = lane >> 5; const int wid = __builtin_amdgcn_readfirstlane(tid >> 6);
    const int half = wid >> 2;
    int map = 0, g = 0, qsub, qcol, kcol, vcol, ocol, qpb;
    if (VAR == 0) { map = wid >> 2; qsub = wid & 3; qpb = 128; qcol = C_AQ + hh * 128 + map * 64; kcol = C_AK + hh * 128; vcol = C_AV + hh * 128; ocol = hh * 128; }
    else { g = wid >> 1; qsub = wid & 1; qpb = 64; qcol = (VAR == 1 ? C_BQ : C_CQ) + (hh * 4 + g) * 64; kcol = (VAR == 1 ? C_BK : C_CK) + hh * 64; vcol = (VAR == 1 ? C_BV : C_CV) + hh * 64; ocol = (VAR == 1 ? 512 : 1024) + (hh * 4 + g) * 64; }
    const int q0w = qb * qpb + qsub * 32;
    const int latbase = b * SEQ, ctxbase = NLAT + b * CTXL;
    const int qrow0 = (ctxq ? ctxbase : latbase) + q0w;
    int NT, lt0 = 0;
    if (ctxq) NT = 4;
    else if (VAR == 2) { lt0 = qb - 2 < 0 ? 0 : qb - 2; const int lt1 = qb + 2 > 31 ? 31 : qb + 2; NT = 4 + (lt1 - lt0 + 1); }
    else NT = 36;
    auto tile_row0 = [&](int t) -> int {
        if (ctxq) return ctxbase + 64 * t;
        if (VAR == 2) return t < 4 ? ctxbase + 64 * t : latbase + 64 * (lt0 + t - 4);
        return t < 32 ? latbase + 64 * t : ctxbase + 64 * (t - 32);
    };
    const GAS bf16_t* Pg = (const GAS bf16_t*)ac.P;
    bf16x8 qr[4];
    { const GAS bf16_t* qp = Pg + (size_t)(qrow0 + r32) * PW + qcol + hi * 8;
#pragma unroll
      for (int d0 = 0; d0 < 4; ++d0) qr[d0] = *(const GAS bf16x8*)(qp + d0 * 16); }
    const GAS bf16_t* kdma = Pg + (size_t)lane * PW + kcol + 8 * wid;
    const GAS bf16_t* vdma = Pg + (size_t)(16 * (wid & 3) + (lane >> 2)) * PW + vcol + (wid >> 2) * 32 + (lane & 3) * 8;
    const unsigned lds0 = (unsigned)(uintptr_t)lds + (unsigned)wid * 1024u;
    auto gloadK = [&](int t, int slot) { const GAS bf16_t* rp = kdma + (size_t)tile_row0(t) * PW;
#pragma unroll
        for (int j = 0; j < NLD; ++j) glds16((const void*)(rp + 64 * j), (unsigned)__builtin_amdgcn_readfirstlane(lds0 + (unsigned)(slot * KB + j * 8192))); };
    auto gloadV = [&](int t, int slot) { const GAS bf16_t* rp = vdma + (size_t)tile_row0(t) * PW;
#pragma unroll
        for (int j = 0; j < NLD; ++j) glds16((const void*)(rp + 64 * j), (unsigned)__builtin_amdgcn_readfirstlane(lds0 + (unsigned)(VBASE + slot * VB + j * 8192))); };
    volatile LAS float* wsf = (volatile LAS float*)(lds + WSF_OFF + wid * 256);
    const int koff = (VAR == 0 ? map * 8192 : 0) + hi * 1024 + r32 * 16;
    const int vlane = (4 * hi + ((lane & 15) >> 2)) * 64 + ((lane >> 4) & 1) * 32 + (lane & 3) * 8;
    f32x16 o[NDB];
#pragma unroll
    for (int d = 0; d < NDB; ++d) o[d] = (f32x16){0.f, 0.f, 0.f, 0.f, 0.f, 0.f, 0.f, 0.f, 0.f, 0.f, 0.f, 0.f, 0.f, 0.f, 0.f, 0.f};
    float m_run = 0.f, l_run = 0.f;
    f32x16 negm = (f32x16){0.f, 0.f, 0.f, 0.f, 0.f, 0.f, 0.f, 0.f, 0.f, 0.f, 0.f, 0.f, 0.f, 0.f, 0.f, 0.f};
    const int tq = q0w + r32;
    f32x16 s0, s1;
    auto qk = [&](int slot) { const LAS unsigned char* bp = lds + slot * KB + koff;
        s0 = negm; s1 = negm;
        constexpr int KH = (VAR == 0) ? 2 : 4;
#pragma unroll
        for (int h = 0; h < 4; h += KH) {
            bf16x8 kf[2 * KH];
#pragma unroll
            for (int d0 = 0; d0 < KH; ++d0) { kf[2 * d0] = *(const LAS bf16x8*)(bp + (h + d0) * 2048); kf[2 * d0 + 1] = *(const LAS bf16x8*)(bp + (h + d0) * 2048 + 512); }
            __builtin_amdgcn_sched_barrier(0);
#pragma unroll
            for (int d0 = 0; d0 < KH; ++d0) {
                s0 = __builtin_amdgcn_mfma_f32_32x32x16_bf16(kf[2 * d0], qr[h + d0], s0, 0, 0, 0);
                s1 = __builtin_amdgcn_mfma_f32_32x32x16_bf16(kf[2 * d0 + 1], qr[h + d0], s1, 0, 0, 0); }
            if (h + KH < 4) __builtin_amdgcn_sched_barrier(0);
        } };
    gloadK(0, 0); gloadV(0, 0);
    if (NT > 1) gloadK(1, 1);
    asm volatile("s_waitcnt vmcnt(0)" ::: "memory"); ATT_BAR();
    if (NT > 2) gloadK(2, 2);
    if (NT > 1) gloadV(1, 1);
    qk(0);
    ATT_BAR();
    if (half == 1) ATT_BAR();
    int k0 = 0;
    for (int t = 0; t < NT; ++t) {
        const bool more1 = t + 1 < NT, more2 = t + 2 < NT, more3 = t + 3 < NT;
        const int k1 = k0 == 2 ? 0 : k0 + 1, k2 = k1 == 2 ? 0 : k1 + 1;
        if (VAR == 2 && !ctxq && t >= 4) {
            const int lt = lt0 + t - 4, kb = 64 * lt + 4 * hi - tq;
            if (lt == qb - 2) {
#pragma unroll
                for (int r = 0; r < 16; ++r) { const int d = kb + (r & 3) + 8 * (r >> 2); if (d < -128) s0[r] = -1e30f; if (d + 32 < -128) s1[r] = -1e30f; }
            } else if (lt == qb + 2) {
#pragma unroll
                for (int r = 0; r < 16; ++r) { const int d = kb + (r & 3) + 8 * (r >> 2); if (d > 128) s0[r] = -1e30f; if (d + 32 > 128) s1[r] = -1e30f; }
            }
        }
        float ma = max3f(s0[0], s0[1], s1[0]), mb = max3f(s0[2], s0[3], s1[1]); ma = max3f(ma, s1[2], s1[3]);
#pragma unroll
        for (int r = 4; r < 16; r += 4) { ma = max3f(ma, s0[r], s0[r + 1]); mb = max3f(mb, s0[r + 2], s0[r + 3]); ma = max3f(ma, s1[r], s1[r + 1]); mb = max3f(mb, s1[r + 2], s1[r + 3]); }
        float mx = fmaxf(ma, mb);
        { const auto rr = __builtin_amdgcn_permlane32_swap(__float_as_uint(mx), __float_as_uint(mx), false, false); mx = fmaxf(__uint_as_float(rr[0]), __uint_as_float(rr[1])); }
        if (t == 0 || __any(mx > ATT_THR)) {
            const float dl = (t == 0) ? mx : fmaxf(mx, 0.f);
            m_run += dl;
#pragma unroll
            for (int r = 0; r < 16; ++r) { s0[r] -= dl; s1[r] -= dl; negm[r] = -m_run; }
            const float f = fast_exp2(-dl);
            l_run *= f;
            if (hi == 0) wsf[r32] = f;
            LDS_WAIT();
#pragma unroll
            for (int r = 0; r < 16; ++r) { const float al = wsf[crow(r, hi)];
#pragma unroll
                for (int d = 0; d < NDB; ++d) o[d][r] *= al; }
        }
        float la = 0.f, lb = 0.f;
#pragma unroll
        for (int r = 0; r < 16; ++r) { s0[r] = fast_exp2(s0[r]); s1[r] = fast_exp2(s1[r]); la += s0[r]; lb += s1[r]; }
        l_run += la + lb;
        bf16x8 pa[4];
        { u32x4 w;
          w.x = cvt_pk_bf16(s0[0], s0[1]); w.y = cvt_pk_bf16(s0[2], s0[3]); w.z = cvt_pk_bf16(s0[4], s0[5]); w.w = cvt_pk_bf16(s0[6], s0[7]); pa[0] = __builtin_bit_cast(bf16x8, w);
          w.x = cvt_pk_bf16(s0[8], s0[9]); w.y = cvt_pk_bf16(s0[10], s0[11]); w.z = cvt_pk_bf16(s0[12], s0[13]); w.w = cvt_pk_bf16(s0[14], s0[15]); pa[1] = __builtin_bit_cast(bf16x8, w);
          w.x = cvt_pk_bf16(s1[0], s1[1]); w.y = cvt_pk_bf16(s1[2], s1[3]); w.z = cvt_pk_bf16(s1[4], s1[5]); w.w = cvt_pk_bf16(s1[6], s1[7]); pa[2] = __builtin_bit_cast(bf16x8, w);
          w.x = cvt_pk_bf16(s1[8], s1[9]); w.y = cvt_pk_bf16(s1[10], s1[11]); w.z = cvt_pk_bf16(s1[12], s1[13]); w.w = cvt_pk_bf16(s1[14], s1[15]); pa[3] = __builtin_bit_cast(bf16x8, w); }
        ATT_BAR();
        if (more3) gloadK(t + 3, k0);
        if (more2) gloadV(t + 2, k2);
        const LAS unsigned char* vp = lds + VBASE + k0 * VB + vlane;
        s16x4 va_lo[NDB], va_hi[NDB], vb_lo[NDB], vb_hi[NDB];
#define ATT_VLOAD(LO, HI, KS) do { _Pragma("unroll") for (int d = 0; d < NDB; ++d) { LO[d] = vtr(vp + d * 4096 + (KS) * 1024); HI[d] = vtr(vp + d * 4096 + (KS) * 1024 + 512); } } while (0)
#define ATT_VMMA(LO, HI, KS) do { _Pragma("unroll") for (int d = 0; d < NDB; ++d) { const bf16x8 vf = (bf16x8){LO[d][0], LO[d][1], LO[d][2], LO[d][3], HI[d][0], HI[d][1], HI[d][2], HI[d][3]}; \
            o[d] = __builtin_amdgcn_mfma_f32_32x32x16_bf16(pa[KS], vf, o[d], 0, 0, 0); } } while (0)
        ATT_VLOAD(va_lo, va_hi, 0); ATT_VLOAD(vb_lo, vb_hi, 1);
        __builtin_amdgcn_sched_barrier(0);
        ATT_VMMA(va_lo, va_hi, 0);
        __builtin_amdgcn_sched_barrier(0);
        ATT_VLOAD(va_lo, va_hi, 2);
        __builtin_amdgcn_sched_barrier(0);
        ATT_VMMA(vb_lo, vb_hi, 1);
        __builtin_amdgcn_sched_barrier(0);
        ATT_VLOAD(vb_lo, vb_hi, 3);
        __builtin_amdgcn_sched_barrier(0);
        ATT_VMMA(va_lo, va_hi, 2);
        ATT_VMMA(vb_lo, vb_hi, 3);
#undef ATT_VLOAD
#undef ATT_VMMA
        if (more1) qk(k1);
        if (more3) { if (NLD == 2) asm volatile("s_waitcnt vmcnt(4)" ::: "memory"); else asm volatile("s_waitcnt vmcnt(2)" ::: "memory"); }
        else if (more2) { if (NLD == 2) asm volatile("s_waitcnt vmcnt(2)" ::: "memory"); else asm volatile("s_waitcnt vmcnt(1)" ::: "memory"); }
        else asm volatile("s_waitcnt vmcnt(0)" ::: "memory");
        ATT_BAR();
        k0 = k1;
    }
    if (half == 0) ATT_BAR();
    { float l_tot; { const auto rr = __builtin_amdgcn_permlane32_swap(__float_as_uint(l_run), __float_as_uint(l_run), false, false); l_tot = __uint_as_float(rr[0]) + __uint_as_float(rr[1]); }
      if (VAR == 2) l_tot += fast_exp2(ac.sink[hh * 4 + g] * LOG2E - m_run);
      if (hi == 0) wsf[r32] = 1.0f / l_tot;
      LDS_WAIT();
#pragma unroll
      for (int r = 0; r < 16; ++r) { const float il = wsf[crow(r, hi)];
#pragma unroll
          for (int d = 0; d < NDB; ++d) o[d][r] *= il; } }
    GAS bf16_t* Og = (GAS bf16_t*)ac.O;
    if (VAR != 0) {
#pragma unroll
        for (int r = 0; r < 16; ++r) { GAS bf16_t* op = Og + (size_t)(qrow0 + crow(r, hi)) * OW + ocol + r32;
#pragma unroll
            for (int d = 0; d < NDB; ++d) op[d * 32] = f2bf(o[d][r]); }
    } else {
        LAS float* tile = (LAS float*)lds + ((wid & 3) * 2 + map) * (32 * 132);
#pragma unroll
        for (int r = 0; r < 16; ++r)
#pragma unroll
            for (int d = 0; d < NDB; ++d) tile[crow(r, hi) * 132 + d * 32 + r32] = o[d][r];
        __syncthreads();
        const int ql = (wid >> 2) * 16 + (lane >> 2), part = lane & 3;
        const LAS float* t0 = (const LAS float*)lds + ((wid & 3) * 2) * (32 * 132) + ql * 132 + part * 32;
        const LAS float* t1 = t0 + 32 * 132;
        f32x4 dv[8]; float ss = 0.f;
#pragma unroll
        for (int j = 0; j < 8; ++j) { const f32x4 a = *(const LAS f32x4*)(t0 + 4 * j), bq = *(const LAS f32x4*)(t1 + 4 * j); dv[j] = a - ac.lam * bq;
            ss += (dv[j][0] * dv[j][0] + dv[j][1] * dv[j][1]) + (dv[j][2] * dv[j][2] + dv[j][3] * dv[j][3]); }
        ss += __shfl_xor(ss, 1); ss += __shfl_xor(ss, 2);
        const float rs = ac.one_m_li / sqrtf(ss * (1.0f / 128.0f) + 1e-5f);
        const GAS float* gp = (const GAS float*)ac.subln_g + part * 32;
        GAS bf16_t* op = Og + (size_t)((ctxq ? ctxbase : latbase) + qb * qpb + (wid & 3) * 32 + ql) * OW + ocol + part * 32;
#pragma unroll
        for (int k = 0; k < 4; ++k) { const f32x4 g0 = *(const GAS f32x4*)(gp + 8 * k), g1 = *(const GAS f32x4*)(gp + 8 * k + 4);
            const f32x4 v0 = dv[2 * k] * g0 * rs, v1 = dv[2 * k + 1] * g1 * rs;
            u32x4 w; w.x = cvt_pk_bf16(v0[0], v0[1]); w.y = cvt_pk_bf16(v0[2], v0[3]); w.z = cvt_pk_bf16(v1[0], v1[1]); w.w = cvt_pk_bf16(v1[2], v1[3]);
            *(GAS u32x4*)(op + 8 * k) = w; }
    }
}

using pg8::Unit;
struct SchedInproj {
    int c, G, nM, ntot, nfz; const char* xn; const char* win; const char* wfz; char* p; char* zz; char* zzc; const char* rope; char* gates; const float* rsc;
    __device__ __forceinline__ bool next(int i, Unit& u) const {
        const int L = i * G + c; if (L >= ntot + nfz) return false;
        u.aux = nullptr;
        if (L < ntot) { int pm, pn; pg8::tile_of(L, nM, 28, pm, pn);
            u.A = xn + (size_t)pm * 256 * DM; u.B = win + (size_t)pn * 256 * DM; u.aux2 = (const char*)(rsc + (size_t)pm * 256);
            if (pn < 12) { u.out = p + ((size_t)pm * 256 * PW + pn * 256) * 2; u.ldc = PW; } else { u.out = gates + ((size_t)pm * 256 * GW + (pn - 12) * 256); u.ldc = GW; }
            int fl = pm < 64 ? 16 : 0;
            if (pn >= 12) fl |= 1; else if (pn < 2) fl |= 2 | 8; else if (pn < 4) fl |= 2; else if (pn == 9 || pn == 10) fl |= 2 | 8; else if (pn == 11) fl |= 4;
            u.flag = fl; u.aux = rope + (size_t)((pm * 256) & 2047) * 64 * 4; }
        else { const int q = L - ntot;
            if (q < 256) { const int b = q >> 5, pm = (q >> 3) & 3, pn = q & 7;
                u.A = wfz + (size_t)pm * 256 * DM; u.B = xn + (size_t)(b * SEQ + pn * 256) * DM; u.aux2 = (const char*)(rsc + (size_t)(b * SEQ + pn * 256));
                u.out = zz + ((size_t)b * 512 * 4096 + (size_t)((pm & 1) * 256) * 4096 + (pm >> 1) * 2048 + pn * 256); u.ldc = 4096; u.flag = 32; }
            else { const int q2 = q - 256, b = q2 >> 2, pm = q2 & 3;
                u.A = wfz + (size_t)pm * 256 * DM; u.B = xn + (size_t)(NLAT + b * CTXL) * DM; u.aux2 = (const char*)(rsc + (size_t)(NLAT + b * CTXL));
                u.out = zzc + ((size_t)b * 512 * 512 + (size_t)((pm & 1) * 256) * 512 + (pm >> 1) * 256); u.ldc = 512; u.flag = 32; } }
        return true;
    }
};
struct SchedDft {
    int c; const char* T; const char* zz; char* o;
    __device__ __forceinline__ bool next(int i, Unit& u) const {
        if (i > 0 || c >= 128) return false;
        const int b = c >> 4, pm = (c >> 1) & 7, pn = c & 1;
        u.A = T + (size_t)pm * 256 * 4096; u.B = zz + ((size_t)b * 512 + pn * 256) * 4096;
        u.out = o + ((size_t)(b * SEQ + pm * 256) * OW + 1536 + pn * 256) * 2; u.ldc = OW; u.flag = 0; u.aux = nullptr; u.aux2 = nullptr; return true;
    }
};
struct SchedDftCtx {
    int c; const char* T; const char* zzc; char* o;
    __device__ __forceinline__ bool next(int i, Unit& u) const {
        if (i > 0 || c < 128 || c >= 144) return false;
        const int q = c - 128, b = q >> 1, pn = q & 1;
        u.A = T; u.B = zzc + ((size_t)b * 512 + pn * 256) * 512;
        u.out = o + ((size_t)(NLAT + b * CTXL) * OW + 1536 + pn * 256) * 2; u.ldc = OW; u.flag = 0; u.aux = nullptr; u.aux2 = nullptr; return true;
    }
};
struct SchedBranch {
    int c, G, ntile; const char* o; const char* wbr; const char* p; char* merged;
    __device__ __forceinline__ bool next(int i, pg8::BUnit& u) const {
        const int xcd = c & 7, j = i * (G >> 3) + (c >> 3), pm = xcd + 8 * (j >> 3), pn2 = j & 7;
        if (pm * 8 >= ntile) return false;
        u.A = o + (size_t)pm * 256 * OW * 2; u.B = wbr + (size_t)pn2 * 128 * 2048 * 2;
        u.gate = p + ((size_t)pm * 256 * GW + pn2 * 128);
        u.out = merged + ((size_t)pm * 256 * 1024 + pn2 * 128) * 2; return true;
    }
};
struct SchedResid {
    int c, G, nM, K; const char* A; const char* B; char* xs; const char* modv; int goff; const char* xin; const char* cin;
    __device__ __forceinline__ bool next(int i, Unit& u) const {
        const int L = i * G + c; if (L >= nM * 4) return false;
        int pm, pn; pg8::tile_of(L, nM, 4, pm, pn);
        u.A = A + (size_t)pm * 256 * K * 2; u.B = B + (size_t)pn * 256 * K * 2; u.out = xs + ((size_t)pm * 256 * DM + pn * 256) * 2; u.ldc = DM;
        u.aux = modv + ((size_t)(pm < 64 ? (pm >> 3) : 8) * 6144 + goff + pn * 256) * 4; u.flag = xin ? 1 : 0;
        u.aux2 = xin ? (pm < 64 ? xin + ((size_t)pm * 256 * DM + pn * 256) * 4 : cin + ((size_t)(pm - 64) * 256 * DM + pn * 256) * 4) : (const char*)u.out; return true;
    }
};
struct SchedUp {
    int c, G, nM; const char* xn; const char* w; char* h; int eb; const float* rsc;
    __device__ __forceinline__ bool next(int i, Unit& u) const {
        const int L = i * G + c; if (L >= nM * 22) return false;
        int pm, pn; pg8::tile_of(L, nM, 22, pm, pn);
        u.A = xn + (size_t)pm * 256 * DM; u.B = w + (size_t)pn * 256 * DM; u.out = h + ((size_t)pm * 256 * DFF + pn * 128) * eb; u.ldc = DFF; u.flag = 0; u.aux = (const char*)(rsc + (size_t)pm * 256); u.aux2 = nullptr; return true;
    }
};
struct SchedMoe {
    int c, G, NT, K, RT; MoeTiles mt; const char* A; const char* W; size_t wsub; char* out; int ldc, colw, esz; const float* rsc;
    __device__ __forceinline__ bool next(int i, Unit& u) const {
        const int L0 = i * G + c, ntot = RT * NT; if (L0 >= ntot) return false;
        int L = L0; if (NT > 4) { const int q = ntot / 8, r = ntot % 8, xcd = L0 % 8, off = L0 / 8; L = (xcd < r ? xcd * (q + 1) : r * (q + 1) + (xcd - r) * q) + off; }
        const int gs = 8 * NT, g8 = L / gs, rem = L % gs, left = RT - 8 * g8, gsz = left < 8 ? left : 8;
        const int rt = 8 * g8 + rem % gsz, pn = rem / gsz;
        int e = 0;
#pragma unroll
        for (int k = 1; k < 8; ++k) e += (rt >= mt.tb[k]) ? 1 : 0;
        u.A = A + (size_t)rt * 256 * K * 2; u.B = W + (size_t)e * W_EXPERT + wsub + (size_t)pn * 256 * K * 2;
        u.out = out + ((size_t)rt * 256 * ldc + (size_t)pn * colw) * esz; u.ldc = ldc; u.flag = 0; u.aux = rsc ? (const char*)(rsc + (size_t)rt * 256) : nullptr; u.aux2 = nullptr; return true;
    }
};

struct SchedMoeSplit {
    int c, G, RF, RT; MoeTiles mt; const char* A; const char* W; char* y0; char* y1;
    __device__ __forceinline__ bool next(int i, Unit& u) const {
        const int L = i * G + c; if (L >= (RT - RF) * 8) return false;
        const int ts = L >> 1, kh = L & 1, rt = RF + (ts >> 2), pn = ts & 3;
        int e = 0;
#pragma unroll
        for (int k = 1; k < 8; ++k) e += (rt >= mt.tb[k]) ? 1 : 0;
        u.A = A + ((size_t)rt * 256 * DFE + kh * (DFE / 2)); u.B = W + (size_t)e * W_EXPERT + W_MD + ((size_t)pn * 256 * DFE + kh * (DFE / 2));
        u.out = kh ? y1 + ((size_t)(rt - RF) * 256 * DM + pn * 256) * 2 : y0 + ((size_t)rt * 256 * DM + pn * 256) * 2;
        u.ldc = DM; u.flag = 0; u.aux = nullptr; u.aux2 = nullptr; return true;
    }
};

#define LAUNDER_S(x) asm volatile("" : "+s"(x))
#define LAUNDER_V(x) asm volatile("" : "+v"(x))
constexpr int LDS_ARGOFF = LDS_CTLOFF + 512;
__device__ __forceinline__ const float* ARGP(LAS unsigned char* lds, int i) {
    unsigned off = LDS_ARGOFF + 8 * i; asm volatile("" : "+s"(off));
    volatile LAS unsigned* p = (volatile LAS unsigned*)(lds + off);
    const unsigned lo = __builtin_amdgcn_readfirstlane(p[0]), hi = __builtin_amdgcn_readfirstlane(p[1]);
    return (const float*)(((unsigned long long)hi << 32) | lo);
}
__device__ __forceinline__ void grid_barrier(LAS unsigned char* lds, int wv) {
    XcdBarrier b; b.bar = (unsigned*)((unsigned char*)ARGP(lds, 24) + WS_CTL) + CW_BAR; b.x = xb_xcc_id(); b.st = (volatile LAS unsigned*)(lds + LDS_CTLOFF);
    xcd_barrier(b, wv == 0 && lane_id() == 0);
}
struct Fr { LAS unsigned char* lds; unsigned char* ws; int tid, lane, wave, bid, G, gw, NGW; unsigned* ctl; };
__device__ __forceinline__ Fr make_frame(LAS unsigned char* lds, int wv) {
    Fr F; F.lds = lds;
    F.ws = (unsigned char*)ARGP(lds, 24); int t = wv * 64 + lane_id(); LAUNDER_V(t); F.tid = t; F.lane = t & 63; F.wave = wv;
    int b = blockIdx.x; LAUNDER_S(b); F.bid = b; int g = gridDim.x; LAUNDER_S(g); F.G = g; F.gw = b * 8 + F.wave; F.NGW = g * 8; F.ctl = (unsigned*)(F.ws + WS_CTL);
    return F;
}

constexpr int CV_PRO = 4 * CV_LAYER + 2 * CV_DENSE;
constexpr int CV_M1 = CV_PRO, CV_M3 = CV_PRO + 8 * CV_EXP;
#ifndef BG_BRW
#define BG_BRW 6
#endif
#ifndef BG_DDW
#define BG_DDW 12
#endif
constexpr int BG_BR = 192 * 8 * BG_BRW, BG_OUT = 224 * 8 * 4, BG_DD = 224 * 8 * BG_DDW;
constexpr int CVQ_BLK = 32;
constexpr int cmin_(int a, int b) { return a < b ? a : b; }
constexpr int MQ1_E = CV_M3, MQ2_E = CV_TOTAL, MQ1_S = cmin_(CV_M1 + BG_BR + BG_OUT + BG_DD + BG_BR, MQ1_E), MQ2_S = cmin_(CV_M3 + BG_OUT + BG_BR + BG_OUT + BG_DD, MQ2_E);
static_assert(MQ1_S <= MQ1_E && MQ2_S <= MQ2_E && (MQ1_E - MQ1_S) % (8 * CVQ_BLK) == 0 && (MQ2_E - MQ2_S) % (8 * CVQ_BLK) == 0, "queue conversion ranges are whole units per XCD queue");
__device__ __forceinline__ void convert_range(LAS unsigned char* lds, const Fr& F, int start, int end, int gwi, int nw) {
    Args a;
#pragma unroll
    for (int i = 0; i < 23; ++i) a.in[i] = ARGP(lds, i);
    a.out = nullptr; a.ws = F.ws;
    LAS float* scr = (LAS float*)(lds + F.wave * 8704);
    float ra[32], rb[32]; ConvDesc d, dn; int it = start + gwi; bool have = it < end;
    if (have) { d = conv_decode(a, it); conv_load(d, ra, F.lane); }
    while (have) {
        const int itn = it + nw; const bool hn = itn < end;
        if (hn) { dn = conv_decode(a, itn); conv_load(dn, rb, F.lane); }
        conv_store(d, ra, scr, F.lane);
        if (hn) {
#pragma unroll
            for (int i = 0; i < 32; ++i) ra[i] = rb[i];
            d = dn; }
        it = itn; have = hn;
    }
}
__device__ __forceinline__ void bg_window(int kind, int l, int& s, int& e) {
    s = 0; e = 0;
    const int m1a = CV_M1, m1b = cmin_(m1a + BG_BR, MQ1_E), m1c = cmin_(m1b + BG_OUT, MQ1_E), m1d = cmin_(m1c + BG_DD, MQ1_E), m1e = MQ1_S;
    const int m3a = CV_M3, m3b = cmin_(m3a + BG_OUT, MQ2_E), m3c = cmin_(m3b + BG_BR, MQ2_E), m3d = cmin_(m3c + BG_OUT, MQ2_E), m3e = MQ2_S;
    if (kind == 0) { if (l == 0) { s = m1a; e = m1b; } else if (l == 1) { s = m1d; e = m1e; } else if (l == 2) { s = m3b; e = m3c; } }
    else if (kind == 1) { if (l == 0) { s = m1b; e = m1c; } else if (l == 1) { s = m3a; e = m3b; } else if (l == 2) { s = m3c; e = m3d; } }
    else { if (l == 0) { s = m1c; e = m1d; } else if (l == 2) { s = m3d; e = m3e; } }
}
__device__ __forceinline__ void phase_prologue(LAS unsigned char* lds, int wv) {
    const Fr F = make_frame(lds, wv);
    Args a;
#pragma unroll
    for (int i = 0; i < 23; ++i) a.in[i] = ARGP(lds, i);
    a.out = nullptr; a.ws = F.ws;
    if (F.bid < 96) mod_item(a, F.bid, lds, F.tid);
    for (int it = F.gw; it < 2048; it += F.NGW) fzfold_item(a, it, F.lane);
    convert_range(lds, F, 0, CV_LAYER, F.gw, F.NGW);
    float* rope = (float*)(F.ws + WS_ROPE);
    for (int i = F.gw * 64 + F.lane; i < SEQ * 64; i += F.NGW * 64) { const int t = i >> 6, j = i & 63, ax = j >> 5, isin = (j >> 4) & 1, f = j & 15;
        const float pos = (float)(ax == 0 ? (t >> 6) : (t & 63));
        const float inv = powf(10000.0f, -(float)f / 16.0f); const float ang = pos * inv;
        rope[i] = isin ? sinf(ang) : cosf(ang); }
    signed char* T = (signed char*)(F.ws + WS_T);
    for (int i = F.gw * 64 + F.lane; i < 2048 * 2048; i += F.NGW * 64) { const int k = i >> 11, n = i & 2047; const float x = (float)((k * n) & 2047) * (1.0f / 1024.0f);
        T[(size_t)k * 4096 + n] = (signed char)(int)__builtin_rintf(127.0f * cospif(x)); T[(size_t)k * 4096 + 2048 + n] = (signed char)(int)__builtin_rintf(-127.0f * sinpif(x)); }
    signed char* T2 = (signed char*)(F.ws + WS_T256);
    for (int i = F.gw * 64 + F.lane; i < 256 * 256; i += F.NGW * 64) { const int k = i >> 8, n = i & 255; const float x = (float)((k * n) & 255) * (1.0f / 128.0f);
        T2[k * 512 + n] = (signed char)(int)__builtin_rintf(127.0f * cospif(x)); T2[k * 512 + 256 + n] = (signed char)(int)__builtin_rintf(-127.0f * sinpif(x)); }
}
__device__ __forceinline__ void phase_first_norm(LAS unsigned char* lds, int wv) {
    const Fr F = make_frame(lds, wv);
    const float* X = ARGP(lds, I_X); const float* CX = ARGP(lds, I_CTX); const float* n1g = ARGP(lds, I_N1G);
    float* xs = (float*)(F.ws + WS_XS); bf16_t* xn = (bf16_t*)(F.ws + WS_XN); const float* modv_all = (const float*)(F.ws + WS_MODV);
    for (int row = F.gw; row < NTOK; row += F.NGW) {
        const float* src = row < NLAT ? X + (size_t)row * DM : CX + (size_t)(row - NLAT) * DM;
        const RowV x = load_row_f32(src, F.lane);
        const float* mv = modv_all + (size_t)mod_row_of(row) * 6144;
        const RowV y = adaln_row(x, n1g, mv, mv + 1024, F.lane);
        const RowQ yq = quant_row_i8(y);
        store_rowq(F.ws + WS_XN8 + (size_t)row * DM, yq, F.lane); if (F.lane == 0) ((float*)(F.ws + WS_RSC1))[row] = yq.sc;
    }
}
__device__ __forceinline__ void phase_inproj(LAS unsigned char* lds, int wv, int l) {
    const Fr F = make_frame(lds, wv); unsigned char* ws = F.ws; const bool lastl = l == DEPTH - 1;
    SchedInproj S{F.bid, F.G, NTOK / 256, (NTOK / 256) * 28, lastl ? 256 : 288, (const char*)(ws + WS_XN8), (const char*)w_layer(ws, l, W_IN), (const char*)w_layer(ws, l, W_FZ), (char*)(ws + WS_P), (char*)(ws + WS_ZZ), (char*)(ws + WS_ZZC), (const char*)(ws + WS_ROPE), (char*)(ws + WS_G), (const float*)(ws + WS_RSC1)};
    pg8::EpiInproj E{};
    pg8::gemm_phase<pg8::EpiInproj, SchedInproj, true, true, 2>(lds, F.tid, DM / 2, DM / 2, DM / 2, S, E);
}
__device__ __forceinline__ void phase_post(LAS unsigned char* lds, int wv, int l) {
    const Fr F = make_frame(lds, wv);
    GAS bf16_t* P = (GAS bf16_t*)(F.ws + WS_P); const GAS float* rope = (const GAS float*)(F.ws + WS_ROPE);
    const GAS float* gq = (const GAS float*)ARGP(lds, I_QKG) + l * 128; const GAS float* gk = gq + 64;
    const int lane = F.lane, a = (lane & 7) >> 2, i0 = 4 * (lane & 3);
    float gqv[8], gkv[8];
#pragma unroll
    for (int e = 0; e < 8; ++e) { const int d = 32 * a + 16 * (e & 1) + i0 + (e >> 1); gqv[e] = gq[d]; gkv[e] = gk[d]; }
    for (int row = F.gw; row < NTOK; row += F.NGW) {
        GAS bf16_t* pr = P + (size_t)row * PW;
        const bool lat = row < NLAT;
        f32x4 cs = (f32x4){1.f, 1.f, 1.f, 1.f}, sn = (f32x4){0.f, 0.f, 0.f, 0.f};
        if (lat) { const GAS float* rt = rope + (size_t)(row & 2047) * 64 + a * 32 + i0; cs = *(const GAS f32x4*)rt; sn = *(const GAS f32x4*)(rt + 16); }
        const u32x4 qw = *(const GAS u32x4*)(pr + C_BQ + 8 * lane);
        u32x4 kw = (u32x4){0u, 0u, 0u, 0u};
        if (lane < 16) kw = *(const GAS u32x4*)(pr + C_BK + 8 * lane);
        float x[8], y[8];
        x[0] = bf_lo(qw.x); x[1] = bf_hi(qw.x); x[2] = bf_lo(qw.y); x[3] = bf_hi(qw.y); x[4] = bf_lo(qw.z); x[5] = bf_hi(qw.z); x[6] = bf_lo(qw.w); x[7] = bf_hi(qw.w);
        y[0] = bf_lo(kw.x); y[1] = bf_hi(kw.x); y[2] = bf_lo(kw.y); y[3] = bf_hi(kw.y); y[4] = bf_lo(kw.z); y[5] = bf_hi(kw.z); y[6] = bf_lo(kw.w); y[7] = bf_hi(kw.w);
        float sq = 0.f, sk = 0.f;
#pragma unroll
        for (int e = 0; e < 8; ++e) { sq += x[e] * x[e]; sk += y[e] * y[e]; }
        sq += __shfl_xor(sq, 1); sq += __shfl_xor(sq, 2); sq += __shfl_xor(sq, 4);
        sk += __shfl_xor(sk, 1); sk += __shfl_xor(sk, 2); sk += __shfl_xor(sk, 4);
        const float rq = 1.0f / sqrtf(sq * (1.0f / 64.0f) + 1e-6f), rk = 1.0f / sqrtf(sk * (1.0f / 64.0f) + 1e-6f);
#pragma unroll
        for (int e = 0; e < 8; ++e) { x[e] *= rq * gqv[e]; y[e] *= rk * gkv[e]; }
        float xo[8], yo[8];
#pragma unroll
        for (int p2 = 0; p2 < 4; ++p2) { const float c = cs[p2], s = sn[p2];
            xo[2 * p2] = (x[2 * p2] * c - x[2 * p2 + 1] * s) * C2; xo[2 * p2 + 1] = (x[2 * p2 + 1] * c + x[2 * p2] * s) * C2;
            yo[2 * p2] = y[2 * p2] * c - y[2 * p2 + 1] * s; yo[2 * p2 + 1] = y[2 * p2 + 1] * c + y[2 * p2] * s; }
        u32x4 ow; ow.x = cvt_pk_bf16(xo[0], xo[1]); ow.y = cvt_pk_bf16(xo[2], xo[3]); ow.z = cvt_pk_bf16(xo[4], xo[5]); ow.w = cvt_pk_bf16(xo[6], xo[7]);
        *(GAS u32x4*)(pr + C_BQ + 8 * lane) = ow;
        if (lane < 16) { u32x4 kk; kk.x = cvt_pk_bf16(yo[0], yo[1]); kk.y = cvt_pk_bf16(yo[2], yo[3]); kk.z = cvt_pk_bf16(yo[4], yo[5]); kk.w = cvt_pk_bf16(yo[6], yo[7]);
            *(GAS u32x4*)(pr + C_BK + 8 * lane) = kk; }
    }
}
constexpr int CVQ_UNITS = (CV_PRO - CV_LAYER) / (8 * CVQ_BLK);
static_assert(CVQ_UNITS * 8 * CVQ_BLK == CV_PRO - CV_LAYER, "conversion units tile the deferred block range");
__device__ __forceinline__ void phase_mix(LAS unsigned char* lds, int wv, int l, int rep) {
    const Fr F = make_frame(lds, wv); unsigned char* ws = F.ws; const bool lastl = l == DEPTH - 1;
    volatile LAS unsigned* LCTL = (volatile LAS unsigned*)(lds + LDS_CTLOFF);
    { SchedDft S{F.bid, (const char*)(ws + WS_T), (const char*)(ws + WS_ZZ), (char*)(ws + WS_O)}; pg8::EpiStoreI8 E{1.0f / (362.03867196751236f * 127.0f * ZZ8)};
      pg8::gemm_phase<pg8::EpiStoreI8, SchedDft, false, true, 2>(lds, F.tid, 2048, 2048, 2048, S, E); }
    if (!lastl) { SchedDftCtx S{F.bid, (const char*)(ws + WS_T256), (const char*)(ws + WS_ZZC), (char*)(ws + WS_O)}; pg8::EpiStoreI8 E{1.0f / (128.0f * 127.0f * ZZ8)};
      int tl = F.tid; LAUNDER_V(tl);
      pg8::gemm_phase<pg8::EpiStoreI8, SchedDftCtx, false, true, 2>(lds, tl, 256, 256, 256, S, E); }
    float c08 = 0.8f; asm volatile("" : "+v"(c08));
    const float li = c08 - 0.6f * expf(-0.3f * (float)l);
    const float* lp = ARGP(lds, I_DLAM) + l * 256;
    float d01 = 0.f, d23 = 0.f;
    for (int k = 0; k < 64; ++k) { d01 += lp[k] * lp[64 + k]; d23 += lp[128 + k] * lp[192 + k]; }
    const float lam_u = __builtin_bit_cast(float, __builtin_amdgcn_readfirstlane(__builtin_bit_cast(int, expf(d01) - expf(d23) + li)));
    const float oml_u = __builtin_bit_cast(float, __builtin_amdgcn_readfirstlane(__builtin_bit_cast(int, 1.0f - li)));
    AttnCtx ac{(const bf16_t*)(ws + WS_P), (bf16_t*)(ws + WS_O), ARGP(lds, I_SUBLN) + l * 128, lam_u, oml_u, ARGP(lds, I_SINK) + l * 8};
    const int NUB = lastl ? 192 : 216;
    int NCV = 0, cvbase = 0;
    if (rep == 0) { if (l == 0) { NCV = CVQ_UNITS; cvbase = CV_LAYER; } else if (l == 1) { NCV = (MQ1_E - MQ1_S) / (8 * CVQ_BLK); cvbase = MQ1_S; } else if (l == 2) { NCV = (MQ2_E - MQ2_S) / (8 * CVQ_BLK); cvbase = MQ2_S; } }
    const int bq = F.bid & 7;
    unsigned* qc = F.ctl + CW_Q + 64 * (8 * (l + 4 * rep) + bq);
    for (;;) {
        __syncthreads();
        if (F.tid == 0) LCTL[2] = xb_add(qc, 1u);
        __syncthreads();
        const int u = __builtin_amdgcn_readfirstlane((int)LCTL[2]);
        if (u >= NUB + NCV) break;
        if (u >= NUB) { const int s = cvbase + ((u - NUB) * 8 + bq) * CVQ_BLK; convert_range(lds, F, s, s + CVQ_BLK, F.wave, 8); continue; }
        int tl = F.tid; LAUNDER_V(tl);
        if (u < 64) attn_unit<0>(lds, tl, ac, bq, u >> 4, u & 15, false);
        else if (u < 128) { const int v = u - 64; attn_unit<1>(lds, tl, ac, bq, v >> 5, v & 31, false); }
        else if (u < 192) { const int v = u - 128; attn_unit<2>(lds, tl, ac, bq, v >> 5, v & 31, false); }
        else if (u < 200) { const int v = u - 192; attn_unit<0>(lds, tl, ac, bq, v >> 1, v & 1, true); }
        else if (u < 208) { const int v = u - 200; attn_unit<1>(lds, tl, ac, bq, v >> 2, v & 3, true); }
        else { const int v = u - 208; attn_unit<2>(lds, tl, ac, bq, v >> 2, v & 3, true); }
    }
}
__device__ __forceinline__ void phase_branch(LAS unsigned char* lds, int wv, int l) {
    const Fr F = make_frame(lds, wv); unsigned char* ws = F.ws; const int nMact = (l == DEPTH - 1) ? NLAT / 256 : NTOK / 256;
    SchedBranch S{F.bid, F.G, nMact * 8, (const char*)(ws + WS_O), (const char*)w_layer(ws, l, W_BR), (const char*)(ws + WS_G), (char*)(ws + WS_XN)};
    pg8::branch_phase<SchedBranch>(lds, F.tid, S);
    if (nMact == NTOK / 256 && (F.bid >> 3) >= 8) {
        int s, e; bg_window(0, l, s, e);
        if (e > s) convert_range(lds, F, s, e, ((F.bid & 7) * 24 + (F.bid >> 3) - 8) * 8 + F.wave, 192 * 8);
    }
}
__device__ __forceinline__ void phase_out(LAS unsigned char* lds, int wv, int l) {
    const Fr F = make_frame(lds, wv); unsigned char* ws = F.ws; const int nMact = (l == DEPTH - 1) ? NLAT / 256 : NTOK / 256;
    SchedResid S{F.bid, F.G, nMact, DM, (const char*)(ws + WS_XN), (const char*)w_layer(ws, l, W_OUT), (char*)(ws + WS_XS), (const char*)(ws + WS_MODV + (size_t)l * 9 * 6144 * 4), 2048, l == 0 ? (const char*)ARGP(lds, I_X) : nullptr, l == 0 ? (const char*)ARGP(lds, I_CTX) : nullptr};
    pg8::EpiResid E{};
    pg8::gemm_phase<pg8::EpiResid, SchedResid, true, true>(lds, F.tid, DM, DM, DM, S, E);
    if (nMact == NTOK / 256 && F.bid >= 32) {
        int s, e; bg_window(1, l, s, e);
        if (e > s) convert_range(lds, F, s, e, (F.bid - 32) * 8 + F.wave, 224 * 8);
    }
}
__device__ __forceinline__ void phase_norm2_dense(LAS unsigned char* lds, int wv, int l) {
    const Fr F = make_frame(lds, wv); const int nrows = (l == DEPTH - 1) ? NLAT : NTOK;
    const bf16_t* xs = (const bf16_t*)(F.ws + WS_XS); bf16_t* xn = (bf16_t*)(F.ws + WS_XN); const float* modv = (const float*)(F.ws + WS_MODV) + (size_t)l * 9 * 6144;
    const float* n2g = ARGP(lds, I_N2G) + l * DM;
    const int rpw = nrows / F.NGW, r0 = F.gw * rpw, r1 = r0 + rpw;
    AdaCoef co; co.mr = -1;
    for (int r = r0; r < r1; r += 3) {
        RowV x[3];
#pragma unroll
        for (int q = 0; q < 3; ++q) x[q] = load_row_bf16(xs + (size_t)(r + q < r1 ? r + q : r) * DM, F.lane);
#pragma unroll
        for (int q = 0; q < 3; ++q) if (r + q < r1) { ada_coef_update(co, r + q, n2g, modv, 3072, 4096, F.lane);
            const RowQ yq = quant_row_i8(adaln_apply(x[q], co));
            store_rowq((unsigned char*)xn + (size_t)(r + q) * DM, yq, F.lane); if (F.lane == 0) ((float*)(F.ws + WS_RSC))[r + q] = yq.sc; }
    }
}
__device__ __forceinline__ void phase_up_dense(LAS unsigned char* lds, int wv, int l) {
    const Fr F = make_frame(lds, wv); unsigned char* ws = F.ws; const int nMact = (l == DEPTH - 1) ? NLAT / 256 : NTOK / 256;
    if ((DENSE_F8_MASK >> (l >> 1)) & 1) {
        SchedUp S{F.bid, F.G, nMact, (const char*)(ws + WS_XN), (const char*)w_dense(ws, l >> 1, W_DGU), (char*)(ws + WS_P), 1, (const float*)(ws + WS_RSC)};
        pg8::EpiSwigluI8<true> E{1.0f / W8_GU};
        pg8::gemm_phase<pg8::EpiSwigluI8<true>, SchedUp, true, true, 2>(lds, F.tid, DM / 2, DM / 2, DM / 2, S, E);
    } else {
        SchedUp S{F.bid, F.G, nMact, (const char*)(ws + WS_XN), (const char*)w_dense(ws, l >> 1, W_DGU), (char*)(ws + WS_P), 2, (const float*)(ws + WS_RSC)};
        pg8::EpiSwigluI8<false> E{1.0f / W8_GU};
        pg8::gemm_phase<pg8::EpiSwigluI8<false>, SchedUp, true, true, 2>(lds, F.tid, DM / 2, DM / 2, DM / 2, S, E);
    }
}
__device__ __forceinline__ void phase_down_dense(LAS unsigned char* lds, int wv, int l) {
    const Fr F = make_frame(lds, wv); unsigned char* ws = F.ws; const int nMact = (l == DEPTH - 1) ? NLAT / 256 : NTOK / 256;
    pg8::EpiResid E{};
    if ((DENSE_F8_MASK >> (l >> 1)) & 1) {
        SchedResid S{F.bid, F.G, nMact, DFF / 2, (const char*)(ws + WS_P), (const char*)w_dense(ws, l >> 1, W_DD), (char*)(ws + WS_XS), (const char*)(ws + WS_MODV + (size_t)l * 9 * 6144 * 4), 5120, nullptr, nullptr};
        pg8::gemm_phase<pg8::EpiResid, SchedResid, true, true, true>(lds, F.tid, DFF / 2, DFF / 2, DFF / 2, S, E, 119);
    } else {
        SchedResid S{F.bid, F.G, nMact, DFF, (const char*)(ws + WS_P), (const char*)w_dense(ws, l >> 1, W_DD), (char*)(ws + WS_XS), (const char*)(ws + WS_MODV + (size_t)l * 9 * 6144 * 4), 5120, nullptr, nullptr};
        pg8::gemm_phase<pg8::EpiResid, SchedResid, true, true>(lds, F.tid, DFF, DFF, DFF, S, E);
    }
    if (nMact == NTOK / 256 && F.bid >= 32) {
        int s, e; bg_window(2, l, s, e);
        if (e > s) convert_range(lds, F, s, e, (F.bid - 32) * 8 + F.wave, 224 * 8);
    }
}
__device__ __forceinline__ void phase_norm2_moe(LAS unsigned char* lds, int wv, int l) {
    const Fr F = make_frame(lds, wv); const int nrows = (l == DEPTH - 1) ? NLAT : NTOK; const int mi = l >> 1;
    volatile LAS unsigned* LCTL = (volatile LAS unsigned*)(lds + LDS_CTLOFF);
    const bf16_t* xs = (const bf16_t*)(F.ws + WS_XS); bf16_t* xn = (bf16_t*)(F.ws + WS_XN); const float* modv = (const float*)(F.ws + WS_MODV) + (size_t)l * 9 * 6144;
    const float* n2g = ARGP(lds, I_N2G) + l * DM;
    int* toklist = (int*)(F.ws + WS_MOE); int* rec = toklist + 8 * NTOK;
    const int rpb = nrows / F.G;
    const int tid = F.tid, lane = F.lane;
    LAS int* lrec = (LAS int*)(lds + 1024);
    const float* rw = ARGP(lds, I_RW) + (size_t)mi * DM * 8;
    for (int rr = F.wave; rr < rpb; rr += 8) {
        const int row = F.bid * rpb + rr;
        const RowV x = load_row_bf16(xs + (size_t)row * DM, lane);
        const float* mv = modv + (size_t)mod_row_of(row) * 6144;
        const RowV y = adaln_row(x, n2g, mv + 3072, mv + 4096, lane);
        float lg[8];
#pragma unroll
        for (int e = 0; e < 8; ++e) lg[e] = 0.f;
#pragma unroll
        for (int j = 0; j < 4; ++j)
#pragma unroll
            for (int cc = 0; cc < 4; ++cc) { const float* wp = rw + (size_t)(256 * j + 4 * lane + cc) * 8; const f32x4 w0 = *(const f32x4*)wp, w1 = *(const f32x4*)(wp + 4); const float hv = y.v[j][cc];
                lg[0] += hv * w0[0]; lg[1] += hv * w0[1]; lg[2] += hv * w0[2]; lg[3] += hv * w0[3]; lg[4] += hv * w1[0]; lg[5] += hv * w1[1]; lg[6] += hv * w1[2]; lg[7] += hv * w1[3]; }
#pragma unroll
        for (int e = 0; e < 8; ++e) lg[e] = wave_sum(lg[e]);
        int i0 = 0; float v0 = lg[0];
#pragma unroll
        for (int e = 1; e < 8; ++e) if (lg[e] > v0) { v0 = lg[e]; i0 = e; }
        int i1 = -1; float v1 = -3.0e38f;
#pragma unroll
        for (int e = 0; e < 8; ++e) if (e != i0 && lg[e] > v1) { v1 = lg[e]; i1 = e; }
        if (lane == 0) {
            const float w0 = 1.0f / (1.0f + expf(v1 - v0)), w1 = 1.0f - w0;
            lrec[rr * 6 + 0] = i0; lrec[rr * 6 + 2] = __float_as_int(w0); lrec[rr * 6 + 3] = i1; lrec[rr * 6 + 5] = __float_as_int(w1);
        }
    }
    __syncthreads();
    { const int e = F.wave; int cnt = 0;
      for (int a0 = 0; a0 < 2 * rpb; a0 += 64) { const int a = a0 + lane; const bool valid = a < 2 * rpb; const int rr = a >> 1, k3 = 3 * (a & 1);
          const bool match = valid && lrec[rr * 6 + k3] == e;
          const unsigned long long bal = __ballot(match);
          if (match) lrec[rr * 6 + k3 + 1] = cnt + (int)__popcll(bal & ((1ull << lane) - 1ull));
          cnt += (int)__popcll(bal); }
      if (lane == 0) { toklist[F.bid * 8 + e] = cnt;
          (void)xb_add(F.ctl + CW_CNT + 64 * (8 * mi + e), (unsigned)cnt); } }
    __syncthreads();
    for (int rr = tid; rr < rpb; rr += 512) {
        const int row = F.bid * rpb + rr;
        int* rc = rec + (size_t)row * 8;
        rc[0] = lrec[rr * 6 + 0]; rc[1] = lrec[rr * 6 + 1]; rc[2] = lrec[rr * 6 + 2]; rc[3] = lrec[rr * 6 + 3]; rc[4] = lrec[rr * 6 + 4]; rc[5] = lrec[rr * 6 + 5];
    }
}
__device__ __forceinline__ void phase_moe_gather(LAS unsigned char* lds, int wv, int l) {
    const Fr F = make_frame(lds, wv); const int mi = l >> 1; const int nrows = (l == DEPTH - 1) ? NLAT : NTOK; const int rpb = nrows / F.G;
    volatile LAS unsigned* LCTL = (volatile LAS unsigned*)(lds + LDS_CTLOFF);
    const MoeTiles mt = moe_tiles(F.ctl, mi);
    const GAS bf16_t* xn = (const GAS bf16_t*)(F.ws + WS_XN); GAS bf16_t* hs = (GAS bf16_t*)(F.ws + WS_HY);
    const GAS int* blkcnt = (const GAS int*)(F.ws + WS_MOE); GAS int* rec = (GAS int*)(F.ws + WS_MOE) + 8 * NTOK;
    LAS int* red = (LAS int*)(lds + 1024);
    { const int e = F.tid & 7, ch = F.tid >> 3; int s = 0;
#pragma unroll
      for (int j = 0; j < 4; ++j) { const int bb = ch * 4 + j; if (bb < F.bid) s += blkcnt[bb * 8 + e]; }
      red[e * 64 + ch] = s; }
    __syncthreads();
    if (F.tid < 8) { int s = 0; for (int ch = 0; ch < 64; ++ch) s += red[F.tid * 64 + ch]; LCTL[16 + F.tid] = (unsigned)s; }
    __syncthreads();
    LAS int* sl = (LAS int*)(lds + 4096);
    for (int rr = F.tid; rr < rpb; rr += 512) {
        GAS int* rc = rec + (size_t)(F.bid * rpb + rr) * 8;
        const int e0 = rc[0], e1 = rc[3];
        const int p0 = rc[1] + (int)LCTL[16 + e0], p1 = rc[4] + (int)LCTL[16 + e1];
        int t0 = 0, t1 = 0;
#pragma unroll
        for (int k = 0; k < 8; ++k) { t0 = (e0 == k) ? mt.tb[k] : t0; t1 = (e1 == k) ? mt.tb[k] : t1; }
        sl[rr * 2] = t0 * 256 + p0; sl[rr * 2 + 1] = t1 * 256 + p1;
        rc[1] = p0; rc[4] = p1;
    }
    __syncthreads();
    const bf16_t* xs = (const bf16_t*)(F.ws + WS_XS); const float* modv = (const float*)(F.ws + WS_MODV) + (size_t)l * 9 * 6144; const float* n2g = ARGP(lds, I_N2G) + l * DM;
    AdaCoef co; co.mr = -1;
    for (int r0 = F.wave * (rpb >> 3); r0 < (F.wave + 1) * (rpb >> 3); r0 += 3) {
        RowV x[3]; int s[3][2];
#pragma unroll
        for (int q = 0; q < 3; ++q) { const int rr = r0 + q; const bool ok = rr < (F.wave + 1) * (rpb >> 3);
            x[q] = load_row_bf16(xs + (size_t)(F.bid * rpb + (ok ? rr : r0)) * DM, F.lane);
            s[q][0] = ok ? sl[rr * 2] : -1; s[q][1] = ok ? sl[rr * 2 + 1] : -1; }
#pragma unroll
        for (int q = 0; q < 3; ++q) if (s[q][0] >= 0) { const int row = F.bid * rpb + r0 + q;
            ada_coef_update(co, row, n2g, modv, 3072, 4096, F.lane);
            const RowV y = adaln_apply(x[q], co);
            const RowQ yq = quant_row_i8(y);
            store_rowq((unsigned char*)hs + (size_t)s[q][0] * DM, yq, F.lane); store_rowq((unsigned char*)hs + (size_t)s[q][1] * DM, yq, F.lane);
            if (F.lane == 0) { float* ssc = (float*)(F.ws + WS_SSC); ssc[s[q][0]] = yq.sc; ssc[s[q][1]] = yq.sc; } }
    }
    for (int idx = F.gw; idx < 8 * 256; idx += F.NGW) { const int e = idx >> 8, j = idx & 255;
        const int cnt = __builtin_amdgcn_readfirstlane((int)__hip_atomic_load(F.ctl + CW_CNT + 64 * (8 * mi + e), __ATOMIC_RELAXED, __HIP_MEMORY_SCOPE_AGENT));
        const int pad = ((cnt + 255) & ~255) - cnt; int tbe = 0;
#pragma unroll
        for (int k = 0; k < 8; ++k) tbe = (e == k) ? mt.tb[k] : tbe;
        if (j < pad) { unsigned z = 0u; asm volatile("" : "+v"(z));
            GAS u32x4* dp = (GAS u32x4*)((GAS unsigned char*)hs + (size_t)(tbe * 256 + cnt + j) * DM) + F.lane; dp[0] = (u32x4){z, z, z, z}; if (F.lane == 0) ((GAS float*)(F.ws + WS_SSC))[tbe * 256 + cnt + j] = __uint_as_float(z); } }
}
__device__ __forceinline__ void phase_up_moe(LAS unsigned char* lds, int wv, int l) {
    const Fr F = make_frame(lds, wv); unsigned char* ws = F.ws; const int mi = l >> 1;
    const MoeTiles mt = moe_tiles(F.ctl, mi);
    SchedMoe S{F.bid, F.G, 28, DM / 2, mt.tb[8], mt, (const char*)(ws + WS_HY), (const char*)w_moe(ws, mi, 0, 0), W_MGU, (char*)(ws + WS_P), DFE, 128, 1, (const float*)(ws + WS_SSC)};
    pg8::EpiSwigluI8<true> E{1.0f / W8_GU};
    pg8::gemm_phase<pg8::EpiSwigluI8<true>, SchedMoe, true, true, 2>(lds, F.tid, DM / 2, DM / 2, DM / 2, S, E);
}
__device__ __forceinline__ void phase_down_moe(LAS unsigned char* lds, int wv, int l) {
    const Fr F = make_frame(lds, wv); unsigned char* ws = F.ws; const int mi = l >> 1;
    const MoeTiles mt = moe_tiles(F.ctl, mi);
    const int RT = mt.tb[8], RF = RT < MOE_RF ? RT : MOE_RF;
    pg8::EpiStore E{1.0f};
    { SchedMoe S{F.bid, F.G, 4, DFE / 2, RF, mt, (const char*)(ws + WS_P), (const char*)w_moe(ws, mi, 0, 0), W_MD, (char*)(ws + WS_HY), DM, 256, 2};
      pg8::gemm_phase<pg8::EpiStore, SchedMoe, true, true, true>(lds, F.tid, DFE / 2, DFE / 2, DFE / 2, S, E, 119); }
    if (RT > RF) {
        SchedMoeSplit S2{F.bid, F.G, RF, RT, mt, (const char*)(ws + WS_P), (const char*)w_moe(ws, mi, 0, 0), (char*)(ws + WS_HY), (char*)(ws + WS_Y1)};
        pg8::gemm_phase<pg8::EpiStore, SchedMoeSplit, true, true, true>(lds, F.tid, DFE / 4, DFE / 2, DFE / 2, S2, E, 119);
    }
}
__device__ __forceinline__ void phase_next_norm(LAS unsigned char* lds, int wv, int l) {
    const Fr F = make_frame(lds, wv); const bool lastl = l == DEPTH - 1; const int nrows = lastl ? NLAT : NTOK; const int mi = l >> 1;
    const bool moe = (l & 1) != 0;
    MoeTiles mt; if (moe) mt = moe_tiles(F.ctl, mi); else {
#pragma unroll
        for (int k = 0; k < 9; ++k) mt.tb[k] = 0; }
    bf16_t* xs = (bf16_t*)(F.ws + WS_XS); bf16_t* xn = (bf16_t*)(F.ws + WS_XN);
    const bf16_t* yb = (const bf16_t*)(F.ws + WS_HY); const bf16_t* yb1 = (const bf16_t*)(F.ws + WS_Y1); const int* rec = (const int*)(F.ws + WS_MOE) + 8 * NTOK;
    const float* modv = (const float*)(F.ws + WS_MODV) + (size_t)l * 9 * 6144;
    const float* modn = modv + 9 * 6144;
    const float* n1g = ARGP(lds, I_N1G) + (lastl ? 0 : (l + 1) * DM); const float* fg = ARGP(lds, I_FINALG); float* outp = (float*)ARGP(lds, 23);
    const int lane = F.lane;
    for (int row = F.gw; row < nrows; row += F.NGW) {
        RowV x = load_row_bf16(xs + (size_t)row * DM, lane);
        if (moe) {
            const int* rc = rec + (size_t)row * 8;
            const int e0 = rc[0], p0 = rc[1], e1 = rc[3], p1 = rc[4]; const float w0 = __int_as_float(rc[2]), w1 = __int_as_float(rc[5]);
            int t0 = 0, t1 = 0;
#pragma unroll
            for (int k = 0; k < 8; ++k) { t0 = (e0 == k) ? mt.tb[k] : t0; t1 = (e1 == k) ? mt.tb[k] : t1; }
            RowV y0 = load_row_bf16(yb + (size_t)(t0 * 256 + p0) * DM, lane), y1 = load_row_bf16(yb + (size_t)(t1 * 256 + p1) * DM, lane);
            { const int rt0 = t0 + (p0 >> 8), rt1 = t1 + (p1 >> 8);
              if (rt0 >= MOE_RF) { const RowV z = load_row_bf16(yb1 + (size_t)((rt0 - MOE_RF) * 256 + (p0 & 255)) * DM, lane);
#pragma unroll
                  for (int j = 0; j < 4; ++j) y0.v[j] += z.v[j]; }
              if (rt1 >= MOE_RF) { const RowV z = load_row_bf16(yb1 + (size_t)((rt1 - MOE_RF) * 256 + (p1 & 255)) * DM, lane);
#pragma unroll
                  for (int j = 0; j < 4; ++j) y1.v[j] += z.v[j]; } }
            const RowV g2 = load_row_f32(modv + (size_t)mod_row_of(row) * 6144 + 5120, lane);
#pragma unroll
            for (int j = 0; j < 4; ++j) x.v[j] += g2.v[j] * (w0 * y0.v[j] + w1 * y1.v[j]);
            if (!lastl) store_row_bf16(xs + (size_t)row * DM, x, lane);
        }
        if (!lastl) {
            const float* mv = modn + (size_t)mod_row_of(row) * 6144;
            const RowV y = adaln_row(x, n1g, mv, mv + 1024, lane);
            const RowQ yq = quant_row_i8(y);
            store_rowq(F.ws + WS_XN8 + (size_t)row * DM, yq, lane); if (lane == 0) ((float*)(F.ws + WS_RSC1))[row] = yq.sc;
        } else {
            float ss = 0.f;
#pragma unroll
            for (int j = 0; j < 4; ++j) ss += (x.v[j][0] * x.v[j][0] + x.v[j][1] * x.v[j][1]) + (x.v[j][2] * x.v[j][2] + x.v[j][3] * x.v[j][3]);
            const float rstd = 1.0f / sqrtf(wave_sum(ss) * (1.0f / DM) + 1e-6f);
            const RowV gv = load_row_f32(fg, lane);
            RowV y;
#pragma unroll
            for (int j = 0; j < 4; ++j) y.v[j] = x.v[j] * rstd * gv.v[j];
            store_row_f32(outp + (size_t)row * DM, y, lane);
        }
    }
}

__global__ void __launch_bounds__(512, 2) mega_fwd(Args a) {
    extern __shared__ __attribute__((aligned(16))) unsigned char lds_raw[];
    LAS unsigned char* lds = (LAS unsigned char*)lds_raw;
    volatile LAS unsigned* LCTL = (volatile LAS unsigned*)(lds + LDS_CTLOFF);
    const int wv = __builtin_amdgcn_readfirstlane((int)(threadIdx.x >> 6));
    {
        const int tid = threadIdx.x;
        for (int u = tid; u < 64; u += 512) LCTL[u] = 0u;
        if (tid == 0) { LAS unsigned long long* ap = (LAS unsigned long long*)(lds + LDS_ARGOFF);
#pragma unroll
            for (int i = 0; i < 23; ++i) ap[i] = (unsigned long long)a.in[i];
            ap[23] = (unsigned long long)a.out; ap[24] = (unsigned long long)a.ws; }
        __syncthreads();
    }
    (void)xcd_barrier_post((unsigned*)(a.ws + WS_CTL) + CW_BAR, LCTL);
    phase_prologue(lds, wv);
    grid_barrier(lds, wv);
#if DUP_PRO
    phase_prologue(lds, wv);
    grid_barrier(lds, wv);
#endif
    phase_first_norm(lds, wv);
    grid_barrier(lds, wv);
    for (int l = 0; l < DEPTH; ++l) {
        phase_inproj(lds, wv, l);  grid_barrier(lds, wv);
#if DUP_INPROJ
        phase_inproj(lds, wv, l);  grid_barrier(lds, wv);
#endif
        phase_post(lds, wv, l);    grid_barrier(lds, wv);
        phase_mix(lds, wv, l, 0);  grid_barrier(lds, wv);
#if DUP_MIX
        phase_mix(lds, wv, l, 1);  grid_barrier(lds, wv);
#endif
        phase_branch(lds, wv, l);  grid_barrier(lds, wv);
#if DUP_BRANCH
        phase_branch(lds, wv, l);  grid_barrier(lds, wv);
#endif
        phase_out(lds, wv, l);     grid_barrier(lds, wv);
        if ((l & 1) == 0) {
            phase_norm2_dense(lds, wv, l); grid_barrier(lds, wv);
#if DUP_N2D
            phase_norm2_dense(lds, wv, l); grid_barrier(lds, wv);
#endif
            phase_up_dense(lds, wv, l);    grid_barrier(lds, wv);
#if DUP_UPD
            phase_up_dense(lds, wv, l);    grid_barrier(lds, wv);
#endif
            phase_down_dense(lds, wv, l);  grid_barrier(lds, wv);
        } else {
            phase_norm2_moe(lds, wv, l);   grid_barrier(lds, wv);
            phase_moe_gather(lds, wv, l);  grid_barrier(lds, wv);
#if DUP_GATH
            phase_moe_gather(lds, wv, l);  grid_barrier(lds, wv);
#endif
            phase_up_moe(lds, wv, l);      grid_barrier(lds, wv);
#if DUP_MOEG == 1
            phase_up_moe(lds, wv, l);      grid_barrier(lds, wv);
#endif
            phase_down_moe(lds, wv, l);    grid_barrier(lds, wv);
#if DUP_MOEG == 2
            phase_down_moe(lds, wv, l);    grid_barrier(lds, wv);
#endif
        }
        phase_next_norm(lds, wv, l);
        if (l != DEPTH - 1) grid_barrier(lds, wv);
    }
}

extern "C" void kernel_launch(void* const* d_in, const int* in_sizes, int n_in, void* d_out, int out_size, void* d_ws, size_t ws_size, hipStream_t stream) {
    static int grid = 0;
    if (grid == 0) {
        if (n_in != 23 || out_size != NLAT * DM || ws_size < WS_END) { fprintf(stderr, "kernel_launch: unexpected problem (n_in %d out %d ws %zu need %zu)\n", n_in, out_size, ws_size, (size_t)WS_END); grid = -1; return; }
        int dev = 0, cus = 0, per_cu = 0;
        if (hipGetDevice(&dev) != hipSuccess || hipDeviceGetAttribute(&cus, hipDeviceAttributeMultiprocessorCount, dev) != hipSuccess) { grid = -1; return; }
        if (hipFuncSetAttribute((const void*)mega_fwd, hipFuncAttributeMaxDynamicSharedMemorySize, LDS_BYTES) != hipSuccess) { fprintf(stderr, "kernel_launch: hipFuncSetAttribute failed\n"); grid = -1; return; }
        if (hipOccupancyMaxActiveBlocksPerMultiprocessor(&per_cu, (const void*)mega_fwd, 512, LDS_BYTES) != hipSuccess || per_cu < 1) { fprintf(stderr, "kernel_launch: occupancy query says %d\n", per_cu); }
        (void)hipGetLastError();
        grid = cus;
        if (grid != 256) fprintf(stderr, "kernel_launch: %d CUs (built for 256)\n", grid);
    }
    if (grid < 0) return;
    (void)hipMemsetAsync((char*)d_ws + WS_CTL, 0, CTL_ZERO_BYTES, stream);
    Args a{};
    for (int i = 0; i < 23; ++i) a.in[i] = (const float*)d_in[i];
    a.out = (float*)d_out; a.ws = (unsigned char*)d_ws;
    hipLaunchKernelGGL(mega_fwd, dim3(grid), dim3(512), LDS_BYTES, stream, a);
}
```
